# Optimizing an MI355X kernel written in HIP

```python
import math
import jax
import jax.numpy as jnp
from jax import lax
import numpy as np

D_MODEL = 1024
BATCH = 16
SEQ = 2048
DEPTH = 2

GRID_W = 64
CTX_LEN = 256

D_HY = 512
HY_ORDER = 2
HY_SHORT = 3
HY_BANDS = 16
HY_EMB = 1 + 2 * HY_BANDS
HY_HID = 64
HY_COLS = (HY_ORDER + 1) * D_HY
HY_FILT_COLS = HY_ORDER * 2 * D_HY
HY_DECAY_MIN = math.log(1e2) / 1.5
HY_DECAY_MAX = math.log(1e2) / 0.3

D_CF = 512
CF_KERNEL = 31
CF_COLS = 2 * D_CF

D_S5 = 512
S5_GROUP = 16
S5_GROUPS = D_S5 // S5_GROUP
S5_STATE = 64
S5_MAX_RE = -1e-4

N_BRANCH = 3
CF_OFF = HY_COLS
S5_OFF = CF_OFF + CF_COLS
GATE_OFF = S5_OFF + D_S5
IN_COLS = GATE_OFF + N_BRANCH * D_MODEL

D_FF = 2816
N_EXPERTS = 8
TOP_K = 2
D_EXPERT = 3584
N_DENSE = (DEPTH + 1) // 2
N_MOE = DEPTH // 2

ALPHA = (2.0 * DEPTH) ** 0.25
BETA = (8.0 * DEPTH) ** -0.25
LN_EPS = 1e-5

kernel_name = "hybrid_hyena_conformer_s5_moe_dit"


def layer_norm(x, g=None, b=None):
    xf = x.astype(jnp.float32)
    mu = jnp.mean(xf, axis=-1, keepdims=True)
    var = jnp.mean(jnp.square(xf - mu), axis=-1, keepdims=True)
    y = ((xf - mu) * lax.rsqrt(var + LN_EPS)).astype(x.dtype)
    if g is not None:
        y = y * g + b
    return y


def modulate(x, shift, scale):
    return layer_norm(x) * (1 + scale) + shift


def dwconv(u, w, b):
    pad = (w.shape[0] - 1) // 2
    y = lax.conv_general_dilated(
        u, w[:, None, :].astype(u.dtype), window_strides=(1,), padding=[(pad, pad)],
        dimension_numbers=("NWC", "WIO", "NWC"), feature_group_count=u.shape[-1])
    return y + b


def hyena_filters(L, w1, b1, w2, b2, w3, b3, freq, decay):
    f32 = jnp.float32
    t = jnp.arange(L, dtype=f32)[:, None]
    tn = t / max(L - 1, 1)
    bands = jnp.arange(1, HY_BANDS + 1, dtype=f32)
    ang = t * bands * (2.0 * math.pi / L)
    z = jnp.concatenate([tn, jnp.cos(ang), jnp.sin(ang)], axis=-1)
    freq = freq.astype(f32)
    h = jnp.sin(freq[0] * (z @ w1.astype(f32) + b1.astype(f32)))
    h = jnp.sin(freq[1] * (h @ w2.astype(f32) + b2.astype(f32)))
    h = h @ w3.astype(f32) + b3.astype(f32)
    h = h * jnp.exp(-tn * jnp.abs(decay.astype(f32)))
    return h.reshape(L, HY_ORDER, 2, D_HY)


def two_sided_long_conv(u, h_fwd, h_bwd, bias):
    L = u.shape[1]
    n = 2 * L
    k = jnp.concatenate([h_fwd, jnp.zeros_like(h_fwd[:1]), h_bwd[1:][::-1]], axis=0)
    uf = u.astype(jnp.float32)
    y = jnp.fft.irfft(jnp.fft.rfft(uf, n=n, axis=1) * jnp.fft.rfft(k, n=n, axis=0)[None], n=n, axis=1)[:, :L]
    return (y + uf * bias.astype(jnp.float32)).astype(u.dtype)


def hyena_branch(p, short_w, short_b, f_w1, f_b1, f_w2, f_b2, f_w3, f_b3, freq, decay, bias, w_out):
    L = p.shape[1]
    parts = jnp.split(dwconv(p, short_w, short_b), HY_ORDER + 1, axis=-1)
    filt = hyena_filters(L, f_w1, f_b1, f_w2, f_b2, f_w3, f_b3, freq, decay)
    z = parts[-1]
    for o in range(HY_ORDER):
        z = parts[o] * two_sided_long_conv(z, filt[:, o, 0], filt[:, o, 1], bias[o])
    return z @ w_out


def conformer_branch(p, grid_rows, dw_w, dw_b, ln_g, ln_b, w_out):
    a, g = jnp.split(p, 2, axis=-1)
    u = a * jax.nn.sigmoid(g)
    bsz, L, C = u.shape
    if grid_rows is not None:
        u = dwconv(u.reshape(bsz * grid_rows, GRID_W, C), dw_w, dw_b).reshape(bsz, L, C)
    else:
        u = dwconv(u, dw_w, dw_b)
    u = jax.nn.silu(layer_norm(u, ln_g, ln_b))
    return u @ w_out


def _ssm_combine(left, right):
    a1r, a1i, b1r, b1i = left
    a2r, a2i, b2r, b2i = right
    return (a2r * a1r - a2i * a1i, a2r * a1i + a2i * a1r,
            a2r * b1r - a2i * b1i + b2r, a2r * b1i + a2i * b1r + b2i)


def s5_discretize(a_re, a_im, log_dt, b_re, b_im):
    f32 = jnp.float32
    lam_re = jnp.minimum(a_re.astype(f32), S5_MAX_RE)
    lam_im = a_im.astype(f32)
    dt = jnp.exp(log_dt.astype(f32))[:, None]
    mag = jnp.exp(lam_re * dt)
    ang = lam_im * dt
    abar_re = mag * jnp.cos(ang)
    abar_im = mag * jnp.sin(ang)
    den = lam_re * lam_re + lam_im * lam_im
    q_re = ((abar_re - 1.0) * lam_re + abar_im * lam_im) / den
    q_im = (abar_im * lam_re - (abar_re - 1.0) * lam_im) / den
    br = b_re.astype(f32)
    bi = b_im.astype(f32)
    bb_re = q_re[..., None] * br - q_im[..., None] * bi
    bb_im = q_re[..., None] * bi + q_im[..., None] * br
    return abar_re, abar_im, bb_re, bb_im


def s5_scans(u, a_re, a_im, log_dt, b_re, b_im, c_re, c_im, init, want_final):
    f32 = jnp.float32
    bsz, L, _ = u.shape
    ug = u.astype(f32).reshape(bsz, L, S5_GROUPS, S5_GROUP)
    ys, finals = [], []
    for d, reverse in enumerate((False, True)):
        abr, abi, bbr, bbi = s5_discretize(a_re[d], a_im[d], log_dt[d], b_re[d], b_im[d])
        bur = jnp.einsum("blgc,gpc->blgp", ug, bbr)
        bui = jnp.einsum("blgc,gpc->blgp", ug, bbi)
        if init is not None:
            s0r, s0i = init[d]
            first = L - 1 if reverse else 0
            bur = bur.at[:, first].add(abr * s0r - abi * s0i)
            bui = bui.at[:, first].add(abr * s0i + abi * s0r)
        ar = jnp.broadcast_to(abr, (1, L) + abr.shape)
        ai = jnp.broadcast_to(abi, (1, L) + abi.shape)
        _, _, sr, si = lax.associative_scan(_ssm_combine, (ar, ai, bur, bui), reverse=reverse, axis=1)
        ys.append(jnp.einsum("blgp,gcp->blgc", sr, c_re[d].astype(f32))
                  - jnp.einsum("blgp,gcp->blgc", si, c_im[d].astype(f32)))
        if want_final:
            last = 0 if reverse else L - 1
            finals.append((sr[:, last], si[:, last]))
    y = (ys[0] + ys[1]).reshape(bsz, L, D_S5)
    return y, finals


def s5_branch(p, s5_p, d_skip, w_glu, b_glu, w_out, init, want_final):
    y, finals = s5_scans(p, *s5_p, init, want_final)
    y = y.astype(p.dtype) + d_skip * p
    g = jax.nn.gelu(y)
    y = g * jax.nn.sigmoid(g @ w_glu + b_glu)
    return y @ w_out, finals


def token_mixer(p, grid_rows, hy_p, cf_p, s5_p, s5_out_p, w_o, init, want_final):
    y_hy = hyena_branch(p[..., :CF_OFF], *hy_p)
    y_cf = conformer_branch(p[..., CF_OFF:S5_OFF], grid_rows, *cf_p)
    y_s5, finals = s5_branch(p[..., S5_OFF:GATE_OFF], s5_p, *s5_out_p, init, want_final)
    g_hy, g_cf, g_s5 = jnp.split(jax.nn.sigmoid(p[..., GATE_OFF:]), N_BRANCH, axis=-1)
    return (g_hy * y_hy + g_cf * y_cf + g_s5 * y_s5) @ w_o, finals


def swiglu(h, w1, w3, w2):
    return (jax.nn.silu(h @ w1) * (h @ w3)) @ w2


def moe_swiglu(h, router, w1, w3, w2):
    logits = (h @ router).astype(jnp.float32)
    top_v, top_i = lax.top_k(logits, TOP_K)
    top_w = jax.nn.softmax(top_v, axis=-1)
    comb = jnp.einsum("blk,blke->ble", top_w,
                      jax.nn.one_hot(top_i, N_EXPERTS, dtype=jnp.float32)).astype(h.dtype)
    out = comb[..., 0:1] * swiglu(h, w1[0], w3[0], w2[0])
    for e in range(1, N_EXPERTS):
        out = out + comb[..., e:e + 1] * swiglu(h, w1[e], w3[e], w2[e])
    return out


def channel_mixer(h, layer, ffn_w1, ffn_w3, ffn_w2, moe_router, moe_w1, moe_w3, moe_w2):
    i = layer // 2
    if layer % 2 == 0:
        return swiglu(h, ffn_w1[i], ffn_w3[i], ffn_w2[i])
    return moe_swiglu(h, moe_router[i], moe_w1[i], moe_w3[i], moe_w2[i])


def setup_inputs(seed: int = 0) -> dict:
    key = jax.random.key(seed)
    keys = iter(jax.random.split(key, 64))
    f32 = jnp.float32

    def nrm(shape, scale):
        return jax.random.normal(next(keys), shape, f32) * scale

    def unif(shape, lo, hi):
        return jax.random.uniform(next(keys), shape, f32, lo, hi)

    D = D_MODEL
    G, P, K = S5_GROUPS, S5_STATE, S5_GROUP
    n_idx = jnp.arange(S5_STATE, dtype=f32)
    return {
        "x": nrm((BATCH, SEQ, D), 1.0),
        "c": nrm((BATCH, D), 1.0),
        "ctx": nrm((BATCH, CTX_LEN, D), 1.0),
        "c_ctx": nrm((D,), 1.0),
        "w_mod": nrm((DEPTH, D, 6 * D), 0.5 * D ** -0.5),
        "b_mod": nrm((DEPTH, 6 * D), 0.02),
        "w_in": nrm((DEPTH, D, IN_COLS), D ** -0.5),
        "hy_short_w": nrm((DEPTH, HY_SHORT, HY_COLS), HY_SHORT ** -0.5),
        "hy_short_b": nrm((DEPTH, HY_COLS), 0.02),
        "hy_f_w1": nrm((DEPTH, HY_EMB, HY_HID), HY_EMB ** -0.5),
        "hy_f_b1": nrm((DEPTH, HY_HID), 0.1),
        "hy_f_w2": nrm((DEPTH, HY_HID, HY_HID), HY_HID ** -0.5),
        "hy_f_b2": nrm((DEPTH, HY_HID), 0.1),
        "hy_f_w3": nrm((DEPTH, HY_HID, HY_FILT_COLS), 0.05 * HY_HID ** -0.5),
        "hy_f_b3": nrm((DEPTH, HY_FILT_COLS), 0.01),
        "hy_freq": 1.0 + nrm((DEPTH, 2, HY_HID), 0.01),
        "hy_decay": unif((DEPTH, HY_FILT_COLS), HY_DECAY_MIN, HY_DECAY_MAX),
        "hy_bias": nrm((DEPTH, HY_ORDER, D_HY), 0.5),
        "w_hy_out": nrm((DEPTH, D_HY, D), D_HY ** -0.5),
        "cf_dw_w": nrm((DEPTH, CF_KERNEL, D_CF), CF_KERNEL ** -0.5),
        "cf_dw_b": nrm((DEPTH, D_CF), 0.02),
        "cf_ln_g": 1.0 + nrm((DEPTH, D_CF), 0.02),
        "cf_ln_b": nrm((DEPTH, D_CF), 0.02),
        "w_cf_out": nrm((DEPTH, D_CF, D), D_CF ** -0.5),
        "s5_a_re": -0.5 + nrm((DEPTH, 2, G, P), 0.01),
        "s5_a_im": math.pi * n_idx + nrm((DEPTH, 2, G, P), 0.01),
        "s5_log_dt": unif((DEPTH, 2, G), math.log(1e-3), math.log(1e-1)),
        "s5_b_re": nrm((DEPTH, 2, G, P, K), K ** -0.5),
        "s5_b_im": nrm((DEPTH, 2, G, P, K), K ** -0.5),
        "s5_c_re": nrm((DEPTH, 2, G, K, P), P ** -0.5),
        "s5_c_im": nrm((DEPTH, 2, G, K, P), P ** -0.5),
        "s5_d": nrm((DEPTH, D_S5), 1.0),
        "s5_w_glu": nrm((DEPTH, D_S5, D_S5), D_S5 ** -0.5),
        "s5_b_glu": nrm((DEPTH, D_S5), 0.02),
        "w_s5_out": nrm((DEPTH, D_S5, D), D_S5 ** -0.5),
        "w_o": nrm((DEPTH, D, D), BETA * D ** -0.5),
        "ln1_g": 1.0 + nrm((DEPTH, D), 0.02),
        "ln1_b": nrm((DEPTH, D), 0.02),
        "ln2_g": 1.0 + nrm((DEPTH, D), 0.02),
        "ln2_b": nrm((DEPTH, D), 0.02),
        "ffn_w1": nrm((N_DENSE, D, D_FF), D ** -0.5),
        "ffn_w3": nrm((N_DENSE, D, D_FF), D ** -0.5),
        "ffn_w2": nrm((N_DENSE, D_FF, D), BETA * D_FF ** -0.5),
        "moe_router": nrm((N_MOE, D, N_EXPERTS), D ** -0.5),
        "moe_w1": nrm((N_MOE, N_EXPERTS, D, D_EXPERT), D ** -0.5),
        "moe_w3": nrm((N_MOE, N_EXPERTS, D, D_EXPERT), D ** -0.5),
        "moe_w2": nrm((N_MOE, N_EXPERTS, D_EXPERT, D), BETA * D_EXPERT ** -0.5),
    }


def reference(x, c, ctx, c_ctx, w_mod, b_mod, w_in,
              hy_short_w, hy_short_b, hy_f_w1, hy_f_b1, hy_f_w2, hy_f_b2, hy_f_w3, hy_f_b3,
              hy_freq, hy_decay, hy_bias, w_hy_out,
              cf_dw_w, cf_dw_b, cf_ln_g, cf_ln_b, w_cf_out,
              s5_a_re, s5_a_im, s5_log_dt, s5_b_re, s5_b_im, s5_c_re, s5_c_im,
              s5_d, s5_w_glu, s5_b_glu, w_s5_out,
              w_o, ln1_g, ln1_b, ln2_g, ln2_b,
              ffn_w1, ffn_w3, ffn_w2, moe_router, moe_w1, moe_w3, moe_w2):
    rows = x.shape[1] // GRID_W
    xc = ctx
    silu_c = jax.nn.silu(c)
    silu_cc = jax.nn.silu(c_ctx)
    ffn_p = (ffn_w1, ffn_w3, ffn_w2, moe_router, moe_w1, moe_w3, moe_w2)
    for l in range(DEPTH):
        last = l == DEPTH - 1
        sh1, sc1, g1, sh2, sc2, g2 = [m[:, None, :] for m in
                                      jnp.split(silu_c @ w_mod[l] + b_mod[l], 6, axis=-1)]
        csh1, csc1, cg1, csh2, csc2, cg2 = jnp.split(silu_cc @ w_mod[l] + b_mod[l], 6, axis=-1)
        hy_p = (hy_short_w[l], hy_short_b[l], hy_f_w1[l], hy_f_b1[l], hy_f_w2[l], hy_f_b2[l],
                hy_f_w3[l], hy_f_b3[l], hy_freq[l], hy_decay[l], hy_bias[l], w_hy_out[l])
        cf_p = (cf_dw_w[l], cf_dw_b[l], cf_ln_g[l], cf_ln_b[l], w_cf_out[l])
        s5_p = (s5_a_re[l], s5_a_im[l], s5_log_dt[l], s5_b_re[l], s5_b_im[l], s5_c_re[l], s5_c_im[l])
        s5_out_p = (s5_d[l], s5_w_glu[l], s5_b_glu[l], w_s5_out[l])

        hc = modulate(xc, csh1, csc1)
        if last:
            _, finals = s5_scans(hc @ w_in[l][:, S5_OFF:GATE_OFF], *s5_p, None, True)
        else:
            yc, finals = token_mixer(hc @ w_in[l], None, hy_p, cf_p, s5_p, s5_out_p, w_o[l], None, True)
            xc = layer_norm(ALPHA * xc + cg1 * yc, ln1_g[l], ln1_b[l])
            fc = channel_mixer(modulate(xc, csh2, csc2), l, *ffn_p)
            xc = layer_norm(ALPHA * xc + cg2 * fc, ln2_g[l], ln2_b[l])

        hx = modulate(x, sh1, sc1)
        yx, _ = token_mixer(hx @ w_in[l], rows, hy_p, cf_p, s5_p, s5_out_p, w_o[l], finals, False)
        x = layer_norm(ALPHA * x + g1 * yx, ln1_g[l], ln1_b[l])
        fx = channel_mixer(modulate(x, sh2, sc2), l, *ffn_p)
        x = layer_norm(ALPHA * x + g2 * fx, ln2_g[l], ln2_b[l])
    return x
```

```cpp
#include <hip/hip_runtime.h>
#include <cstdio>
#include <cstdint>

#ifndef DBG_REP
#define DBG_REP 0
#endif
#define NREP(bit) (((DBG_REP >> (bit)) & 1) ? 2 : 1)
#define REPEAT(n, ...) do { __VA_ARGS__; if ((n) == 2) { __VA_ARGS__; } } while (0)
#ifndef DBG_NPH
#define DBG_NPH N_PHASES
#endif
#ifndef MK_PER_PHASE_LAUNCH
#define MK_PER_PHASE_LAUNCH 0
#endif

#define GAS __attribute__((address_space(1)))
#define LAS __attribute__((address_space(3)))
typedef unsigned short bf16;
typedef unsigned v4u __attribute__((ext_vector_type(4)));
typedef unsigned v2u __attribute__((ext_vector_type(2)));
typedef float f32x4 __attribute__((ext_vector_type(4)));
typedef float f32x2 __attribute__((ext_vector_type(2)));
typedef short bf16x8 __attribute__((ext_vector_type(8)));

constexpr int NB = 16, LSEQ = 2048, LCTX = 256, DM = 1024;
constexpr int NX = NB * LSEQ;
constexpr int NCX = NB * LCTX;
constexpr int RT = NX + NCX;
constexpr int INC = 6144, DFF = 2816, DEX = 3584, NEXP = 8;
constexpr float ALPHA_F = 1.41421356237f;
constexpr float LN_EPS = 1e-5f;

enum { I_X = 0, I_C, I_CTX, I_CCTX, I_WMOD, I_BMOD, I_WIN, I_HSW, I_HSB, I_FW1, I_FB1, I_FW2, I_FB2, I_FW3, I_FB3, I_FREQ, I_DECAY, I_HBIAS, I_WHY,
       I_CFW, I_CFB, I_CFG, I_CFLB, I_WCF, I_SARE, I_SAIM, I_SLDT, I_SBRE, I_SBIM, I_SCRE, I_SCIM, I_SD, I_SWGLU, I_SBGLU, I_WS5, I_WO,
       I_LN1G, I_LN1B, I_LN2G, I_LN2B, I_FFW1, I_FFW3, I_FFW2, I_ROUTER, I_MW1, I_MW3, I_MW2, N_IN };

constexpr size_t MiB = 1u << 20;
constexpr size_t WS_CTL = 0, CTL_ZERO_BYTES = 1 * MiB;
constexpr size_t WS_MODS = 1 * MiB;
constexpr size_t WS_S5P = 2 * MiB;
constexpr size_t WS_META = 3 * MiB;
constexpr size_t WS_FILT = 4 * MiB;
constexpr size_t WS_XC = 22 * MiB;
constexpr size_t WS_WIN = 38 * MiB;
constexpr size_t WS_WOUTS = 62 * MiB;
constexpr size_t WS_WGLU = 68 * MiB;
constexpr size_t WS_WO = 69 * MiB;
constexpr size_t WS_W13 = 73 * MiB;
constexpr size_t WS_W2 = 84 * MiB;
constexpr size_t WS_HX = 90 * MiB;
constexpr size_t WS_G = 162 * MiB;
constexpr size_t WS_PHYT = WS_G, WS_YDIR = WS_G + 108 * MiB, WS_UCF = WS_G + 180 * MiB;
constexpr size_t WS_PS5 = 378 * MiB;
constexpr size_t WS_Z2 = 414 * MiB;
constexpr size_t WS_UCF2 = 450 * MiB;
constexpr size_t WS_S5Y = 486 * MiB;
constexpr size_t WS_KRL = 522 * MiB;
constexpr size_t WS_KRC = 586 * MiB;
constexpr size_t WS_END = 594 * MiB;
constexpr size_t WS_SORT = 90 * MiB;
constexpr size_t WS_MOEY = 156 * MiB;
constexpr size_t WS_MW13 = 288 * MiB;
constexpr size_t WS_MW2 = 344 * MiB;
constexpr size_t WS_HID = 372 * MiB;
constexpr size_t HID_BUF = 56 * MiB;
constexpr size_t WS_END2 = 604 * MiB;
static_assert(WS_HID + (size_t)67584 * 3584 <= WS_END2, "moe map");
constexpr size_t META_TOKE = 0, META_TOKW = 256 * 1024, META_POS = 512 * 1024, META_TILE = 768 * 1024;
constexpr int CW_BAR = 4096;
constexpr int CW_CNT = 8192, CW_CUR = 8256;

constexpr int LDS_BYTES = 155648;
constexpr int MISC_OFF = 147456;
constexpr int NWAVES = 8;

typedef __bf16 bf2_t __attribute__((ext_vector_type(2)));
__device__ __forceinline__ unsigned pk2(float lo, float hi) { bf2_t v; v.x = (__bf16)lo; v.y = (__bf16)hi; return __builtin_bit_cast(unsigned, v); }
__device__ __forceinline__ unsigned f2bf(float f) { return (unsigned)__builtin_bit_cast(unsigned short, (__bf16)f); }
__device__ __forceinline__ unsigned pk4_fp8(float a, float b, float c, float d) { int w = 0; w = __builtin_amdgcn_cvt_pk_fp8_f32(a, b, w, false); w = __builtin_amdgcn_cvt_pk_fp8_f32(c, d, w, true); return (unsigned)w; }
__device__ __forceinline__ float bf2f(unsigned short b) { return __builtin_bit_cast(float, ((unsigned)b) << 16); }
__device__ __forceinline__ float bflo(unsigned w) { return __builtin_bit_cast(float, w << 16); }
__device__ __forceinline__ float bfhi(unsigned w) { return __builtin_bit_cast(float, w & 0xffff0000u); }
__device__ __forceinline__ float sigmoidf_(float x) { return __builtin_amdgcn_rcpf(1.0f + __expf(-x)); }
__device__ __forceinline__ float siluf_(float x) { return x * sigmoidf_(x); }
__device__ __forceinline__ float gelu_tanh(float x) { const float y = 0.7978845608028654f * (x + 0.044715f * x * x * x); const float e = __expf(2.0f * y); const float th = 1.0f - 2.0f * __builtin_amdgcn_rcpf(e + 1.0f); return 0.5f * x * (1.0f + th); }
__device__ __forceinline__ float wave_sum(float v) {
    v += __builtin_bit_cast(float, __builtin_amdgcn_mov_dpp(__builtin_bit_cast(int, v), 0xB1, 0xf, 0xf, true));
    v += __builtin_bit_cast(float, __builtin_amdgcn_mov_dpp(__builtin_bit_cast(int, v), 0x4E, 0xf, 0xf, true));
    v += __builtin_bit_cast(float, __builtin_amdgcn_mov_dpp(__builtin_bit_cast(int, v), 0x141, 0xf, 0xf, true));
    v += __builtin_bit_cast(float, __builtin_amdgcn_mov_dpp(__builtin_bit_cast(int, v), 0x140, 0xf, 0xf, true));
    v += __builtin_bit_cast(float, __builtin_amdgcn_ds_swizzle(__builtin_bit_cast(int, v), 0x401F));
    const unsigned u = __builtin_bit_cast(unsigned, v); const auto r = __builtin_amdgcn_permlane32_swap(u, u, false, false);
    return __builtin_bit_cast(float, (unsigned)r[0]) + __builtin_bit_cast(float, (unsigned)r[1]);
}
__device__ __forceinline__ float lane_bcast(float v, int k) { return __builtin_bit_cast(float, __builtin_amdgcn_readlane(__builtin_bit_cast(int, v), k)); }
#define LDS_WAIT() asm volatile("s_waitcnt lgkmcnt(0)" ::: "memory")
#define VM_WAIT() asm volatile("s_waitcnt vmcnt(0)" ::: "memory")

namespace pg8 {
#define PG8_LAS __attribute__((address_space(3)))
constexpr int BM = 256, BK = 64, HALF = 128, HTB = HALF * BK * 2, STAGE_BYTES = 8 * HTB, NXCD = 8, WGM = 8;
__host__ __device__ __forceinline__ int lds_byte(int r, int c) { const int st = (r >> 4) * 2 + (c >> 5), rr = r & 15, cc = c & 31, ob = rr * 64 + cc * 2; return st * 1024 + (ob ^ (((ob >> 9) & 1) << 5)); }
__host__ __device__ __forceinline__ void stage_rc(int b, int& R, int& C) { const int st = b / 1024, sb = b % 1024, swz = sb ^ (((sb >> 9) & 1) << 5); R = (st >> 1) * 16 + swz / 64; C = (st & 1) * 32 + (swz % 64) / 2; }
__host__ __device__ __forceinline__ int perm32(int rho) { const int n = rho >> 4, i = rho & 15; return 8 * (i >> 2) + 4 * n + (i & 3); }

struct Unit { int pm, pn, seg, ex; const char* A; const char* B; };

struct Rect {
    int nM, nN, nwg, G, c;
    __device__ __forceinline__ void init(int nM_, int nN_, int G_, int c_) { nM = nM_; nN = nN_; nwg = nM * nN; G = G_; c = c_; }
    __device__ __forceinline__ bool map(int L, int& pm, int& pn) const {
        if (L >= nwg) return false;
        int wgid = L; { const int q = nwg / NXCD, r = nwg % NXCD, xcd = wgid % NXCD, off = wgid / NXCD; wgid = (xcd < r ? xcd * (q + 1) : r * (q + 1) + (xcd - r) * q) + off; }
        const int nig = WGM * nN, gid = wgid / nig, fm = gid * WGM, gsz = (nM - fm) < WGM ? (nM - fm) : WGM;
        pm = fm + ((wgid % nig) % gsz); pn = (wgid % nig) / gsz; return true;
    }
};

__device__ __forceinline__ unsigned cvt_pk_bf16(float lo, float hi) { return pk2(lo, hi); }

typedef int v8i_t __attribute__((ext_vector_type(8)));
typedef int v4i_t __attribute__((ext_vector_type(4)));
__device__ __forceinline__ v8i_t cat8(const bf16x8 a, const bf16x8 b) { return __builtin_shufflevector(__builtin_bit_cast(v4i_t, a), __builtin_bit_cast(v4i_t, b), 0, 1, 2, 3, 4, 5, 6, 7); }
__device__ __forceinline__ bf16x8 lo8(const v8i_t v) { return __builtin_bit_cast(bf16x8, __builtin_shufflevector(v, v, 0, 1, 2, 3)); }
__device__ __forceinline__ bf16x8 hi8(const v8i_t v) { return __builtin_bit_cast(bf16x8, __builtin_shufflevector(v, v, 4, 5, 6, 7)); }
template <class Epi, class Sched, bool F8 = false, bool ALIGN_EPI = true, bool SP2 = true>
__device__ __forceinline__ void gemm_phase(PG8_LAS unsigned char* lds, const int tid, const int KB, const Sched& S, const Epi& E) {
    const int wid = __builtin_amdgcn_readfirstlane(tid >> 6), lane = tid & 63, wr = wid >> 2, wc = wid & 3, fr = lane & 15, fq = lane >> 4;
    const int nt = KB / (BK * 2);
    unsigned voffA[2], voffB[2];
#pragma unroll
    for (int i = 0; i < 2; ++i) { int R, C; stage_rc(tid * 16 + i * 8192, R, C); const int Rb = Epi::PERM ? ((R & ~31) + perm32(R & 31)) : R;
        voffA[i] = (unsigned)(R * KB + C * 2); voffB[i] = (unsigned)(Rb * KB + C * 2); }
    const size_t kstep = (size_t)(BK * 2);
    const size_t hstep = (size_t)HALF * KB;
    const unsigned ldsw = (unsigned)wid * 1024u;
    const int aoff = lds_byte(wr * 64 + fr, fq * (F8 ? 16 : 8)), boff = lds_byte(wc * 32 + fr, fq * (F8 ? 16 : 8));
    constexpr int KOFF = F8 ? 16 : 1024;
#define PG8_SA(b, h) (((b) * 2 + (h)) * HTB)
#define PG8_SB(b, h) ((4 + (b) * 2 + (h)) * HTB)
#define PG8_STAGE(bufoff, gbase, voff) do { _Pragma("unroll") for (int _i = 0; _i < 2; ++_i) \
        __builtin_amdgcn_global_load_lds((const unsigned*)((const char*)(gbase) + (voff)[_i]), (PG8_LAS unsigned*)(lds + (bufoff) + ldsw + _i * 8192), 16, 0, 0); } while (0)
#define PG8_LDA(dst, b, h) do { _Pragma("unroll") for (int m = 0; m < 4; ++m) dst[m] = cat8(*(const PG8_LAS bf16x8*)(lds + PG8_SA(b, h) + aoff + m * 2048), *(const PG8_LAS bf16x8*)(lds + PG8_SA(b, h) + aoff + m * 2048 + KOFF)); } while (0)
#define PG8_LDB(dst, b, h) do { _Pragma("unroll") for (int n = 0; n < 2; ++n) dst[n] = cat8(*(const PG8_LAS bf16x8*)(lds + PG8_SB(b, h) + boff + n * 2048), *(const PG8_LAS bf16x8*)(lds + PG8_SB(b, h) + boff + n * 2048 + KOFF)); } while (0)
#define PG8_MMA(ai, bj, At, Bt) do { __builtin_amdgcn_s_setprio(1); _Pragma("unroll") for (int m = 0; m < 4; ++m) _Pragma("unroll") for (int n = 0; n < 2; ++n) { \
        if constexpr (F8) asm volatile("v_mfma_scale_f32_16x16x128_f8f6f4 %0, %1, %2, %0, %3, %3 op_sel_hi:[0,0,0]" : "+v"(acc[ai][bj][m][n]) : "v"(Bt[n]), "v"(At[m]), "v"(sc1)); \
        else { acc[ai][bj][m][n] = __builtin_amdgcn_mfma_f32_16x16x32_bf16(lo8(Bt[n]), lo8(At[m]), acc[ai][bj][m][n], 0, 0, 0); \
               acc[ai][bj][m][n] = __builtin_amdgcn_mfma_f32_16x16x32_bf16(hi8(Bt[n]), hi8(At[m]), acc[ai][bj][m][n], 0, 0, 0); } } \
        __builtin_amdgcn_s_setprio(0); } while (0)
#define PG8_WAIT_V(n) asm volatile("s_waitcnt vmcnt(" #n ")" ::: "memory")
#define PG8_WAIT_L(n) asm volatile("s_waitcnt lgkmcnt(" #n ")" ::: "memory")
#define PG8_BAR __builtin_amdgcn_s_barrier()
#define PG8_SCHED __builtin_amdgcn_sched_barrier(0)
    const int sc1 = 0x7f7f7f7f;
    Unit cur, nxt; int ui = 0;
    if (!S.next(0, cur)) return;
    f32x4 acc[2][2][4][2];
#pragma unroll
    for (int a = 0; a < 2; ++a)
#pragma unroll
        for (int b = 0; b < 2; ++b)
#pragma unroll
            for (int m = 0; m < 4; ++m)
#pragma unroll
                for (int n = 0; n < 2; ++n) acc[a][b][m][n] = (f32x4){0.f, 0.f, 0.f, 0.f};
    v8i_t At[4], B0[2], B1[2];
    const char* cA = cur.A; const char* cB = cur.B;
    if constexpr (SP2) {
        PG8_STAGE(PG8_SB(0, 0), cB, voffB); PG8_STAGE(PG8_SB(0, 1), cB + hstep, voffB); PG8_STAGE(PG8_SA(0, 0), cA, voffA); PG8_STAGE(PG8_SA(0, 1), cA + hstep, voffA);
        if (wr == 1) PG8_BAR;
        PG8_WAIT_V(2); PG8_BAR;
        PG8_STAGE(PG8_SB(1, 0), cB + kstep, voffB); PG8_STAGE(PG8_SA(1, 0), cA + kstep, voffA); PG8_STAGE(PG8_SB(1, 1), cB + hstep + kstep, voffB);
        PG8_WAIT_V(6); PG8_BAR;
    } else {
        PG8_STAGE(PG8_SB(0, 0), cB, voffB); PG8_STAGE(PG8_SA(0, 0), cA, voffA); PG8_STAGE(PG8_SB(0, 1), cB + hstep, voffB); PG8_STAGE(PG8_SA(0, 1), cA + hstep, voffA);
        if (wr == 1) PG8_BAR;
        PG8_WAIT_V(4); PG8_BAR;
        PG8_STAGE(PG8_SB(1, 0), cB + kstep, voffB); PG8_STAGE(PG8_SA(1, 0), cA + kstep, voffA); PG8_STAGE(PG8_SB(1, 1), cB + hstep + kstep, voffB);
        PG8_WAIT_V(6); PG8_BAR;
    }
    for (;;) {
        const bool has_next = S.next(ui + 1, nxt);
        const char* nA = has_next ? nxt.A : cA; const char* nB = has_next ? nxt.B : cB;
#pragma unroll 1
        for (int t = 0; t < nt; t += 2) {
            const bool last = (t == nt - 2);
            const char* a1 = cA + (size_t)(t + 1) * kstep;
            const char* a2 = last ? nA : cA + (size_t)(t + 2) * kstep; const char* b2 = last ? nB : cB + (size_t)(t + 2) * kstep;
            const char* a3 = a2 + kstep; const char* b3 = b2 + kstep;
            if constexpr (SP2) {
            PG8_LDB(B0, 0, 0); PG8_LDB(B1, 0, 1); PG8_SCHED; PG8_LDA(At, 0, 0); PG8_STAGE(PG8_SA(1, 1), a1 + hstep, voffA);
            PG8_WAIT_V(8); PG8_WAIT_L(0); PG8_BAR; PG8_MMA(0, 0, At, B0); PG8_MMA(0, 1, At, B1); PG8_BAR; PG8_SCHED;
            PG8_LDA(At, 0, 1); PG8_STAGE(PG8_SB(0, 0), b2, voffB); PG8_STAGE(PG8_SB(0, 1), b2 + hstep, voffB); PG8_STAGE(PG8_SA(0, 0), a2, voffA);
            PG8_WAIT_V(8); PG8_WAIT_L(0); PG8_BAR; PG8_MMA(1, 0, At, B0); PG8_MMA(1, 1, At, B1); PG8_BAR; PG8_SCHED;
            PG8_LDB(B0, 1, 0); PG8_LDB(B1, 1, 1); PG8_SCHED; PG8_LDA(At, 1, 0); PG8_STAGE(PG8_SA(0, 1), a2 + hstep, voffA);
            PG8_WAIT_V(8); PG8_WAIT_L(0); PG8_BAR; PG8_MMA(0, 0, At, B0); PG8_MMA(0, 1, At, B1); PG8_BAR; PG8_SCHED;
            PG8_LDA(At, 1, 1); PG8_STAGE(PG8_SB(1, 0), b3, voffB); PG8_STAGE(PG8_SB(1, 1), b3 + hstep, voffB); PG8_STAGE(PG8_SA(1, 0), a3, voffA);
            PG8_WAIT_V(8); PG8_WAIT_L(0); PG8_BAR; PG8_MMA(1, 0, At, B0); PG8_MMA(1, 1, At, B1); PG8_BAR; PG8_SCHED;
            } else {
            PG8_LDB(B0, 0, 0); PG8_SCHED; PG8_LDA(At, 0, 0); PG8_STAGE(PG8_SA(1, 1), a1 + hstep, voffA);
            PG8_WAIT_L(8); PG8_BAR; PG8_WAIT_L(0); PG8_MMA(0, 0, At, B0); PG8_BAR; PG8_SCHED;
            PG8_LDB(B1, 0, 1); PG8_STAGE(PG8_SB(0, 0), b2, voffB);
            PG8_BAR; PG8_WAIT_L(0); PG8_MMA(0, 1, At, B1); PG8_BAR;
            PG8_LDA(At, 0, 1); PG8_STAGE(PG8_SA(0, 0), a2, voffA);
            PG8_BAR; PG8_WAIT_L(0); PG8_MMA(1, 0, At, B0); PG8_BAR; PG8_SCHED;
            PG8_STAGE(PG8_SB(0, 1), b2 + hstep, voffB);
            PG8_WAIT_V(6); PG8_BAR; PG8_MMA(1, 1, At, B1); PG8_BAR;
            PG8_LDB(B0, 1, 0); PG8_SCHED; PG8_LDA(At, 1, 0); PG8_STAGE(PG8_SA(0, 1), a2 + hstep, voffA);
            PG8_WAIT_L(8); PG8_BAR; PG8_WAIT_L(0); PG8_MMA(0, 0, At, B0); PG8_BAR; PG8_SCHED;
            PG8_LDB(B1, 1, 1); PG8_STAGE(PG8_SB(1, 0), b3, voffB);
            PG8_BAR; PG8_WAIT_L(0); PG8_MMA(0, 1, At, B1); PG8_BAR;
            PG8_LDA(At, 1, 1); PG8_STAGE(PG8_SA(1, 0), a3, voffA);
            PG8_BAR; PG8_WAIT_L(0); PG8_MMA(1, 0, At, B0); PG8_BAR; PG8_SCHED;
            PG8_STAGE(PG8_SB(1, 1), b3 + hstep, voffB);
            PG8_WAIT_V(6); PG8_BAR; PG8_MMA(1, 1, At, B1); PG8_BAR;
            }
        }
        if constexpr (F8) asm volatile("s_nop 15\n\ts_nop 15" ::: "memory");
        if constexpr (ALIGN_EPI) { if (wr == 0) PG8_BAR; }
        E(acc, cur, wr, wc, fr, fq);
        if (!has_next) break;
#pragma unroll
        for (int a = 0; a < 2; ++a)
#pragma unroll
            for (int b = 0; b < 2; ++b)
#pragma unroll
                for (int m = 0; m < 4; ++m)
#pragma unroll
                    for (int n = 0; n < 2; ++n) acc[a][b][m][n] = (f32x4){0.f, 0.f, 0.f, 0.f};
        cur = nxt; cA = nA; cB = nB; ++ui;
        if constexpr (ALIGN_EPI) { if (wr == 1) PG8_BAR; }
    }
    PG8_WAIT_V(0);
    if constexpr (!ALIGN_EPI) { if (wr == 0) PG8_BAR; }
    PG8_BAR;
#undef PG8_SA
#undef PG8_SB
#undef PG8_STAGE
#undef PG8_LDA
#undef PG8_LDB
#undef PG8_MMA
#undef PG8_WAIT_V
#undef PG8_WAIT_L
#undef PG8_BAR
#undef PG8_SCHED
}
}
using pg8::Unit;

#define XB_TMO      128
#define XB_XCNT(j)  (256  + 64 * (j))
#define XB_XSUB(j)  (1280 + 64 * (j))
#define XB_XGEN(j)  (2304 + 64 * (j))
#define XB_TOP      3328
#define XB_TOPGEN   3392
#define XCD_BAR_WORDS 3456
#define XB_SPIN_CAP (1u << 18)
__device__ __forceinline__ unsigned xb_ld(unsigned* p)              { return __hip_atomic_load(p, __ATOMIC_RELAXED, __HIP_MEMORY_SCOPE_AGENT); }
__device__ __forceinline__ unsigned xb_add(unsigned* p, unsigned v) { return __hip_atomic_fetch_add(p, v, __ATOMIC_RELAXED, __HIP_MEMORY_SCOPE_AGENT); }
__device__ __forceinline__ unsigned xb_xcc_id() { return (unsigned)__builtin_amdgcn_s_getreg((3 << 11) | 20) & 0xFu; }
#define XB_SPIN(cond, bar) do { unsigned _sp = 0; while (cond) { __builtin_amdgcn_s_sleep(1); \
    if ((++_sp & 255u) == 0u) { if (xb_ld(&(bar)[XB_TMO])) break; if (_sp > XB_SPIN_CAP) { atomicAdd(&(bar)[XB_TMO], 1u); break; } } } } while (0)
struct XcdBarrier { unsigned* bar; unsigned x; volatile LAS unsigned* st; };
__device__ __forceinline__ XcdBarrier xcd_barrier_post(unsigned* bar, volatile LAS unsigned* st) {
    XcdBarrier b; b.bar = bar; b.x = xb_xcc_id(); b.st = st;
    if (threadIdx.x == 0) (void)xb_add(&bar[XB_XCNT(b.x)], 1u);
    return b;
}
__device__ __forceinline__ void xcd_barrier_complete(unsigned* bar, unsigned x, unsigned& nloc, unsigned& nx) {
    const unsigned G = gridDim.x * gridDim.y * gridDim.z;
    unsigned sum, cnt, mine, sp = 0u;
    for (;;) {
        sum = 0u; cnt = 0u; mine = 0u;
#pragma unroll
        for (unsigned j = 0; j < 16; ++j) { const unsigned c = xb_ld(&bar[XB_XCNT(j)]); sum += c; cnt += (c > 0u) ? 1u : 0u; mine = (j == x) ? c : mine; }
        if (sum == G) break;
        __builtin_amdgcn_s_sleep(1);
        if ((++sp & 255u) == 0u) { if (xb_ld(&bar[XB_TMO])) break; if (sp > XB_SPIN_CAP) { atomicAdd(&bar[XB_TMO], 1u); break; } }
    }
    nloc = mine > 0u ? mine : 1u; nx = cnt > 0u ? cnt : 1u;
}
__device__ __forceinline__ void xcd_barrier(const XcdBarrier& b, const int wave_s) {
    asm volatile("s_waitcnt vmcnt(0)" ::: "memory");
    __syncthreads();
    if (wave_s == 0 && __builtin_amdgcn_mbcnt_hi(~0u, __builtin_amdgcn_mbcnt_lo(~0u, 0u)) == 0u) {
        unsigned* bar = b.bar; asm volatile("" : "+v"(bar));
        __builtin_amdgcn_s_waitcnt(0);
        unsigned nloc = b.st[0], nx = b.st[1];
        if (nloc == 0u) { xcd_barrier_complete(bar, b.x, nloc, nx); b.st[0] = nloc; b.st[1] = nx; }
        const unsigned old = xb_add(&bar[XB_XSUB(b.x)], 1u);
        const unsigned gen = old / nloc;
        if (old + 1u == (gen + 1u) * nloc) {
            __builtin_amdgcn_fence(__ATOMIC_RELEASE, "agent");
            asm volatile("s_waitcnt vmcnt(0)" ::: "memory");
            const unsigned og = xb_add(&bar[XB_TOP], 1u);
            const unsigned tg = og / nx;
            if (og + 1u == (tg + 1u) * nx) xb_add(&bar[XB_TOPGEN], 1u);
            else XB_SPIN(xb_ld(&bar[XB_TOPGEN]) == tg, bar);
            __builtin_amdgcn_fence(__ATOMIC_ACQUIRE, "agent");
            xb_add(&bar[XB_XGEN(b.x)], 1u);
            asm volatile("s_waitcnt vmcnt(0)" ::: "memory");
        } else {
            XB_SPIN(xb_ld(&bar[XB_XGEN(b.x)]) == gen, bar);
            __builtin_amdgcn_fence(__ATOMIC_ACQUIRE, "agent");
            asm volatile("s_waitcnt vmcnt(0)" ::: "memory");
        }
    }
    __syncthreads();
}

struct Args { const float* in[N_IN]; float* out; unsigned char* ws; int ph_lo, ph_hi; };

struct Frame {
    LAS unsigned char* lds;
    int tid, lane, wave, vcu, G;
    const float* const* in; float* out; unsigned char* ws;
};

__device__ __forceinline__ const float* inp(const Frame& F, int k) { const float* p = F.in[k]; asm volatile("" : "+s"(p)); return p; }

struct SchedPlain {
    pg8::Rect R; const char* A; const char* B; size_t tsA, tsB; int xM, xN0, xNn;
    __device__ __forceinline__ bool next(int i, Unit& u) const {
        const int L = i * R.G + R.c;
        if (R.map(L, u.pm, u.pn)) {} else { const int e = L - R.nwg; if (e >= xM * xNn) return false; u.pm = R.nM + e / xNn; u.pn = xN0 + e % xNn; }
        u.seg = 0; u.ex = 0; u.A = A + (size_t)u.pm * tsA; u.B = B + (size_t)u.pn * tsB; return true;
    }
};
struct SchedMerge {
    pg8::Rect R; const char* A; const char* B; size_t tsA, tsB, sA, sB;
    __device__ __forceinline__ bool next(int i, Unit& u) const {
        const int ti = i / 3, sg = i - 3 * ti; const int L = ti * R.G + R.c;
        if (!R.map(L, u.pm, u.pn)) return false;
        u.seg = sg; u.ex = 0;
        u.A = A + (size_t)sg * sA + (size_t)u.pm * tsA; u.B = B + (size_t)sg * sB + (size_t)u.pn * tsB; return true;
    }
};
struct SchedMoe {
    pg8::Rect R; const char* A; const char* B; size_t tsA, tsB, esB; const int* tile_e; int tile0; bool a_global;
    __device__ __forceinline__ bool next(int i, Unit& u) const {
        const int L = i * R.G + R.c;
        if (!R.map(L, u.pm, u.pn)) return false;
        const int gt = tile0 + u.pm; u.ex = gt; u.seg = 0; const int e = tile_e[gt];
        u.A = A + (size_t)(a_global ? gt : u.pm) * tsA; u.B = B + (size_t)e * esB + (size_t)u.pn * tsB; return true;
    }
};

typedef const f32x4 (&AccRef)[2][2][4][2];
__device__ __forceinline__ v4u pack8(const f32x4 a, const f32x4 b) { v4u w; w.x = pg8::cvt_pk_bf16(a[0], a[1]); w.y = pg8::cvt_pk_bf16(a[2], a[3]); w.z = pg8::cvt_pk_bf16(b[0], b[1]); w.w = pg8::cvt_pk_bf16(b[2], b[3]); return w; }
__device__ __forceinline__ void unpack8(const v4u w, f32x4& a, f32x4& b) { a = (f32x4){bflo(w.x), bfhi(w.x), bflo(w.y), bfhi(w.y)}; b = (f32x4){bflo(w.z), bfhi(w.z), bflo(w.w), bfhi(w.w)}; }

struct EpiInproj {
    static constexpr bool PERM = true;
    bf16* phyT; bf16* ucf; bf16* ps5;
    __device__ __forceinline__ void operator()(AccRef acc, const Unit& u, int wr, int wc, int fr, int fq) const {
        const int row0 = u.pm * 256 + wr * 64 + fr;
        if (u.pn < 6) {
#pragma unroll
            for (int ai = 0; ai < 2; ++ai)
#pragma unroll
                for (int m = 0; m < 4; ++m) { const int r = row0 + ai * 128 + m * 16;
#pragma unroll
                    for (int bj = 0; bj < 2; ++bj)
#pragma unroll
                        for (int n = 0; n < 2; ++n)
#pragma unroll
                            for (int j = 0; j < 4; ++j) { const int c = u.pn * 256 + bj * 128 + wc * 32 + 8 * fq + 4 * n + j; phyT[(size_t)c * RT + r] = (bf16)f2bf(acc[ai][bj][m][n][j]); } }
        } else if (u.pn < 10) {
            const int col0 = (u.pn - 6) * 128 + wc * 32 + 8 * fq;
#pragma unroll
            for (int ai = 0; ai < 2; ++ai)
#pragma unroll
                for (int m = 0; m < 4; ++m) { const int r = row0 + ai * 128 + m * 16; f32x4 o[2];
#pragma unroll
                    for (int n = 0; n < 2; ++n)
#pragma unroll
                        for (int j = 0; j < 4; ++j) o[n][j] = acc[ai][0][m][n][j] * sigmoidf_(acc[ai][1][m][n][j]);
                    *(v4u*)(ucf + (size_t)r * 512 + col0) = pack8(o[0], o[1]); }
        } else {
#pragma unroll
            for (int ai = 0; ai < 2; ++ai)
#pragma unroll
                for (int m = 0; m < 4; ++m) { const int r = row0 + ai * 128 + m * 16;
#pragma unroll
                    for (int bj = 0; bj < 2; ++bj) { const int col0 = (u.pn - 10) * 256 + bj * 128 + wc * 32 + 8 * fq; *(v4u*)(ps5 + (size_t)r * 512 + col0) = pack8(acc[ai][bj][m][0], acc[ai][bj][m][1]); } }
        }
    }
};
struct EpiGates {
    static constexpr bool PERM = true;
    bf16* O;
    __device__ __forceinline__ void operator()(AccRef acc, const Unit& u, int wr, int wc, int fr, int fq) const {
        const int row0 = u.pm * 256 + wr * 64 + fr;
#pragma unroll
        for (int ai = 0; ai < 2; ++ai)
#pragma unroll
            for (int m = 0; m < 4; ++m) { const int r = row0 + ai * 128 + m * 16;
#pragma unroll
                for (int bj = 0; bj < 2; ++bj) { const int col0 = u.pn * 256 + bj * 128 + wc * 32 + 8 * fq; f32x4 o[2];
#pragma unroll
                    for (int n = 0; n < 2; ++n)
#pragma unroll
                        for (int j = 0; j < 4; ++j) o[n][j] = sigmoidf_(acc[ai][bj][m][n][j]);
                    *(v4u*)(O + (size_t)r * 3072 + col0) = pack8(o[0], o[1]); } }
    }
};
struct EpiGlu {
    static constexpr bool PERM = true;
    const bf16* SG; bf16* O; const float* bglu;
    __device__ __forceinline__ void operator()(AccRef acc, const Unit& u, int wr, int wc, int fr, int fq) const {
        const int row0 = u.pm * 256 + wr * 64 + fr;
#pragma unroll
        for (int bj = 0; bj < 2; ++bj) { const int col0 = u.pn * 256 + bj * 128 + wc * 32 + 8 * fq;
            const f32x4 b0 = *(const f32x4*)(bglu + col0), b1 = *(const f32x4*)(bglu + col0 + 4);
#pragma unroll
            for (int ai = 0; ai < 2; ++ai)
#pragma unroll
                for (int m = 0; m < 4; ++m) { const int r = row0 + ai * 128 + m * 16;
                    const v4u gw = *(const v4u*)(SG + (size_t)r * 512 + col0); f32x4 g0, g1; unpack8(gw, g0, g1); f32x4 o0, o1;
#pragma unroll
                    for (int j = 0; j < 4; ++j) { o0[j] = g0[j] * sigmoidf_(acc[ai][bj][m][0][j] + b0[j]); o1[j] = g1[j] * sigmoidf_(acc[ai][bj][m][1][j] + b1[j]); }
                    *(v4u*)(O + (size_t)r * 512 + col0) = pack8(o0, o1); } }
    }
};
struct EpiMerge {
    static constexpr bool PERM = true;
    const bf16* GT; bf16* O;
    __device__ __forceinline__ void operator()(AccRef acc, const Unit& u, int wr, int wc, int fr, int fq) const {
        const int row0 = u.pm * 256 + wr * 64 + fr;
#pragma unroll
        for (int ai = 0; ai < 2; ++ai)
#pragma unroll
            for (int m = 0; m < 4; ++m) { const int r = row0 + ai * 128 + m * 16;
#pragma unroll
                for (int bj = 0; bj < 2; ++bj) { const int col0 = u.pn * 256 + bj * 128 + wc * 32 + 8 * fq;
                    const v4u gw = *(const v4u*)(GT + (size_t)r * 3072 + u.seg * 1024 + col0); f32x4 g0, g1; unpack8(gw, g0, g1);
                    f32x4 o0 = g0 * acc[ai][bj][m][0], o1 = g1 * acc[ai][bj][m][1];
                    bf16* dst = O + (size_t)r * 1024 + col0;
                    if (u.seg > 0) { const v4u pw = *(const v4u*)dst; f32x4 p0, p1; unpack8(pw, p0, p1); o0 += p0; o1 += p1; }
                    *(v4u*)dst = pack8(o0, o1); } }
    }
};
struct EpiRes {
    static constexpr bool PERM = false;
    const float* xl; const float* xc; float* ol; float* oc; const float* gbase; float sc;
    __device__ __forceinline__ void operator()(AccRef acc, const Unit& u, int wr, int wc, int fr, int fq) const {
        const bool isl = u.pm < (NX / 256);
        const int prow = isl ? u.pm * 256 : (u.pm - NX / 256) * 256; const int mi = isl ? (u.pm >> 3) : 16;
        const float* xs = isl ? xl : xc; float* os = isl ? ol : oc; const float* gv = gbase + (size_t)mi * INC;
        const int row0 = prow + wr * 64 + fr, col0 = u.pn * 256 + wc * 32 + 4 * fq;
#pragma unroll
        for (int bj = 0; bj < 2; ++bj)
#pragma unroll
            for (int n = 0; n < 2; ++n) { const int c = col0 + bj * 128 + n * 16; const f32x4 g = *(const f32x4*)(gv + c) * sc;
#pragma unroll
                for (int ai = 0; ai < 2; ++ai)
#pragma unroll
                    for (int m = 0; m < 4; ++m) { const size_t off = (size_t)(row0 + ai * 128 + m * 16) * 1024 + c;
                        const f32x4 xr = *(const f32x4*)(xs + off); *(f32x4*)(os + off) = xr * ALPHA_F + g * acc[ai][bj][m][n]; } }
    }
};
struct EpiSwiglu {
    static constexpr bool PERM = true;
    bf16* O; int ldc;
    __device__ __forceinline__ void operator()(AccRef acc, const Unit& u, int wr, int wc, int fr, int fq) const {
        const int row0 = u.pm * 256 + wr * 64 + fr, col0 = u.pn * 128 + wc * 32 + 8 * fq;
#pragma unroll
        for (int ai = 0; ai < 2; ++ai)
#pragma unroll
            for (int m = 0; m < 4; ++m) { const int r = row0 + ai * 128 + m * 16; f32x4 o[2];
#pragma unroll
                for (int n = 0; n < 2; ++n)
#pragma unroll
                    for (int j = 0; j < 4; ++j) o[n][j] = siluf_(acc[ai][0][m][n][j]) * acc[ai][1][m][n][j];
                *(v4u*)(O + (size_t)r * ldc + col0) = pack8(o[0], o[1]); }
    }
};
struct EpiSwigluF8 {
    static constexpr bool PERM = true;
    unsigned char* O; int ldc; float sc;
    __device__ __forceinline__ void operator()(AccRef acc, const Unit& u, int wr, int wc, int fr, int fq) const {
        const int row0 = u.pm * 256 + wr * 64 + fr, col0 = u.pn * 128 + wc * 32 + 8 * fq;
#pragma unroll
        for (int ai = 0; ai < 2; ++ai)
#pragma unroll
            for (int m = 0; m < 4; ++m) { const int r = row0 + ai * 128 + m * 16; f32x4 o[2];
#pragma unroll
                for (int n = 0; n < 2; ++n)
#pragma unroll
                    for (int j = 0; j < 4; ++j) o[n][j] = siluf_(acc[ai][0][m][n][j] * sc) * (acc[ai][1][m][n][j] * sc);
                v2u w; w.x = pk4_fp8(o[0][0], o[0][1], o[0][2], o[0][3]); w.y = pk4_fp8(o[1][0], o[1][1], o[1][2], o[1][3]);
                *(v2u*)(O + (size_t)r * ldc + col0) = w; }
    }
};
struct EpiMoeDown {
    static constexpr bool PERM = true;
    bf16* O; float sc;
    __device__ __forceinline__ void operator()(AccRef acc, const Unit& u, int wr, int wc, int fr, int fq) const {
        const int row0 = u.ex * 256 + wr * 64 + fr;
#pragma unroll
        for (int ai = 0; ai < 2; ++ai)
#pragma unroll
            for (int m = 0; m < 4; ++m) { const int r = row0 + ai * 128 + m * 16;
#pragma unroll
                for (int bj = 0; bj < 2; ++bj) { const int col0 = u.pn * 256 + bj * 128 + wc * 32 + 8 * fq; *(v4u*)(O + (size_t)r * 1024 + col0) = pack8(acc[ai][bj][m][0] * sc, acc[ai][bj][m][1] * sc); } }
    }
};

template <bool F8>
__device__ __forceinline__ void transpose_item64(const float* W, int K, int N, unsigned char* WT, int dst_row0, int k0, int n0, float scale, LAS float* scr, int lane) {
#pragma unroll 4
    for (int i = 0; i < 16; ++i) { const int row = 4 * i + (lane >> 4), nc = 4 * (lane & 15);
        const f32x4 v = *(const f32x4*)(W + (size_t)(k0 + row) * N + n0 + nc); *(LAS f32x4*)(scr + row * 68 + nc) = v * scale; }
    LDS_WAIT(); asm volatile("" ::: "memory");
    const LAS float* sp = scr + lane;
    if constexpr (F8) {
        unsigned char* dst = WT + (size_t)(dst_row0 + lane) * K + k0;
#pragma unroll
        for (int c4 = 0; c4 < 4; ++c4) { v4u o;
#pragma unroll
            for (int e = 0; e < 4; ++e) { const int kk = 16 * c4 + 4 * e; o[e] = pk4_fp8(sp[(kk + 0) * 68], sp[(kk + 1) * 68], sp[(kk + 2) * 68], sp[(kk + 3) * 68]); }
            *(v4u*)(dst + 16 * c4) = o; }
    } else {
        unsigned char* dst = WT + ((size_t)(dst_row0 + lane) * K + k0) * 2;
#pragma unroll
        for (int c8 = 0; c8 < 8; ++c8) { v4u o;
#pragma unroll
            for (int e = 0; e < 4; ++e) { const int kk = 8 * c8 + 2 * e; o[e] = pk2(sp[kk * 68], sp[(kk + 1) * 68]); }
            *(v4u*)(dst + 16 * c8) = o; }
    }
    LDS_WAIT(); asm volatile("" ::: "memory");
}
__device__ __forceinline__ int dst_row_map(int kind, int n0) {
    if (kind == 1) { if (n0 >= 1536 && n0 < 2560) { const int i = (n0 - 1536) & 511, hi = (n0 - 1536) >> 9; return 1536 + 256 * (i >> 7) + 128 * hi + (i & 127); } return n0; }
    if (kind == 2) return 256 * (n0 >> 7) + (n0 & 127);
    if (kind == 3) return 256 * (n0 >> 7) + 128 + (n0 & 127);
    return n0;
}
__device__ __forceinline__ void conv_matrix_item(const float* W, int K, int N, bf16* WT, int kind, int item, LAS float* scr, int lane) {
    const int nblk = N / 64, kb = item / nblk, nb = item - kb * nblk;
    transpose_item64<false>(W, K, N, (unsigned char*)WT, dst_row_map(kind, 64 * nb), 64 * kb, 64 * nb, 1.0f, scr, lane);
}
__device__ __forceinline__ void conv_matrix_item_f8(const float* W, int K, int N, unsigned char* WT, int kind, int item, float scale, LAS float* scr, int lane) {
    const int nblk = N / 64, kb = item / nblk, nb = item - kb * nblk;
    transpose_item64<true>(W, K, N, WT, dst_row_map(kind, 64 * nb), 64 * kb, 64 * nb, scale, scr, lane);
}
__device__ __forceinline__ void p0a_prologue(Frame& F) {
    LAS float* scr = (LAS float*)(F.lds + F.wave * 17408);
    const int gw = F.vcu * NWAVES + F.wave, NGW = F.G * NWAVES;
    bf16* ws_win = (bf16*)(F.ws + WS_WIN); bf16* ws_outs = (bf16*)(F.ws + WS_WOUTS); bf16* ws_glu = (bf16*)(F.ws + WS_WGLU); bf16* ws_wo = (bf16*)(F.ws + WS_WO);
    bf16* ws_w13 = (bf16*)(F.ws + WS_W13); bf16* ws_w2 = (bf16*)(F.ws + WS_W2);
    constexpr int I_IN = (1024 / 64) * (6144 / 64), I_OUT = (512 / 64) * (1024 / 64), I_GLU = (512 / 64) * (512 / 64), I_WOI = (1024 / 64) * (1024 / 64), I_F1 = (1024 / 64) * (2816 / 64), I_F2 = (2816 / 64) * (1024 / 64);
    constexpr int NITEMS = 2 * I_IN + 6 * I_OUT + 2 * I_GLU + 2 * I_WOI + 2 * I_F1 + I_F2;
    for (int it = gw; it < NITEMS; it += NGW) {
        int r = it;
        if (r < 2 * I_IN) { const int l = r / I_IN; conv_matrix_item(inp(F, I_WIN) + (size_t)l * 1024 * 6144, 1024, 6144, ws_win + (size_t)l * 6144 * 1024, 1, r - l * I_IN, scr, F.lane); continue; } r -= 2 * I_IN;
        if (r < 6 * I_OUT) { const int q = r / I_OUT, l = q / 3, s = q - 3 * l; const float* src = inp(F, s == 0 ? I_WHY : (s == 1 ? I_WCF : I_WS5)) + (size_t)l * 512 * 1024;
            conv_matrix_item(src, 512, 1024, ws_outs + (size_t)(l * 3 + s) * 1024 * 512, 0, r - q * I_OUT, scr, F.lane); continue; } r -= 6 * I_OUT;
        if (r < 2 * I_GLU) { const int l = r / I_GLU; conv_matrix_item(inp(F, I_SWGLU) + (size_t)l * 512 * 512, 512, 512, ws_glu + (size_t)l * 512 * 512, 0, r - l * I_GLU, scr, F.lane); continue; } r -= 2 * I_GLU;
        if (r < 2 * I_WOI) { const int l = r / I_WOI; conv_matrix_item(inp(F, I_WO) + (size_t)l * 1024 * 1024, 1024, 1024, ws_wo + (size_t)l * 1024 * 1024, 0, r - l * I_WOI, scr, F.lane); continue; } r -= 2 * I_WOI;
        if (r < I_F1) { conv_matrix_item_f8(inp(F, I_FFW1), 1024, 2816, (unsigned char*)ws_w13, 2, r, 32.f, scr, F.lane); continue; } r -= I_F1;
        if (r < I_F1) { conv_matrix_item_f8(inp(F, I_FFW3), 1024, 2816, (unsigned char*)ws_w13, 3, r, 32.f, scr, F.lane); continue; } r -= I_F1;
        conv_matrix_item_f8(inp(F, I_FFW2), 2816, 1024, (unsigned char*)ws_w2, 0, r, 128.f, scr, F.lane);
    }
    __syncthreads();
    float* part = (float*)(F.ws + WS_HX);
    LAS float* sc = (LAS float*)F.lds;
    for (int it = F.vcu; it < 2 * 8 * 12; it += F.G) {
        const int l = it / 96, r = it - l * 96, ks = r / 12, nb = r - ks * 12;
        __syncthreads();
        for (int e = F.tid; e < 17 * 128; e += 512) { const int i = e >> 7, k = e & 127; const float cv = i < 16 ? inp(F, I_C)[i * 1024 + ks * 128 + k] : inp(F, I_CCTX)[ks * 128 + k]; sc[k * 20 + i] = siluf_(cv); }
        __syncthreads();
        const int n = nb * 512 + F.tid; const float* w = inp(F, I_WMOD) + (size_t)l * 1024 * 6144 + (size_t)(ks * 128) * 6144 + n;
        float acc[17];
#pragma unroll
        for (int i = 0; i < 17; ++i) acc[i] = 0.f;
        for (int k = 0; k < 128; ++k) { const float wv = w[(size_t)k * 6144];
#pragma unroll
            for (int i = 0; i < 17; ++i) acc[i] += sc[k * 20 + i] * wv; }
#pragma unroll
        for (int i = 0; i < 17; ++i) part[((size_t)(ks * 2 + l) * 17 + i) * 6144 + n] = acc[i];
    }
}
__device__ __forceinline__ void p0b_mods(Frame& F) {
    const float* part = (const float*)(F.ws + WS_HX); float* mods = (float*)(F.ws + WS_MODS);
    for (int e = F.vcu * 512 + F.tid; e < 2 * 17 * 6144; e += F.G * 512) {
        const int l = e / (17 * 6144), r = e - l * 17 * 6144, i = r / 6144, n = r - i * 6144;
        float s = inp(F, I_BMOD)[l * 6144 + n];
#pragma unroll
        for (int ks = 0; ks < 8; ++ks) s += part[((size_t)(ks * 2 + l) * 17 + i) * 6144 + n];
        mods[e] = s;
    }
}

__device__ __forceinline__ void h2table_phase(Frame& F, int l) {
    const int gw = F.vcu * NWAVES + F.wave, NGW = F.G * NWAVES, lane = F.lane;
    float* H2 = (float*)(F.ws + WS_FILT);
    const float* w1 = inp(F, I_FW1) + l * 33 * 64; const float* b1 = inp(F, I_FB1) + l * 64; const float* w2 = inp(F, I_FW2) + l * 64 * 64; const float* b2 = inp(F, I_FB2) + l * 64;
    const float* fq = inp(F, I_FREQ) + l * 128;
    for (int pos = gw; pos < LSEQ + LCTX; pos += NGW) {
        const bool isc = pos >= LSEQ; const int L = isc ? LCTX : LSEQ; const int t = isc ? pos - LSEQ : pos;
        const float tn = (float)t / (float)(L - 1);
        float z = 0.f;
        if (lane == 0) z = tn;
        else if (lane <= 32) { const int band = lane <= 16 ? lane : lane - 16; const int ph = (t * band) % L; const float ang = 6.283185307179586f * ((float)ph / (float)L); z = lane <= 16 ? cosf(ang) : sinf(ang); }
        float h = b1[lane];
        for (int k = 0; k < 33; ++k) h += lane_bcast(z, k) * w1[k * 64 + lane];
        h = sinf(fq[lane] * h);
        float h2 = b2[lane];
        for (int k = 0; k < 64; ++k) h2 += lane_bcast(h, k) * w2[k * 64 + lane];
        H2[(size_t)pos * 64 + lane] = sinf(fq[64 + lane] * h2);
    }
}
__device__ __forceinline__ void filter_expand_phase(Frame& F, int l) {
    const int gw = F.vcu * NWAVES + F.wave, NGW = F.G * NWAVES, lane = F.lane;
    const float* H2 = (const float*)(F.ws + WS_FILT);
    const float* w3 = inp(F, I_FW3) + (size_t)l * 64 * 2048; const float* b3 = inp(F, I_FB3) + l * 2048; const float* dec = inp(F, I_DECAY) + l * 2048; const float* hb = inp(F, I_HBIAS) + l * 1024;
    LAS float* W = (LAS float*)(F.lds + F.wave * 17408);
#pragma unroll 1
    for (int it = gw; it < 1024 + 128; it += NGW) {
        const bool isc = it >= 1024; const int ii = isc ? it - 1024 : it; const int chunk = ii >> 5, grp = ii & 31;
        const int L = isc ? LCTX : LSEQ; const int t = chunk * 64 + lane; const int pos = isc ? LSEQ + t : t;
        bf16* KR = isc ? (bf16*)(F.ws + WS_KRC) : (bf16*)(F.ws + WS_KRL); const int KLEN = 2 * L;
        const float tn = (float)t / (float)(L - 1);
#pragma unroll 4
        for (int k = 0; k < 64; ++k) W[lane * 68 + k] = w3[(size_t)k * 2048 + grp * 64 + lane];
        f32x4 h2[16];
#pragma unroll
        for (int k = 0; k < 16; ++k) h2[k] = *(const f32x4*)(H2 + (size_t)pos * 64 + 4 * k);
        const int colL = grp * 64 + lane; const float b3L = b3[colL], decL = fabsf(dec[colL]); const float hbL = ((colL >> 9) & 1) == 0 ? hb[(colL >> 10) * 512 + (colL & 511)] : 0.f;
        LDS_WAIT();
#pragma unroll 1
        for (int cc = 0; cc < 64; ++cc) {
            const int col = grp * 64 + cc; float a = lane_bcast(b3L, cc);
#pragma unroll
            for (int k = 0; k < 16; ++k) { const f32x4 wv = *(const LAS f32x4*)(W + cc * 68 + 4 * k); a += (h2[k][0] * wv[0] + h2[k][1] * wv[1]) + (h2[k][2] * wv[2] + h2[k][3] * wv[3]); }
            const int o = col >> 10, dir = (col >> 9) & 1, c = col & 511;
            float v = a * __expf(-tn * lane_bcast(decL, cc));
            if (t == 0 && dir == 0) v += lane_bcast(hbL, cc);
            const bool valid = !(t == 0 && dir == 1);
            const int i = dir ? L + t : L - t;
            const unsigned short bv = (unsigned short)f2bf(v);
            bf16* base = KR + (size_t)((o * 512 + c) * 8) * KLEN;
#pragma unroll
            for (int m = 0; m < 8; ++m) { const int e = i - m; if (valid && e >= 0) base[(size_t)m * KLEN + e] = bv; }
        }
        LDS_WAIT();
    }
    __syncthreads();
}
__device__ __forceinline__ void s5params_phase(Frame& F, int l) {
    float* P = (float*)(F.ws + WS_S5P);
    for (int e = F.vcu * 512 + F.tid; e < 2 * 32 * 64; e += F.G * 512) {
        const int base = l * 4096 + e;
        const int dg = e >> 6;
        const float lam_re = fminf(inp(F, I_SARE)[base], -1e-4f), lam_im = inp(F, I_SAIM)[base];
        const float dt = expf(inp(F, I_SLDT)[l * 64 + dg]);
        const float mag = expf(lam_re * dt), ang = lam_im * dt; const float abr = mag * cosf(ang), abi = mag * sinf(ang);
        const float den = lam_re * lam_re + lam_im * lam_im;
        const float qre = ((abr - 1.0f) * lam_re + abi * lam_im) / den, qim = (abi * lam_re - (abr - 1.0f) * lam_im) / den;
        float* o = P + (size_t)e * 36; o[0] = abr; o[1] = abi;
        const float* br = inp(F, I_SBRE) + (size_t)base * 16; const float* bi = inp(F, I_SBIM) + (size_t)base * 16;
        for (int c = 0; c < 16; ++c) { o[2 + c] = qre * br[c] - qim * bi[c]; o[18 + c] = qre * bi[c] + qim * br[c]; }
        o[34] = 0.f; o[35] = 0.f;
    }
}

struct Row { f32x4 v[4]; };
__device__ __forceinline__ void row_load(Row& r, const float* p, int lane) { const f32x4* x = (const f32x4*)p + lane;
#pragma unroll
    for (int j = 0; j < 4; ++j) r.v[j] = x[64 * j]; }
__device__ __forceinline__ void row_store(const Row& r, float* p, int lane) { f32x4* x = (f32x4*)p + lane;
#pragma unroll
    for (int j = 0; j < 4; ++j) x[64 * j] = r.v[j]; }
__device__ __forceinline__ void row_norm(Row& r) {
    float s = 0.f;
#pragma unroll
    for (int j = 0; j < 4; ++j) s += (r.v[j][0] + r.v[j][1]) + (r.v[j][2] + r.v[j][3]);
    const float mean = wave_sum(s) * (1.f / DM); float q = 0.f;
#pragma unroll
    for (int j = 0; j < 4; ++j) { r.v[j] = r.v[j] - mean; q += (r.v[j][0] * r.v[j][0] + r.v[j][1] * r.v[j][1]) + (r.v[j][2] * r.v[j][2] + r.v[j][3] * r.v[j][3]); }
    const float rstd = 1.f / sqrtf(wave_sum(q) * (1.f / DM) + LN_EPS);
#pragma unroll
    for (int j = 0; j < 4; ++j) r.v[j] = r.v[j] * rstd;
}
__device__ __forceinline__ void row_affine(Row& r, const float* g, const float* b, int lane, float gadd) {
    const f32x4* gp = (const f32x4*)g + lane; const f32x4* bp = (const f32x4*)b + lane;
#pragma unroll
    for (int j = 0; j < 4; ++j) r.v[j] = r.v[j] * (gp[64 * j] + gadd) + bp[64 * j];
}
__device__ __forceinline__ void row_store_bf16(const Row& r, bf16* p, int lane) { unsigned long long* o = (unsigned long long*)p + lane;
#pragma unroll
    for (int j = 0; j < 4; ++j) o[64 * j] = (unsigned long long)pk2(r.v[j][0], r.v[j][1]) | ((unsigned long long)pk2(r.v[j][2], r.v[j][3]) << 32); }

__device__ __forceinline__ const float* mod_vec(Frame& F, int l, int row, int which) { const int i = row < NX ? (row >> 11) : 16; return (const float*)(F.ws + WS_MODS) + ((size_t)l * 17 + i) * INC + which * 1024; }
__device__ __forceinline__ const float* xrow_ptr(Frame& F, int l, int row) {
    if (l == 0) return row < NX ? inp(F, I_X) + (size_t)row * DM : inp(F, I_CTX) + (size_t)(row - NX) * DM;
    return row < NX ? F.out + (size_t)row * DM : (const float*)(F.ws + WS_XC) + (size_t)(row - NX) * DM;
}
__device__ __forceinline__ float* xcur_ptr(Frame& F, int row) { return row < NX ? F.out + (size_t)row * DM : (float*)(F.ws + WS_XC) + (size_t)(row - NX) * DM; }

__device__ __forceinline__ void lnmod_phase(Frame& F, int l) {
    const int gw = F.vcu * NWAVES + F.wave, NGW = F.G * NWAVES; bf16* hx = (bf16*)(F.ws + WS_HX);
    for (int m = gw; m < RT; m += NGW) { Row r; row_load(r, xrow_ptr(F, l, m), F.lane); row_norm(r); row_affine(r, mod_vec(F, l, m, 1), mod_vec(F, l, m, 0), F.lane, 1.0f); row_store_bf16(r, hx + (size_t)m * DM, F.lane); }
}
__device__ __forceinline__ void ln1_phase(Frame& F, int l) {
    const int gw = F.vcu * NWAVES + F.wave, NGW = F.G * NWAVES; bf16* hx = (bf16*)(F.ws + WS_HX); const int M = l == 0 ? RT : NX;
    const float* g = inp(F, I_LN1G) + l * DM; const float* b = inp(F, I_LN1B) + l * DM;
    int* toke = (int*)(F.ws + WS_META + META_TOKE); float* tokw = (float*)(F.ws + WS_META + META_TOKW);
    LAS unsigned* lcnt = (LAS unsigned*)(F.lds);
    unsigned c8[8];
#pragma unroll
    for (int e = 0; e < 8; ++e) c8[e] = 0u;
    if (l == 1) { if (F.tid < 8) lcnt[F.tid] = 0u; __syncthreads(); }
    for (int m = gw; m < M; m += NGW) {
        float* xp = xcur_ptr(F, m); Row r; row_load(r, xp, F.lane); row_norm(r); row_affine(r, g, b, F.lane, 0.0f); row_store(r, xp, F.lane);
        row_norm(r); row_affine(r, mod_vec(F, l, m, 4), mod_vec(F, l, m, 3), F.lane, 1.0f);
        if (l == 0) { unsigned* d8 = (unsigned*)((unsigned char*)hx + (size_t)m * DM) + F.lane;
#pragma unroll
            for (int j = 0; j < 4; ++j) d8[64 * j] = pk4_fp8(r.v[j][0], r.v[j][1], r.v[j][2], r.v[j][3]); }
        else {
            const float* rt = inp(F, I_ROUTER); float lg[8];
#pragma unroll
            for (int e = 0; e < 8; ++e) lg[e] = 0.f;
#pragma unroll
            for (int j = 0; j < 4; ++j)
#pragma unroll
                for (int q = 0; q < 4; ++q) { const int k = 256 * j + 4 * F.lane + q; const f32x4 r0 = *(const f32x4*)(rt + k * 8), r1 = *(const f32x4*)(rt + k * 8 + 4); const float hv = r.v[j][q];
                    lg[0] += hv * r0[0]; lg[1] += hv * r0[1]; lg[2] += hv * r0[2]; lg[3] += hv * r0[3]; lg[4] += hv * r1[0]; lg[5] += hv * r1[1]; lg[6] += hv * r1[2]; lg[7] += hv * r1[3]; }
#pragma unroll
            for (int e = 0; e < 8; ++e) lg[e] = wave_sum(lg[e]);
            int e0 = 0; float v0 = lg[0];
#pragma unroll
            for (int e = 1; e < 8; ++e) if (lg[e] > v0) { v0 = lg[e]; e0 = e; }
            int e1 = -1; float v1 = -3.0e38f;
#pragma unroll
            for (int e = 0; e < 8; ++e) if (e != e0 && lg[e] > v1) { v1 = lg[e]; e1 = e; }
            const float ex = __expf(v1 - v0); const float w0 = 1.0f / (1.0f + ex), w1 = ex / (1.0f + ex);
            if (F.lane == 0) { toke[2 * m] = e0; toke[2 * m + 1] = e1; tokw[2 * m] = w0; tokw[2 * m + 1] = w1; }
#pragma unroll
            for (int e = 0; e < 8; ++e) c8[e] += (e0 == e ? 1u : 0u) + (e1 == e ? 1u : 0u);
        }
    }
    if (l == 1) {
        if (F.lane == 0) {
#pragma unroll
            for (int e = 0; e < 8; ++e) if (c8[e]) atomicAdd((unsigned*)&lcnt[e], c8[e]); }
        __syncthreads();
        if (F.tid < 8) { const unsigned v = lcnt[F.tid]; if (v) atomicAdd((unsigned*)(F.ws + WS_CTL) + CW_CNT + F.tid, v); }
        __syncthreads();
    }
}
__device__ __forceinline__ void ln2_phase(Frame& F, int l) {
    const int gw = F.vcu * NWAVES + F.wave, NGW = F.G * NWAVES;
    const float* g = inp(F, I_LN2G) + l * DM; const float* b = inp(F, I_LN2B) + l * DM;
    for (int m = gw; m < RT; m += NGW) { float* xp = xcur_ptr(F, m); Row r; row_load(r, xp, F.lane); row_norm(r); row_affine(r, g, b, F.lane, 0.0f); row_store(r, xp, F.lane); }
}

__device__ __forceinline__ void moe_convert_phase(Frame& F) {
    LAS float* scr = (LAS float*)(F.lds + 4096 + F.wave * 17408);
    const int gw = F.vcu * NWAVES + F.wave, NGW = F.G * NWAVES;
    unsigned char* w13 = F.ws + WS_MW13; unsigned char* w2 = F.ws + WS_MW2;
    constexpr int I1 = (1024 / 64) * (3584 / 64), I2 = (3584 / 64) * (1024 / 64);
    for (int it = gw; it < 8 * (2 * I1 + I2); it += NGW) {
        const int e = it / (2 * I1 + I2); int r = it - e * (2 * I1 + I2);
        if (r < I1) { conv_matrix_item_f8(inp(F, I_MW1) + (size_t)e * 1024 * 3584, 1024, 3584, w13 + (size_t)e * 7168 * 1024, 2, r, 32.f, scr, F.lane); continue; } r -= I1;
        if (r < I1) { conv_matrix_item_f8(inp(F, I_MW3) + (size_t)e * 1024 * 3584, 1024, 3584, w13 + (size_t)e * 7168 * 1024, 3, r, 32.f, scr, F.lane); continue; } r -= I1;
        conv_matrix_item_f8(inp(F, I_MW2) + (size_t)e * 3584 * 1024, 3584, 1024, w2 + (size_t)e * 1024 * 3584, 0, r, 128.f, scr, F.lane);
    }
}
__device__ __forceinline__ void moe_offsets(Frame& F, int (&off)[8], int& ntiles) {
    const unsigned* cnt = (const unsigned*)(F.ws + WS_CTL) + CW_CNT; int o = 0;
#pragma unroll
    for (int e = 0; e < 8; ++e) { off[e] = o; o += (int)((cnt[e] + 255u) & ~255u); }
    ntiles = o >> 8;
}
__device__ __forceinline__ void moe_setup_phase(Frame& F) {
    const int gw = F.vcu * NWAVES + F.wave, NGW = F.G * NWAVES, lane = F.lane;
    int off[8], ntiles; moe_offsets(F, off, ntiles);
    const int* toke = (const int*)(F.ws + WS_META + META_TOKE); int* tpos = (int*)(F.ws + WS_META + META_POS); int* tile_e = (int*)(F.ws + WS_META + META_TILE);
    unsigned* cur = (unsigned*)(F.ws + WS_CTL) + CW_CUR; unsigned char* srt = F.ws + WS_SORT;
    if (F.vcu == 0 && F.tid < 8) { const int e = F.tid; const int t0 = off[e] >> 8; const int t1 = (e == 7 ? ntiles : (off[e + 1] >> 8)); for (int t = t0; t < t1; ++t) tile_e[t] = e; if (e == 0) tile_e[511] = ntiles; }
    for (int base = gw; base < NX; base += 64 * NGW) {
        const int m = base + lane * NGW; const bool act = m < NX;
        const int e0 = act ? toke[2 * m] : -1, e1 = act ? toke[2 * m + 1] : -1;
        int p0 = 0, p1 = 0;
        const unsigned long long lt = (1ull << lane) - 1ull;
#pragma unroll
        for (int e = 0; e < 8; ++e) {
            const unsigned long long m0 = __ballot(e0 == e), m1 = __ballot(e1 == e);
            const int c = __popcll(m0) + __popcll(m1); int bs = 0;
            if (lane == 0 && c) bs = (int)atomicAdd(cur + e, (unsigned)c);
            bs = __builtin_amdgcn_readfirstlane(bs) + off[e];
            if (e0 == e) p0 = bs + __popcll(m0 & lt);
            if (e1 == e) p1 = bs + __popcll(m0) + __popcll(m1 & lt);
        }
        if (act) { tpos[2 * m] = p0; tpos[2 * m + 1] = p1; }
        const int nrows = (NX - base + NGW - 1) / NGW;
        for (int i = 0; i < 64 && i < nrows; ++i) {
            const int mi = base + i * NGW; const int q0 = __builtin_amdgcn_readlane(p0, i), q1 = __builtin_amdgcn_readlane(p1, i);
            Row r; row_load(r, F.out + (size_t)mi * DM, lane); row_norm(r); row_affine(r, mod_vec(F, 1, mi, 4), mod_vec(F, 1, mi, 3), lane, 1.0f);
            unsigned* d0 = (unsigned*)(srt + (size_t)q0 * DM) + lane; unsigned* d1 = (unsigned*)(srt + (size_t)q1 * DM) + lane;
#pragma unroll
            for (int j = 0; j < 4; ++j) { const unsigned w8 = pk4_fp8(r.v[j][0], r.v[j][1], r.v[j][2], r.v[j][3]); d0[64 * j] = w8; d1[64 * j] = w8; }
        }
    }
}
__device__ __forceinline__ void moe_combine_phase(Frame& F) {
    const int gw = F.vcu * NWAVES + F.wave, NGW = F.G * NWAVES, lane = F.lane;
    const float* tokw = (const float*)(F.ws + WS_META + META_TOKW); const int* tpos = (const int*)(F.ws + WS_META + META_POS); const bf16* Y = (const bf16*)(F.ws + WS_MOEY);
    const float* g = inp(F, I_LN2G) + DM; const float* b = inp(F, I_LN2B) + DM;
    for (int m = gw; m < NX; m += NGW) {
        const float w0 = tokw[2 * m], w1 = tokw[2 * m + 1]; const int p0 = tpos[2 * m], p1 = tpos[2 * m + 1];
        Row r; row_load(r, F.out + (size_t)m * DM, lane);
        const unsigned long long* y0 = (const unsigned long long*)(Y + (size_t)p0 * DM) + lane; const unsigned long long* y1 = (const unsigned long long*)(Y + (size_t)p1 * DM) + lane;
        const f32x4* g2 = (const f32x4*)mod_vec(F, 1, m, 5) + lane;
#pragma unroll
        for (int j = 0; j < 4; ++j) { const unsigned long long a = y0[64 * j], c = y1[64 * j];
            const f32x4 ya = (f32x4){bflo((unsigned)a), bfhi((unsigned)a), bflo((unsigned)(a >> 32)), bfhi((unsigned)(a >> 32))};
            const f32x4 yc = (f32x4){bflo((unsigned)c), bfhi((unsigned)c), bflo((unsigned)(c >> 32)), bfhi((unsigned)(c >> 32))};
            r.v[j] = r.v[j] * ALPHA_F + g2[64 * j] * (ya * w0 + yc * w1); }
        row_norm(r); row_affine(r, g, b, lane, 0.0f); row_store(r, F.out + (size_t)m * DM, lane);
    }
}

constexpr int HY_U_OFF = 0, HY_U_STRIDE = 4128, HY_K_OFF = 16 * HY_U_STRIDE, HY_K_STRIDE = 8208;
constexpr int HYC_U_STRIDE = 544, HYC_K_STRIDE = 1040;
static_assert(HY_K_OFF + 8 * HY_K_STRIDE + 64 <= MISC_OFF, "hyena LDS map");
__device__ __forceinline__ float hy_short4(const bf16* p, int tb, int L, float w0, float w1, float w2, float bs, f32x4& x) {
    const v2u pw = *(const v2u*)(p + tb); const float c0 = bflo(pw.x), c1 = bfhi(pw.x), c2 = bflo(pw.y), c3 = bfhi(pw.y);
    const float pm = tb > 0 ? bf2f(p[tb - 1]) : 0.f, pp = tb + 4 < L ? bf2f(p[tb + 4]) : 0.f;
    x[0] = bs + w0 * pm + w1 * c0 + w2 * c1; x[1] = bs + w0 * c0 + w1 * c1 + w2 * c2; x[2] = bs + w0 * c1 + w1 * c2 + w2 * c3; x[3] = bs + w0 * c2 + w1 * c3 + w2 * pp; return 0.f;
}
__device__ __forceinline__ void hy_short4u(const bf16* pi, bool first, bool last, float w0, float w1, float w2, float bs, f32x4& x) {
    const v2u pw = *(const v2u*)pi; const float c0 = bflo(pw.x), c1 = bfhi(pw.x), c2 = bflo(pw.y), c3 = bfhi(pw.y);
    float pm = bf2f(pi[-1]), pp = bf2f(pi[4]); pm = first ? 0.f : pm; pp = last ? 0.f : pp;
    x[0] = bs + w0 * pm + w1 * c0 + w2 * c1; x[1] = bs + w0 * c0 + w1 * c1 + w2 * c2; x[2] = bs + w0 * c1 + w1 * c2 + w2 * c3; x[3] = bs + w0 * c2 + w1 * c3 + w2 * pp;
}
template <int L, int USTR>
__device__ __forceinline__ void hy_fill_u(Frame& F, const bf16* phyT, int col, int rowb0, float w0, float w1, float w2, float bs) {
    const bf16* pc = phyT + (size_t)col * RT + rowb0;
    constexpr int NIT = 16 * L / 8 / 512 > 0 ? 16 * L / 8 / 512 : 1;
#pragma unroll 4
    for (int it = 0; it < NIT; ++it) { const int ch = F.tid + 512 * it; const int b = ch / (L / 8), tb = (ch - b * (L / 8)) * 8; const bf16* p = pc + (size_t)b * L + tb;
        const v4u cw = *(const v4u*)p; float pm = bf2f(p[-1]), pp = bf2f(p[8]); pm = tb == 0 ? 0.f : pm; pp = tb + 8 >= L ? 0.f : pp;
        const float c0 = bflo(cw.x), c1 = bfhi(cw.x), c2 = bflo(cw.y), c3 = bfhi(cw.y), c4 = bflo(cw.z), c5 = bfhi(cw.z), c6 = bflo(cw.w), c7 = bfhi(cw.w);
        v4u o; o.x = pk2(bs + w0 * pm + w1 * c0 + w2 * c1, bs + w0 * c0 + w1 * c1 + w2 * c2); o.y = pk2(bs + w0 * c1 + w1 * c2 + w2 * c3, bs + w0 * c2 + w1 * c3 + w2 * c4);
        o.z = pk2(bs + w0 * c3 + w1 * c4 + w2 * c5, bs + w0 * c4 + w1 * c5 + w2 * c6); o.w = pk2(bs + w0 * c5 + w1 * c6 + w2 * c7, bs + w0 * c6 + w1 * c7 + w2 * pp);
        *(LAS v4u*)(F.lds + HY_U_OFF + b * USTR + tb * 2) = o; }
}
template <int KLEN, int KSTR>
__device__ __forceinline__ void hy_fill_k(Frame& F, const bf16* kr) {
    const bf16* src = kr + (size_t)F.wave * KLEN + F.lane * 8;
#pragma unroll
    for (int i = 0; i < KLEN * 2 / 1024; ++i)
        __builtin_amdgcn_global_load_lds((const unsigned*)(src + i * 512), (LAS unsigned*)(F.lds + HY_K_OFF + F.wave * KSTR + i * 1024), 16, 0, 0);
    VM_WAIT();
}
__device__ __forceinline__ void hyena_unit(Frame& F, int l, int c, bool with_ctx) {
    const bf16* phyT = (const bf16*)(F.ws + WS_PHYT); bf16* z2 = (bf16*)(F.ws + WS_Z2);
    const bf16* KRL = (const bf16*)(F.ws + WS_KRL); const bf16* KRC = (const bf16*)(F.ws + WS_KRC);
    const float* sw = inp(F, I_HSW) + l * 3 * 1536; const float* sb = inp(F, I_HSB) + l * 1536;
    const int lane = F.lane, w = F.wave, r = lane & 15, q = lane >> 4, m = (-r) & 7;
    __syncthreads();
    { const int col = 1024 + c; hy_fill_u<LSEQ, HY_U_STRIDE>(F, phyT, col, 0, sw[col], sw[1536 + col], sw[3072 + col], sb[col]); }
    hy_fill_k<4096, HY_K_STRIDE>(F, KRL + (size_t)((0 * 512 + c) * 8) * 4096);
    __syncthreads();
#pragma unroll 1
    for (int o = 0; o < 2; ++o) {
        f32x4 acc[16];
#pragma unroll 1
        for (int rep_ = 0; rep_ < NREP(15); ++rep_) {
#pragma unroll
        for (int i = 0; i < 16; ++i) acc[i] = (f32x4){0.f, 0.f, 0.f, 0.f};
        const LAS unsigned char* pa = F.lds + HY_K_OFF + m * HY_K_STRIDE + 2 * (8 * q - r - m + 2048 - 256 * w);
        const LAS unsigned char* pb = F.lds + HY_U_OFF + r * HY_U_STRIDE + 16 * q;
        bf16x8 R[16];
#pragma unroll
        for (int i = 0; i < 16; ++i) R[i] = *(const LAS bf16x8*)(pa - 32 * i);
        bf16x8 bcur = *(const LAS bf16x8*)pb;
#pragma unroll 1
        for (int kg = 0; kg < 8; ++kg) {
#pragma unroll
            for (int kk = 0; kk < 8; ++kk) {
                const bf16x8 bnext = *(const LAS bf16x8*)(pb + 64 * (kk + 1));
                const bf16x8 n0 = *(const LAS bf16x8*)(pa + 64 * (kk + 1)), n1 = *(const LAS bf16x8*)(pa + 64 * (kk + 1) - 32);
#pragma unroll
                for (int i = 0; i < 16; ++i) acc[i] = __builtin_amdgcn_mfma_f32_16x16x32_bf16(R[(i - 2 * kk) & 15], bcur, acc[i], 0, 0, 0);
                R[(-2 * (kk + 1)) & 15] = n0; R[(1 - 2 * (kk + 1)) & 15] = n1; bcur = bnext;
                __builtin_amdgcn_sched_barrier(0);
            }
            pa += 512; pb += 512;
        }
        }
        const int col = o * 512 + c; const float w0 = sw[col], w1 = sw[1536 + col], w2 = sw[3072 + col], bs = sb[col];
        int tb0 = 256 * w + 4 * q; asm volatile("" : "+v"(tb0));
        const bf16* p = phyT + (size_t)col * RT + (size_t)r * LSEQ + tb0;
#pragma unroll
        for (int i = 0; i < 16; ++i) { f32x4 x; hy_short4u(p + 16 * i, tb0 + 16 * i == 0, tb0 + 16 * i + 4 >= LSEQ, w0, w1, w2, bs, x); acc[i] = acc[i] * x; }
        if (o == 0) {
            __syncthreads();
#pragma unroll
            for (int i = 0; i < 16; ++i) { v2u zw; zw.x = pk2(acc[i][0], acc[i][1]); zw.y = pk2(acc[i][2], acc[i][3]); *(LAS v2u*)(F.lds + HY_U_OFF + r * HY_U_STRIDE + (tb0 + 16 * i) * 2) = zw; }
            hy_fill_k<4096, HY_K_STRIDE>(F, KRL + (size_t)((1 * 512 + c) * 8) * 4096);
            __syncthreads();
        } else {
#pragma unroll
            for (int i = 0; i < 16; ++i) { bf16* zp = z2 + (size_t)(r * LSEQ + tb0 + 16 * i) * 512 + c; asm volatile("" : "+v"(zp));
#pragma unroll
                for (int e = 0; e < 4; ++e) zp[e * 512] = (bf16)f2bf(acc[i][e]); }
        }
    }
    if (!with_ctx) return;
    __syncthreads();
    { const int col = 1024 + c; hy_fill_u<LCTX, HYC_U_STRIDE>(F, phyT, col, NX, sw[col], sw[1536 + col], sw[3072 + col], sb[col]); }
    hy_fill_k<512, HYC_K_STRIDE>(F, KRC + (size_t)((0 * 512 + c) * 8) * 512);
    __syncthreads();
#pragma unroll 1
    for (int o = 0; o < 2; ++o) {
        f32x4 acc[2];
        acc[0] = (f32x4){0.f, 0.f, 0.f, 0.f}; acc[1] = acc[0];
        const LAS unsigned char* pa = F.lds + HY_K_OFF + m * HYC_K_STRIDE + 2 * (8 * q - r - m + 256 - 32 * w);
        const LAS unsigned char* pb = F.lds + HY_U_OFF + r * HYC_U_STRIDE + 16 * q;
#pragma unroll
        for (int k = 0; k < 8; ++k) { const bf16x8 bfr = *(const LAS bf16x8*)(pb + 64 * k);
#pragma unroll
            for (int i = 0; i < 2; ++i) acc[i] = __builtin_amdgcn_mfma_f32_16x16x32_bf16(*(const LAS bf16x8*)(pa + 64 * k - 32 * i), bfr, acc[i], 0, 0, 0); }
        const int col = o * 512 + c; const float w0 = sw[col], w1 = sw[1536 + col], w2 = sw[3072 + col], bs = sb[col];
        int tb0 = 32 * w + 4 * q; asm volatile("" : "+v"(tb0));
        const bf16* p = phyT + (size_t)col * RT + NX + (size_t)r * LCTX + tb0;
#pragma unroll
        for (int i = 0; i < 2; ++i) { f32x4 x; hy_short4u(p + 16 * i, tb0 + 16 * i == 0, tb0 + 16 * i + 4 >= LCTX, w0, w1, w2, bs, x); acc[i] = acc[i] * x; }
        if (o == 0) {
            __syncthreads();
#pragma unroll
            for (int i = 0; i < 2; ++i) { v2u zw; zw.x = pk2(acc[i][0], acc[i][1]); zw.y = pk2(acc[i][2], acc[i][3]); *(LAS v2u*)(F.lds + HY_U_OFF + r * HYC_U_STRIDE + (tb0 + 16 * i) * 2) = zw; }
            hy_fill_k<512, HYC_K_STRIDE>(F, KRC + (size_t)((1 * 512 + c) * 8) * 512);
            __syncthreads();
        } else {
#pragma unroll
            for (int i = 0; i < 2; ++i)
#pragma unroll
                for (int e = 0; e < 4; ++e) z2[(size_t)(NX + r * LCTX + tb0 + 16 * i + e) * 512 + c] = (bf16)f2bf(acc[i][e]);
        }
    }
}

__device__ __forceinline__ void cf_unit(Frame& F, int l, int seqrow, int seqlen, int t0) {
    LAS bf16* U = (LAS bf16*)F.lds;
    LAS float* O = (LAS float*)(F.lds + 98304);
    const bf16* ucf = (const bf16*)(F.ws + WS_UCF); bf16* out = (bf16*)(F.ws + WS_UCF2);
    __syncthreads();
    for (int pc = F.tid; pc < 94 * 64; pc += 512) { const int i = pc >> 6, ch = pc & 63; const int t = t0 - 15 + i;
        v4u w = (v4u){0u, 0u, 0u, 0u}; if (t >= 0 && t < seqlen) w = *(const v4u*)(ucf + (size_t)(seqrow + t) * 512 + ch * 8);
        *(LAS v4u*)(U + i * 512 + ch * 8) = w; }
    const int c = F.tid;
    float w[31];
#pragma unroll
    for (int k = 0; k < 31; ++k) w[k] = inp(F, I_CFW)[(size_t)l * 31 * 512 + k * 512 + c];
    const float bias = inp(F, I_CFB)[l * 512 + c];
    const f32x4 g0 = *((const f32x4*)(inp(F, I_CFG) + l * 512) + F.lane), g1 = *((const f32x4*)(inp(F, I_CFG) + l * 512) + 64 + F.lane);
    const f32x4 b0 = *((const f32x4*)(inp(F, I_CFLB) + l * 512) + F.lane), b1 = *((const f32x4*)(inp(F, I_CFLB) + l * 512) + 64 + F.lane);
    __syncthreads();
#pragma unroll 1
    for (int r = 0; r < 4; ++r) {
        float v[16];
#pragma unroll
        for (int t = 0; t < 16; ++t) v[t] = bias;
        const LAS bf16* Ur = U + (16 * r) * 512 + c;
#pragma unroll
        for (int ii = 0; ii < 46; ++ii) { const float x = bf2f(Ur[ii * 512]);
#pragma unroll
            for (int t = 0; t < 16; ++t) { if (ii - t >= 0 && ii - t <= 30) v[t] += w[ii - t] * x; } }
#pragma unroll
        for (int t = 0; t < 16; ++t) O[t * 512 + c] = v[t];
        __syncthreads();
#pragma unroll
        for (int q = 0; q < 2; ++q) {
            const int tt = 2 * F.wave + q;
            f32x4 x0 = *((const LAS f32x4*)(O + tt * 512) + F.lane), x1 = *((const LAS f32x4*)(O + tt * 512) + 64 + F.lane);
            const float mean = wave_sum((x0[0] + x0[1]) + (x0[2] + x0[3]) + (x1[0] + x1[1]) + (x1[2] + x1[3])) * (1.f / 512.f);
            x0 = x0 - mean; x1 = x1 - mean;
            const float var = wave_sum((x0[0] * x0[0] + x0[1] * x0[1]) + (x0[2] * x0[2] + x0[3] * x0[3]) + (x1[0] * x1[0] + x1[1] * x1[1]) + (x1[2] * x1[2] + x1[3] * x1[3])) * (1.f / 512.f);
            const float rstd = 1.f / sqrtf(var + LN_EPS);
            f32x4 y0 = x0 * rstd * g0 + b0, y1 = x1 * rstd * g1 + b1;
#pragma unroll
            for (int j = 0; j < 4; ++j) { y0[j] = siluf_(y0[j]); y1[j] = siluf_(y1[j]); }
            bf16* orow = out + (size_t)(seqrow + t0 + 16 * r + tt) * 512;
            v2u o0, o1; o0.x = pk2(y0[0], y0[1]); o0.y = pk2(y0[2], y0[3]); o1.x = pk2(y1[0], y1[1]); o1.y = pk2(y1[2], y1[3]);
            *((v2u*)orow + F.lane) = o0; *((v2u*)orow + 64 + F.lane) = o1;
        }
        __syncthreads();
    }
}

__device__ __forceinline__ void s5_unit(Frame& F, int l, int b, int gp) {
    const int lane = F.lane, w = F.wave;
    bf16* ps5 = (bf16*)(F.ws + WS_PS5); bf16* ydir = (bf16*)(F.ws + WS_YDIR);
    __syncthreads();
#pragma unroll 1
    for (int rep_ = 0; rep_ < NREP(14); ++rep_)
    {
        const int gd = w & 3, role = w >> 2;
        const int g = 2 * gp + (gd >> 1), dir = gd & 1;
        const int r = lane & 15, q = lane >> 4;
        LAS unsigned char* wl = F.lds + gd * 32768;
        LAS unsigned char* uS0 = wl;
        LAS float* BuS0 = (LAS float*)(wl + 2560);
        LAS unsigned char* stS0 = wl + 2560 + 2 * 10240;
        constexpr int NCH = (LCTX + LSEQ) / 16;
        const float* P = (const float*)(F.ws + WS_S5P) + (size_t)((dir * 32 + g) * 64) * 36;
        float abr = 0.f, abi = 0.f; f32x2 s2 = (f32x2){0.f, 0.f}, Aa = s2, Bn = s2;
        bf16x8 Bf[8], Cf[4];
        const int ti = lane >> 2, cq = lane & 3;
        auto urow = [&](int k) -> size_t { const bool isc = k < LCTX / 16; const int kk = isc ? k : k - LCTX / 16; const int Ls = isc ? LCTX : LSEQ; const int rowb = isc ? NX + b * LCTX : b * LSEQ;
            const int st = kk * 16 + ti; const int t = dir ? (Ls - 1 - st) : st; return (size_t)(rowb + t) * 512 + g * 16 + 4 * cq; };
        v2u unext = (v2u){0u, 0u};
        if (role == 0) { abr = P[lane * 36]; abi = P[lane * 36 + 1]; Aa = (f32x2){abr, abr}; Bn = (f32x2){-abi, abi}; }
        else {
#pragma unroll
            for (int blk = 0; blk < 8; ++blk) { const int pp = 16 * blk + r; const float* src = P + (size_t)(pp & 63) * 36 + (pp < 64 ? 2 : 18) + 8 * (q & 1);
                v4u t4; t4.x = pk2(src[0], src[1]); t4.y = pk2(src[2], src[3]); t4.z = pk2(src[4], src[5]); t4.w = pk2(src[6], src[7]);
                if (q >= 2) t4 = (v4u){0u, 0u, 0u, 0u};
                Bf[blk] = __builtin_bit_cast(bf16x8, t4); }
            const float* cre = inp(F, I_SCRE) + (size_t)(((l * 2 + dir) * 32 + g) * 16) * 64; const float* cim = inp(F, I_SCIM) + (size_t)(((l * 2 + dir) * 32 + g) * 16) * 64;
#pragma unroll
            for (int ks = 0; ks < 4; ++ks) { const int p0 = 16 * ks + 4 * q; const f32x4 a = *(const f32x4*)(cre + r * 64 + p0), c4 = *(const f32x4*)(cim + r * 64 + p0);
                v4u t4; t4.x = pk2(a[0], -c4[0]); t4.y = pk2(a[1], -c4[1]); t4.z = pk2(a[2], -c4[2]); t4.w = pk2(a[3], -c4[3]);
                Cf[ks] = __builtin_bit_cast(bf16x8, t4); }
            for (int e = lane; e < 2 * 16 * 20; e += 64) ((LAS unsigned*)uS0)[e] = 0u;
            LDS_WAIT();
            *(LAS v2u*)(uS0 + ti * 80 + 8 * cq) = *(const v2u*)(ps5 + urow(0));
            unext = *(const v2u*)(ps5 + urow(1));
        }
        LDS_WAIT(); __builtin_amdgcn_s_barrier(); asm volatile("" ::: "memory");
#pragma unroll 1
        for (int k = 0; k < NCH + 2; ++k) {
            const int p0 = k & 1, p1 = p0 ^ 1;
            if (role == 1) {
                bf16x8 ua, sf[4];
                if (k < NCH) ua = *(const LAS bf16x8*)(uS0 + p0 * 1280 + r * 80 + 16 * q);
                if (k >= 2) {
#pragma unroll
                    for (int ks = 0; ks < 4; ++ks) sf[ks] = *(const LAS bf16x8*)(stS0 + p0 * 4352 + r * 272 + 64 * ks + 16 * q); }
                if (k + 1 < NCH) { *(LAS v2u*)(uS0 + p1 * 1280 + ti * 80 + 8 * cq) = unext; if (k + 2 < NCH) unext = *(const v2u*)(ps5 + urow(k + 2)); }
                if (k < NCH) {
#pragma unroll
                    for (int blk = 0; blk < 8; ++blk) { const f32x4 d = __builtin_amdgcn_mfma_f32_16x16x32_bf16(ua, Bf[blk], (f32x4){0.f, 0.f, 0.f, 0.f}, 0, 0, 0);
                        *(LAS f32x4*)(BuS0 + p0 * 2560 + (16 * blk + r) * 20 + 4 * q) = d; }
                }
                if (k >= 2) {
                    f32x4 y0 = __builtin_amdgcn_mfma_f32_16x16x32_bf16(sf[0], Cf[0], (f32x4){0.f, 0.f, 0.f, 0.f}, 0, 0, 0), y1 = __builtin_amdgcn_mfma_f32_16x16x32_bf16(sf[1], Cf[1], (f32x4){0.f, 0.f, 0.f, 0.f}, 0, 0, 0);
                    y0 = __builtin_amdgcn_mfma_f32_16x16x32_bf16(sf[2], Cf[2], y0, 0, 0, 0); y1 = __builtin_amdgcn_mfma_f32_16x16x32_bf16(sf[3], Cf[3], y1, 0, 0, 0);
                    const f32x4 y = y0 + y1; const int kc = k - 2;
                    const bool isc = kc < LCTX / 16; const int kk = isc ? kc : kc - LCTX / 16; const int Ls = isc ? LCTX : LSEQ; const int rowb = isc ? NX + b * LCTX : b * LSEQ;
#pragma unroll
                    for (int i = 0; i < 4; ++i) { const int st = kk * 16 + 4 * q + i; const int t = dir ? (Ls - 1 - st) : st;
                        ydir[(size_t)dir * RT * 512 + (size_t)(rowb + t) * 512 + g * 16 + r] = (bf16)f2bf(y[i]); } }
            } else if (k >= 1 && k <= NCH) {
                f32x4 bre[4], bim[4];
#pragma unroll
                for (int j = 0; j < 4; ++j) { bre[j] = *(const LAS f32x4*)(BuS0 + p1 * 2560 + lane * 20 + 4 * j); bim[j] = *(const LAS f32x4*)(BuS0 + p1 * 2560 + (64 + lane) * 20 + 4 * j); }
#pragma unroll
                for (int i = 0; i < 16; ++i) {
                    const f32x2 b2 = (f32x2){bre[i >> 2][i & 3], bim[i >> 2][i & 3]};
                    const float nr = abr * s2[0] - abi * s2[1] + b2[0], ni = abr * s2[1] + abi * s2[0] + b2[1]; s2 = (f32x2){nr, ni};
                    *(LAS unsigned*)(stS0 + p1 * 4352 + i * 272 + 4 * lane) = pk2(s2[0], s2[1]); }
            }
            LDS_WAIT(); __builtin_amdgcn_s_barrier(); asm volatile("" ::: "memory");
        }
    }
    VM_WAIT();
    __syncthreads();
    const float* dsk = inp(F, I_SD) + l * 512 + gp * 32;
    for (int e = F.tid; e < (LCTX + LSEQ) * 4; e += 512) {
        const int rr = e >> 2, pc = e & 3; const int row = rr < LSEQ ? b * LSEQ + rr : NX + b * LCTX + (rr - LSEQ);
        const size_t off = (size_t)row * 512 + gp * 32 + pc * 8;
        const v4u uw = *(const v4u*)(ps5 + off), fw = *(const v4u*)(ydir + off), bw = *(const v4u*)(ydir + (size_t)RT * 512 + off);
        f32x4 u0, u1, f0, f1, b0, b1; unpack8(uw, u0, u1); unpack8(fw, f0, f1); unpack8(bw, b0, b1);
        const f32x4 d0 = *(const f32x4*)(dsk + pc * 8), d1 = *(const f32x4*)(dsk + pc * 8 + 4);
        f32x4 o0, o1;
#pragma unroll
        for (int j = 0; j < 4; ++j) { o0[j] = gelu_tanh(f0[j] + b0[j] + d0[j] * u0[j]); o1[j] = gelu_tanh(f1[j] + b1[j] + d1[j] * u1[j]); }
        *(v4u*)(ps5 + off) = pack8(o0, o1);
    }
}

__device__ __forceinline__ Frame make_frame(const Args& args, LAS unsigned char* lds, int wave_s);
__device__ __forceinline__ void mixers_phase(const Args& args, LAS unsigned char* lds, int wave_s, int l) {
#ifndef MIXMASK
#define MIXMASK 7
#endif
    if (MIXMASK & 1) { Frame F = make_frame(args, lds, wave_s);
#pragma unroll 1
        for (int u = F.vcu; u < NB * 16; u += F.G) s5_unit(F, l, u >> 4, u & 15); }
    if (MIXMASK & 2) { Frame F = make_frame(args, lds, wave_s);
#pragma unroll 1
        for (int u = F.vcu; u < 512; u += F.G) hyena_unit(F, l, u, l == 0);
        if (NREP(10) == 2) {
#pragma unroll 1
            for (int u = F.vcu; u < 512; u += F.G) hyena_unit(F, l, u, l == 0); } }
    if (MIXMASK & 4) { Frame F = make_frame(args, lds, wave_s);
        const int ncf = l == 0 ? NB * 32 + NB * 4 : NB * 32;
#pragma unroll 1
        for (int u = F.vcu; u < ncf; u += F.G) { if (u < NB * 32) cf_unit(F, l, u * 64, 64, 0); else { const int q = u - NB * 32; cf_unit(F, l, NX + (q >> 2) * LCTX, LCTX, (q & 3) * 64); } } }
    __syncthreads();
}

constexpr int PH_P0A = 0, PH_P0B = 1, PH_L0 = 2, PH_L1 = 12, N_PHASES = 27;
__device__ __forceinline__ Frame make_frame(const Args& args, LAS unsigned char* lds, int wave_s) {
    unsigned z0 = 0u; asm volatile("" : "+v"(z0));
    Frame F; int t = wave_s * 64 + (int)__builtin_amdgcn_mbcnt_hi(~0u, __builtin_amdgcn_mbcnt_lo(~0u, z0)); asm volatile("" : "+v"(t));
    unsigned char* ws = args.ws; float* out = args.out;
    F.lds = lds; F.tid = t; F.lane = t & 63; F.wave = wave_s;
    int G = gridDim.x, bx = blockIdx.x; asm volatile("" : "+s"(G), "+s"(bx));
    F.G = G; F.vcu = (G % 8 == 0) ? (bx % 8) * (G / 8) + bx / 8 : bx;
    const float* const* inp = args.in;
    F.in = inp; F.out = out; F.ws = ws; return F;
}
__global__ void __launch_bounds__(NWAVES * 64, 2) mega_fwd(Args args) {
    extern __shared__ __attribute__((aligned(16))) unsigned char lds_raw[];
    LAS unsigned char* const lds = (LAS unsigned char*)lds_raw;
    volatile LAS unsigned* MISC = (volatile LAS unsigned*)(lds + MISC_OFF);
    for (int u = threadIdx.x; u < (LDS_BYTES - MISC_OFF) / 4; u += NWAVES * 64) ((LAS unsigned*)(lds + MISC_OFF))[u] = 0u;
    int wave_s = __builtin_amdgcn_readfirstlane((int)threadIdx.x >> 6); asm volatile("" : "+s"(wave_s));
    __syncthreads();
    const int lo = MK_PER_PHASE_LAUNCH ? args.ph_lo : 0, hi = MK_PER_PHASE_LAUNCH ? args.ph_hi : N_PHASES;
    XcdBarrier bar; bar.bar = (unsigned*)(args.ws + WS_CTL) + CW_BAR; bar.x = 0; bar.st = nullptr;
    if (hi - lo > 1) bar = xcd_barrier_post((unsigned*)(args.ws + WS_CTL) + CW_BAR, MISC + 8);
#ifndef PHMASK
#define PHMASK 0xffffffffu
#endif
#define IN(k) (lo <= (k) && (k) < hi)
#define PM(b) ((PHMASK >> (b)) & 1u)
#define SEAM(k) do { if (IN(k) && IN((k) + 1)) xcd_barrier(bar, wave_s); } while (0)
#define FRAME() Frame F = make_frame(args, lds, wave_s); const char* ws = (const char*)F.ws; const int c = F.G == (int)gridDim.x ? (int)blockIdx.x : 0; (void)ws; (void)c

    if (PM(0) && IN(PH_P0A)) { FRAME(); REPEAT(NREP(12), p0a_prologue(F)); } SEAM(PH_P0A);
    if (PM(1) && IN(PH_P0B)) { FRAME(); p0b_mods(F); } SEAM(PH_P0B);

#pragma unroll 1
    for (int l = 0; l < 2; ++l) {
        const int pb = l == 0 ? PH_L0 : PH_L1;
        const int nMl = l == 0 ? RT / 256 : NX / 256;
        if (PM(2) && IN(pb + 0)) { { FRAME(); REPEAT(NREP(8), lnmod_phase(F, l)); } { FRAME(); h2table_phase(F, l); } { FRAME(); s5params_phase(F, l); } } SEAM(pb + 0);
        if (PM(3) && IN(pb + 1)) { { FRAME(); REPEAT(NREP(9), filter_expand_phase(F, l)); }
            FRAME();
            SchedPlain S; S.R.init(nMl, 12, F.G, c); S.A = ws + WS_HX; S.B = ws + WS_WIN + (size_t)l * 6144 * 1024 * 2; S.tsA = 256 * 1024 * 2; S.tsB = 256 * 1024 * 2;
            S.xM = l == 0 ? 0 : NCX / 256; S.xN0 = 10; S.xNn = 2;
            EpiInproj E{(bf16*)(F.ws + WS_PHYT), (bf16*)(F.ws + WS_UCF), (bf16*)(F.ws + WS_PS5)};
            REPEAT(NREP(0), pg8::gemm_phase<EpiInproj, SchedPlain>(F.lds, F.tid, 2048, S, E));
        } SEAM(pb + 1);
        if (PM(4) && IN(pb + 2)) { mixers_phase(args, lds, wave_s, l); } SEAM(pb + 2);
        if (PM(5) && IN(pb + 3)) {
            { FRAME(); SchedPlain S; S.R.init(nMl, 12, F.G, c); S.A = ws + WS_HX; S.B = ws + WS_WIN + ((size_t)l * 6144 + 3072) * 1024 * 2; S.tsA = 256 * 1024 * 2; S.tsB = 256 * 1024 * 2; S.xM = 0; S.xN0 = 0; S.xNn = 1;
              EpiGates E{(bf16*)(F.ws + WS_G)}; REPEAT(NREP(1), pg8::gemm_phase<EpiGates, SchedPlain>(F.lds, F.tid, 2048, S, E)); }
#ifndef DBG_SKIP_GLU
            { FRAME(); SchedPlain S; S.R.init(nMl, 2, F.G, (c + F.G / 4) % F.G); S.A = ws + WS_PS5; S.B = ws + WS_WGLU + (size_t)l * 512 * 512 * 2; S.tsA = 256 * 512 * 2; S.tsB = 256 * 512 * 2; S.xM = 0; S.xN0 = 0; S.xNn = 1;
              EpiGlu E{(const bf16*)(F.ws + WS_PS5), (bf16*)(F.ws + WS_S5Y), inp(F, I_SBGLU) + l * 512}; REPEAT(NREP(2), pg8::gemm_phase<EpiGlu, SchedPlain>(F.lds, F.tid, 1024, S, E)); }
#endif
        } SEAM(pb + 3);
        if (PM(6) && IN(pb + 4)) { FRAME();
            SchedMerge S; S.R.init(nMl, 4, F.G, c); S.A = ws + WS_Z2; S.sA = WS_UCF2 - WS_Z2; S.B = ws + WS_WOUTS + (size_t)(l * 3) * 1024 * 512 * 2; S.sB = (size_t)1024 * 512 * 2;
            S.tsA = 256 * 512 * 2; S.tsB = 256 * 512 * 2;
            EpiMerge E{(const bf16*)(F.ws + WS_G), (bf16*)(F.ws + WS_HX)};
            REPEAT(NREP(3), pg8::gemm_phase<EpiMerge, SchedMerge>(F.lds, F.tid, 1024, S, E));
        } SEAM(pb + 4);
        if (PM(7) && IN(pb + 5)) { FRAME();
            SchedPlain S; S.R.init(nMl, 4, F.G, c); S.A = ws + WS_HX; S.B = ws + WS_WO + (size_t)l * 1024 * 1024 * 2; S.tsA = 256 * 1024 * 2; S.tsB = 256 * 1024 * 2; S.xM = 0; S.xN0 = 0; S.xNn = 1;
            EpiRes E{l == 0 ? inp(F, I_X) : F.out, l == 0 ? inp(F, I_CTX) : (const float*)(F.ws + WS_XC), F.out, (float*)(F.ws + WS_XC), (const float*)(F.ws + WS_MODS) + (size_t)l * 17 * INC + 2 * 1024, 1.0f};
            REPEAT(((l == 0) ? NREP(4) : 1), pg8::gemm_phase<EpiRes, SchedPlain>(F.lds, F.tid, 2048, S, E));
        } SEAM(pb + 5);
        if (PM(8) && IN(pb + 6)) { { FRAME(); ln1_phase(F, l); } if (l == 1) { FRAME(); REPEAT(NREP(13), moe_convert_phase(F)); } } SEAM(pb + 6);
        if (l == 0) {
            if (PM(9) && IN(pb + 7)) { FRAME();
                SchedPlain S; S.R.init(RT / 256, 22, F.G, c); S.A = ws + WS_HX; S.B = ws + WS_W13; S.tsA = 256 * 1024; S.tsB = 256 * 1024; S.xM = 0; S.xN0 = 0; S.xNn = 1;
                EpiSwigluF8 E{F.ws + WS_G, DFF, 0.03125f}; REPEAT(NREP(5), pg8::gemm_phase<EpiSwigluF8, SchedPlain, true>(F.lds, F.tid, 1024, S, E));
            } SEAM(pb + 7);
            if (PM(10) && IN(pb + 8)) { FRAME();
                SchedPlain S; S.R.init(RT / 256, 4, F.G, c); S.A = ws + WS_G; S.B = ws + WS_W2; S.tsA = (size_t)256 * DFF; S.tsB = (size_t)256 * DFF; S.xM = 0; S.xN0 = 0; S.xNn = 1;
                EpiRes E{F.out, (const float*)(F.ws + WS_XC), F.out, (float*)(F.ws + WS_XC), (const float*)(F.ws + WS_MODS) + 5 * 1024, 0.0078125f};
                pg8::gemm_phase<EpiRes, SchedPlain, true>(F.lds, F.tid, DFF, S, E);
            } SEAM(pb + 8);
            if (PM(11) && IN(pb + 9)) { FRAME(); ln2_phase(F, l); } SEAM(pb + 9);
        } else {
            if (PM(15) && IN(pb + 7)) { FRAME(); moe_setup_phase(F); } SEAM(pb + 7);
#pragma unroll 1
            for (int st = 0; st < 6; ++st) {
                if (PM(13) && IN(pb + 8 + st) && st >= 1) { FRAME(); const int* tile_e = (const int*)(F.ws + WS_META + META_TILE); const int ch = st - 1;
                    const int ntiles = tile_e[511]; int nmc = ntiles - 64 * ch; nmc = nmc < 0 ? 0 : (nmc > 64 ? 64 : nmc);
                    SchedMoe S; S.R.init(nmc, 4, F.G, c); S.A = ws + WS_HID + (size_t)(ch & 1) * HID_BUF; S.B = ws + WS_MW2; S.tsA = (size_t)256 * DEX; S.tsB = (size_t)256 * DEX; S.esB = (size_t)1024 * DEX; S.tile_e = tile_e; S.tile0 = 64 * ch; S.a_global = false;
                    EpiMoeDown E{(bf16*)(F.ws + WS_MOEY), 0.0078125f}; REPEAT(NREP(7), pg8::gemm_phase<EpiMoeDown, SchedMoe, true>(F.lds, F.tid, DEX, S, E));
                }
                if (PM(12) && IN(pb + 8 + st) && st <= 4) { FRAME(); const int* tile_e = (const int*)(F.ws + WS_META + META_TILE); const int ch = st;
                    const int ntiles = tile_e[511]; int nmc = ntiles - 64 * ch; nmc = nmc < 0 ? 0 : (nmc > 64 ? 64 : nmc);
                    SchedMoe S; S.R.init(nmc, 28, F.G, c); S.A = ws + WS_SORT; S.B = ws + WS_MW13; S.tsA = 256 * 1024; S.tsB = 256 * 1024; S.esB = (size_t)7168 * 1024; S.tile_e = tile_e; S.tile0 = 64 * ch; S.a_global = true;
                    EpiSwigluF8 E{F.ws + WS_HID + (size_t)(ch & 1) * HID_BUF, DEX, 0.03125f}; REPEAT(NREP(6), pg8::gemm_phase<EpiSwigluF8, SchedMoe, true>(F.lds, F.tid, 1024, S, E));
                }
                SEAM(pb + 8 + st);
            }
            if (PM(14) && IN(pb + 14)) { FRAME(); moe_combine_phase(F); }
        }
    }
#undef IN
#undef SEAM
#undef FRAME
}


#ifdef DBG_DUMP
__global__ void dbg_dump(const unsigned char* ws, float* out) {
    const size_t NE = (size_t)RT * 512; const bf16* a = (const bf16*)(ws + WS_PS5); const bf16* b = (const bf16*)(ws + WS_Z2); const bf16* c = (const bf16*)(ws + WS_UCF2);
    for (size_t i = (size_t)blockIdx.x * blockDim.x + threadIdx.x; i < (size_t)NX * DM; i += (size_t)gridDim.x * blockDim.x) {
        const size_t j = i % NE; const int k = (int)(i / NE);
        float v;
        if (DBG_DUMP == 8) v = i < (size_t)26 * 1024 * 1024 ? bf2f(((const bf16*)(ws + WS_WIN))[i]) : 0.f;
        else if (DBG_DUMP == 7) v = k == 0 ? bf2f(a[j]) : bf2f(((const bf16*)(ws + WS_UCF))[j]);
        else if (DBG_DUMP == 4) v = bf2f(((const bf16*)(ws + WS_HX))[i]);
        else if (DBG_DUMP == 5) v = bf2f(((const bf16*)(ws + WS_G))[i]);
        else if (DBG_DUMP == 6) v = bf2f(((const bf16*)(ws + WS_S5Y))[i % NE]);
        else if (DBG_DUMP == 1) v = k == 0 ? bf2f(a[j]) : bf2f(b[j]);
        else if (DBG_DUMP == 2) v = k == 0 ? bf2f(b[j]) : bf2f(c[j]);
        else v = k == 0 ? bf2f(c[j]) : bf2f(a[j]);
        out[i] = v;
    }
}
#endif
extern "C" void kernel_launch(void* const* d_in, const int* in_sizes, int n_in, void* d_out, int out_size, void* d_ws, size_t ws_size, hipStream_t stream) {
    static int grid = 0;
    if (grid == 0) {
        if (n_in != N_IN || out_size != NX * DM || ws_size < WS_END2) { fprintf(stderr, "kernel_launch: unexpected shapes (n_in %d, out %d, ws %zu)\n", n_in, out_size, ws_size); grid = -1; return; }
        int dev = 0, cus = 0, per_cu = 0;
        if (hipGetDevice(&dev) != hipSuccess || hipDeviceGetAttribute(&cus, hipDeviceAttributeMultiprocessorCount, dev) != hipSuccess) { grid = -1; return; }
        if (hipFuncSetAttribute((const void*)mega_fwd, hipFuncAttributeMaxDynamicSharedMemorySize, LDS_BYTES) != hipSuccess) { fprintf(stderr, "kernel_launch: hipFuncSetAttribute failed\n"); grid = -1; return; }
        if (hipOccupancyMaxActiveBlocksPerMultiprocessor(&per_cu, (const void*)mega_fwd, NWAVES * 64, LDS_BYTES) != hipSuccess || per_cu < 1) fprintf(stderr, "kernel_launch: occupancy query reports %d\n", per_cu);
        (void)hipGetLastError();
        grid = cus;
    }
    if (grid < 0) return;
    (void)hipMemsetAsync((char*)d_ws + WS_CTL, 0, CTL_ZERO_BYTES, stream);
    Args a{};
    for (int i = 0; i < N_IN; ++i) a.in[i] = (const float*)d_in[i];
    a.out = (float*)d_out; a.ws = (unsigned char*)d_ws;
#if MK_PER_PHASE_LAUNCH
    for (int p = 0; p < DBG_NPH; ++p) { a.ph_lo = p; a.ph_hi = p + 1; hipLaunchKernelGGL(mega_fwd, dim3(grid), dim3(NWAVES * 64), LDS_BYTES, stream, a); }
#ifdef DBG_DUMP
    hipLaunchKernelGGL(dbg_dump, dim3(2048), dim3(256), 0, stream, (const unsigned char*)d_ws, (float*)d_out);
#endif
#else
    a.ph_lo = 0; a.ph_hi = N_PHASES; hipLaunchKernelGGL(mega_fwd, dim3(grid), dim3(NWAVES * 64), LDS_BYTES, stream, a);
#endif
}
```

```cpp
#include <hip/hip_runtime.h>
#include <cstdio>
#include <cstdint>

#ifndef DBG_REP
#define DBG_REP 0
#endif
#define NREP(bit) (((DBG_REP >> (bit)) & 1) ? 2 : 1)
#define REPEAT(n, ...) do { __VA_ARGS__; if ((n) == 2) { __VA_ARGS__; } } while (0)
#ifndef DBG_NPH
#define DBG_NPH N_PHASES
#endif
#ifndef MK_PER_PHASE_LAUNCH
#define MK_PER_PHASE_LAUNCH 0
#endif

#define GAS __attribute__((address_space(1)))
#define LAS __attribute__((address_space(3)))
typedef unsigned short bf16;
typedef unsigned v4u __attribute__((ext_vector_type(4)));
typedef unsigned v2u __attribute__((ext_vector_type(2)));
typedef float f32x4 __attribute__((ext_vector_type(4)));
typedef float f32x2 __attribute__((ext_vector_type(2)));
typedef short bf16x8 __attribute__((ext_vector_type(8)));

constexpr int NB = 16, LSEQ = 2048, LCTX = 256, DM = 1024;
constexpr int NX = NB * LSEQ;
constexpr int NCX = NB * LCTX;
constexpr int RT = NX + NCX;
constexpr int INC = 6144, DFF = 2816, DEX = 3584, NEXP = 8;
constexpr float ALPHA_F = 1.41421356237f;
constexpr float LN_EPS = 1e-5f;

enum { I_X = 0, I_C, I_CTX, I_CCTX, I_WMOD, I_BMOD, I_WIN, I_HSW, I_HSB, I_FW1, I_FB1, I_FW2, I_FB2, I_FW3, I_FB3, I_FREQ, I_DECAY, I_HBIAS, I_WHY,
       I_CFW, I_CFB, I_CFG, I_CFLB, I_WCF, I_SARE, I_SAIM, I_SLDT, I_SBRE, I_SBIM, I_SCRE, I_SCIM, I_SD, I_SWGLU, I_SBGLU, I_WS5, I_WO,
       I_LN1G, I_LN1B, I_LN2G, I_LN2B, I_FFW1, I_FFW3, I_FFW2, I_ROUTER, I_MW1, I_MW3, I_MW2, N_IN };

constexpr size_t MiB = 1u << 20;
constexpr size_t WS_CTL = 0, CTL_ZERO_BYTES = 1 * MiB;
constexpr size_t WS_MODS = 1 * MiB;
constexpr size_t WS_S5P = 2 * MiB;
constexpr size_t WS_META = 3 * MiB;
constexpr size_t WS_FILT = 4 * MiB;
constexpr size_t WS_XC = 22 * MiB;
constexpr size_t WS_WIN = 38 * MiB;
constexpr size_t WS_WOUTS = 62 * MiB;
constexpr size_t WS_WGLU = 68 * MiB;
constexpr size_t WS_WO = 69 * MiB;
constexpr size_t WS_W13 = 73 * MiB;
constexpr size_t WS_W2 = 84 * MiB;
constexpr size_t WS_HX = 90 * MiB;
constexpr size_t WS_G = 162 * MiB;
constexpr size_t WS_PHYT = WS_G, WS_YDIR = WS_G + 108 * MiB, WS_UCF = WS_G + 180 * MiB;
constexpr size_t WS_PS5 = 378 * MiB;
constexpr size_t WS_Z2 = 414 * MiB;
constexpr size_t WS_UCF2 = 450 * MiB;
constexpr size_t WS_S5Y = 486 * MiB;
constexpr size_t WS_KRL = 522 * MiB;
constexpr size_t WS_KRC = 586 * MiB;
constexpr size_t WS_KDUMMY = 594 * MiB;
constexpr size_t WS_END = 595 * MiB;
constexpr size_t WS_SORT = 90 * MiB;
constexpr size_t WS_MOEY = 156 * MiB;
constexpr size_t WS_MW13 = 288 * MiB;
constexpr size_t WS_MW2 = 344 * MiB;
constexpr size_t WS_HID = 372 * MiB;
constexpr size_t HID_BUF = 56 * MiB;
constexpr size_t WS_END2 = 604 * MiB;
static_assert(WS_HID + (size_t)67584 * 3584 <= WS_END2, "moe map");
constexpr size_t META_TOKE = 0, META_TOKW = 256 * 1024, META_POS = 512 * 1024, META_TILE = 768 * 1024;
constexpr int CW_BAR = 4096;
constexpr int CW_CNT = 8192, CW_CUR = 8256;

constexpr int LDS_BYTES = 155648;
constexpr int MISC_OFF = 147456;
constexpr int NWAVES = 8;

typedef __bf16 bf2_t __attribute__((ext_vector_type(2)));
__device__ __forceinline__ unsigned pk2(float lo, float hi) { bf2_t v; v.x = (__bf16)lo; v.y = (__bf16)hi; return __builtin_bit_cast(unsigned, v); }
__device__ __forceinline__ unsigned f2bf(float f) { return (unsigned)__builtin_bit_cast(unsigned short, (__bf16)f); }
__device__ __forceinline__ unsigned pk4_fp8(float a, float b, float c, float d) { int w = 0; w = __builtin_amdgcn_cvt_pk_fp8_f32(a, b, w, false); w = __builtin_amdgcn_cvt_pk_fp8_f32(c, d, w, true); return (unsigned)w; }
__device__ __forceinline__ float bf2f(unsigned short b) { return __builtin_bit_cast(float, ((unsigned)b) << 16); }
__device__ __forceinline__ float bflo(unsigned w) { return __builtin_bit_cast(float, w << 16); }
__device__ __forceinline__ float bfhi(unsigned w) { return __builtin_bit_cast(float, w & 0xffff0000u); }
__device__ __forceinline__ float sigmoidf_(float x) { return __builtin_amdgcn_rcpf(1.0f + __expf(-x)); }
__device__ __forceinline__ float siluf_(float x) { return x * sigmoidf_(x); }
__device__ __forceinline__ float gelu_tanh(float x) { const float y = 0.7978845608028654f * (x + 0.044715f * x * x * x); const float e = __expf(2.0f * y); const float th = 1.0f - 2.0f * __builtin_amdgcn_rcpf(e + 1.0f); return 0.5f * x * (1.0f + th); }
__device__ __forceinline__ float wave_sum(float v) {
    v += __builtin_bit_cast(float, __builtin_amdgcn_mov_dpp(__builtin_bit_cast(int, v), 0xB1, 0xf, 0xf, true));
    v += __builtin_bit_cast(float, __builtin_amdgcn_mov_dpp(__builtin_bit_cast(int, v), 0x4E, 0xf, 0xf, true));
    v += __builtin_bit_cast(float, __builtin_amdgcn_mov_dpp(__builtin_bit_cast(int, v), 0x141, 0xf, 0xf, true));
    v += __builtin_bit_cast(float, __builtin_amdgcn_mov_dpp(__builtin_bit_cast(int, v), 0x140, 0xf, 0xf, true));
    v += __builtin_bit_cast(float, __builtin_amdgcn_ds_swizzle(__builtin_bit_cast(int, v), 0x401F));
    const unsigned u = __builtin_bit_cast(unsigned, v); const auto r = __builtin_amdgcn_permlane32_swap(u, u, false, false);
    return __builtin_bit_cast(float, (unsigned)r[0]) + __builtin_bit_cast(float, (unsigned)r[1]);
}
__device__ __forceinline__ float lane_bcast(float v, int k) { return __builtin_bit_cast(float, __builtin_amdgcn_readlane(__builtin_bit_cast(int, v), k)); }
#define LDS_WAIT() asm volatile("s_waitcnt lgkmcnt(0)" ::: "memory")
#define VM_WAIT() asm volatile("s_waitcnt vmcnt(0)" ::: "memory")

namespace pg8 {
#define PG8_LAS __attribute__((address_space(3)))
constexpr int BM = 256, BK = 64, HALF = 128, HTB = HALF * BK * 2, STAGE_BYTES = 8 * HTB, NXCD = 8, WGM = 8;
__host__ __device__ __forceinline__ int lds_byte(int r, int c) { const int st = (r >> 4) * 2 + (c >> 5), rr = r & 15, cc = c & 31, ob = rr * 64 + cc * 2; return st * 1024 + (ob ^ (((ob >> 9) & 1) << 5)); }
__host__ __device__ __forceinline__ void stage_rc(int b, int& R, int& C) { const int st = b / 1024, sb = b % 1024, swz = sb ^ (((sb >> 9) & 1) << 5); R = (st >> 1) * 16 + swz / 64; C = (st & 1) * 32 + (swz % 64) / 2; }
__host__ __device__ __forceinline__ int perm32(int rho) { const int n = rho >> 4, i = rho & 15; return 8 * (i >> 2) + 4 * n + (i & 3); }

struct Unit { int pm, pn, seg, ex; const char* A; const char* B; };

struct Rect {
    int nM, nN, nwg, G, c;
    __device__ __forceinline__ void init(int nM_, int nN_, int G_, int c_) { nM = nM_; nN = nN_; nwg = nM * nN; G = G_; c = c_; }
    __device__ __forceinline__ bool map(int L, int& pm, int& pn) const {
        if (L >= nwg) return false;
        int wgid = L; { const int q = nwg / NXCD, r = nwg % NXCD, xcd = wgid % NXCD, off = wgid / NXCD; wgid = (xcd < r ? xcd * (q + 1) : r * (q + 1) + (xcd - r) * q) + off; }
        const int nig = WGM * nN, gid = wgid / nig, fm = gid * WGM, gsz = (nM - fm) < WGM ? (nM - fm) : WGM;
        pm = fm + ((wgid % nig) % gsz); pn = (wgid % nig) / gsz; return true;
    }
};

__device__ __forceinline__ unsigned cvt_pk_bf16(float lo, float hi) { return pk2(lo, hi); }

typedef int v8i_t __attribute__((ext_vector_type(8)));
typedef int v4i_t __attribute__((ext_vector_type(4)));
__device__ __forceinline__ v8i_t cat8(const bf16x8 a, const bf16x8 b) { return __builtin_shufflevector(__builtin_bit_cast(v4i_t, a), __builtin_bit_cast(v4i_t, b), 0, 1, 2, 3, 4, 5, 6, 7); }
__device__ __forceinline__ bf16x8 lo8(const v8i_t v) { return __builtin_bit_cast(bf16x8, __builtin_shufflevector(v, v, 0, 1, 2, 3)); }
__device__ __forceinline__ bf16x8 hi8(const v8i_t v) { return __builtin_bit_cast(bf16x8, __builtin_shufflevector(v, v, 4, 5, 6, 7)); }
template <class Epi, class Sched, bool F8 = false, bool ALIGN_EPI = true, bool SP2 = true>
__device__ __forceinline__ void gemm_phase(PG8_LAS unsigned char* lds, const int tid, const int KB, const Sched& S, const Epi& E) {
    const int wid = __builtin_amdgcn_readfirstlane(tid >> 6), lane = tid & 63, wr = wid >> 2, wc = wid & 3, fr = lane & 15, fq = lane >> 4;
    const int nt = KB / (BK * 2);
    unsigned voffA[2], voffB[2];
#pragma unroll
    for (int i = 0; i < 2; ++i) { int R, C; stage_rc(tid * 16 + i * 8192, R, C); const int Rb = Epi::PERM ? ((R & ~31) + perm32(R & 31)) : R;
        voffA[i] = (unsigned)(R * KB + C * 2); voffB[i] = (unsigned)(Rb * KB + C * 2); }
    const size_t kstep = (size_t)(BK * 2);
    const size_t hstep = (size_t)HALF * KB;
    const unsigned ldsw = (unsigned)wid * 1024u;
    const int aoff = lds_byte(wr * 64 + fr, fq * (F8 ? 16 : 8)), boff = lds_byte(wc * 32 + fr, fq * (F8 ? 16 : 8));
    constexpr int KOFF = F8 ? 16 : 1024;
#define PG8_SA(b, h) (((b) * 2 + (h)) * HTB)
#define PG8_SB(b, h) ((4 + (b) * 2 + (h)) * HTB)
#define PG8_STAGE(bufoff, gbase, voff) do { _Pragma("unroll") for (int _i = 0; _i < 2; ++_i) \
        __builtin_amdgcn_global_load_lds((const unsigned*)((const char*)(gbase) + (voff)[_i]), (PG8_LAS unsigned*)(lds + (bufoff) + ldsw + _i * 8192), 16, 0, 0); } while (0)
#define PG8_LDA(dst, b, h) do { _Pragma("unroll") for (int m = 0; m < 4; ++m) dst[m] = cat8(*(const PG8_LAS bf16x8*)(lds + PG8_SA(b, h) + aoff + m * 2048), *(const PG8_LAS bf16x8*)(lds + PG8_SA(b, h) + aoff + m * 2048 + KOFF)); } while (0)
#define PG8_LDB(dst, b, h) do { _Pragma("unroll") for (int n = 0; n < 2; ++n) dst[n] = cat8(*(const PG8_LAS bf16x8*)(lds + PG8_SB(b, h) + boff + n * 2048), *(const PG8_LAS bf16x8*)(lds + PG8_SB(b, h) + boff + n * 2048 + KOFF)); } while (0)
#define PG8_MMA(ai, bj, At, Bt) do { __builtin_amdgcn_s_setprio(1); _Pragma("unroll") for (int m = 0; m < 4; ++m) _Pragma("unroll") for (int n = 0; n < 2; ++n) { \
        if constexpr (F8) asm volatile("v_mfma_scale_f32_16x16x128_f8f6f4 %0, %1, %2, %0, %3, %3 op_sel_hi:[0,0,0]" : "+v"(acc[ai][bj][m][n]) : "v"(Bt[n]), "v"(At[m]), "v"(sc1)); \
        else { acc[ai][bj][m][n] = __builtin_amdgcn_mfma_f32_16x16x32_bf16(lo8(Bt[n]), lo8(At[m]), acc[ai][bj][m][n], 0, 0, 0); \
               acc[ai][bj][m][n] = __builtin_amdgcn_mfma_f32_16x16x32_bf16(hi8(Bt[n]), hi8(At[m]), acc[ai][bj][m][n], 0, 0, 0); } } \
        __builtin_amdgcn_s_setprio(0); } while (0)
#define PG8_WAIT_V(n) asm volatile("s_waitcnt vmcnt(" #n ")" ::: "memory")
#define PG8_WAIT_L(n) asm volatile("s_waitcnt lgkmcnt(" #n ")" ::: "memory")
#define PG8_BAR __builtin_amdgcn_s_barrier()
#define PG8_SCHED __builtin_amdgcn_sched_barrier(0)
    const int sc1 = 0x7f7f7f7f;
    Unit cur, nxt; int ui = 0;
    if (!S.next(0, cur)) return;
    f32x4 acc[2][2][4][2];
#pragma unroll
    for (int a = 0; a < 2; ++a)
#pragma unroll
        for (int b = 0; b < 2; ++b)
#pragma unroll
            for (int m = 0; m < 4; ++m)
#pragma unroll
                for (int n = 0; n < 2; ++n) acc[a][b][m][n] = (f32x4){0.f, 0.f, 0.f, 0.f};
    v8i_t At[4], B0[2], B1[2];
    const char* cA = cur.A; const char* cB = cur.B;
    if constexpr (SP2) {
        PG8_STAGE(PG8_SB(0, 0), cB, voffB); PG8_STAGE(PG8_SB(0, 1), cB + hstep, voffB); PG8_STAGE(PG8_SA(0, 0), cA, voffA); PG8_STAGE(PG8_SA(0, 1), cA + hstep, voffA);
        if (wr == 1) PG8_BAR;
        PG8_WAIT_V(2); PG8_BAR;
        PG8_STAGE(PG8_SB(1, 0), cB + kstep, voffB); PG8_STAGE(PG8_SA(1, 0), cA + kstep, voffA); PG8_STAGE(PG8_SB(1, 1), cB + hstep + kstep, voffB);
        PG8_WAIT_V(6); PG8_BAR;
    } else {
        PG8_STAGE(PG8_SB(0, 0), cB, voffB); PG8_STAGE(PG8_SA(0, 0), cA, voffA); PG8_STAGE(PG8_SB(0, 1), cB + hstep, voffB); PG8_STAGE(PG8_SA(0, 1), cA + hstep, voffA);
        if (wr == 1) PG8_BAR;
        PG8_WAIT_V(4); PG8_BAR;
        PG8_STAGE(PG8_SB(1, 0), cB + kstep, voffB); PG8_STAGE(PG8_SA(1, 0), cA + kstep, voffA); PG8_STAGE(PG8_SB(1, 1), cB + hstep + kstep, voffB);
        PG8_WAIT_V(6); PG8_BAR;
    }
    for (;;) {
        const bool has_next = S.next(ui + 1, nxt);
        const char* nA = has_next ? nxt.A : cA; const char* nB = has_next ? nxt.B : cB;
#pragma unroll 1
        for (int t = 0; t < nt; t += 2) {
            const bool last = (t == nt - 2);
            const char* a1 = cA + (size_t)(t + 1) * kstep;
            const char* a2 = last ? nA : cA + (size_t)(t + 2) * kstep; const char* b2 = last ? nB : cB + (size_t)(t + 2) * kstep;
            const char* a3 = a2 + kstep; const char* b3 = b2 + kstep;
            if constexpr (SP2) {
            PG8_LDB(B0, 0, 0); PG8_LDB(B1, 0, 1); PG8_SCHED; PG8_LDA(At, 0, 0); PG8_STAGE(PG8_SA(1, 1), a1 + hstep, voffA);
            PG8_WAIT_V(8); PG8_WAIT_L(0); PG8_BAR; PG8_MMA(0, 0, At, B0); PG8_MMA(0, 1, At, B1); PG8_BAR; PG8_SCHED;
            PG8_LDA(At, 0, 1); PG8_STAGE(PG8_SB(0, 0), b2, voffB); PG8_STAGE(PG8_SB(0, 1), b2 + hstep, voffB); PG8_STAGE(PG8_SA(0, 0), a2, voffA);
            PG8_WAIT_V(8); PG8_WAIT_L(0); PG8_BAR; PG8_MMA(1, 0, At, B0); PG8_MMA(1, 1, At, B1); PG8_BAR; PG8_SCHED;
            PG8_LDB(B0, 1, 0); PG8_LDB(B1, 1, 1); PG8_SCHED; PG8_LDA(At, 1, 0); PG8_STAGE(PG8_SA(0, 1), a2 + hstep, voffA);
            PG8_WAIT_V(8); PG8_WAIT_L(0); PG8_BAR; PG8_MMA(0, 0, At, B0); PG8_MMA(0, 1, At, B1); PG8_BAR; PG8_SCHED;
            PG8_LDA(At, 1, 1); PG8_STAGE(PG8_SB(1, 0), b3, voffB); PG8_STAGE(PG8_SB(1, 1), b3 + hstep, voffB); PG8_STAGE(PG8_SA(1, 0), a3, voffA);
            PG8_WAIT_V(8); PG8_WAIT_L(0); PG8_BAR; PG8_MMA(1, 0, At, B0); PG8_MMA(1, 1, At, B1); PG8_BAR; PG8_SCHED;
            } else {
            PG8_LDB(B0, 0, 0); PG8_SCHED; PG8_LDA(At, 0, 0); PG8_STAGE(PG8_SA(1, 1), a1 + hstep, voffA);
            PG8_WAIT_L(8); PG8_BAR; PG8_WAIT_L(0); PG8_MMA(0, 0, At, B0); PG8_BAR; PG8_SCHED;
            PG8_LDB(B1, 0, 1); PG8_STAGE(PG8_SB(0, 0), b2, voffB);
            PG8_BAR; PG8_WAIT_L(0); PG8_MMA(0, 1, At, B1); PG8_BAR;
            PG8_LDA(At, 0, 1); PG8_STAGE(PG8_SA(0, 0), a2, voffA);
            PG8_BAR; PG8_WAIT_L(0); PG8_MMA(1, 0, At, B0); PG8_BAR; PG8_SCHED;
            PG8_STAGE(PG8_SB(0, 1), b2 + hstep, voffB);
            PG8_WAIT_V(6); PG8_BAR; PG8_MMA(1, 1, At, B1); PG8_BAR;
            PG8_LDB(B0, 1, 0); PG8_SCHED; PG8_LDA(At, 1, 0); PG8_STAGE(PG8_SA(0, 1), a2 + hstep, voffA);
            PG8_WAIT_L(8); PG8_BAR; PG8_WAIT_L(0); PG8_MMA(0, 0, At, B0); PG8_BAR; PG8_SCHED;
            PG8_LDB(B1, 1, 1); PG8_STAGE(PG8_SB(1, 0), b3, voffB);
            PG8_BAR; PG8_WAIT_L(0); PG8_MMA(0, 1, At, B1); PG8_BAR;
            PG8_LDA(At, 1, 1); PG8_STAGE(PG8_SA(1, 0), a3, voffA);
            PG8_BAR; PG8_WAIT_L(0); PG8_MMA(1, 0, At, B0); PG8_BAR; PG8_SCHED;
            PG8_STAGE(PG8_SB(1, 1), b3 + hstep, voffB);
            PG8_WAIT_V(6); PG8_BAR; PG8_MMA(1, 1, At, B1); PG8_BAR;
            }
        }
        if constexpr (F8) asm volatile("s_nop 15\n\ts_nop 15" ::: "memory");
        if constexpr (ALIGN_EPI) { if (wr == 0) PG8_BAR; }
        E(acc, cur, wr, wc, fr, fq);
        if (!has_next) break;
#pragma unroll
        for (int a = 0; a < 2; ++a)
#pragma unroll
            for (int b = 0; b < 2; ++b)
#pragma unroll
                for (int m = 0; m < 4; ++m)
#pragma unroll
                    for (int n = 0; n < 2; ++n) acc[a][b][m][n] = (f32x4){0.f, 0.f, 0.f, 0.f};
        cur = nxt; cA = nA; cB = nB; ++ui;
        if constexpr (ALIGN_EPI) { if (wr == 1) PG8_BAR; }
    }
    PG8_WAIT_V(0);
    if constexpr (!ALIGN_EPI) { if (wr == 0) PG8_BAR; }
    PG8_BAR;
#undef PG8_SA
#undef PG8_SB
#undef PG8_STAGE
#undef PG8_LDA
#undef PG8_LDB
#undef PG8_MMA
#undef PG8_WAIT_V
#undef PG8_WAIT_L
#undef PG8_BAR
#undef PG8_SCHED
}
}
using pg8::Unit;

#define XB_TMO      128
#define XB_XCNT(j)  (256  + 64 * (j))
#define XB_XSUB(j)  (1280 + 64 * (j))
#define XB_XGEN(j)  (2304 + 64 * (j))
#define XB_TOP      3328
#define XB_TOPGEN   3392
#define XCD_BAR_WORDS 3456
#define XB_SPIN_CAP (1u << 18)
__device__ __forceinline__ unsigned xb_ld(unsigned* p)              { return __hip_atomic_load(p, __ATOMIC_RELAXED, __HIP_MEMORY_SCOPE_AGENT); }
__device__ __forceinline__ unsigned xb_add(unsigned* p, unsigned v) { return __hip_atomic_fetch_add(p, v, __ATOMIC_RELAXED, __HIP_MEMORY_SCOPE_AGENT); }
__device__ __forceinline__ unsigned xb_xcc_id() { return (unsigned)__builtin_amdgcn_s_getreg((3 << 11) | 20) & 0xFu; }
#define XB_SPIN(cond, bar) do { unsigned _sp = 0; while (cond) { __builtin_amdgcn_s_sleep(1); \
    if ((++_sp & 255u) == 0u) { if (xb_ld(&(bar)[XB_TMO])) break; if (_sp > XB_SPIN_CAP) { atomicAdd(&(bar)[XB_TMO], 1u); break; } } } } while (0)
struct XcdBarrier { unsigned* bar; unsigned x; volatile LAS unsigned* st; };
__device__ __forceinline__ XcdBarrier xcd_barrier_post(unsigned* bar, volatile LAS unsigned* st) {
    XcdBarrier b; b.bar = bar; b.x = xb_xcc_id(); b.st = st;
    if (threadIdx.x == 0) (void)xb_add(&bar[XB_XCNT(b.x)], 1u);
    return b;
}
__device__ __forceinline__ void xcd_barrier_complete(unsigned* bar, unsigned x, unsigned& nloc, unsigned& nx) {
    const unsigned G = gridDim.x * gridDim.y * gridDim.z;
    unsigned sum, cnt, mine, sp = 0u;
    for (;;) {
        sum = 0u; cnt = 0u; mine = 0u;
#pragma unroll
        for (unsigned j = 0; j < 16; ++j) { const unsigned c = xb_ld(&bar[XB_XCNT(j)]); sum += c; cnt += (c > 0u) ? 1u : 0u; mine = (j == x) ? c : mine; }
        if (sum == G) break;
        __builtin_amdgcn_s_sleep(1);
        if ((++sp & 255u) == 0u) { if (xb_ld(&bar[XB_TMO])) break; if (sp > XB_SPIN_CAP) { atomicAdd(&bar[XB_TMO], 1u); break; } }
    }
    nloc = mine > 0u ? mine : 1u; nx = cnt > 0u ? cnt : 1u;
}
__device__ __forceinline__ void xcd_barrier(const XcdBarrier& b, const int wave_s) {
    asm volatile("s_waitcnt vmcnt(0)" ::: "memory");
    __syncthreads();
    if (wave_s == 0 && __builtin_amdgcn_mbcnt_hi(~0u, __builtin_amdgcn_mbcnt_lo(~0u, 0u)) == 0u) {
        unsigned* bar = b.bar; asm volatile("" : "+v"(bar));
        __builtin_amdgcn_s_waitcnt(0);
        unsigned nloc = b.st[0], nx = b.st[1];
        if (nloc == 0u) { xcd_barrier_complete(bar, b.x, nloc, nx); b.st[0] = nloc; b.st[1] = nx; }
        const unsigned old = xb_add(&bar[XB_XSUB(b.x)], 1u);
        const unsigned gen = old / nloc;
        if (old + 1u == (gen + 1u) * nloc) {
            __builtin_amdgcn_fence(__ATOMIC_RELEASE, "agent");
            asm volatile("s_waitcnt vmcnt(0)" ::: "memory");
            const unsigned og = xb_add(&bar[XB_TOP], 1u);
            const unsigned tg = og / nx;
            if (og + 1u == (tg + 1u) * nx) xb_add(&bar[XB_TOPGEN], 1u);
            else XB_SPIN(xb_ld(&bar[XB_TOPGEN]) == tg, bar);
            __builtin_amdgcn_fence(__ATOMIC_ACQUIRE, "agent");
            xb_add(&bar[XB_XGEN(b.x)], 1u);
            asm volatile("s_waitcnt vmcnt(0)" ::: "memory");
        } else {
            XB_SPIN(xb_ld(&bar[XB_XGEN(b.x)]) == gen, bar);
            __builtin_amdgcn_fence(__ATOMIC_ACQUIRE, "agent");
            asm volatile("s_waitcnt vmcnt(0)" ::: "memory");
        }
    }
    __syncthreads();
}

struct Args { const float* in[N_IN]; float* out; unsigned char* ws; int ph_lo, ph_hi; };

struct Frame {
    LAS unsigned char* lds;
    int tid, lane, wave, vcu, G;
    const float* const* in; float* out; unsigned char* ws;
};

__device__ __forceinline__ const float* inp(const Frame& F, int k) { const float* p = F.in[k]; asm volatile("" : "+s"(p)); return p; }

struct SchedPlain {
    pg8::Rect R; const char* A; const char* B; size_t tsA, tsB; int xM, xN0, xNn;
    __device__ __forceinline__ bool next(int i, Unit& u) const {
        const int L = i * R.G + R.c;
        if (R.map(L, u.pm, u.pn)) {} else { const int e = L - R.nwg; if (e >= xM * xNn) return false; u.pm = R.nM + e / xNn; u.pn = xN0 + e % xNn; }
        u.seg = 0; u.ex = 0; u.A = A + (size_t)u.pm * tsA; u.B = B + (size_t)u.pn * tsB; return true;
    }
};
struct SchedMerge {
    pg8::Rect R; const char* A; const char* B; size_t tsA, tsB, sA, sB;
    __device__ __forceinline__ bool next(int i, Unit& u) const {
        const int ti = i / 3, sg = i - 3 * ti; const int L = ti * R.G + R.c;
        if (!R.map(L, u.pm, u.pn)) return false;
        u.seg = sg; u.ex = 0;
        u.A = A + (size_t)sg * sA + (size_t)u.pm * tsA; u.B = B + (size_t)sg * sB + (size_t)u.pn * tsB; return true;
    }
};
struct SchedMoe {
    pg8::Rect R; const char* A; const char* B; size_t tsA, tsB, esB; const int* tile_e; int tile0; bool a_global;
    __device__ __forceinline__ bool next(int i, Unit& u) const {
        const int L = i * R.G + R.c;
        if (!R.map(L, u.pm, u.pn)) return false;
        const int gt = tile0 + u.pm; u.ex = gt; u.seg = 0; const int e = tile_e[gt];
        u.A = A + (size_t)(a_global ? gt : u.pm) * tsA; u.B = B + (size_t)e * esB + (size_t)u.pn * tsB; return true;
    }
};

typedef const f32x4 (&AccRef)[2][2][4][2];
__device__ __forceinline__ v4u pack8(const f32x4 a, const f32x4 b) { v4u w; w.x = pg8::cvt_pk_bf16(a[0], a[1]); w.y = pg8::cvt_pk_bf16(a[2], a[3]); w.z = pg8::cvt_pk_bf16(b[0], b[1]); w.w = pg8::cvt_pk_bf16(b[2], b[3]); return w; }
__device__ __forceinline__ void unpack8(const v4u w, f32x4& a, f32x4& b) { a = (f32x4){bflo(w.x), bfhi(w.x), bflo(w.y), bfhi(w.y)}; b = (f32x4){bflo(w.z), bfhi(w.z), bflo(w.w), bfhi(w.w)}; }

struct EpiInproj {
    static constexpr bool PERM = true;
    bf16* phyT; bf16* ucf; bf16* ps5;
    __device__ __forceinline__ void operator()(AccRef acc, const Unit& u, int wr, int wc, int fr, int fq) const {
        const int row0 = u.pm * 256 + wr * 64 + fr;
        if (u.pn < 6) {
#pragma unroll
            for (int ai = 0; ai < 2; ++ai)
#pragma unroll
                for (int m = 0; m < 4; ++m) { const int r = row0 + ai * 128 + m * 16;
#pragma unroll
                    for (int bj = 0; bj < 2; ++bj)
#pragma unroll
                        for (int n = 0; n < 2; ++n)
#pragma unroll
                            for (int j = 0; j < 4; ++j) { const int c = u.pn * 256 + bj * 128 + wc * 32 + 8 * fq + 4 * n + j; phyT[(size_t)c * RT + r] = (bf16)f2bf(acc[ai][bj][m][n][j]); } }
        } else if (u.pn < 10) {
            const int col0 = (u.pn - 6) * 128 + wc * 32 + 8 * fq;
#pragma unroll
            for (int ai = 0; ai < 2; ++ai)
#pragma unroll
                for (int m = 0; m < 4; ++m) { const int r = row0 + ai * 128 + m * 16; f32x4 o[2];
#pragma unroll
                    for (int n = 0; n < 2; ++n)
#pragma unroll
                        for (int j = 0; j < 4; ++j) o[n][j] = acc[ai][0][m][n][j] * sigmoidf_(acc[ai][1][m][n][j]);
                    *(v4u*)(ucf + (size_t)r * 512 + col0) = pack8(o[0], o[1]); }
        } else {
#pragma unroll
            for (int ai = 0; ai < 2; ++ai)
#pragma unroll
                for (int m = 0; m < 4; ++m) { const int r = row0 + ai * 128 + m * 16;
#pragma unroll
                    for (int bj = 0; bj < 2; ++bj) { const int col0 = (u.pn - 10) * 256 + bj * 128 + wc * 32 + 8 * fq; *(v4u*)(ps5 + (size_t)r * 512 + col0) = pack8(acc[ai][bj][m][0], acc[ai][bj][m][1]); } }
        }
    }
};
struct EpiGates {
    static constexpr bool PERM = true;
    bf16* O;
    __device__ __forceinline__ void operator()(AccRef acc, const Unit& u, int wr, int wc, int fr, int fq) const {
        const int row0 = u.pm * 256 + wr * 64 + fr;
#pragma unroll
        for (int ai = 0; ai < 2; ++ai)
#pragma unroll
            for (int m = 0; m < 4; ++m) { const int r = row0 + ai * 128 + m * 16;
#pragma unroll
                for (int bj = 0; bj < 2; ++bj) { const int col0 = u.pn * 256 + bj * 128 + wc * 32 + 8 * fq; f32x4 o[2];
#pragma unroll
                    for (int n = 0; n < 2; ++n)
#pragma unroll
                        for (int j = 0; j < 4; ++j) o[n][j] = sigmoidf_(acc[ai][bj][m][n][j]);
                    *(v4u*)(O + (size_t)r * 3072 + col0) = pack8(o[0], o[1]); } }
    }
};
struct EpiGlu {
    static constexpr bool PERM = true;
    const bf16* SG; bf16* O; const float* bglu;
    __device__ __forceinline__ void operator()(AccRef acc, const Unit& u, int wr, int wc, int fr, int fq) const {
        const int row0 = u.pm * 256 + wr * 64 + fr;
#pragma unroll
        for (int bj = 0; bj < 2; ++bj) { const int col0 = u.pn * 256 + bj * 128 + wc * 32 + 8 * fq;
            const f32x4 b0 = *(const f32x4*)(bglu + col0), b1 = *(const f32x4*)(bglu + col0 + 4);
#pragma unroll
            for (int ai = 0; ai < 2; ++ai)
#pragma unroll
                for (int m = 0; m < 4; ++m) { const int r = row0 + ai * 128 + m * 16;
                    const v4u gw = *(const v4u*)(SG + (size_t)r * 512 + col0); f32x4 g0, g1; unpack8(gw, g0, g1); f32x4 o0, o1;
#pragma unroll
                    for (int j = 0; j < 4; ++j) { o0[j] = g0[j] * sigmoidf_(acc[ai][bj][m][0][j] + b0[j]); o1[j] = g1[j] * sigmoidf_(acc[ai][bj][m][1][j] + b1[j]); }
                    *(v4u*)(O + (size_t)r * 512 + col0) = pack8(o0, o1); } }
    }
};
struct EpiMerge {
    static constexpr bool PERM = true;
    const bf16* GT; bf16* O;
    __device__ __forceinline__ void operator()(AccRef acc, const Unit& u, int wr, int wc, int fr, int fq) const {
        const int row0 = u.pm * 256 + wr * 64 + fr;
#pragma unroll
        for (int ai = 0; ai < 2; ++ai)
#pragma unroll
            for (int m = 0; m < 4; ++m) { const int r = row0 + ai * 128 + m * 16;
#pragma unroll
                for (int bj = 0; bj < 2; ++bj) { const int col0 = u.pn * 256 + bj * 128 + wc * 32 + 8 * fq;
                    const v4u gw = *(const v4u*)(GT + (size_t)r * 3072 + u.seg * 1024 + col0); f32x4 g0, g1; unpack8(gw, g0, g1);
                    f32x4 o0 = g0 * acc[ai][bj][m][0], o1 = g1 * acc[ai][bj][m][1];
                    bf16* dst = O + (size_t)r * 1024 + col0;
                    if (u.seg > 0) { const v4u pw = *(const v4u*)dst; f32x4 p0, p1; unpack8(pw, p0, p1); o0 += p0; o1 += p1; }
                    *(v4u*)dst = pack8(o0, o1); } }
    }
};
struct EpiRes {
    static constexpr bool PERM = false;
    const float* xl; const float* xc; float* ol; float* oc; const float* gbase; float sc;
    __device__ __forceinline__ void operator()(AccRef acc, const Unit& u, int wr, int wc, int fr, int fq) const {
        const bool isl = u.pm < (NX / 256);
        const int prow = isl ? u.pm * 256 : (u.pm - NX / 256) * 256; const int mi = isl ? (u.pm >> 3) : 16;
        const float* xs = isl ? xl : xc; float* os = isl ? ol : oc; const float* gv = gbase + (size_t)mi * INC;
        const int row0 = prow + wr * 64 + fr, col0 = u.pn * 256 + wc * 32 + 4 * fq;
#pragma unroll
        for (int bj = 0; bj < 2; ++bj)
#pragma unroll
            for (int n = 0; n < 2; ++n) { const int c = col0 + bj * 128 + n * 16; const f32x4 g = *(const f32x4*)(gv + c) * sc;
#pragma unroll
                for (int ai = 0; ai < 2; ++ai)
#pragma unroll
                    for (int m = 0; m < 4; ++m) { const size_t off = (size_t)(row0 + ai * 128 + m * 16) * 1024 + c;
                        const f32x4 xr = *(const f32x4*)(xs + off); *(f32x4*)(os + off) = xr * ALPHA_F + g * acc[ai][bj][m][n]; } }
    }
};
struct EpiSwiglu {
    static constexpr bool PERM = true;
    bf16* O; int ldc;
    __device__ __forceinline__ void operator()(AccRef acc, const Unit& u, int wr, int wc, int fr, int fq) const {
        const int row0 = u.pm * 256 + wr * 64 + fr, col0 = u.pn * 128 + wc * 32 + 8 * fq;
#pragma unroll
        for (int ai = 0; ai < 2; ++ai)
#pragma unroll
            for (int m = 0; m < 4; ++m) { const int r = row0 + ai * 128 + m * 16; f32x4 o[2];
#pragma unroll
                for (int n = 0; n < 2; ++n)
#pragma unroll
                    for (int j = 0; j < 4; ++j) o[n][j] = siluf_(acc[ai][0][m][n][j]) * acc[ai][1][m][n][j];
                *(v4u*)(O + (size_t)r * ldc + col0) = pack8(o[0], o[1]); }
    }
};
struct EpiSwigluF8 {
    static constexpr bool PERM = true;
    unsigned char* O; int ldc; float sc;
    __device__ __forceinline__ void operator()(AccRef acc, const Unit& u, int wr, int wc, int fr, int fq) const {
        const int row0 = u.pm * 256 + wr * 64 + fr, col0 = u.pn * 128 + wc * 32 + 8 * fq;
#pragma unroll
        for (int ai = 0; ai < 2; ++ai)
#pragma unroll
            for (int m = 0; m < 4; ++m) { const int r = row0 + ai * 128 + m * 16; f32x4 o[2];
#pragma unroll
                for (int n = 0; n < 2; ++n)
#pragma unroll
                    for (int j = 0; j < 4; ++j) o[n][j] = siluf_(acc[ai][0][m][n][j] * sc) * (acc[ai][1][m][n][j] * sc);
                v2u w; w.x = pk4_fp8(o[0][0], o[0][1], o[0][2], o[0][3]); w.y = pk4_fp8(o[1][0], o[1][1], o[1][2], o[1][3]);
                *(v2u*)(O + (size_t)r * ldc + col0) = w; }
    }
};
struct EpiMoeDown {
    static constexpr bool PERM = true;
    bf16* O; float sc;
    __device__ __forceinline__ void operator()(AccRef acc, const Unit& u, int wr, int wc, int fr, int fq) const {
        const int row0 = u.ex * 256 + wr * 64 + fr;
#pragma unroll
        for (int ai = 0; ai < 2; ++ai)
#pragma unroll
            for (int m = 0; m < 4; ++m) { const int r = row0 + ai * 128 + m * 16;
#pragma unroll
                for (int bj = 0; bj < 2; ++bj) { const int col0 = u.pn * 256 + bj * 128 + wc * 32 + 8 * fq; *(v4u*)(O + (size_t)r * 1024 + col0) = pack8(acc[ai][bj][m][0] * sc, acc[ai][bj][m][1] * sc); } }
    }
};

template <bool F8>
__device__ __forceinline__ void transpose_item64(const float* W, int K, int N, unsigned char* WT, int dst_row0, int k0, int n0, float scale, LAS float* scr, int lane) {
#pragma unroll 4
    for (int i = 0; i < 16; ++i) { const int row = 4 * i + (lane >> 4), nc = 4 * (lane & 15);
        const f32x4 v = *(const f32x4*)(W + (size_t)(k0 + row) * N + n0 + nc); *(LAS f32x4*)(scr + row * 68 + nc) = v * scale; }
    LDS_WAIT(); asm volatile("" ::: "memory");
    const LAS float* sp = scr + lane;
    if constexpr (F8) {
        unsigned char* dst = WT + (size_t)(dst_row0 + lane) * K + k0;
#pragma unroll
        for (int c4 = 0; c4 < 4; ++c4) { v4u o;
#pragma unroll
            for (int e = 0; e < 4; ++e) { const int kk = 16 * c4 + 4 * e; o[e] = pk4_fp8(sp[(kk + 0) * 68], sp[(kk + 1) * 68], sp[(kk + 2) * 68], sp[(kk + 3) * 68]); }
            *(v4u*)(dst + 16 * c4) = o; }
    } else {
        unsigned char* dst = WT + ((size_t)(dst_row0 + lane) * K + k0) * 2;
#pragma unroll
        for (int c8 = 0; c8 < 8; ++c8) { v4u o;
#pragma unroll
            for (int e = 0; e < 4; ++e) { const int kk = 8 * c8 + 2 * e; o[e] = pk2(sp[kk * 68], sp[(kk + 1) * 68]); }
            *(v4u*)(dst + 16 * c8) = o; }
    }
    LDS_WAIT(); asm volatile("" ::: "memory");
}
__device__ __forceinline__ int dst_row_map(int kind, int n0) {
    if (kind == 1) { if (n0 >= 1536 && n0 < 2560) { const int i = (n0 - 1536) & 511, hi = (n0 - 1536) >> 9; return 1536 + 256 * (i >> 7) + 128 * hi + (i & 127); } return n0; }
    if (kind == 2) return 256 * (n0 >> 7) + (n0 & 127);
    if (kind == 3) return 256 * (n0 >> 7) + 128 + (n0 & 127);
    return n0;
}
__device__ __forceinline__ void conv_matrix_item(const float* W, int K, int N, bf16* WT, int kind, int item, LAS float* scr, int lane) {
    const int nblk = N / 64, kb = item / nblk, nb = item - kb * nblk;
    transpose_item64<false>(W, K, N, (unsigned char*)WT, dst_row_map(kind, 64 * nb), 64 * kb, 64 * nb, 1.0f, scr, lane);
}
__device__ __forceinline__ void conv_matrix_item_f8(const float* W, int K, int N, unsigned char* WT, int kind, int item, float scale, LAS float* scr, int lane) {
    const int nblk = N / 64, kb = item / nblk, nb = item - kb * nblk;
    transpose_item64<true>(W, K, N, WT, dst_row_map(kind, 64 * nb), 64 * kb, 64 * nb, scale, scr, lane);
}
__device__ __forceinline__ void p0a_prologue(Frame& F) {
    LAS float* scr = (LAS float*)(F.lds + F.wave * 17408);
    const int gw = F.vcu * NWAVES + F.wave, NGW = F.G * NWAVES;
    bf16* ws_win = (bf16*)(F.ws + WS_WIN); bf16* ws_outs = (bf16*)(F.ws + WS_WOUTS); bf16* ws_glu = (bf16*)(F.ws + WS_WGLU); bf16* ws_wo = (bf16*)(F.ws + WS_WO);
    bf16* ws_w13 = (bf16*)(F.ws + WS_W13); bf16* ws_w2 = (bf16*)(F.ws + WS_W2);
    constexpr int I_IN = (1024 / 64) * (6144 / 64), I_OUT = (512 / 64) * (1024 / 64), I_GLU = (512 / 64) * (512 / 64), I_WOI = (1024 / 64) * (1024 / 64), I_F1 = (1024 / 64) * (2816 / 64), I_F2 = (2816 / 64) * (1024 / 64);
    constexpr int NITEMS = 2 * I_IN + 6 * I_OUT + 2 * I_GLU + 2 * I_WOI + 2 * I_F1 + I_F2;
    for (int it = gw; it < NITEMS; it += NGW) {
        int r = it;
        if (r < 2 * I_IN) { const int l = r / I_IN; conv_matrix_item(inp(F, I_WIN) + (size_t)l * 1024 * 6144, 1024, 6144, ws_win + (size_t)l * 6144 * 1024, 1, r - l * I_IN, scr, F.lane); continue; } r -= 2 * I_IN;
        if (r < 6 * I_OUT) { const int q = r / I_OUT, l = q / 3, s = q - 3 * l; const float* src = inp(F, s == 0 ? I_WHY : (s == 1 ? I_WCF : I_WS5)) + (size_t)l * 512 * 1024;
            conv_matrix_item(src, 512, 1024, ws_outs + (size_t)(l * 3 + s) * 1024 * 512, 0, r - q * I_OUT, scr, F.lane); continue; } r -= 6 * I_OUT;
        if (r < 2 * I_GLU) { const int l = r / I_GLU; conv_matrix_item(inp(F, I_SWGLU) + (size_t)l * 512 * 512, 512, 512, ws_glu + (size_t)l * 512 * 512, 0, r - l * I_GLU, scr, F.lane); continue; } r -= 2 * I_GLU;
        if (r < 2 * I_WOI) { const int l = r / I_WOI; conv_matrix_item(inp(F, I_WO) + (size_t)l * 1024 * 1024, 1024, 1024, ws_wo + (size_t)l * 1024 * 1024, 0, r - l * I_WOI, scr, F.lane); continue; } r -= 2 * I_WOI;
        if (r < I_F1) { conv_matrix_item_f8(inp(F, I_FFW1), 1024, 2816, (unsigned char*)ws_w13, 2, r, 32.f, scr, F.lane); continue; } r -= I_F1;
        if (r < I_F1) { conv_matrix_item_f8(inp(F, I_FFW3), 1024, 2816, (unsigned char*)ws_w13, 3, r, 32.f, scr, F.lane); continue; } r -= I_F1;
        conv_matrix_item_f8(inp(F, I_FFW2), 2816, 1024, (unsigned char*)ws_w2, 0, r, 128.f, scr, F.lane);
    }
    __syncthreads();
    float* part = (float*)(F.ws + WS_HX);
    LAS float* sc = (LAS float*)F.lds;
    for (int it = F.vcu; it < 2 * 8 * 12; it += F.G) {
        const int l = it / 96, r = it - l * 96, ks = r / 12, nb = r - ks * 12;
        __syncthreads();
        for (int e = F.tid; e < 17 * 128; e += 512) { const int i = e >> 7, k = e & 127; const float cv = i < 16 ? inp(F, I_C)[i * 1024 + ks * 128 + k] : inp(F, I_CCTX)[ks * 128 + k]; sc[k * 20 + i] = siluf_(cv); }
        __syncthreads();
        const int n = nb * 512 + F.tid; const float* w = inp(F, I_WMOD) + (size_t)l * 1024 * 6144 + (size_t)(ks * 128) * 6144 + n;
        float acc[17];
#pragma unroll
        for (int i = 0; i < 17; ++i) acc[i] = 0.f;
        for (int k = 0; k < 128; ++k) { const float wv = w[(size_t)k * 6144];
#pragma unroll
            for (int i = 0; i < 17; ++i) acc[i] += sc[k * 20 + i] * wv; }
#pragma unroll
        for (int i = 0; i < 17; ++i) part[((size_t)(ks * 2 + l) * 17 + i) * 6144 + n] = acc[i];
    }
}
__device__ __forceinline__ void p0b_mods(Frame& F) {
    const float* part = (const float*)(F.ws + WS_HX); float* mods = (float*)(F.ws + WS_MODS);
    for (int e = F.vcu * 512 + F.tid; e < 2 * 17 * 6144; e += F.G * 512) {
        const int l = e / (17 * 6144), r = e - l * 17 * 6144, i = r / 6144, n = r - i * 6144;
        float s = inp(F, I_BMOD)[l * 6144 + n];
#pragma unroll
        for (int ks = 0; ks < 8; ++ks) s += part[((size_t)(ks * 2 + l) * 17 + i) * 6144 + n];
        mods[e] = s;
    }
}

__device__ __forceinline__ void h2table_phase(Frame& F, int l) {
    const int gw = F.vcu * NWAVES + F.wave, NGW = F.G * NWAVES, lane = F.lane;
    float* H2 = (float*)(F.ws + WS_FILT);
    const float* w1 = inp(F, I_FW1) + l * 33 * 64; const float* b1 = inp(F, I_FB1) + l * 64; const float* w2 = inp(F, I_FW2) + l * 64 * 64; const float* b2 = inp(F, I_FB2) + l * 64;
    const float* fq = inp(F, I_FREQ) + l * 128;
    for (int pos = gw; pos < LSEQ + LCTX; pos += NGW) {
        const bool isc = pos >= LSEQ; const int L = isc ? LCTX : LSEQ; const int t = isc ? pos - LSEQ : pos;
        const float tn = (float)t / (float)(L - 1);
        float z = 0.f;
        if (lane == 0) z = tn;
        else if (lane <= 32) { const int band = lane <= 16 ? lane : lane - 16; const int ph = (t * band) % L; const float ang = 6.283185307179586f * ((float)ph / (float)L); z = lane <= 16 ? cosf(ang) : sinf(ang); }
        float h = b1[lane];
        for (int k = 0; k < 33; ++k) h += lane_bcast(z, k) * w1[k * 64 + lane];
        h = sinf(fq[lane] * h);
        float h2 = b2[lane];
        for (int k = 0; k < 64; ++k) h2 += lane_bcast(h, k) * w2[k * 64 + lane];
        H2[(size_t)pos * 64 + lane] = sinf(fq[64 + lane] * h2);
    }
}
__device__ __forceinline__ void filter_expand_phase(Frame& F, int l) {
    const int gw = F.vcu * NWAVES + F.wave, NGW = F.G * NWAVES, lane = F.lane;
    const float* H2 = (const float*)(F.ws + WS_FILT);
    const float* w3 = inp(F, I_FW3) + (size_t)l * 64 * 2048; const float* b3 = inp(F, I_FB3) + l * 2048; const float* dec = inp(F, I_DECAY) + l * 2048; const float* hb = inp(F, I_HBIAS) + l * 1024;
    LAS float* W = (LAS float*)(F.lds + F.wave * 17408);
#pragma unroll 1
    for (int it = gw; it < 1024 + 128; it += NGW) {
        const bool isc = it >= 1024; const int ii = isc ? it - 1024 : it; const int chunk = ii >> 5, grp = ii & 31;
        const int L = isc ? LCTX : LSEQ; const int t = chunk * 64 + lane; const int pos = isc ? LSEQ + t : t;
        bf16* KR = isc ? (bf16*)(F.ws + WS_KRC) : (bf16*)(F.ws + WS_KRL); const int KLEN = 2 * L;
        const float tn = (float)t / (float)(L - 1);
#pragma unroll 4
        for (int k = 0; k < 64; ++k) W[lane * 68 + k] = w3[(size_t)k * 2048 + grp * 64 + lane];
        f32x4 h2[16];
#pragma unroll
        for (int k = 0; k < 16; ++k) h2[k] = *(const f32x4*)(H2 + (size_t)pos * 64 + 4 * k);
        const int colL = grp * 64 + lane; const float b3L = b3[colL], decL = fabsf(dec[colL]); const float hbL = ((colL >> 9) & 1) == 0 ? hb[(colL >> 10) * 512 + (colL & 511)] : 0.f;
        LDS_WAIT();
#pragma unroll 1
        for (int cc = 0; cc < 64; ++cc) {
            const int col = grp * 64 + cc; float a = lane_bcast(b3L, cc);
#pragma unroll
            for (int k = 0; k < 16; ++k) { const f32x4 wv = *(const LAS f32x4*)(W + cc * 68 + 4 * k); a += (h2[k][0] * wv[0] + h2[k][1] * wv[1]) + (h2[k][2] * wv[2] + h2[k][3] * wv[3]); }
            const int o = col >> 10, dir = (col >> 9) & 1, c = col & 511;
            float v = a * __expf(-tn * lane_bcast(decL, cc));
            if (t == 0 && dir == 0) v += lane_bcast(hbL, cc);
            const bool valid = !(t == 0 && dir == 1);
            const int i = dir ? L + t : L - t;
            const unsigned short bv = (unsigned short)f2bf(v);
            bf16* base = (valid ? KR + (size_t)((o * 512 + c) * 8) * KLEN : (bf16*)(F.ws + WS_KDUMMY) + 16) + i;
#pragma unroll
            for (int m = 0; m < 8; ++m) base[(ptrdiff_t)m * (KLEN - 1)] = bv;
        }
        LDS_WAIT();
    }
    __syncthreads();
}
__device__ __forceinline__ void s5params_phase(Frame& F, int l) {
    float* P = (float*)(F.ws + WS_S5P);
    for (int e = F.vcu * 512 + F.tid; e < 2 * 32 * 64; e += F.G * 512) {
        const int base = l * 4096 + e;
        const int dg = e >> 6;
        const float lam_re = fminf(inp(F, I_SARE)[base], -1e-4f), lam_im = inp(F, I_SAIM)[base];
        const float dt = expf(inp(F, I_SLDT)[l * 64 + dg]);
        const float mag = expf(lam_re * dt), ang = lam_im * dt; const float abr = mag * cosf(ang), abi = mag * sinf(ang);
        const float den = lam_re * lam_re + lam_im * lam_im;
        const float qre = ((abr - 1.0f) * lam_re + abi * lam_im) / den, qim = (abi * lam_re - (abr - 1.0f) * lam_im) / den;
        float* o = P + (size_t)e * 36; o[0] = abr; o[1] = abi;
        const float* br = inp(F, I_SBRE) + (size_t)base * 16; const float* bi = inp(F, I_SBIM) + (size_t)base * 16;
        for (int c = 0; c < 16; ++c) { o[2 + c] = qre * br[c] - qim * bi[c]; o[18 + c] = qre * bi[c] + qim * br[c]; }
        o[34] = 0.f; o[35] = 0.f;
    }
}

struct Row { f32x4 v[4]; };
__device__ __forceinline__ void row_load(Row& r, const float* p, int lane) { const f32x4* x = (const f32x4*)p + lane;
#pragma unroll
    for (int j = 0; j < 4; ++j) r.v[j] = x[64 * j]; }
__device__ __forceinline__ void row_store(const Row& r, float* p, int lane) { f32x4* x = (f32x4*)p + lane;
#pragma unroll
    for (int j = 0; j < 4; ++j) x[64 * j] = r.v[j]; }
__device__ __forceinline__ void row_norm(Row& r) {
    float s = 0.f;
#pragma unroll
    for (int j = 0; j < 4; ++j) s += (r.v[j][0] + r.v[j][1]) + (r.v[j][2] + r.v[j][3]);
    const float mean = wave_sum(s) * (1.f / DM); float q = 0.f;
#pragma unroll
    for (int j = 0; j < 4; ++j) { r.v[j] = r.v[j] - mean; q += (r.v[j][0] * r.v[j][0] + r.v[j][1] * r.v[j][1]) + (r.v[j][2] * r.v[j][2] + r.v[j][3] * r.v[j][3]); }
    const float rstd = 1.f / sqrtf(wave_sum(q) * (1.f / DM) + LN_EPS);
#pragma unroll
    for (int j = 0; j < 4; ++j) r.v[j] = r.v[j] * rstd;
}
__device__ __forceinline__ void row_affine(Row& r, const float* g, const float* b, int lane, float gadd) {
    const f32x4* gp = (const f32x4*)g + lane; const f32x4* bp = (const f32x4*)b + lane;
#pragma unroll
    for (int j = 0; j < 4; ++j) r.v[j] = r.v[j] * (gp[64 * j] + gadd) + bp[64 * j];
}
__device__ __forceinline__ void row_store_bf16(const Row& r, bf16* p, int lane) { unsigned long long* o = (unsigned long long*)p + lane;
#pragma unroll
    for (int j = 0; j < 4; ++j) o[64 * j] = (unsigned long long)pk2(r.v[j][0], r.v[j][1]) | ((unsigned long long)pk2(r.v[j][2], r.v[j][3]) << 32); }

__device__ __forceinline__ const float* mod_vec(Frame& F, int l, int row, int which) { const int i = row < NX ? (row >> 11) : 16; return (const float*)(F.ws + WS_MODS) + ((size_t)l * 17 + i) * INC + which * 1024; }
__device__ __forceinline__ const float* xrow_ptr(Frame& F, int l, int row) {
    if (l == 0) return row < NX ? inp(F, I_X) + (size_t)row * DM : inp(F, I_CTX) + (size_t)(row - NX) * DM;
    return row < NX ? F.out + (size_t)row * DM : (const float*)(F.ws + WS_XC) + (size_t)(row - NX) * DM;
}
__device__ __forceinline__ float* xcur_ptr(Frame& F, int row) { return row < NX ? F.out + (size_t)row * DM : (float*)(F.ws + WS_XC) + (size_t)(row - NX) * DM; }

__device__ __forceinline__ void lnmod_phase(Frame& F, int l) {
    const int gw = F.vcu * NWAVES + F.wave, NGW = F.G * NWAVES; bf16* hx = (bf16*)(F.ws + WS_HX);
    for (int m = gw; m < RT; m += NGW) { Row r; row_load(r, xrow_ptr(F, l, m), F.lane); row_norm(r); row_affine(r, mod_vec(F, l, m, 1), mod_vec(F, l, m, 0), F.lane, 1.0f); row_store_bf16(r, hx + (size_t)m * DM, F.lane); }
}
__device__ __forceinline__ void ln1_phase(Frame& F, int l) {
    const int gw = F.vcu * NWAVES + F.wave, NGW = F.G * NWAVES; bf16* hx = (bf16*)(F.ws + WS_HX); const int M = l == 0 ? RT : NX;
    const float* g = inp(F, I_LN1G) + l * DM; const float* b = inp(F, I_LN1B) + l * DM;
    int* toke = (int*)(F.ws + WS_META + META_TOKE); float* tokw = (float*)(F.ws + WS_META + META_TOKW);
    LAS unsigned* lcnt = (LAS unsigned*)(F.lds);
    unsigned c8[8];
#pragma unroll
    for (int e = 0; e < 8; ++e) c8[e] = 0u;
    if (l == 1) { if (F.tid < 8) lcnt[F.tid] = 0u; __syncthreads(); }
    for (int m = gw; m < M; m += NGW) {
        float* xp = xcur_ptr(F, m); Row r; row_load(r, xp, F.lane); row_norm(r); row_affine(r, g, b, F.lane, 0.0f); row_store(r, xp, F.lane);
        row_norm(r); row_affine(r, mod_vec(F, l, m, 4), mod_vec(F, l, m, 3), F.lane, 1.0f);
        if (l == 0) { unsigned* d8 = (unsigned*)((unsigned char*)hx + (size_t)m * DM) + F.lane;
#pragma unroll
            for (int j = 0; j < 4; ++j) d8[64 * j] = pk4_fp8(r.v[j][0], r.v[j][1], r.v[j][2], r.v[j][3]); }
        else {
            const float* rt = inp(F, I_ROUTER); float lg[8];
#pragma unroll
            for (int e = 0; e < 8; ++e) lg[e] = 0.f;
#pragma unroll
            for (int j = 0; j < 4; ++j)
#pragma unroll
                for (int q = 0; q < 4; ++q) { const int k = 256 * j + 4 * F.lane + q; const f32x4 r0 = *(const f32x4*)(rt + k * 8), r1 = *(const f32x4*)(rt + k * 8 + 4); const float hv = r.v[j][q];
                    lg[0] += hv * r0[0]; lg[1] += hv * r0[1]; lg[2] += hv * r0[2]; lg[3] += hv * r0[3]; lg[4] += hv * r1[0]; lg[5] += hv * r1[1]; lg[6] += hv * r1[2]; lg[7] += hv * r1[3]; }
#pragma unroll
            for (int e = 0; e < 8; ++e) lg[e] = wave_sum(lg[e]);
            int e0 = 0; float v0 = lg[0];
#pragma unroll
            for (int e = 1; e < 8; ++e) if (lg[e] > v0) { v0 = lg[e]; e0 = e; }
            int e1 = -1; float v1 = -3.0e38f;
#pragma unroll
            for (int e = 0; e < 8; ++e) if (e != e0 && lg[e] > v1) { v1 = lg[e]; e1 = e; }
            const float ex = __expf(v1 - v0); const float w0 = 1.0f / (1.0f + ex), w1 = ex / (1.0f + ex);
            if (F.lane == 0) { toke[2 * m] = e0; toke[2 * m + 1] = e1; tokw[2 * m] = w0; tokw[2 * m + 1] = w1; }
#pragma unroll
            for (int e = 0; e < 8; ++e) c8[e] += (e0 == e ? 1u : 0u) + (e1 == e ? 1u : 0u);
        }
    }
    if (l == 1) {
        if (F.lane == 0) {
#pragma unroll
            for (int e = 0; e < 8; ++e) if (c8[e]) atomicAdd((unsigned*)&lcnt[e], c8[e]); }
        __syncthreads();
        if (F.tid < 8) { const unsigned v = lcnt[F.tid]; if (v) atomicAdd((unsigned*)(F.ws + WS_CTL) + CW_CNT + F.tid, v); }
        __syncthreads();
    }
}
__device__ __forceinline__ void ln2_phase(Frame& F, int l) {
    const int gw = F.vcu * NWAVES + F.wave, NGW = F.G * NWAVES;
    const float* g = inp(F, I_LN2G) + l * DM; const float* b = inp(F, I_LN2B) + l * DM;
    for (int m = gw; m < RT; m += NGW) { float* xp = xcur_ptr(F, m); Row r; row_load(r, xp, F.lane); row_norm(r); row_affine(r, g, b, F.lane, 0.0f); row_store(r, xp, F.lane); }
}

__device__ __forceinline__ void moe_convert_phase(Frame& F) {
    LAS float* scr = (LAS float*)(F.lds + 4096 + F.wave * 17408);
    const int gw = F.vcu * NWAVES + F.wave, NGW = F.G * NWAVES;
    unsigned char* w13 = F.ws + WS_MW13; unsigned char* w2 = F.ws + WS_MW2;
    constexpr int I1 = (1024 / 64) * (3584 / 64), I2 = (3584 / 64) * (1024 / 64);
    for (int it = gw; it < 8 * (2 * I1 + I2); it += NGW) {
        const int e = it / (2 * I1 + I2); int r = it - e * (2 * I1 + I2);
        if (r < I1) { conv_matrix_item_f8(inp(F, I_MW1) + (size_t)e * 1024 * 3584, 1024, 3584, w13 + (size_t)e * 7168 * 1024, 2, r, 32.f, scr, F.lane); continue; } r -= I1;
        if (r < I1) { conv_matrix_item_f8(inp(F, I_MW3) + (size_t)e * 1024 * 3584, 1024, 3584, w13 + (size_t)e * 7168 * 1024, 3, r, 32.f, scr, F.lane); continue; } r -= I1;
        conv_matrix_item_f8(inp(F, I_MW2) + (size_t)e * 3584 * 1024, 3584, 1024, w2 + (size_t)e * 1024 * 3584, 0, r, 128.f, scr, F.lane);
    }
}
__device__ __forceinline__ void moe_offsets(Frame& F, int (&off)[8], int& ntiles) {
    const unsigned* cnt = (const unsigned*)(F.ws + WS_CTL) + CW_CNT; int o = 0;
#pragma unroll
    for (int e = 0; e < 8; ++e) { off[e] = o; o += (int)((cnt[e] + 255u) & ~255u); }
    ntiles = o >> 8;
}
__device__ __forceinline__ void moe_setup_phase(Frame& F) {
    const int gw = F.vcu * NWAVES + F.wave, NGW = F.G * NWAVES, lane = F.lane;
    int off[8], ntiles; moe_offsets(F, off, ntiles);
    const int* toke = (const int*)(F.ws + WS_META + META_TOKE); int* tpos = (int*)(F.ws + WS_META + META_POS); int* tile_e = (int*)(F.ws + WS_META + META_TILE);
    unsigned* cur = (unsigned*)(F.ws + WS_CTL) + CW_CUR; unsigned char* srt = F.ws + WS_SORT;
    if (F.vcu == 0 && F.tid < 8) { const int e = F.tid; const int t0 = off[e] >> 8; const int t1 = (e == 7 ? ntiles : (off[e + 1] >> 8)); for (int t = t0; t < t1; ++t) tile_e[t] = e; if (e == 0) tile_e[511] = ntiles; }
    for (int base = gw; base < NX; base += 64 * NGW) {
        const int m = base + lane * NGW; const bool act = m < NX;
        const int e0 = act ? toke[2 * m] : -1, e1 = act ? toke[2 * m + 1] : -1;
        int p0 = 0, p1 = 0;
        const unsigned long long lt = (1ull << lane) - 1ull;
#pragma unroll
        for (int e = 0; e < 8; ++e) {
            const unsigned long long m0 = __ballot(e0 == e), m1 = __ballot(e1 == e);
            const int c = __popcll(m0) + __popcll(m1); int bs = 0;
            if (lane == 0 && c) bs = (int)atomicAdd(cur + e, (unsigned)c);
            bs = __builtin_amdgcn_readfirstlane(bs) + off[e];
            if (e0 == e) p0 = bs + __popcll(m0 & lt);
            if (e1 == e) p1 = bs + __popcll(m0) + __popcll(m1 & lt);
        }
        if (act) { tpos[2 * m] = p0; tpos[2 * m + 1] = p1; }
        const int nrows = (NX - base + NGW - 1) / NGW;
        for (int i = 0; i < 64 && i < nrows; ++i) {
            const int mi = base + i * NGW; const int q0 = __builtin_amdgcn_readlane(p0, i), q1 = __builtin_amdgcn_readlane(p1, i);
            Row r; row_load(r, F.out + (size_t)mi * DM, lane); row_norm(r); row_affine(r, mod_vec(F, 1, mi, 4), mod_vec(F, 1, mi, 3), lane, 1.0f);
            unsigned* d0 = (unsigned*)(srt + (size_t)q0 * DM) + lane; unsigned* d1 = (unsigned*)(srt + (size_t)q1 * DM) + lane;
#pragma unroll
            for (int j = 0; j < 4; ++j) { const unsigned w8 = pk4_fp8(r.v[j][0], r.v[j][1], r.v[j][2], r.v[j][3]); d0[64 * j] = w8; d1[64 * j] = w8; }
        }
    }
}
__device__ __forceinline__ void moe_combine_phase(Frame& F) {
    const int gw = F.vcu * NWAVES + F.wave, NGW = F.G * NWAVES, lane = F.lane;
    const float* tokw = (const float*)(F.ws + WS_META + META_TOKW); const int* tpos = (const int*)(F.ws + WS_META + META_POS); const bf16* Y = (const bf16*)(F.ws + WS_MOEY);
    const float* g = inp(F, I_LN2G) + DM; const float* b = inp(F, I_LN2B) + DM;
    for (int m = gw; m < NX; m += NGW) {
        const float w0 = tokw[2 * m], w1 = tokw[2 * m + 1]; const int p0 = tpos[2 * m], p1 = tpos[2 * m + 1];
        Row r; row_load(r, F.out + (size_t)m * DM, lane);
        const unsigned long long* y0 = (const unsigned long long*)(Y + (size_t)p0 * DM) + lane; const unsigned long long* y1 = (const unsigned long long*)(Y + (size_t)p1 * DM) + lane;
        const f32x4* g2 = (const f32x4*)mod_vec(F, 1, m, 5) + lane;
#pragma unroll
        for (int j = 0; j < 4; ++j) { const unsigned long long a = y0[64 * j], c = y1[64 * j];
            const f32x4 ya = (f32x4){bflo((unsigned)a), bfhi((unsigned)a), bflo((unsigned)(a >> 32)), bfhi((unsigned)(a >> 32))};
            const f32x4 yc = (f32x4){bflo((unsigned)c), bfhi((unsigned)c), bflo((unsigned)(c >> 32)), bfhi((unsigned)(c >> 32))};
            r.v[j] = r.v[j] * ALPHA_F + g2[64 * j] * (ya * w0 + yc * w1); }
        row_norm(r); row_affine(r, g, b, lane, 0.0f); row_store(r, F.out + (size_t)m * DM, lane);
    }
}

constexpr int HY_U_OFF = 0, HY_U_STRIDE = 4128, HY_K_OFF = 16 * HY_U_STRIDE, HY_K_STRIDE = 8208;
constexpr int HYC_U_STRIDE = 544, HYC_K_STRIDE = 1040;
static_assert(HY_K_OFF + 8 * HY_K_STRIDE + 64 <= MISC_OFF, "hyena LDS map");
__device__ __forceinline__ float hy_short4(const bf16* p, int tb, int L, float w0, float w1, float w2, float bs, f32x4& x) {
    const v2u pw = *(const v2u*)(p + tb); const float c0 = bflo(pw.x), c1 = bfhi(pw.x), c2 = bflo(pw.y), c3 = bfhi(pw.y);
    const float pm = tb > 0 ? bf2f(p[tb - 1]) : 0.f, pp = tb + 4 < L ? bf2f(p[tb + 4]) : 0.f;
    x[0] = bs + w0 * pm + w1 * c0 + w2 * c1; x[1] = bs + w0 * c0 + w1 * c1 + w2 * c2; x[2] = bs + w0 * c1 + w1 * c2 + w2 * c3; x[3] = bs + w0 * c2 + w1 * c3 + w2 * pp; return 0.f;
}
__device__ __forceinline__ void hy_short4u(const bf16* pi, bool first, bool last, float w0, float w1, float w2, float bs, f32x4& x) {
    const v2u pw = *(const v2u*)pi; const float c0 = bflo(pw.x), c1 = bfhi(pw.x), c2 = bflo(pw.y), c3 = bfhi(pw.y);
    float pm = bf2f(pi[-1]), pp = bf2f(pi[4]); pm = first ? 0.f : pm; pp = last ? 0.f : pp;
    x[0] = bs + w0 * pm + w1 * c0 + w2 * c1; x[1] = bs + w0 * c0 + w1 * c1 + w2 * c2; x[2] = bs + w0 * c1 + w1 * c2 + w2 * c3; x[3] = bs + w0 * c2 + w1 * c3 + w2 * pp;
}
template <int L, int USTR>
__device__ __forceinline__ void hy_fill_u(Frame& F, const bf16* phyT, int col, int rowb0, float w0, float w1, float w2, float bs) {
    const bf16* pc = phyT + (size_t)col * RT + rowb0;
    constexpr int NIT = 16 * L / 8 / 512 > 0 ? 16 * L / 8 / 512 : 1;
#pragma unroll 4
    for (int it = 0; it < NIT; ++it) { const int ch = F.tid + 512 * it; const int b = ch / (L / 8), tb = (ch - b * (L / 8)) * 8; const bf16* p = pc + (size_t)b * L + tb;
        const v4u cw = *(const v4u*)p; float pm = bf2f(p[-1]), pp = bf2f(p[8]); pm = tb == 0 ? 0.f : pm; pp = tb + 8 >= L ? 0.f : pp;
        const float c0 = bflo(cw.x), c1 = bfhi(cw.x), c2 = bflo(cw.y), c3 = bfhi(cw.y), c4 = bflo(cw.z), c5 = bfhi(cw.z), c6 = bflo(cw.w), c7 = bfhi(cw.w);
        v4u o; o.x = pk2(bs + w0 * pm + w1 * c0 + w2 * c1, bs + w0 * c0 + w1 * c1 + w2 * c2); o.y = pk2(bs + w0 * c1 + w1 * c2 + w2 * c3, bs + w0 * c2 + w1 * c3 + w2 * c4);
        o.z = pk2(bs + w0 * c3 + w1 * c4 + w2 * c5, bs + w0 * c4 + w1 * c5 + w2 * c6); o.w = pk2(bs + w0 * c5 + w1 * c6 + w2 * c7, bs + w0 * c6 + w1 * c7 + w2 * pp);
        *(LAS v4u*)(F.lds + HY_U_OFF + b * USTR + tb * 2) = o; }
}
template <int KLEN, int KSTR>
__device__ __forceinline__ void hy_fill_k(Frame& F, const bf16* kr) {
    const bf16* src = kr + (size_t)F.wave * KLEN + F.lane * 8;
#pragma unroll
    for (int i = 0; i < KLEN * 2 / 1024; ++i)
        __builtin_amdgcn_global_load_lds((const unsigned*)(src + i * 512), (LAS unsigned*)(F.lds + HY_K_OFF + F.wave * KSTR + i * 1024), 16, 0, 0);
    VM_WAIT();
}
__device__ __forceinline__ void hyena_unit(Frame& F, int l, int c, bool with_ctx) {
    const bf16* phyT = (const bf16*)(F.ws + WS_PHYT); bf16* z2 = (bf16*)(F.ws + WS_Z2);
    const bf16* KRL = (const bf16*)(F.ws + WS_KRL); const bf16* KRC = (const bf16*)(F.ws + WS_KRC);
    const float* sw = inp(F, I_HSW) + l * 3 * 1536; const float* sb = inp(F, I_HSB) + l * 1536;
    const int lane = F.lane, w = F.wave, r = lane & 15, q = lane >> 4, m = (-r) & 7;
    __syncthreads();
    { const int col = 1024 + c; hy_fill_u<LSEQ, HY_U_STRIDE>(F, phyT, col, 0, sw[col], sw[1536 + col], sw[3072 + col], sb[col]); }
    hy_fill_k<4096, HY_K_STRIDE>(F, KRL + (size_t)((0 * 512 + c) * 8) * 4096);
    __syncthreads();
#pragma unroll 1
    for (int o = 0; o < 2; ++o) {
        f32x4 acc[16];
#pragma unroll 1
        for (int rep_ = 0; rep_ < NREP(15); ++rep_) {
#pragma unroll
        for (int i = 0; i < 16; ++i) acc[i] = (f32x4){0.f, 0.f, 0.f, 0.f};
        const LAS unsigned char* pa = F.lds + HY_K_OFF + m * HY_K_STRIDE + 2 * (8 * q - r - m + 2048 - 256 * w);
        const LAS unsigned char* pb = F.lds + HY_U_OFF + r * HY_U_STRIDE + 16 * q;
        bf16x8 R[16];
#pragma unroll
        for (int i = 0; i < 16; ++i) R[i] = *(const LAS bf16x8*)(pa - 32 * i);
        bf16x8 bcur = *(const LAS bf16x8*)pb;
#pragma unroll 1
        for (int kg = 0; kg < 8; ++kg) {
#pragma unroll
            for (int kk = 0; kk < 8; ++kk) {
                const bf16x8 bnext = *(const LAS bf16x8*)(pb + 64 * (kk + 1));
                const bf16x8 n0 = *(const LAS bf16x8*)(pa + 64 * (kk + 1)), n1 = *(const LAS bf16x8*)(pa + 64 * (kk + 1) - 32);
#pragma unroll
                for (int i = 0; i < 16; ++i) acc[i] = __builtin_amdgcn_mfma_f32_16x16x32_bf16(R[(i - 2 * kk) & 15], bcur, acc[i], 0, 0, 0);
                R[(-2 * (kk + 1)) & 15] = n0; R[(1 - 2 * (kk + 1)) & 15] = n1; bcur = bnext;
                __builtin_amdgcn_sched_barrier(0);
            }
            pa += 512; pb += 512;
        }
        }
        const int col = o * 512 + c; const float w0 = sw[col], w1 = sw[1536 + col], w2 = sw[3072 + col], bs = sb[col];
        int tb0 = 256 * w + 4 * q; asm volatile("" : "+v"(tb0));
        const bf16* p = phyT + (size_t)col * RT + (size_t)r * LSEQ + tb0;
#pragma unroll
        for (int i = 0; i < 16; ++i) { f32x4 x; hy_short4u(p + 16 * i, tb0 + 16 * i == 0, tb0 + 16 * i + 4 >= LSEQ, w0, w1, w2, bs, x); acc[i] = acc[i] * x; }
        if (o == 0) {
            __syncthreads();
#pragma unroll
            for (int i = 0; i < 16; ++i) { v2u zw; zw.x = pk2(acc[i][0], acc[i][1]); zw.y = pk2(acc[i][2], acc[i][3]); *(LAS v2u*)(F.lds + HY_U_OFF + r * HY_U_STRIDE + (tb0 + 16 * i) * 2) = zw; }
            hy_fill_k<4096, HY_K_STRIDE>(F, KRL + (size_t)((1 * 512 + c) * 8) * 4096);
            __syncthreads();
        } else {
#pragma unroll
            for (int i = 0; i < 16; ++i) { bf16* zp = z2 + (size_t)(r * LSEQ + tb0 + 16 * i) * 512 + c; asm volatile("" : "+v"(zp));
#pragma unroll
                for (int e = 0; e < 4; ++e) zp[e * 512] = (bf16)f2bf(acc[i][e]); }
        }
    }
    if (!with_ctx) return;
    __syncthreads();
    { const int col = 1024 + c; hy_fill_u<LCTX, HYC_U_STRIDE>(F, phyT, col, NX, sw[col], sw[1536 + col], sw[3072 + col], sb[col]); }
    hy_fill_k<512, HYC_K_STRIDE>(F, KRC + (size_t)((0 * 512 + c) * 8) * 512);
    __syncthreads();
#pragma unroll 1
    for (int o = 0; o < 2; ++o) {
        f32x4 acc[2];
        acc[0] = (f32x4){0.f, 0.f, 0.f, 0.f}; acc[1] = acc[0];
        const LAS unsigned char* pa = F.lds + HY_K_OFF + m * HYC_K_STRIDE + 2 * (8 * q - r - m + 256 - 32 * w);
        const LAS unsigned char* pb = F.lds + HY_U_OFF + r * HYC_U_STRIDE + 16 * q;
#pragma unroll
        for (int k = 0; k < 8; ++k) { const bf16x8 bfr = *(const LAS bf16x8*)(pb + 64 * k);
#pragma unroll
            for (int i = 0; i < 2; ++i) acc[i] = __builtin_amdgcn_mfma_f32_16x16x32_bf16(*(const LAS bf16x8*)(pa + 64 * k - 32 * i), bfr, acc[i], 0, 0, 0); }
        const int col = o * 512 + c; const float w0 = sw[col], w1 = sw[1536 + col], w2 = sw[3072 + col], bs = sb[col];
        int tb0 = 32 * w + 4 * q; asm volatile("" : "+v"(tb0));
        const bf16* p = phyT + (size_t)col * RT + NX + (size_t)r * LCTX + tb0;
#pragma unroll
        for (int i = 0; i < 2; ++i) { f32x4 x; hy_short4u(p + 16 * i, tb0 + 16 * i == 0, tb0 + 16 * i + 4 >= LCTX, w0, w1, w2, bs, x); acc[i] = acc[i] * x; }
        if (o == 0) {
            __syncthreads();
#pragma unroll
            for (int i = 0; i < 2; ++i) { v2u zw; zw.x = pk2(acc[i][0], acc[i][1]); zw.y = pk2(acc[i][2], acc[i][3]); *(LAS v2u*)(F.lds + HY_U_OFF + r * HYC_U_STRIDE + (tb0 + 16 * i) * 2) = zw; }
            hy_fill_k<512, HYC_K_STRIDE>(F, KRC + (size_t)((1 * 512 + c) * 8) * 512);
            __syncthreads();
        } else {
#pragma unroll
            for (int i = 0; i < 2; ++i)
#pragma unroll
                for (int e = 0; e < 4; ++e) z2[(size_t)(NX + r * LCTX + tb0 + 16 * i + e) * 512 + c] = (bf16)f2bf(acc[i][e]);
        }
    }
}

__device__ __forceinline__ void cf_unit(Frame& F, int l, int seqrow, int seqlen, int t0) {
    LAS bf16* U = (LAS bf16*)F.lds;
    LAS float* O = (LAS float*)(F.lds + 98304);
    const bf16* ucf = (const bf16*)(F.ws + WS_UCF); bf16* out = (bf16*)(F.ws + WS_UCF2);
    __syncthreads();
    for (int pc = F.tid; pc < 94 * 64; pc += 512) { const int i = pc >> 6, ch = pc & 63; const int t = t0 - 15 + i;
        v4u w = (v4u){0u, 0u, 0u, 0u}; if (t >= 0 && t < seqlen) w = *(const v4u*)(ucf + (size_t)(seqrow + t) * 512 + ch * 8);
        *(LAS v4u*)(U + i * 512 + ch * 8) = w; }
    const int c = F.tid;
    float w[31];
#pragma unroll
    for (int k = 0; k < 31; ++k) w[k] = inp(F, I_CFW)[(size_t)l * 31 * 512 + k * 512 + c];
    const float bias = inp(F, I_CFB)[l * 512 + c];
    const f32x4 g0 = *((const f32x4*)(inp(F, I_CFG) + l * 512) + F.lane), g1 = *((const f32x4*)(inp(F, I_CFG) + l * 512) + 64 + F.lane);
    const f32x4 b0 = *((const f32x4*)(inp(F, I_CFLB) + l * 512) + F.lane), b1 = *((const f32x4*)(inp(F, I_CFLB) + l * 512) + 64 + F.lane);
    __syncthreads();
#pragma unroll 1
    for (int r = 0; r < 4; ++r) {
        float v[16];
#pragma unroll
        for (int t = 0; t < 16; ++t) v[t] = bias;
        const LAS bf16* Ur = U + (16 * r) * 512 + c;
#pragma unroll
        for (int ii = 0; ii < 46; ++ii) { const float x = bf2f(Ur[ii * 512]);
#pragma unroll
            for (int t = 0; t < 16; ++t) { if (ii - t >= 0 && ii - t <= 30) v[t] += w[ii - t] * x; } }
#pragma unroll
        for (int t = 0; t < 16; ++t) O[t * 512 + c] = v[t];
        __syncthreads();
#pragma unroll
        for (int q = 0; q < 2; ++q) {
            const int tt = 2 * F.wave + q;
            f32x4 x0 = *((const LAS f32x4*)(O + tt * 512) + F.lane), x1 = *((const LAS f32x4*)(O + tt * 512) + 64 + F.lane);
            const float mean = wave_sum((x0[0] + x0[1]) + (x0[2] + x0[3]) + (x1[0] + x1[1]) + (x1[2] + x1[3])) * (1.f / 512.f);
            x0 = x0 - mean; x1 = x1 - mean;
            const float var = wave_sum((x0[0] * x0[0] + x0[1] * x0[1]) + (x0[2] * x0[2] + x0[3] * x0[3]) + (x1[0] * x1[0] + x1[1] * x1[1]) + (x1[2] * x1[2] + x1[3] * x1[3])) * (1.f / 512.f);
            const float rstd = 1.f / sqrtf(var + LN_EPS);
            f32x4 y0 = x0 * rstd * g0 + b0, y1 = x1 * rstd * g1 + b1;
#pragma unroll
            for (int j = 0; j < 4; ++j) { y0[j] = siluf_(y0[j]); y1[j] = siluf_(y1[j]); }
            bf16* orow = out + (size_t)(seqrow + t0 + 16 * r + tt) * 512;
            v2u o0, o1; o0.x = pk2(y0[0], y0[1]); o0.y = pk2(y0[2], y0[3]); o1.x = pk2(y1[0], y1[1]); o1.y = pk2(y1[2], y1[3]);
            *((v2u*)orow + F.lane) = o0; *((v2u*)orow + 64 + F.lane) = o1;
        }
        __syncthreads();
    }
}

__device__ __forceinline__ void s5_unit(Frame& F, int l, int b, int gp) {
    const int lane = F.lane, w = F.wave;
    bf16* ps5 = (bf16*)(F.ws + WS_PS5); bf16* ydir = (bf16*)(F.ws + WS_YDIR);
    __syncthreads();
#pragma unroll 1
    for (int rep_ = 0; rep_ < NREP(14); ++rep_)
    {
        const int gd = w & 3, role = w >> 2;
        const int g = 2 * gp + (gd >> 1), dir = gd & 1;
        const int r = lane & 15, q = lane >> 4;
        LAS unsigned char* wl = F.lds + gd * 32768;
        LAS unsigned char* uS0 = wl;
        LAS float* BuS0 = (LAS float*)(wl + 2560);
        LAS unsigned char* stS0 = wl + 2560 + 2 * 10240;
        constexpr int NCH = (LCTX + LSEQ) / 16;
        const float* P = (const float*)(F.ws + WS_S5P) + (size_t)((dir * 32 + g) * 64) * 36;
        float abr = 0.f, abi = 0.f; f32x2 s2 = (f32x2){0.f, 0.f}, Aa = s2, Bn = s2;
        bf16x8 Bf[8], Cf[4];
        const int ti = lane >> 2, cq = lane & 3;
        auto urow = [&](int k) -> size_t { const bool isc = k < LCTX / 16; const int kk = isc ? k : k - LCTX / 16; const int Ls = isc ? LCTX : LSEQ; const int rowb = isc ? NX + b * LCTX : b * LSEQ;
            const int st = kk * 16 + ti; const int t = dir ? (Ls - 1 - st) : st; return (size_t)(rowb + t) * 512 + g * 16 + 4 * cq; };
        v2u unext = (v2u){0u, 0u};
        if (role == 0) { abr = P[lane * 36]; abi = P[lane * 36 + 1]; Aa = (f32x2){abr, abr}; Bn = (f32x2){-abi, abi}; }
        else {
#pragma unroll
            for (int blk = 0; blk < 8; ++blk) { const int pp = 16 * blk + r; const float* src = P + (size_t)(pp & 63) * 36 + (pp < 64 ? 2 : 18) + 8 * (q & 1);
                v4u t4; t4.x = pk2(src[0], src[1]); t4.y = pk2(src[2], src[3]); t4.z = pk2(src[4], src[5]); t4.w = pk2(src[6], src[7]);
                if (q >= 2) t4 = (v4u){0u, 0u, 0u, 0u};
                Bf[blk] = __builtin_bit_cast(bf16x8, t4); }
            const float* cre = inp(F, I_SCRE) + (size_t)(((l * 2 + dir) * 32 + g) * 16) * 64; const float* cim = inp(F, I_SCIM) + (size_t)(((l * 2 + dir) * 32 + g) * 16) * 64;
#pragma unroll
            for (int ks = 0; ks < 4; ++ks) { const int p0 = 16 * ks + 4 * q; const f32x4 a = *(const f32x4*)(cre + r * 64 + p0), c4 = *(const f32x4*)(cim + r * 64 + p0);
                v4u t4; t4.x = pk2(a[0], -c4[0]); t4.y = pk2(a[1], -c4[1]); t4.z = pk2(a[2], -c4[2]); t4.w = pk2(a[3], -c4[3]);
                Cf[ks] = __builtin_bit_cast(bf16x8, t4); }
            for (int e = lane; e < 2 * 16 * 20; e += 64) ((LAS unsigned*)uS0)[e] = 0u;
            LDS_WAIT();
            *(LAS v2u*)(uS0 + ti * 80 + 8 * cq) = *(const v2u*)(ps5 + urow(0));
            unext = *(const v2u*)(ps5 + urow(1));
        }
        LDS_WAIT(); __builtin_amdgcn_s_barrier(); asm volatile("" ::: "memory");
#pragma unroll 1
        for (int k = 0; k < NCH + 2; ++k) {
            const int p0 = k & 1, p1 = p0 ^ 1;
            if (role == 1) {
                bf16x8 ua, sf[4];
                if (k < NCH) ua = *(const LAS bf16x8*)(uS0 + p0 * 1280 + r * 80 + 16 * q);
                if (k >= 2) {
#pragma unroll
                    for (int ks = 0; ks < 4; ++ks) sf[ks] = *(const LAS bf16x8*)(stS0 + p0 * 4352 + r * 272 + 64 * ks + 16 * q); }
                if (k + 1 < NCH) { *(LAS v2u*)(uS0 + p1 * 1280 + ti * 80 + 8 * cq) = unext; if (k + 2 < NCH) unext = *(const v2u*)(ps5 + urow(k + 2)); }
                if (k < NCH) {
#pragma unroll
                    for (int blk = 0; blk < 8; ++blk) { const f32x4 d = __builtin_amdgcn_mfma_f32_16x16x32_bf16(ua, Bf[blk], (f32x4){0.f, 0.f, 0.f, 0.f}, 0, 0, 0);
                        *(LAS f32x4*)(BuS0 + p0 * 2560 + (16 * blk + r) * 20 + 4 * q) = d; }
                }
                if (k >= 2) {
                    f32x4 y0 = __builtin_amdgcn_mfma_f32_16x16x32_bf16(sf[0], Cf[0], (f32x4){0.f, 0.f, 0.f, 0.f}, 0, 0, 0), y1 = __builtin_amdgcn_mfma_f32_16x16x32_bf16(sf[1], Cf[1], (f32x4){0.f, 0.f, 0.f, 0.f}, 0, 0, 0);
                    y0 = __builtin_amdgcn_mfma_f32_16x16x32_bf16(sf[2], Cf[2], y0, 0, 0, 0); y1 = __builtin_amdgcn_mfma_f32_16x16x32_bf16(sf[3], Cf[3], y1, 0, 0, 0);
                    const f32x4 y = y0 + y1; const int kc = k - 2;
                    const bool isc = kc < LCTX / 16; const int kk = isc ? kc : kc - LCTX / 16; const int Ls = isc ? LCTX : LSEQ; const int rowb = isc ? NX + b * LCTX : b * LSEQ;
#pragma unroll
                    for (int i = 0; i < 4; ++i) { const int st = kk * 16 + 4 * q + i; const int t = dir ? (Ls - 1 - st) : st;
                        ydir[(size_t)dir * RT * 512 + (size_t)(rowb + t) * 512 + g * 16 + r] = (bf16)f2bf(y[i]); } }
            } else if (k >= 1 && k <= NCH) {
                f32x4 bre[4], bim[4];
#pragma unroll
                for (int j = 0; j < 4; ++j) { bre[j] = *(const LAS f32x4*)(BuS0 + p1 * 2560 + lane * 20 + 4 * j); bim[j] = *(const LAS f32x4*)(BuS0 + p1 * 2560 + (64 + lane) * 20 + 4 * j); }
#pragma unroll
                for (int i = 0; i < 16; ++i) {
                    const f32x2 b2 = (f32x2){bre[i >> 2][i & 3], bim[i >> 2][i & 3]};
                    const float nr = abr * s2[0] - abi * s2[1] + b2[0], ni = abr * s2[1] + abi * s2[0] + b2[1]; s2 = (f32x2){nr, ni};
                    *(LAS unsigned*)(stS0 + p1 * 4352 + i * 272 + 4 * lane) = pk2(s2[0], s2[1]); }
            }
            LDS_WAIT(); __builtin_amdgcn_s_barrier(); asm volatile("" ::: "memory");
        }
    }
    VM_WAIT();
    __syncthreads();
    const float* dsk = inp(F, I_SD) + l * 512 + gp * 32;
    for (int e = F.tid; e < (LCTX + LSEQ) * 4; e += 512) {
        const int rr = e >> 2, pc = e & 3; const int row = rr < LSEQ ? b * LSEQ + rr : NX + b * LCTX + (rr - LSEQ);
        const size_t off = (size_t)row * 512 + gp * 32 + pc * 8;
        const v4u uw = *(const v4u*)(ps5 + off), fw = *(const v4u*)(ydir + off), bw = *(const v4u*)(ydir + (size_t)RT * 512 + off);
        f32x4 u0, u1, f0, f1, b0, b1; unpack8(uw, u0, u1); unpack8(fw, f0, f1); unpack8(bw, b0, b1);
        const f32x4 d0 = *(const f32x4*)(dsk + pc * 8), d1 = *(const f32x4*)(dsk + pc * 8 + 4);
        f32x4 o0, o1;
#pragma unroll
        for (int j = 0; j < 4; ++j) { o0[j] = gelu_tanh(f0[j] + b0[j] + d0[j] * u0[j]); o1[j] = gelu_tanh(f1[j] + b1[j] + d1[j] * u1[j]); }
        *(v4u*)(ps5 + off) = pack8(o0, o1);
    }
}

__device__ __forceinline__ Frame make_frame(const Args& args, LAS unsigned char* lds, int wave_s);
__device__ __forceinline__ void mixers_phase(const Args& args, LAS unsigned char* lds, int wave_s, int l) {
#ifndef MIXMASK
#define MIXMASK 7
#endif
    if (MIXMASK & 1) { Frame F = make_frame(args, lds, wave_s);
#pragma unroll 1
        for (int u = F.vcu; u < NB * 16; u += F.G) s5_unit(F, l, u >> 4, u & 15); }
    if (MIXMASK & 2) { Frame F = make_frame(args, lds, wave_s);
#pragma unroll 1
        for (int u = F.vcu; u < 512; u += F.G) hyena_unit(F, l, u, l == 0);
        if (NREP(10) == 2) {
#pragma unroll 1
            for (int u = F.vcu; u < 512; u += F.G) hyena_unit(F, l, u, l == 0); } }
    if (MIXMASK & 4) { Frame F = make_frame(args, lds, wave_s);
        const int ncf = l == 0 ? NB * 32 + NB * 4 : NB * 32;
#pragma unroll 1
        for (int u = F.vcu; u < ncf; u += F.G) { if (u < NB * 32) cf_unit(F, l, u * 64, 64, 0); else { const int q = u - NB * 32; cf_unit(F, l, NX + (q >> 2) * LCTX, LCTX, (q & 3) * 64); } } }
    __syncthreads();
}

constexpr int PH_P0A = 0, PH_P0B = 1, PH_L0 = 2, PH_L1 = 12, N_PHASES = 27;
__device__ __forceinline__ Frame make_frame(const Args& args, LAS unsigned char* lds, int wave_s) {
    unsigned z0 = 0u; asm volatile("" : "+v"(z0));
    Frame F; int t = wave_s * 64 + (int)__builtin_amdgcn_mbcnt_hi(~0u, __builtin_amdgcn_mbcnt_lo(~0u, z0)); asm volatile("" : "+v"(t));
    unsigned char* ws = args.ws; float* out = args.out;
    F.lds = lds; F.tid = t; F.lane = t & 63; F.wave = wave_s;
    int G = gridDim.x, bx = blockIdx.x; asm volatile("" : "+s"(G), "+s"(bx));
    F.G = G; F.vcu = (G % 8 == 0) ? (bx % 8) * (G / 8) + bx / 8 : bx;
    const float* const* inp = args.in;
    F.in = inp; F.out = out; F.ws = ws; return F;
}
__global__ void __launch_bounds__(NWAVES * 64, 2) mega_fwd(Args args) {
    extern __shared__ __attribute__((aligned(16))) unsigned char lds_raw[];
    LAS unsigned char* const lds = (LAS unsigned char*)lds_raw;
    volatile LAS unsigned* MISC = (volatile LAS unsigned*)(lds + MISC_OFF);
    for (int u = threadIdx.x; u < (LDS_BYTES - MISC_OFF) / 4; u += NWAVES * 64) ((LAS unsigned*)(lds + MISC_OFF))[u] = 0u;
    int wave_s = __builtin_amdgcn_readfirstlane((int)threadIdx.x >> 6); asm volatile("" : "+s"(wave_s));
    __syncthreads();
    const int lo = MK_PER_PHASE_LAUNCH ? args.ph_lo : 0, hi = MK_PER_PHASE_LAUNCH ? args.ph_hi : N_PHASES;
    XcdBarrier bar; bar.bar = (unsigned*)(args.ws + WS_CTL) + CW_BAR; bar.x = 0; bar.st = nullptr;
    if (hi - lo > 1) bar = xcd_barrier_post((unsigned*)(args.ws + WS_CTL) + CW_BAR, MISC + 8);
#ifndef PHMASK
#define PHMASK 0xffffffffu
#endif
#define IN(k) (lo <= (k) && (k) < hi)
#define PM(b) ((PHMASK >> (b)) & 1u)
#define SEAM(k) do { if (IN(k) && IN((k) + 1)) xcd_barrier(bar, wave_s); } while (0)
#define FRAME() Frame F = make_frame(args, lds, wave_s); const char* ws = (const char*)F.ws; const int c = F.G == (int)gridDim.x ? (int)blockIdx.x : 0; (void)ws; (void)c

    if (PM(0) && IN(PH_P0A)) { FRAME(); REPEAT(NREP(12), p0a_prologue(F)); } SEAM(PH_P0A);
    if (PM(1) && IN(PH_P0B)) { FRAME(); p0b_mods(F); } SEAM(PH_P0B);

#pragma unroll 1
    for (int l = 0; l < 2; ++l) {
        const int pb = l == 0 ? PH_L0 : PH_L1;
        const int nMl = l == 0 ? RT / 256 : NX / 256;
        if (PM(2) && IN(pb + 0)) { { FRAME(); REPEAT(NREP(8), lnmod_phase(F, l)); } { FRAME(); h2table_phase(F, l); } { FRAME(); s5params_phase(F, l); } } SEAM(pb + 0);
        if (PM(3) && IN(pb + 1)) { { FRAME(); REPEAT(NREP(9), filter_expand_phase(F, l)); }
            FRAME();
            SchedPlain S; S.R.init(nMl, 12, F.G, c); S.A = ws + WS_HX; S.B = ws + WS_WIN + (size_t)l * 6144 * 1024 * 2; S.tsA = 256 * 1024 * 2; S.tsB = 256 * 1024 * 2;
            S.xM = l == 0 ? 0 : NCX / 256; S.xN0 = 10; S.xNn = 2;
            EpiInproj E{(bf16*)(F.ws + WS_PHYT), (bf16*)(F.ws + WS_UCF), (bf16*)(F.ws + WS_PS5)};
            REPEAT(NREP(0), pg8::gemm_phase<EpiInproj, SchedPlain>(F.lds, F.tid, 2048, S, E));
        } SEAM(pb + 1);
        if (PM(4) && IN(pb + 2)) { mixers_phase(args, lds, wave_s, l); } SEAM(pb + 2);
        if (PM(5) && IN(pb + 3)) {
            { FRAME(); SchedPlain S; S.R.init(nMl, 12, F.G, c); S.A = ws + WS_HX; S.B = ws + WS_WIN + ((size_t)l * 6144 + 3072) * 1024 * 2; S.tsA = 256 * 1024 * 2; S.tsB = 256 * 1024 * 2; S.xM = 0; S.xN0 = 0; S.xNn = 1;
              EpiGates E{(bf16*)(F.ws + WS_G)}; REPEAT(NREP(1), pg8::gemm_phase<EpiGates, SchedPlain>(F.lds, F.tid, 2048, S, E)); }
#ifndef DBG_SKIP_GLU
            { FRAME(); SchedPlain S; S.R.init(nMl, 2, F.G, (c + F.G / 4) % F.G); S.A = ws + WS_PS5; S.B = ws + WS_WGLU + (size_t)l * 512 * 512 * 2; S.tsA = 256 * 512 * 2; S.tsB = 256 * 512 * 2; S.xM = 0; S.xN0 = 0; S.xNn = 1;
              EpiGlu E{(const bf16*)(F.ws + WS_PS5), (bf16*)(F.ws + WS_S5Y), inp(F, I_SBGLU) + l * 512}; REPEAT(NREP(2), pg8::gemm_phase<EpiGlu, SchedPlain>(F.lds, F.tid, 1024, S, E)); }
#endif
        } SEAM(pb + 3);
        if (PM(6) && IN(pb + 4)) { FRAME();
            SchedMerge S; S.R.init(nMl, 4, F.G, c); S.A = ws + WS_Z2; S.sA = WS_UCF2 - WS_Z2; S.B = ws + WS_WOUTS + (size_t)(l * 3) * 1024 * 512 * 2; S.sB = (size_t)1024 * 512 * 2;
            S.tsA = 256 * 512 * 2; S.tsB = 256 * 512 * 2;
            EpiMerge E{(const bf16*)(F.ws + WS_G), (bf16*)(F.ws + WS_HX)};
            REPEAT(NREP(3), pg8::gemm_phase<EpiMerge, SchedMerge>(F.lds, F.tid, 1024, S, E));
        } SEAM(pb + 4);
        if (PM(7) && IN(pb + 5)) { FRAME();
            SchedPlain S; S.R.init(nMl, 4, F.G, c); S.A = ws + WS_HX; S.B = ws + WS_WO + (size_t)l * 1024 * 1024 * 2; S.tsA = 256 * 1024 * 2; S.tsB = 256 * 1024 * 2; S.xM = 0; S.xN0 = 0; S.xNn = 1;
            EpiRes E{l == 0 ? inp(F, I_X) : F.out, l == 0 ? inp(F, I_CTX) : (const float*)(F.ws + WS_XC), F.out, (float*)(F.ws + WS_XC), (const float*)(F.ws + WS_MODS) + (size_t)l * 17 * INC + 2 * 1024, 1.0f};
            REPEAT(((l == 0) ? NREP(4) : 1), pg8::gemm_phase<EpiRes, SchedPlain>(F.lds, F.tid, 2048, S, E));
        } SEAM(pb + 5);
        if (PM(8) && IN(pb + 6)) { { FRAME(); ln1_phase(F, l); } if (l == 1) { FRAME(); REPEAT(NREP(13), moe_convert_phase(F)); } } SEAM(pb + 6);
        if (l == 0) {
            if (PM(9) && IN(pb + 7)) { FRAME();
                SchedPlain S; S.R.init(RT / 256, 22, F.G, c); S.A = ws + WS_HX; S.B = ws + WS_W13; S.tsA = 256 * 1024; S.tsB = 256 * 1024; S.xM = 0; S.xN0 = 0; S.xNn = 1;
                EpiSwigluF8 E{F.ws + WS_G, DFF, 0.03125f}; REPEAT(NREP(5), pg8::gemm_phase<EpiSwigluF8, SchedPlain, true>(F.lds, F.tid, 1024, S, E));
            } SEAM(pb + 7);
            if (PM(10) && IN(pb + 8)) { FRAME();
                SchedPlain S; S.R.init(RT / 256, 4, F.G, c); S.A = ws + WS_G; S.B = ws + WS_W2; S.tsA = (size_t)256 * DFF; S.tsB = (size_t)256 * DFF; S.xM = 0; S.xN0 = 0; S.xNn = 1;
                EpiRes E{F.out, (const float*)(F.ws + WS_XC), F.out, (float*)(F.ws + WS_XC), (const float*)(F.ws + WS_MODS) + 5 * 1024, 0.0078125f};
                pg8::gemm_phase<EpiRes, SchedPlain, true>(F.lds, F.tid, DFF, S, E);
            } SEAM(pb + 8);
            if (PM(11) && IN(pb + 9)) { FRAME(); ln2_phase(F, l); } SEAM(pb + 9);
        } else {
            if (PM(15) && IN(pb + 7)) { FRAME(); moe_setup_phase(F); } SEAM(pb + 7);
#pragma unroll 1
            for (int st = 0; st < 6; ++st) {
                if (PM(13) && IN(pb + 8 + st) && st >= 1) { FRAME(); const int* tile_e = (const int*)(F.ws + WS_META + META_TILE); const int ch = st - 1;
                    const int ntiles = tile_e[511]; int nmc = ntiles - 64 * ch; nmc = nmc < 0 ? 0 : (nmc > 64 ? 64 : nmc);
                    SchedMoe S; S.R.init(nmc, 4, F.G, c); S.A = ws + WS_HID + (size_t)(ch & 1) * HID_BUF; S.B = ws + WS_MW2; S.tsA = (size_t)256 * DEX; S.tsB = (size_t)256 * DEX; S.esB = (size_t)1024 * DEX; S.tile_e = tile_e; S.tile0 = 64 * ch; S.a_global = false;
                    EpiMoeDown E{(bf16*)(F.ws + WS_MOEY), 0.0078125f}; REPEAT(NREP(7), pg8::gemm_phase<EpiMoeDown, SchedMoe, true>(F.lds, F.tid, DEX, S, E));
                }
                if (PM(12) && IN(pb + 8 + st) && st <= 4) { FRAME(); const int* tile_e = (const int*)(F.ws + WS_META + META_TILE); const int ch = st;
                    const int ntiles = tile_e[511]; int nmc = ntiles - 64 * ch; nmc = nmc < 0 ? 0 : (nmc > 64 ? 64 : nmc);
                    SchedMoe S; S.R.init(nmc, 28, F.G, c); S.A = ws + WS_SORT; S.B = ws + WS_MW13; S.tsA = 256 * 1024; S.tsB = 256 * 1024; S.esB = (size_t)7168 * 1024; S.tile_e = tile_e; S.tile0 = 64 * ch; S.a_global = true;
                    EpiSwigluF8 E{F.ws + WS_HID + (size_t)(ch & 1) * HID_BUF, DEX, 0.03125f}; REPEAT(NREP(6), pg8::gemm_phase<EpiSwigluF8, SchedMoe, true>(F.lds, F.tid, 1024, S, E));
                }
                SEAM(pb + 8 + st);
            }
            if (PM(14) && IN(pb + 14)) { FRAME(); moe_combine_phase(F); }
        }
    }
#undef IN
#undef SEAM
#undef FRAME
}


#ifdef DBG_DUMP
__global__ void dbg_dump(const unsigned char* ws, float* out) {
    const size_t NE = (size_t)RT * 512; const bf16* a = (const bf16*)(ws + WS_PS5); const bf16* b = (const bf16*)(ws + WS_Z2); const bf16* c = (const bf16*)(ws + WS_UCF2);
    for (size_t i = (size_t)blockIdx.x * blockDim.x + threadIdx.x; i < (size_t)NX * DM; i += (size_t)gridDim.x * blockDim.x) {
        const size_t j = i % NE; const int k = (int)(i / NE);
        float v;
        if (DBG_DUMP == 8) v = i < (size_t)26 * 1024 * 1024 ? bf2f(((const bf16*)(ws + WS_WIN))[i]) : 0.f;
        else if (DBG_DUMP == 7) v = k == 0 ? bf2f(a[j]) : bf2f(((const bf16*)(ws + WS_UCF))[j]);
        else if (DBG_DUMP == 4) v = bf2f(((const bf16*)(ws + WS_HX))[i]);
        else if (DBG_DUMP == 5) v = bf2f(((const bf16*)(ws + WS_G))[i]);
        else if (DBG_DUMP == 6) v = bf2f(((const bf16*)(ws + WS_S5Y))[i % NE]);
        else if (DBG_DUMP == 1) v = k == 0 ? bf2f(a[j]) : bf2f(b[j]);
        else if (DBG_DUMP == 2) v = k == 0 ? bf2f(b[j]) : bf2f(c[j]);
        else v = k == 0 ? bf2f(c[j]) : bf2f(a[j]);
        out[i] = v;
    }
}
#endif
extern "C" void kernel_launch(void* const* d_in, const int* in_sizes, int n_in, void* d_out, int out_size, void* d_ws, size_t ws_size, hipStream_t stream) {
    static int grid = 0;
    if (grid == 0) {
        if (n_in != N_IN || out_size != NX * DM || ws_size < WS_END2) { fprintf(stderr, "kernel_launch: unexpected shapes (n_in %d, out %d, ws %zu)\n", n_in, out_size, ws_size); grid = -1; return; }
        int dev = 0, cus = 0, per_cu = 0;
        if (hipGetDevice(&dev) != hipSuccess || hipDeviceGetAttribute(&cus, hipDeviceAttributeMultiprocessorCount, dev) != hipSuccess) { grid = -1; return; }
        if (hipFuncSetAttribute((const void*)mega_fwd, hipFuncAttributeMaxDynamicSharedMemorySize, LDS_BYTES) != hipSuccess) { fprintf(stderr, "kernel_launch: hipFuncSetAttribute failed\n"); grid = -1; return; }
        if (hipOccupancyMaxActiveBlocksPerMultiprocessor(&per_cu, (const void*)mega_fwd, NWAVES * 64, LDS_BYTES) != hipSuccess || per_cu < 1) fprintf(stderr, "kernel_launch: occupancy query reports %d\n", per_cu);
        (void)hipGetLastError();
        grid = cus;
    }
    if (grid < 0) return;
    (void)hipMemsetAsync((char*)d_ws + WS_CTL, 0, CTL_ZERO_BYTES, stream);
    Args a{};
    for (int i = 0; i < N_IN; ++i) a.in[i] = (const float*)d_in[i];
    a.out = (float*)d_out; a.ws = (unsigned char*)d_ws;
#if MK_PER_PHASE_LAUNCH
    for (int p = 0; p < DBG_NPH; ++p) { a.ph_lo = p; a.ph_hi = p + 1; hipLaunchKernelGGL(mega_fwd, dim3(grid), dim3(NWAVES * 64), LDS_BYTES, stream, a); }
#ifdef DBG_DUMP
    hipLaunchKernelGGL(dbg_dump, dim3(2048), dim3(256), 0, stream, (const unsigned char*)d_ws, (float*)d_out);
#endif
#else
    a.ph_lo = 0; a.ph_hi = N_PHASES; hipLaunchKernelGGL(mega_fwd, dim3(grid), dim3(NWAVES * 64), LDS_BYTES, stream, a);
#endif
}
```

```cpp
#include <hip/hip_runtime.h>
#include <cstdio>
#include <cstdint>

#ifndef DBG_REP
#define DBG_REP 0
#endif
#define NREP(bit) (((DBG_REP >> (bit)) & 1) ? 2 : 1)
#define REPEAT(n, ...) do { __VA_ARGS__; if ((n) == 2) { __VA_ARGS__; } } while (0)
#ifndef DBG_NPH
#define DBG_NPH N_PHASES
#endif
#ifndef MK_PER_PHASE_LAUNCH
#define MK_PER_PHASE_LAUNCH 0
#endif

#define GAS __attribute__((address_space(1)))
#define LAS __attribute__((address_space(3)))
typedef unsigned short bf16;
typedef unsigned v4u __attribute__((ext_vector_type(4)));
typedef unsigned v2u __attribute__((ext_vector_type(2)));
typedef float f32x4 __attribute__((ext_vector_type(4)));
typedef float f32x2 __attribute__((ext_vector_type(2)));
typedef short bf16x8 __attribute__((ext_vector_type(8)));

constexpr int NB = 16, LSEQ = 2048, LCTX = 256, DM = 1024;
constexpr int NX = NB * LSEQ;
constexpr int NCX = NB * LCTX;
constexpr int RT = NX + NCX;
constexpr int INC = 6144, DFF = 2816, DEX = 3584, NEXP = 8;
constexpr float ALPHA_F = 1.41421356237f;
constexpr float LN_EPS = 1e-5f;

enum { I_X = 0, I_C, I_CTX, I_CCTX, I_WMOD, I_BMOD, I_WIN, I_HSW, I_HSB, I_FW1, I_FB1, I_FW2, I_FB2, I_FW3, I_FB3, I_FREQ, I_DECAY, I_HBIAS, I_WHY,
       I_CFW, I_CFB, I_CFG, I_CFLB, I_WCF, I_SARE, I_SAIM, I_SLDT, I_SBRE, I_SBIM, I_SCRE, I_SCIM, I_SD, I_SWGLU, I_SBGLU, I_WS5, I_WO,
       I_LN1G, I_LN1B, I_LN2G, I_LN2B, I_FFW1, I_FFW3, I_FFW2, I_ROUTER, I_MW1, I_MW3, I_MW2, N_IN };

constexpr size_t MiB = 1u << 20;
constexpr size_t WS_CTL = 0, CTL_ZERO_BYTES = 1 * MiB;
constexpr size_t WS_MODS = 1 * MiB;
constexpr size_t WS_S5P = 2 * MiB;
constexpr size_t WS_META = 3 * MiB;
constexpr size_t WS_FILT = 4 * MiB;
constexpr size_t WS_XC = 22 * MiB;
constexpr size_t WS_WIN = 38 * MiB;
constexpr size_t WS_WOUTS = 62 * MiB;
constexpr size_t WS_WGLU = 68 * MiB;
constexpr size_t WS_WO = 69 * MiB;
constexpr size_t WS_W13 = 73 * MiB;
constexpr size_t WS_W2 = 84 * MiB;
constexpr size_t WS_HX = 90 * MiB;
constexpr size_t WS_G = 162 * MiB;
constexpr size_t WS_PHYT = WS_G, WS_YDIR = WS_G + 108 * MiB, WS_UCF = WS_G + 180 * MiB;
constexpr size_t WS_PS5 = 378 * MiB;
constexpr size_t WS_Z2 = 414 * MiB;
constexpr size_t WS_UCF2 = 450 * MiB;
constexpr size_t WS_S5Y = 486 * MiB;
constexpr size_t WS_KRL = 522 * MiB;
constexpr size_t WS_KRC = 586 * MiB;
constexpr size_t WS_KDUMMY = 594 * MiB;
constexpr size_t WS_END = 595 * MiB;
constexpr size_t WS_SORT = 90 * MiB;
constexpr size_t WS_MOEY = 156 * MiB;
constexpr size_t WS_MW13 = 288 * MiB;
constexpr size_t WS_MW2 = 344 * MiB;
constexpr size_t WS_HID = 372 * MiB;
constexpr size_t HID_BUF = 56 * MiB;
constexpr size_t WS_END2 = 604 * MiB;
static_assert(WS_HID + (size_t)67584 * 3584 <= WS_END2, "moe map");
constexpr size_t META_TOKE = 0, META_TOKW = 256 * 1024, META_POS = 512 * 1024, META_TILE = 768 * 1024;
constexpr int CW_BAR = 4096;
constexpr int CW_CNT = 8192, CW_CUR = 8256;

constexpr int LDS_BYTES = 155648;
constexpr int MISC_OFF = 147456;
constexpr int NWAVES = 8;

typedef __bf16 bf2_t __attribute__((ext_vector_type(2)));
__device__ __forceinline__ unsigned pk2(float lo, float hi) { bf2_t v; v.x = (__bf16)lo; v.y = (__bf16)hi; return __builtin_bit_cast(unsigned, v); }
__device__ __forceinline__ unsigned f2bf(float f) { return (unsigned)__builtin_bit_cast(unsigned short, (__bf16)f); }
__device__ __forceinline__ unsigned pk4_fp8(float a, float b, float c, float d) { int w = 0; w = __builtin_amdgcn_cvt_pk_fp8_f32(a, b, w, false); w = __builtin_amdgcn_cvt_pk_fp8_f32(c, d, w, true); return (unsigned)w; }
__device__ __forceinline__ float bf2f(unsigned short b) { return __builtin_bit_cast(float, ((unsigned)b) << 16); }
__device__ __forceinline__ float bflo(unsigned w) { return __builtin_bit_cast(float, w << 16); }
__device__ __forceinline__ float bfhi(unsigned w) { return __builtin_bit_cast(float, w & 0xffff0000u); }
__device__ __forceinline__ float sigmoidf_(float x) { return __builtin_amdgcn_rcpf(1.0f + __expf(-x)); }
__device__ __forceinline__ float siluf_(float x) { return x * sigmoidf_(x); }
__device__ __forceinline__ float gelu_tanh(float x) { const float y = 0.7978845608028654f * (x + 0.044715f * x * x * x); const float e = __expf(2.0f * y); const float th = 1.0f - 2.0f * __builtin_amdgcn_rcpf(e + 1.0f); return 0.5f * x * (1.0f + th); }
__device__ __forceinline__ float wave_sum(float v) {
    v += __builtin_bit_cast(float, __builtin_amdgcn_mov_dpp(__builtin_bit_cast(int, v), 0xB1, 0xf, 0xf, true));
    v += __builtin_bit_cast(float, __builtin_amdgcn_mov_dpp(__builtin_bit_cast(int, v), 0x4E, 0xf, 0xf, true));
    v += __builtin_bit_cast(float, __builtin_amdgcn_mov_dpp(__builtin_bit_cast(int, v), 0x141, 0xf, 0xf, true));
    v += __builtin_bit_cast(float, __builtin_amdgcn_mov_dpp(__builtin_bit_cast(int, v), 0x140, 0xf, 0xf, true));
    v += __builtin_bit_cast(float, __builtin_amdgcn_ds_swizzle(__builtin_bit_cast(int, v), 0x401F));
    const unsigned u = __builtin_bit_cast(unsigned, v); const auto r = __builtin_amdgcn_permlane32_swap(u, u, false, false);
    return __builtin_bit_cast(float, (unsigned)r[0]) + __builtin_bit_cast(float, (unsigned)r[1]);
}
__device__ __forceinline__ float lane_bcast(float v, int k) { return __builtin_bit_cast(float, __builtin_amdgcn_readlane(__builtin_bit_cast(int, v), k)); }
#define LDS_WAIT() asm volatile("s_waitcnt lgkmcnt(0)" ::: "memory")
#define VM_WAIT() asm volatile("s_waitcnt vmcnt(0)" ::: "memory")

namespace pg8 {
#define PG8_LAS __attribute__((address_space(3)))
constexpr int BM = 256, BK = 64, HALF = 128, HTB = HALF * BK * 2, STAGE_BYTES = 8 * HTB, NXCD = 8, WGM = 8;
__host__ __device__ __forceinline__ int lds_byte(int r, int c) { const int st = (r >> 4) * 2 + (c >> 5), rr = r & 15, cc = c & 31, ob = rr * 64 + cc * 2; return st * 1024 + (ob ^ (((ob >> 9) & 1) << 5)); }
__host__ __device__ __forceinline__ void stage_rc(int b, int& R, int& C) { const int st = b / 1024, sb = b % 1024, swz = sb ^ (((sb >> 9) & 1) << 5); R = (st >> 1) * 16 + swz / 64; C = (st & 1) * 32 + (swz % 64) / 2; }
__host__ __device__ __forceinline__ int perm32(int rho) { const int n = rho >> 4, i = rho & 15; return 8 * (i >> 2) + 4 * n + (i & 3); }

struct Unit { int pm, pn, seg, ex; const char* A; const char* B; };

struct Rect {
    int nM, nN, nwg, G, c;
    __device__ __forceinline__ void init(int nM_, int nN_, int G_, int c_) { nM = nM_; nN = nN_; nwg = nM * nN; G = G_; c = c_; }
    __device__ __forceinline__ bool map(int L, int& pm, int& pn) const {
        if (L >= nwg) return false;
        int wgid = L; { const int q = nwg / NXCD, r = nwg % NXCD, xcd = wgid % NXCD, off = wgid / NXCD; wgid = (xcd < r ? xcd * (q + 1) : r * (q + 1) + (xcd - r) * q) + off; }
        const int nig = WGM * nN, gid = wgid / nig, fm = gid * WGM, gsz = (nM - fm) < WGM ? (nM - fm) : WGM;
        pm = fm + ((wgid % nig) % gsz); pn = (wgid % nig) / gsz; return true;
    }
};

__device__ __forceinline__ unsigned cvt_pk_bf16(float lo, float hi) { return pk2(lo, hi); }

typedef int v8i_t __attribute__((ext_vector_type(8)));
typedef int v4i_t __attribute__((ext_vector_type(4)));
__device__ __forceinline__ v8i_t cat8(const bf16x8 a, const bf16x8 b) { return __builtin_shufflevector(__builtin_bit_cast(v4i_t, a), __builtin_bit_cast(v4i_t, b), 0, 1, 2, 3, 4, 5, 6, 7); }
__device__ __forceinline__ bf16x8 lo8(const v8i_t v) { return __builtin_bit_cast(bf16x8, __builtin_shufflevector(v, v, 0, 1, 2, 3)); }
__device__ __forceinline__ bf16x8 hi8(const v8i_t v) { return __builtin_bit_cast(bf16x8, __builtin_shufflevector(v, v, 4, 5, 6, 7)); }
template <class Epi, class Sched, bool F8 = false, bool ALIGN_EPI = true, bool SP2 = true>
__device__ __forceinline__ void gemm_phase(PG8_LAS unsigned char* lds, const int tid, const int KB, const Sched& S, const Epi& E) {
    const int wid = __builtin_amdgcn_readfirstlane(tid >> 6), lane = tid & 63, wr = wid >> 2, wc = wid & 3, fr = lane & 15, fq = lane >> 4;
    const int nt = KB / (BK * 2);
    unsigned voffA[2], voffB[2];
#pragma unroll
    for (int i = 0; i < 2; ++i) { int R, C; stage_rc(tid * 16 + i * 8192, R, C); const int Rb = Epi::PERM ? ((R & ~31) + perm32(R & 31)) : R;
        voffA[i] = (unsigned)(R * KB + C * 2); voffB[i] = (unsigned)(Rb * KB + C * 2); }
    const size_t kstep = (size_t)(BK * 2);
    const size_t hstep = (size_t)HALF * KB;
    const unsigned ldsw = (unsigned)wid * 1024u;
    const int aoff = lds_byte(wr * 64 + fr, fq * (F8 ? 16 : 8)), boff = lds_byte(wc * 32 + fr, fq * (F8 ? 16 : 8));
    constexpr int KOFF = F8 ? 16 : 1024;
#define PG8_SA(b, h) (((b) * 2 + (h)) * HTB)
#define PG8_SB(b, h) ((4 + (b) * 2 + (h)) * HTB)
#define PG8_STAGE(bufoff, gbase, voff) do { _Pragma("unroll") for (int _i = 0; _i < 2; ++_i) \
        __builtin_amdgcn_global_load_lds((const unsigned*)((const char*)(gbase) + (voff)[_i]), (PG8_LAS unsigned*)(lds + (bufoff) + ldsw + _i * 8192), 16, 0, 0); } while (0)
#define PG8_LDA(dst, b, h) do { _Pragma("unroll") for (int m = 0; m < 4; ++m) dst[m] = cat8(*(const PG8_LAS bf16x8*)(lds + PG8_SA(b, h) + aoff + m * 2048), *(const PG8_LAS bf16x8*)(lds + PG8_SA(b, h) + aoff + m * 2048 + KOFF)); } while (0)
#define PG8_LDB(dst, b, h) do { _Pragma("unroll") for (int n = 0; n < 2; ++n) dst[n] = cat8(*(const PG8_LAS bf16x8*)(lds + PG8_SB(b, h) + boff + n * 2048), *(const PG8_LAS bf16x8*)(lds + PG8_SB(b, h) + boff + n * 2048 + KOFF)); } while (0)
#define PG8_MMA(ai, bj, At, Bt) do { __builtin_amdgcn_s_setprio(1); _Pragma("unroll") for (int m = 0; m < 4; ++m) _Pragma("unroll") for (int n = 0; n < 2; ++n) { \
        if constexpr (F8) asm volatile("v_mfma_scale_f32_16x16x128_f8f6f4 %0, %1, %2, %0, %3, %3 op_sel_hi:[0,0,0]" : "+v"(acc[ai][bj][m][n]) : "v"(Bt[n]), "v"(At[m]), "v"(sc1)); \
        else { acc[ai][bj][m][n] = __builtin_amdgcn_mfma_f32_16x16x32_bf16(lo8(Bt[n]), lo8(At[m]), acc[ai][bj][m][n], 0, 0, 0); \
               acc[ai][bj][m][n] = __builtin_amdgcn_mfma_f32_16x16x32_bf16(hi8(Bt[n]), hi8(At[m]), acc[ai][bj][m][n], 0, 0, 0); } } \
        __builtin_amdgcn_s_setprio(0); } while (0)
#define PG8_WAIT_V(n) asm volatile("s_waitcnt vmcnt(" #n ")" ::: "memory")
#define PG8_WAIT_L(n) asm volatile("s_waitcnt lgkmcnt(" #n ")" ::: "memory")
#define PG8_BAR __builtin_amdgcn_s_barrier()
#define PG8_SCHED __builtin_amdgcn_sched_barrier(0)
    const int sc1 = 0x7f7f7f7f;
    Unit cur, nxt; int ui = 0;
    if (!S.next(0, cur)) return;
    f32x4 acc[2][2][4][2];
#pragma unroll
    for (int a = 0; a < 2; ++a)
#pragma unroll
        for (int b = 0; b < 2; ++b)
#pragma unroll
            for (int m = 0; m < 4; ++m)
#pragma unroll
                for (int n = 0; n < 2; ++n) acc[a][b][m][n] = (f32x4){0.f, 0.f, 0.f, 0.f};
    v8i_t At[4], B0[2], B1[2];
    const char* cA = cur.A; const char* cB = cur.B;
    if constexpr (SP2) {
        PG8_STAGE(PG8_SB(0, 0), cB, voffB); PG8_STAGE(PG8_SB(0, 1), cB + hstep, voffB); PG8_STAGE(PG8_SA(0, 0), cA, voffA); PG8_STAGE(PG8_SA(0, 1), cA + hstep, voffA);
        if (wr == 1) PG8_BAR;
        PG8_WAIT_V(2); PG8_BAR;
        PG8_STAGE(PG8_SB(1, 0), cB + kstep, voffB); PG8_STAGE(PG8_SA(1, 0), cA + kstep, voffA); PG8_STAGE(PG8_SB(1, 1), cB + hstep + kstep, voffB);
        PG8_WAIT_V(6); PG8_BAR;
    } else {
        PG8_STAGE(PG8_SB(0, 0), cB, voffB); PG8_STAGE(PG8_SA(0, 0), cA, voffA); PG8_STAGE(PG8_SB(0, 1), cB + hstep, voffB); PG8_STAGE(PG8_SA(0, 1), cA + hstep, voffA);
        if (wr == 1) PG8_BAR;
        PG8_WAIT_V(4); PG8_BAR;
        PG8_STAGE(PG8_SB(1, 0), cB + kstep, voffB); PG8_STAGE(PG8_SA(1, 0), cA + kstep, voffA); PG8_STAGE(PG8_SB(1, 1), cB + hstep + kstep, voffB);
        PG8_WAIT_V(6); PG8_BAR;
    }
    for (;;) {
        const bool has_next = S.next(ui + 1, nxt);
        const char* nA = has_next ? nxt.A : cA; const char* nB = has_next ? nxt.B : cB;
#pragma unroll 1
        for (int t = 0; t < nt; t += 2) {
            const bool last = (t == nt - 2);
            const char* a1 = cA + (size_t)(t + 1) * kstep;
            const char* a2 = last ? nA : cA + (size_t)(t + 2) * kstep; const char* b2 = last ? nB : cB + (size_t)(t + 2) * kstep;
            const char* a3 = a2 + kstep; const char* b3 = b2 + kstep;
            if constexpr (SP2) {
            PG8_LDB(B0, 0, 0); PG8_LDB(B1, 0, 1); PG8_SCHED; PG8_LDA(At, 0, 0); PG8_STAGE(PG8_SA(1, 1), a1 + hstep, voffA);
            PG8_WAIT_V(8); PG8_WAIT_L(0); PG8_BAR; PG8_MMA(0, 0, At, B0); PG8_MMA(0, 1, At, B1); PG8_BAR; PG8_SCHED;
            PG8_LDA(At, 0, 1); PG8_STAGE(PG8_SB(0, 0), b2, voffB); PG8_STAGE(PG8_SB(0, 1), b2 + hstep, voffB); PG8_STAGE(PG8_SA(0, 0), a2, voffA);
            PG8_WAIT_V(8); PG8_WAIT_L(0); PG8_BAR; PG8_MMA(1, 0, At, B0); PG8_MMA(1, 1, At, B1); PG8_BAR; PG8_SCHED;
            PG8_LDB(B0, 1, 0); PG8_LDB(B1, 1, 1); PG8_SCHED; PG8_LDA(At, 1, 0); PG8_STAGE(PG8_SA(0, 1), a2 + hstep, voffA);
            PG8_WAIT_V(8); PG8_WAIT_L(0); PG8_BAR; PG8_MMA(0, 0, At, B0); PG8_MMA(0, 1, At, B1); PG8_BAR; PG8_SCHED;
            PG8_LDA(At, 1, 1); PG8_STAGE(PG8_SB(1, 0), b3, voffB); PG8_STAGE(PG8_SB(1, 1), b3 + hstep, voffB); PG8_STAGE(PG8_SA(1, 0), a3, voffA);
            PG8_WAIT_V(8); PG8_WAIT_L(0); PG8_BAR; PG8_MMA(1, 0, At, B0); PG8_MMA(1, 1, At, B1); PG8_BAR; PG8_SCHED;
            } else {
            PG8_LDB(B0, 0, 0); PG8_SCHED; PG8_LDA(At, 0, 0); PG8_STAGE(PG8_SA(1, 1), a1 + hstep, voffA);
            PG8_WAIT_L(8); PG8_BAR; PG8_WAIT_L(0); PG8_MMA(0, 0, At, B0); PG8_BAR; PG8_SCHED;
            PG8_LDB(B1, 0, 1); PG8_STAGE(PG8_SB(0, 0), b2, voffB);
            PG8_BAR; PG8_WAIT_L(0); PG8_MMA(0, 1, At, B1); PG8_BAR;
            PG8_LDA(At, 0, 1); PG8_STAGE(PG8_SA(0, 0), a2, voffA);
            PG8_BAR; PG8_WAIT_L(0); PG8_MMA(1, 0, At, B0); PG8_BAR; PG8_SCHED;
            PG8_STAGE(PG8_SB(0, 1), b2 + hstep, voffB);
            PG8_WAIT_V(6); PG8_BAR; PG8_MMA(1, 1, At, B1); PG8_BAR;
            PG8_LDB(B0, 1, 0); PG8_SCHED; PG8_LDA(At, 1, 0); PG8_STAGE(PG8_SA(0, 1), a2 + hstep, voffA);
            PG8_WAIT_L(8); PG8_BAR; PG8_WAIT_L(0); PG8_MMA(0, 0, At, B0); PG8_BAR; PG8_SCHED;
            PG8_LDB(B1, 1, 1); PG8_STAGE(PG8_SB(1, 0), b3, voffB);
            PG8_BAR; PG8_WAIT_L(0); PG8_MMA(0, 1, At, B1); PG8_BAR;
            PG8_LDA(At, 1, 1); PG8_STAGE(PG8_SA(1, 0), a3, voffA);
            PG8_BAR; PG8_WAIT_L(0); PG8_MMA(1, 0, At, B0); PG8_BAR; PG8_SCHED;
            PG8_STAGE(PG8_SB(1, 1), b3 + hstep, voffB);
            PG8_WAIT_V(6); PG8_BAR; PG8_MMA(1, 1, At, B1); PG8_BAR;
            }
        }
        if constexpr (F8) asm volatile("s_nop 15\n\ts_nop 15" ::: "memory");
        if constexpr (ALIGN_EPI) { if (wr == 0) PG8_BAR; }
        E(acc, cur, wr, wc, fr, fq);
        if (!has_next) break;
#pragma unroll
        for (int a = 0; a < 2; ++a)
#pragma unroll
            for (int b = 0; b < 2; ++b)
#pragma unroll
                for (int m = 0; m < 4; ++m)
#pragma unroll
                    for (int n = 0; n < 2; ++n) acc[a][b][m][n] = (f32x4){0.f, 0.f, 0.f, 0.f};
        cur = nxt; cA = nA; cB = nB; ++ui;
        if constexpr (ALIGN_EPI) { if (wr == 1) PG8_BAR; }
    }
    PG8_WAIT_V(0);
    if constexpr (!ALIGN_EPI) { if (wr == 0) PG8_BAR; }
    PG8_BAR;
#undef PG8_SA
#undef PG8_SB
#undef PG8_STAGE
#undef PG8_LDA
#undef PG8_LDB
#undef PG8_MMA
#undef PG8_WAIT_V
#undef PG8_WAIT_L
#undef PG8_BAR
#undef PG8_SCHED
}
}
using pg8::Unit;

#define XB_TMO      128
#define XB_XCNT(j)  (256  + 64 * (j))
#define XB_XSUB(j)  (1280 + 64 * (j))
#define XB_XGEN(j)  (2304 + 64 * (j))
#define XB_TOP      3328
#define XB_TOPGEN   3392
#define XCD_BAR_WORDS 3456
#define XB_SPIN_CAP (1u << 18)
__device__ __forceinline__ unsigned xb_ld(unsigned* p)              { return __hip_atomic_load(p, __ATOMIC_RELAXED, __HIP_MEMORY_SCOPE_AGENT); }
__device__ __forceinline__ unsigned xb_add(unsigned* p, unsigned v) { return __hip_atomic_fetch_add(p, v, __ATOMIC_RELAXED, __HIP_MEMORY_SCOPE_AGENT); }
__device__ __forceinline__ unsigned xb_xcc_id() { return (unsigned)__builtin_amdgcn_s_getreg((3 << 11) | 20) & 0xFu; }
#define XB_SPIN(cond, bar) do { unsigned _sp = 0; while (cond) { __builtin_amdgcn_s_sleep(1); \
    if ((++_sp & 255u) == 0u) { if (xb_ld(&(bar)[XB_TMO])) break; if (_sp > XB_SPIN_CAP) { atomicAdd(&(bar)[XB_TMO], 1u); break; } } } } while (0)
struct XcdBarrier { unsigned* bar; unsigned x; volatile LAS unsigned* st; };
__device__ __forceinline__ XcdBarrier xcd_barrier_post(unsigned* bar, volatile LAS unsigned* st) {
    XcdBarrier b; b.bar = bar; b.x = xb_xcc_id(); b.st = st;
    if (threadIdx.x == 0) (void)xb_add(&bar[XB_XCNT(b.x)], 1u);
    return b;
}
__device__ __forceinline__ void xcd_barrier_complete(unsigned* bar, unsigned x, unsigned& nloc, unsigned& nx) {
    const unsigned G = gridDim.x * gridDim.y * gridDim.z;
    unsigned sum, cnt, mine, sp = 0u;
    for (;;) {
        sum = 0u; cnt = 0u; mine = 0u;
#pragma unroll
        for (unsigned j = 0; j < 16; ++j) { const unsigned c = xb_ld(&bar[XB_XCNT(j)]); sum += c; cnt += (c > 0u) ? 1u : 0u; mine = (j == x) ? c : mine; }
        if (sum == G) break;
        __builtin_amdgcn_s_sleep(1);
        if ((++sp & 255u) == 0u) { if (xb_ld(&bar[XB_TMO])) break; if (sp > XB_SPIN_CAP) { atomicAdd(&bar[XB_TMO], 1u); break; } }
    }
    nloc = mine > 0u ? mine : 1u; nx = cnt > 0u ? cnt : 1u;
}
__device__ __forceinline__ void xcd_barrier(const XcdBarrier& b, const int wave_s) {
    asm volatile("s_waitcnt vmcnt(0)" ::: "memory");
    __syncthreads();
    if (wave_s == 0 && __builtin_amdgcn_mbcnt_hi(~0u, __builtin_amdgcn_mbcnt_lo(~0u, 0u)) == 0u) {
        unsigned* bar = b.bar; asm volatile("" : "+v"(bar));
        __builtin_amdgcn_s_waitcnt(0);
        unsigned nloc = b.st[0], nx = b.st[1];
        if (nloc == 0u) { xcd_barrier_complete(bar, b.x, nloc, nx); b.st[0] = nloc; b.st[1] = nx; }
        const unsigned old = xb_add(&bar[XB_XSUB(b.x)], 1u);
        const unsigned gen = old / nloc;
        if (old + 1u == (gen + 1u) * nloc) {
            __builtin_amdgcn_fence(__ATOMIC_RELEASE, "agent");
            asm volatile("s_waitcnt vmcnt(0)" ::: "memory");
            const unsigned og = xb_add(&bar[XB_TOP], 1u);
            const unsigned tg = og / nx;
            if (og + 1u == (tg + 1u) * nx) xb_add(&bar[XB_TOPGEN], 1u);
            else XB_SPIN(xb_ld(&bar[XB_TOPGEN]) == tg, bar);
            __builtin_amdgcn_fence(__ATOMIC_ACQUIRE, "agent");
            xb_add(&bar[XB_XGEN(b.x)], 1u);
            asm volatile("s_waitcnt vmcnt(0)" ::: "memory");
        } else {
            XB_SPIN(xb_ld(&bar[XB_XGEN(b.x)]) == gen, bar);
            __builtin_amdgcn_fence(__ATOMIC_ACQUIRE, "agent");
            asm volatile("s_waitcnt vmcnt(0)" ::: "memory");
        }
    }
    __syncthreads();
}

struct Args { const float* in[N_IN]; float* out; unsigned char* ws; int ph_lo, ph_hi; };

struct Frame {
    LAS unsigned char* lds;
    int tid, lane, wave, vcu, G;
    const float* const* in; float* out; unsigned char* ws;
};

__device__ __forceinline__ const float* inp(const Frame& F, int k) { const float* p = F.in[k]; asm volatile("" : "+s"(p)); return p; }

struct SchedPlain {
    pg8::Rect R; const char* A; const char* B; size_t tsA, tsB; int xM, xN0, xNn;
    __device__ __forceinline__ bool next(int i, Unit& u) const {
        const int L = i * R.G + R.c;
        if (R.map(L, u.pm, u.pn)) {} else { const int e = L - R.nwg; if (e >= xM * xNn) return false; u.pm = R.nM + e / xNn; u.pn = xN0 + e % xNn; }
        u.seg = 0; u.ex = 0; u.A = A + (size_t)u.pm * tsA; u.B = B + (size_t)u.pn * tsB; return true;
    }
};
struct SchedMerge {
    pg8::Rect R; const char* A; const char* B; size_t tsA, tsB, sA, sB;
    __device__ __forceinline__ bool next(int i, Unit& u) const {
        const int ti = i / 3, sg = i - 3 * ti; const int L = ti * R.G + R.c;
        if (!R.map(L, u.pm, u.pn)) return false;
        u.seg = sg; u.ex = 0;
        u.A = A + (size_t)sg * sA + (size_t)u.pm * tsA; u.B = B + (size_t)sg * sB + (size_t)u.pn * tsB; return true;
    }
};
struct SchedMoe {
    pg8::Rect R; const char* A; const char* B; size_t tsA, tsB, esB; const int* tile_e; int tile0; bool a_global;
    __device__ __forceinline__ bool next(int i, Unit& u) const {
        const int L = i * R.G + R.c;
        if (!R.map(L, u.pm, u.pn)) return false;
        const int gt = tile0 + u.pm; u.ex = gt; u.seg = 0; const int e = tile_e[gt];
        u.A = A + (size_t)(a_global ? gt : u.pm) * tsA; u.B = B + (size_t)e * esB + (size_t)u.pn * tsB; return true;
    }
};

typedef const f32x4 (&AccRef)[2][2][4][2];
__device__ __forceinline__ v4u pack8(const f32x4 a, const f32x4 b) { v4u w; w.x = pg8::cvt_pk_bf16(a[0], a[1]); w.y = pg8::cvt_pk_bf16(a[2], a[3]); w.z = pg8::cvt_pk_bf16(b[0], b[1]); w.w = pg8::cvt_pk_bf16(b[2], b[3]); return w; }
__device__ __forceinline__ void unpack8(const v4u w, f32x4& a, f32x4& b) { a = (f32x4){bflo(w.x), bfhi(w.x), bflo(w.y), bfhi(w.y)}; b = (f32x4){bflo(w.z), bfhi(w.z), bflo(w.w), bfhi(w.w)}; }

struct EpiInproj {
    static constexpr bool PERM = true;
    bf16* phyT; bf16* ucf; bf16* ps5;
    __device__ __forceinline__ void operator()(AccRef acc, const Unit& u, int wr, int wc, int fr, int fq) const {
        const int row0 = u.pm * 256 + wr * 64 + fr;
        if (u.pn < 6) {
#pragma unroll
            for (int ai = 0; ai < 2; ++ai)
#pragma unroll
                for (int m = 0; m < 4; ++m) { const int r = row0 + ai * 128 + m * 16;
#pragma unroll
                    for (int bj = 0; bj < 2; ++bj)
#pragma unroll
                        for (int n = 0; n < 2; ++n)
#pragma unroll
                            for (int j = 0; j < 4; ++j) { const int c = u.pn * 256 + bj * 128 + wc * 32 + 8 * fq + 4 * n + j; phyT[(size_t)c * RT + r] = (bf16)f2bf(acc[ai][bj][m][n][j]); } }
        } else if (u.pn < 10) {
            const int col0 = (u.pn - 6) * 128 + wc * 32 + 8 * fq;
#pragma unroll
            for (int ai = 0; ai < 2; ++ai)
#pragma unroll
                for (int m = 0; m < 4; ++m) { const int r = row0 + ai * 128 + m * 16; f32x4 o[2];
#pragma unroll
                    for (int n = 0; n < 2; ++n)
#pragma unroll
                        for (int j = 0; j < 4; ++j) o[n][j] = acc[ai][0][m][n][j] * sigmoidf_(acc[ai][1][m][n][j]);
                    *(v4u*)(ucf + (size_t)r * 512 + col0) = pack8(o[0], o[1]); }
        } else {
#pragma unroll
            for (int ai = 0; ai < 2; ++ai)
#pragma unroll
                for (int m = 0; m < 4; ++m) { const int r = row0 + ai * 128 + m * 16;
#pragma unroll
                    for (int bj = 0; bj < 2; ++bj) { const int col0 = (u.pn - 10) * 256 + bj * 128 + wc * 32 + 8 * fq; *(v4u*)(ps5 + (size_t)r * 512 + col0) = pack8(acc[ai][bj][m][0], acc[ai][bj][m][1]); } }
        }
    }
};
struct EpiGates {
    static constexpr bool PERM = true;
    bf16* O;
    __device__ __forceinline__ void operator()(AccRef acc, const Unit& u, int wr, int wc, int fr, int fq) const {
        const int row0 = u.pm * 256 + wr * 64 + fr;
#pragma unroll
        for (int ai = 0; ai < 2; ++ai)
#pragma unroll
            for (int m = 0; m < 4; ++m) { const int r = row0 + ai * 128 + m * 16;
#pragma unroll
                for (int bj = 0; bj < 2; ++bj) { const int col0 = u.pn * 256 + bj * 128 + wc * 32 + 8 * fq; f32x4 o[2];
#pragma unroll
                    for (int n = 0; n < 2; ++n)
#pragma unroll
                        for (int j = 0; j < 4; ++j) o[n][j] = sigmoidf_(acc[ai][bj][m][n][j]);
                    *(v4u*)(O + (size_t)r * 3072 + col0) = pack8(o[0], o[1]); } }
    }
};
struct EpiGlu {
    static constexpr bool PERM = true;
    const bf16* SG; bf16* O; const float* bglu;
    __device__ __forceinline__ void operator()(AccRef acc, const Unit& u, int wr, int wc, int fr, int fq) const {
        const int row0 = u.pm * 256 + wr * 64 + fr;
#pragma unroll
        for (int bj = 0; bj < 2; ++bj) { const int col0 = u.pn * 256 + bj * 128 + wc * 32 + 8 * fq;
            const f32x4 b0 = *(const f32x4*)(bglu + col0), b1 = *(const f32x4*)(bglu + col0 + 4);
#pragma unroll
            for (int ai = 0; ai < 2; ++ai)
#pragma unroll
                for (int m = 0; m < 4; ++m) { const int r = row0 + ai * 128 + m * 16;
                    const v4u gw = *(const v4u*)(SG + (size_t)r * 512 + col0); f32x4 g0, g1; unpack8(gw, g0, g1); f32x4 o0, o1;
#pragma unroll
                    for (int j = 0; j < 4; ++j) { o0[j] = g0[j] * sigmoidf_(acc[ai][bj][m][0][j] + b0[j]); o1[j] = g1[j] * sigmoidf_(acc[ai][bj][m][1][j] + b1[j]); }
                    *(v4u*)(O + (size_t)r * 512 + col0) = pack8(o0, o1); } }
    }
};
struct EpiMerge {
    static constexpr bool PERM = true;
    const bf16* GT; bf16* O;
    __device__ __forceinline__ void operator()(AccRef acc, const Unit& u, int wr, int wc, int fr, int fq) const {
        const int row0 = u.pm * 256 + wr * 64 + fr;
#pragma unroll
        for (int ai = 0; ai < 2; ++ai)
#pragma unroll
            for (int m = 0; m < 4; ++m) { const int r = row0 + ai * 128 + m * 16;
#pragma unroll
                for (int bj = 0; bj < 2; ++bj) { const int col0 = u.pn * 256 + bj * 128 + wc * 32 + 8 * fq;
                    const v4u gw = *(const v4u*)(GT + (size_t)r * 3072 + u.seg * 1024 + col0); f32x4 g0, g1; unpack8(gw, g0, g1);
                    f32x4 o0 = g0 * acc[ai][bj][m][0], o1 = g1 * acc[ai][bj][m][1];
                    bf16* dst = O + (size_t)r * 1024 + col0;
                    if (u.seg > 0) { const v4u pw = *(const v4u*)dst; f32x4 p0, p1; unpack8(pw, p0, p1); o0 += p0; o1 += p1; }
                    *(v4u*)dst = pack8(o0, o1); } }
    }
};
struct EpiRes {
    static constexpr bool PERM = false;
    const float* xl; const float* xc; float* ol; float* oc; const float* gbase; float sc;
    __device__ __forceinline__ void operator()(AccRef acc, const Unit& u, int wr, int wc, int fr, int fq) const {
        const bool isl = u.pm < (NX / 256);
        const int prow = isl ? u.pm * 256 : (u.pm - NX / 256) * 256; const int mi = isl ? (u.pm >> 3) : 16;
        const float* xs = isl ? xl : xc; float* os = isl ? ol : oc; const float* gv = gbase + (size_t)mi * INC;
        const int row0 = prow + wr * 64 + fr, col0 = u.pn * 256 + wc * 32 + 4 * fq;
#pragma unroll
        for (int bj = 0; bj < 2; ++bj)
#pragma unroll
            for (int n = 0; n < 2; ++n) { const int c = col0 + bj * 128 + n * 16; const f32x4 g = *(const f32x4*)(gv + c) * sc;
#pragma unroll
                for (int ai = 0; ai < 2; ++ai)
#pragma unroll
                    for (int m = 0; m < 4; ++m) { const size_t off = (size_t)(row0 + ai * 128 + m * 16) * 1024 + c;
                        const f32x4 xr = *(const f32x4*)(xs + off); *(f32x4*)(os + off) = xr * ALPHA_F + g * acc[ai][bj][m][n]; } }
    }
};
struct EpiSwiglu {
    static constexpr bool PERM = true;
    bf16* O; int ldc;
    __device__ __forceinline__ void operator()(AccRef acc, const Unit& u, int wr, int wc, int fr, int fq) const {
        const int row0 = u.pm * 256 + wr * 64 + fr, col0 = u.pn * 128 + wc * 32 + 8 * fq;
#pragma unroll
        for (int ai = 0; ai < 2; ++ai)
#pragma unroll
            for (int m = 0; m < 4; ++m) { const int r = row0 + ai * 128 + m * 16; f32x4 o[2];
#pragma unroll
                for (int n = 0; n < 2; ++n)
#pragma unroll
                    for (int j = 0; j < 4; ++j) o[n][j] = siluf_(acc[ai][0][m][n][j]) * acc[ai][1][m][n][j];
                *(v4u*)(O + (size_t)r * ldc + col0) = pack8(o[0], o[1]); }
    }
};
struct EpiSwigluF8 {
    static constexpr bool PERM = true;
    unsigned char* O; int ldc; float sc;
    __device__ __forceinline__ void operator()(AccRef acc, const Unit& u, int wr, int wc, int fr, int fq) const {
        const int row0 = u.pm * 256 + wr * 64 + fr, col0 = u.pn * 128 + wc * 32 + 8 * fq;
#pragma unroll
        for (int ai = 0; ai < 2; ++ai)
#pragma unroll
            for (int m = 0; m < 4; ++m) { const int r = row0 + ai * 128 + m * 16; f32x4 o[2];
#pragma unroll
                for (int n = 0; n < 2; ++n)
#pragma unroll
                    for (int j = 0; j < 4; ++j) o[n][j] = siluf_(acc[ai][0][m][n][j] * sc) * (acc[ai][1][m][n][j] * sc);
                v2u w; w.x = pk4_fp8(o[0][0], o[0][1], o[0][2], o[0][3]); w.y = pk4_fp8(o[1][0], o[1][1], o[1][2], o[1][3]);
                *(v2u*)(O + (size_t)r * ldc + col0) = w; }
    }
};
struct EpiMoeDown {
    static constexpr bool PERM = true;
    bf16* O; float sc;
    __device__ __forceinline__ void operator()(AccRef acc, const Unit& u, int wr, int wc, int fr, int fq) const {
        const int row0 = u.ex * 256 + wr * 64 + fr;
#pragma unroll
        for (int ai = 0; ai < 2; ++ai)
#pragma unroll
            for (int m = 0; m < 4; ++m) { const int r = row0 + ai * 128 + m * 16;
#pragma unroll
                for (int bj = 0; bj < 2; ++bj) { const int col0 = u.pn * 256 + bj * 128 + wc * 32 + 8 * fq; *(v4u*)(O + (size_t)r * 1024 + col0) = pack8(acc[ai][bj][m][0] * sc, acc[ai][bj][m][1] * sc); } }
    }
};

template <bool F8>
__device__ __forceinline__ void transpose_item64(const float* W, int K, int N, unsigned char* WT, int dst_row0, int k0, int n0, float scale, LAS float* scr, int lane) {
#pragma unroll 4
    for (int i = 0; i < 16; ++i) { const int row = 4 * i + (lane >> 4), nc = 4 * (lane & 15);
        const f32x4 v = *(const f32x4*)(W + (size_t)(k0 + row) * N + n0 + nc); *(LAS f32x4*)(scr + row * 68 + nc) = v * scale; }
    LDS_WAIT(); asm volatile("" ::: "memory");
    const LAS float* sp = scr + lane;
    if constexpr (F8) {
        unsigned char* dst = WT + (size_t)(dst_row0 + lane) * K + k0;
#pragma unroll
        for (int c4 = 0; c4 < 4; ++c4) { v4u o;
#pragma unroll
            for (int e = 0; e < 4; ++e) { const int kk = 16 * c4 + 4 * e; o[e] = pk4_fp8(sp[(kk + 0) * 68], sp[(kk + 1) * 68], sp[(kk + 2) * 68], sp[(kk + 3) * 68]); }
            *(v4u*)(dst + 16 * c4) = o; }
    } else {
        unsigned char* dst = WT + ((size_t)(dst_row0 + lane) * K + k0) * 2;
#pragma unroll
        for (int c8 = 0; c8 < 8; ++c8) { v4u o;
#pragma unroll
            for (int e = 0; e < 4; ++e) { const int kk = 8 * c8 + 2 * e; o[e] = pk2(sp[kk * 68], sp[(kk + 1) * 68]); }
            *(v4u*)(dst + 16 * c8) = o; }
    }
    LDS_WAIT(); asm volatile("" ::: "memory");
}
__device__ __forceinline__ int dst_row_map(int kind, int n0) {
    if (kind == 1) { if (n0 >= 1536 && n0 < 2560) { const int i = (n0 - 1536) & 511, hi = (n0 - 1536) >> 9; return 1536 + 256 * (i >> 7) + 128 * hi + (i & 127); } return n0; }
    if (kind == 2) return 256 * (n0 >> 7) + (n0 & 127);
    if (kind == 3) return 256 * (n0 >> 7) + 128 + (n0 & 127);
    return n0;
}
__device__ __forceinline__ void conv_matrix_item(const float* W, int K, int N, bf16* WT, int kind, int item, LAS float* scr, int lane) {
    const int nblk = N / 64, kb = item / nblk, nb = item - kb * nblk;
    transpose_item64<false>(W, K, N, (unsigned char*)WT, dst_row_map(kind, 64 * nb), 64 * kb, 64 * nb, 1.0f, scr, lane);
}
__device__ __forceinline__ void conv_matrix_item_f8(const float* W, int K, int N, unsigned char* WT, int kind, int item, float scale, LAS float* scr, int lane) {
    const int nblk = N / 64, kb = item / nblk, nb = item - kb * nblk;
    transpose_item64<true>(W, K, N, WT, dst_row_map(kind, 64 * nb), 64 * kb, 64 * nb, scale, scr, lane);
}
__device__ __forceinline__ void p0a_prologue(Frame& F) {
    LAS float* scr = (LAS float*)(F.lds + F.wave * 17408);
    const int gw = F.vcu * NWAVES + F.wave, NGW = F.G * NWAVES;
    bf16* ws_win = (bf16*)(F.ws + WS_WIN); bf16* ws_outs = (bf16*)(F.ws + WS_WOUTS); bf16* ws_glu = (bf16*)(F.ws + WS_WGLU); bf16* ws_wo = (bf16*)(F.ws + WS_WO);
    bf16* ws_w13 = (bf16*)(F.ws + WS_W13); bf16* ws_w2 = (bf16*)(F.ws + WS_W2);
    constexpr int I_IN = (1024 / 64) * (6144 / 64), I_OUT = (512 / 64) * (1024 / 64), I_GLU = (512 / 64) * (512 / 64), I_WOI = (1024 / 64) * (1024 / 64), I_F1 = (1024 / 64) * (2816 / 64), I_F2 = (2816 / 64) * (1024 / 64);
    constexpr int NITEMS = 2 * I_IN + 6 * I_OUT + 2 * I_GLU + 2 * I_WOI + 2 * I_F1 + I_F2;
    for (int it = gw; it < NITEMS; it += NGW) {
        int r = it;
        if (r < 2 * I_IN) { const int l = r / I_IN; conv_matrix_item(inp(F, I_WIN) + (size_t)l * 1024 * 6144, 1024, 6144, ws_win + (size_t)l * 6144 * 1024, 1, r - l * I_IN, scr, F.lane); continue; } r -= 2 * I_IN;
        if (r < 6 * I_OUT) { const int q = r / I_OUT, l = q / 3, s = q - 3 * l; const float* src = inp(F, s == 0 ? I_WHY : (s == 1 ? I_WCF : I_WS5)) + (size_t)l * 512 * 1024;
            conv_matrix_item(src, 512, 1024, ws_outs + (size_t)(l * 3 + s) * 1024 * 512, 0, r - q * I_OUT, scr, F.lane); continue; } r -= 6 * I_OUT;
        if (r < 2 * I_GLU) { const int l = r / I_GLU; conv_matrix_item(inp(F, I_SWGLU) + (size_t)l * 512 * 512, 512, 512, ws_glu + (size_t)l * 512 * 512, 0, r - l * I_GLU, scr, F.lane); continue; } r -= 2 * I_GLU;
        if (r < 2 * I_WOI) { const int l = r / I_WOI; conv_matrix_item(inp(F, I_WO) + (size_t)l * 1024 * 1024, 1024, 1024, ws_wo + (size_t)l * 1024 * 1024, 0, r - l * I_WOI, scr, F.lane); continue; } r -= 2 * I_WOI;
        if (r < I_F1) { conv_matrix_item_f8(inp(F, I_FFW1), 1024, 2816, (unsigned char*)ws_w13, 2, r, 32.f, scr, F.lane); continue; } r -= I_F1;
        if (r < I_F1) { conv_matrix_item_f8(inp(F, I_FFW3), 1024, 2816, (unsigned char*)ws_w13, 3, r, 32.f, scr, F.lane); continue; } r -= I_F1;
        conv_matrix_item_f8(inp(F, I_FFW2), 2816, 1024, (unsigned char*)ws_w2, 0, r, 128.f, scr, F.lane);
    }
    __syncthreads();
    float* part = (float*)(F.ws + WS_HX);
    LAS float* sc = (LAS float*)F.lds;
    for (int it = F.vcu; it < 2 * 8 * 12; it += F.G) {
        const int l = it / 96, r = it - l * 96, ks = r / 12, nb = r - ks * 12;
        __syncthreads();
        for (int e = F.tid; e < 17 * 128; e += 512) { const int i = e >> 7, k = e & 127; const float cv = i < 16 ? inp(F, I_C)[i * 1024 + ks * 128 + k] : inp(F, I_CCTX)[ks * 128 + k]; sc[k * 20 + i] = siluf_(cv); }
        __syncthreads();
        const int n = nb * 512 + F.tid; const float* w = inp(F, I_WMOD) + (size_t)l * 1024 * 6144 + (size_t)(ks * 128) * 6144 + n;
        float acc[17];
#pragma unroll
        for (int i = 0; i < 17; ++i) acc[i] = 0.f;
        for (int k = 0; k < 128; ++k) { const float wv = w[(size_t)k * 6144];
#pragma unroll
            for (int i = 0; i < 17; ++i) acc[i] += sc[k * 20 + i] * wv; }
#pragma unroll
        for (int i = 0; i < 17; ++i) part[((size_t)(ks * 2 + l) * 17 + i) * 6144 + n] = acc[i];
    }
}
__device__ __forceinline__ void p0b_mods(Frame& F) {
    const float* part = (const float*)(F.ws + WS_HX); float* mods = (float*)(F.ws + WS_MODS);
    for (int e = F.vcu * 512 + F.tid; e < 2 * 17 * 6144; e += F.G * 512) {
        const int l = e / (17 * 6144), r = e - l * 17 * 6144, i = r / 6144, n = r - i * 6144;
        float s = inp(F, I_BMOD)[l * 6144 + n];
#pragma unroll
        for (int ks = 0; ks < 8; ++ks) s += part[((size_t)(ks * 2 + l) * 17 + i) * 6144 + n];
        mods[e] = s;
    }
}

__device__ __forceinline__ void h2table_phase(Frame& F, int l) {
    const int gw = F.vcu * NWAVES + F.wave, NGW = F.G * NWAVES, lane = F.lane;
    float* H2 = (float*)(F.ws + WS_FILT);
    const float* w1 = inp(F, I_FW1) + l * 33 * 64; const float* b1 = inp(F, I_FB1) + l * 64; const float* w2 = inp(F, I_FW2) + l * 64 * 64; const float* b2 = inp(F, I_FB2) + l * 64;
    const float* fq = inp(F, I_FREQ) + l * 128;
    for (int pos = gw; pos < LSEQ + LCTX; pos += NGW) {
        const bool isc = pos >= LSEQ; const int L = isc ? LCTX : LSEQ; const int t = isc ? pos - LSEQ : pos;
        const float tn = (float)t / (float)(L - 1);
        float z = 0.f;
        if (lane == 0) z = tn;
        else if (lane <= 32) { const int band = lane <= 16 ? lane : lane - 16; const int ph = (t * band) % L; const float ang = 6.283185307179586f * ((float)ph / (float)L); z = lane <= 16 ? cosf(ang) : sinf(ang); }
        float h = b1[lane];
        for (int k = 0; k < 33; ++k) h += lane_bcast(z, k) * w1[k * 64 + lane];
        h = sinf(fq[lane] * h);
        float h2 = b2[lane];
        for (int k = 0; k < 64; ++k) h2 += lane_bcast(h, k) * w2[k * 64 + lane];
        H2[(size_t)pos * 64 + lane] = sinf(fq[64 + lane] * h2);
    }
}
__device__ __forceinline__ void filter_expand_phase(Frame& F, int l) {
    const int gw = F.vcu * NWAVES + F.wave, NGW = F.G * NWAVES, lane = F.lane;
    const float* H2 = (const float*)(F.ws + WS_FILT);
    const float* w3 = inp(F, I_FW3) + (size_t)l * 64 * 2048; const float* b3 = inp(F, I_FB3) + l * 2048; const float* dec = inp(F, I_DECAY) + l * 2048; const float* hb = inp(F, I_HBIAS) + l * 1024;
    LAS float* W = (LAS float*)(F.lds + F.wave * 17408);
#pragma unroll 1
    for (int it = gw; it < 1024 + 128; it += NGW) {
        const bool isc = it >= 1024; const int ii = isc ? it - 1024 : it; const int chunk = ii >> 5, grp = ii & 31;
        const int L = isc ? LCTX : LSEQ; const int t = chunk * 64 + lane; const int pos = isc ? LSEQ + t : t;
        bf16* KR = isc ? (bf16*)(F.ws + WS_KRC) : (bf16*)(F.ws + WS_KRL); const int KLEN = 2 * L;
        const float tn = (float)t / (float)(L - 1);
#pragma unroll 4
        for (int k = 0; k < 64; ++k) W[lane * 68 + k] = w3[(size_t)k * 2048 + grp * 64 + lane];
        f32x4 h2[16];
#pragma unroll
        for (int k = 0; k < 16; ++k) h2[k] = *(const f32x4*)(H2 + (size_t)pos * 64 + 4 * k);
        const int colL = grp * 64 + lane; const float b3L = b3[colL], decL = fabsf(dec[colL]); const float hbL = ((colL >> 9) & 1) == 0 ? hb[(colL >> 10) * 512 + (colL & 511)] : 0.f;
        LDS_WAIT();
#pragma unroll 1
        for (int cc = 0; cc < 64; ++cc) {
            const int col = grp * 64 + cc; float a = lane_bcast(b3L, cc);
#pragma unroll
            for (int k = 0; k < 16; ++k) { const f32x4 wv = *(const LAS f32x4*)(W + cc * 68 + 4 * k); a += (h2[k][0] * wv[0] + h2[k][1] * wv[1]) + (h2[k][2] * wv[2] + h2[k][3] * wv[3]); }
            const int o = col >> 10, dir = (col >> 9) & 1, c = col & 511;
            float v = a * __expf(-tn * lane_bcast(decL, cc));
            if (t == 0 && dir == 0) v += lane_bcast(hbL, cc);
            const bool valid = !(t == 0 && dir == 1);
            const int i = dir ? L + t : L - t;
            const unsigned short bv = (unsigned short)f2bf(v);
            bf16* base = (valid ? KR + (size_t)((o * 512 + c) * 8) * KLEN : (bf16*)(F.ws + WS_KDUMMY) + 16) + i;
#pragma unroll
            for (int m = 0; m < 8; ++m) base[(ptrdiff_t)m * (KLEN - 1)] = bv;
        }
        LDS_WAIT();
    }
    __syncthreads();
}
__device__ __forceinline__ void s5params_phase(Frame& F, int l) {
    float* P = (float*)(F.ws + WS_S5P);
    for (int e = F.vcu * 512 + F.tid; e < 2 * 32 * 64; e += F.G * 512) {
        const int base = l * 4096 + e;
        const int dg = e >> 6;
        const float lam_re = fminf(inp(F, I_SARE)[base], -1e-4f), lam_im = inp(F, I_SAIM)[base];
        const float dt = expf(inp(F, I_SLDT)[l * 64 + dg]);
        const float mag = expf(lam_re * dt), ang = lam_im * dt; const float abr = mag * cosf(ang), abi = mag * sinf(ang);
        const float den = lam_re * lam_re + lam_im * lam_im;
        const float qre = ((abr - 1.0f) * lam_re + abi * lam_im) / den, qim = (abi * lam_re - (abr - 1.0f) * lam_im) / den;
        float* o = P + (size_t)e * 36; o[0] = abr; o[1] = abi;
        const float* br = inp(F, I_SBRE) + (size_t)base * 16; const float* bi = inp(F, I_SBIM) + (size_t)base * 16;
        for (int c = 0; c < 16; ++c) { o[2 + c] = qre * br[c] - qim * bi[c]; o[18 + c] = qre * bi[c] + qim * br[c]; }
        o[34] = 0.f; o[35] = 0.f;
    }
}

struct Row { f32x4 v[4]; };
__device__ __forceinline__ void row_load(Row& r, const float* p, int lane) { const f32x4* x = (const f32x4*)p + lane;
#pragma unroll
    for (int j = 0; j < 4; ++j) r.v[j] = x[64 * j]; }
__device__ __forceinline__ void row_store(const Row& r, float* p, int lane) { f32x4* x = (f32x4*)p + lane;
#pragma unroll
    for (int j = 0; j < 4; ++j) x[64 * j] = r.v[j]; }
__device__ __forceinline__ void row_norm(Row& r) {
    float s = 0.f;
#pragma unroll
    for (int j = 0; j < 4; ++j) s += (r.v[j][0] + r.v[j][1]) + (r.v[j][2] + r.v[j][3]);
    const float mean = wave_sum(s) * (1.f / DM); float q = 0.f;
#pragma unroll
    for (int j = 0; j < 4; ++j) { r.v[j] = r.v[j] - mean; q += (r.v[j][0] * r.v[j][0] + r.v[j][1] * r.v[j][1]) + (r.v[j][2] * r.v[j][2] + r.v[j][3] * r.v[j][3]); }
    const float rstd = 1.f / sqrtf(wave_sum(q) * (1.f / DM) + LN_EPS);
#pragma unroll
    for (int j = 0; j < 4; ++j) r.v[j] = r.v[j] * rstd;
}
__device__ __forceinline__ void row_affine(Row& r, const float* g, const float* b, int lane, float gadd) {
    const f32x4* gp = (const f32x4*)g + lane; const f32x4* bp = (const f32x4*)b + lane;
#pragma unroll
    for (int j = 0; j < 4; ++j) r.v[j] = r.v[j] * (gp[64 * j] + gadd) + bp[64 * j];
}
__device__ __forceinline__ void row_store_bf16(const Row& r, bf16* p, int lane) { unsigned long long* o = (unsigned long long*)p + lane;
#pragma unroll
    for (int j = 0; j < 4; ++j) o[64 * j] = (unsigned long long)pk2(r.v[j][0], r.v[j][1]) | ((unsigned long long)pk2(r.v[j][2], r.v[j][3]) << 32); }

__device__ __forceinline__ const float* mod_vec(Frame& F, int l, int row, int which) { const int i = row < NX ? (row >> 11) : 16; return (const float*)(F.ws + WS_MODS) + ((size_t)l * 17 + i) * INC + which * 1024; }
__device__ __forceinline__ const float* xrow_ptr(Frame& F, int l, int row) {
    if (l == 0) return row < NX ? inp(F, I_X) + (size_t)row * DM : inp(F, I_CTX) + (size_t)(row - NX) * DM;
    return row < NX ? F.out + (size_t)row * DM : (const float*)(F.ws + WS_XC) + (size_t)(row - NX) * DM;
}
__device__ __forceinline__ float* xcur_ptr(Frame& F, int row) { return row < NX ? F.out + (size_t)row * DM : (float*)(F.ws + WS_XC) + (size_t)(row - NX) * DM; }

__device__ __forceinline__ void lnmod_phase(Frame& F, int l) {
    const int gw = F.vcu * NWAVES + F.wave, NGW = F.G * NWAVES; bf16* hx = (bf16*)(F.ws + WS_HX);
    for (int m = gw; m < RT; m += NGW) { Row r; row_load(r, xrow_ptr(F, l, m), F.lane); row_norm(r); row_affine(r, mod_vec(F, l, m, 1), mod_vec(F, l, m, 0), F.lane, 1.0f); row_store_bf16(r, hx + (size_t)m * DM, F.lane); }
}
__device__ __forceinline__ void ln1_phase(Frame& F, int l) {
    const int gw = F.vcu * NWAVES + F.wave, NGW = F.G * NWAVES; bf16* hx = (bf16*)(F.ws + WS_HX); const int M = l == 0 ? RT : NX;
    const float* g = inp(F, I_LN1G) + l * DM; const float* b = inp(F, I_LN1B) + l * DM;
    int* toke = (int*)(F.ws + WS_META + META_TOKE); float* tokw = (float*)(F.ws + WS_META + META_TOKW);
    LAS unsigned* lcnt = (LAS unsigned*)(F.lds);
    unsigned c8[8];
#pragma unroll
    for (int e = 0; e < 8; ++e) c8[e] = 0u;
    if (l == 1) { if (F.tid < 8) lcnt[F.tid] = 0u; __syncthreads(); }
    f32x4 rtr[4][4][2];
    if (l == 1) { const float* rt = inp(F, I_ROUTER);
#pragma unroll
        for (int j = 0; j < 4; ++j)
#pragma unroll
            for (int q = 0; q < 4; ++q) { const int k = 256 * j + 4 * F.lane + q; rtr[j][q][0] = *(const f32x4*)(rt + k * 8); rtr[j][q][1] = *(const f32x4*)(rt + k * 8 + 4); } }
    for (int m = gw; m < M; m += NGW) {
        float* xp = xcur_ptr(F, m); Row r; row_load(r, xp, F.lane); row_norm(r); row_affine(r, g, b, F.lane, 0.0f); row_store(r, xp, F.lane);
        row_norm(r); row_affine(r, mod_vec(F, l, m, 4), mod_vec(F, l, m, 3), F.lane, 1.0f);
        if (l == 0) { unsigned* d8 = (unsigned*)((unsigned char*)hx + (size_t)m * DM) + F.lane;
#pragma unroll
            for (int j = 0; j < 4; ++j) d8[64 * j] = pk4_fp8(r.v[j][0], r.v[j][1], r.v[j][2], r.v[j][3]); }
        else {
            float lg[8];
#pragma unroll
            for (int e = 0; e < 8; ++e) lg[e] = 0.f;
#pragma unroll
            for (int j = 0; j < 4; ++j)
#pragma unroll
                for (int q = 0; q < 4; ++q) { const f32x4 r0 = rtr[j][q][0], r1 = rtr[j][q][1]; const float hv = r.v[j][q];
                    lg[0] += hv * r0[0]; lg[1] += hv * r0[1]; lg[2] += hv * r0[2]; lg[3] += hv * r0[3]; lg[4] += hv * r1[0]; lg[5] += hv * r1[1]; lg[6] += hv * r1[2]; lg[7] += hv * r1[3]; }
#pragma unroll
            for (int e = 0; e < 8; ++e) lg[e] = wave_sum(lg[e]);
            int e0 = 0; float v0 = lg[0];
#pragma unroll
            for (int e = 1; e < 8; ++e) if (lg[e] > v0) { v0 = lg[e]; e0 = e; }
            int e1 = -1; float v1 = -3.0e38f;
#pragma unroll
            for (int e = 0; e < 8; ++e) if (e != e0 && lg[e] > v1) { v1 = lg[e]; e1 = e; }
            const float ex = __expf(v1 - v0); const float w0 = 1.0f / (1.0f + ex), w1 = ex / (1.0f + ex);
            if (F.lane == 0) { toke[2 * m] = e0; toke[2 * m + 1] = e1; tokw[2 * m] = w0; tokw[2 * m + 1] = w1; }
#pragma unroll
            for (int e = 0; e < 8; ++e) c8[e] += (e0 == e ? 1u : 0u) + (e1 == e ? 1u : 0u);
        }
    }
    if (l == 1) {
        if (F.lane == 0) {
#pragma unroll
            for (int e = 0; e < 8; ++e) if (c8[e]) atomicAdd((unsigned*)&lcnt[e], c8[e]); }
        __syncthreads();
        if (F.tid < 8) { const unsigned v = lcnt[F.tid]; if (v) atomicAdd((unsigned*)(F.ws + WS_CTL) + CW_CNT + F.tid, v); }
        __syncthreads();
    }
}
__device__ __forceinline__ void ln2_phase(Frame& F, int l) {
    const int gw = F.vcu * NWAVES + F.wave, NGW = F.G * NWAVES;
    const float* g = inp(F, I_LN2G) + l * DM; const float* b = inp(F, I_LN2B) + l * DM;
    for (int m = gw; m < RT; m += NGW) { float* xp = xcur_ptr(F, m); Row r; row_load(r, xp, F.lane); row_norm(r); row_affine(r, g, b, F.lane, 0.0f); row_store(r, xp, F.lane); }
}

__device__ __forceinline__ void moe_convert_phase(Frame& F) {
    LAS float* scr = (LAS float*)(F.lds + 4096 + F.wave * 17408);
    const int gw = F.vcu * NWAVES + F.wave, NGW = F.G * NWAVES;
    unsigned char* w13 = F.ws + WS_MW13; unsigned char* w2 = F.ws + WS_MW2;
    constexpr int I1 = (1024 / 64) * (3584 / 64), I2 = (3584 / 64) * (1024 / 64);
    for (int it = gw; it < 8 * (2 * I1 + I2); it += NGW) {
        const int e = it / (2 * I1 + I2); int r = it - e * (2 * I1 + I2);
        if (r < I1) { conv_matrix_item_f8(inp(F, I_MW1) + (size_t)e * 1024 * 3584, 1024, 3584, w13 + (size_t)e * 7168 * 1024, 2, r, 32.f, scr, F.lane); continue; } r -= I1;
        if (r < I1) { conv_matrix_item_f8(inp(F, I_MW3) + (size_t)e * 1024 * 3584, 1024, 3584, w13 + (size_t)e * 7168 * 1024, 3, r, 32.f, scr, F.lane); continue; } r -= I1;
        conv_matrix_item_f8(inp(F, I_MW2) + (size_t)e * 3584 * 1024, 3584, 1024, w2 + (size_t)e * 1024 * 3584, 0, r, 128.f, scr, F.lane);
    }
}
__device__ __forceinline__ void moe_offsets(Frame& F, int (&off)[8], int& ntiles) {
    const unsigned* cnt = (const unsigned*)(F.ws + WS_CTL) + CW_CNT; int o = 0;
#pragma unroll
    for (int e = 0; e < 8; ++e) { off[e] = o; o += (int)((cnt[e] + 255u) & ~255u); }
    ntiles = o >> 8;
}
__device__ __forceinline__ void moe_setup_phase(Frame& F) {
    const int gw = F.vcu * NWAVES + F.wave, NGW = F.G * NWAVES, lane = F.lane;
    int off[8], ntiles; moe_offsets(F, off, ntiles);
    const int* toke = (const int*)(F.ws + WS_META + META_TOKE); int* tpos = (int*)(F.ws + WS_META + META_POS); int* tile_e = (int*)(F.ws + WS_META + META_TILE);
    unsigned* cur = (unsigned*)(F.ws + WS_CTL) + CW_CUR; unsigned char* srt = F.ws + WS_SORT;
    if (F.vcu == 0 && F.tid < 8) { const int e = F.tid; const int t0 = off[e] >> 8; const int t1 = (e == 7 ? ntiles : (off[e + 1] >> 8)); for (int t = t0; t < t1; ++t) tile_e[t] = e; if (e == 0) tile_e[511] = ntiles; }
    for (int base = gw; base < NX; base += 64 * NGW) {
        const int m = base + lane * NGW; const bool act = m < NX;
        const int e0 = act ? toke[2 * m] : -1, e1 = act ? toke[2 * m + 1] : -1;
        int p0 = 0, p1 = 0;
        const unsigned long long lt = (1ull << lane) - 1ull;
#pragma unroll
        for (int e = 0; e < 8; ++e) {
            const unsigned long long m0 = __ballot(e0 == e), m1 = __ballot(e1 == e);
            const int c = __popcll(m0) + __popcll(m1); int bs = 0;
            if (lane == 0 && c) bs = (int)atomicAdd(cur + e, (unsigned)c);
            bs = __builtin_amdgcn_readfirstlane(bs) + off[e];
            if (e0 == e) p0 = bs + __popcll(m0 & lt);
            if (e1 == e) p1 = bs + __popcll(m0) + __popcll(m1 & lt);
        }
        if (act) { tpos[2 * m] = p0; tpos[2 * m + 1] = p1; }
        const int nrows = (NX - base + NGW - 1) / NGW;
        for (int i = 0; i < 64 && i < nrows; ++i) {
            const int mi = base + i * NGW; const int q0 = __builtin_amdgcn_readlane(p0, i), q1 = __builtin_amdgcn_readlane(p1, i);
            Row r; row_load(r, F.out + (size_t)mi * DM, lane); row_norm(r); row_affine(r, mod_vec(F, 1, mi, 4), mod_vec(F, 1, mi, 3), lane, 1.0f);
            unsigned* d0 = (unsigned*)(srt + (size_t)q0 * DM) + lane; unsigned* d1 = (unsigned*)(srt + (size_t)q1 * DM) + lane;
#pragma unroll
            for (int j = 0; j < 4; ++j) { const unsigned w8 = pk4_fp8(r.v[j][0], r.v[j][1], r.v[j][2], r.v[j][3]); d0[64 * j] = w8; d1[64 * j] = w8; }
        }
    }
}
__device__ __forceinline__ void moe_combine_phase(Frame& F) {
    const int gw = F.vcu * NWAVES + F.wave, NGW = F.G * NWAVES, lane = F.lane;
    const float* tokw = (const float*)(F.ws + WS_META + META_TOKW); const int* tpos = (const int*)(F.ws + WS_META + META_POS); const bf16* Y = (const bf16*)(F.ws + WS_MOEY);
    const float* g = inp(F, I_LN2G) + DM; const float* b = inp(F, I_LN2B) + DM;
    for (int m = gw; m < NX; m += NGW) {
        const float w0 = tokw[2 * m], w1 = tokw[2 * m + 1]; const int p0 = tpos[2 * m], p1 = tpos[2 * m + 1];
        Row r; row_load(r, F.out + (size_t)m * DM, lane);
        const unsigned long long* y0 = (const unsigned long long*)(Y + (size_t)p0 * DM) + lane; const unsigned long long* y1 = (const unsigned long long*)(Y + (size_t)p1 * DM) + lane;
        const f32x4* g2 = (const f32x4*)mod_vec(F, 1, m, 5) + lane;
#pragma unroll
        for (int j = 0; j < 4; ++j) { const unsigned long long a = y0[64 * j], c = y1[64 * j];
            const f32x4 ya = (f32x4){bflo((unsigned)a), bfhi((unsigned)a), bflo((unsigned)(a >> 32)), bfhi((unsigned)(a >> 32))};
            const f32x4 yc = (f32x4){bflo((unsigned)c), bfhi((unsigned)c), bflo((unsigned)(c >> 32)), bfhi((unsigned)(c >> 32))};
            r.v[j] = r.v[j] * ALPHA_F + g2[64 * j] * (ya * w0 + yc * w1); }
        row_norm(r); row_affine(r, g, b, lane, 0.0f); row_store(r, F.out + (size_t)m * DM, lane);
    }
}

constexpr int HY_U_OFF = 0, HY_U_STRIDE = 4128, HY_K_OFF = 16 * HY_U_STRIDE, HY_K_STRIDE = 8208;
constexpr int HYC_U_STRIDE = 544, HYC_K_STRIDE = 1040;
static_assert(HY_K_OFF + 8 * HY_K_STRIDE + 64 <= MISC_OFF, "hyena LDS map");
__device__ __forceinline__ float hy_short4(const bf16* p, int tb, int L, float w0, float w1, float w2, float bs, f32x4& x) {
    const v2u pw = *(const v2u*)(p + tb); const float c0 = bflo(pw.x), c1 = bfhi(pw.x), c2 = bflo(pw.y), c3 = bfhi(pw.y);
    const float pm = tb > 0 ? bf2f(p[tb - 1]) : 0.f, pp = tb + 4 < L ? bf2f(p[tb + 4]) : 0.f;
    x[0] = bs + w0 * pm + w1 * c0 + w2 * c1; x[1] = bs + w0 * c0 + w1 * c1 + w2 * c2; x[2] = bs + w0 * c1 + w1 * c2 + w2 * c3; x[3] = bs + w0 * c2 + w1 * c3 + w2 * pp; return 0.f;
}
__device__ __forceinline__ void hy_short4u(const bf16* pi, bool first, bool last, float w0, float w1, float w2, float bs, f32x4& x) {
    const v2u pw = *(const v2u*)pi; const float c0 = bflo(pw.x), c1 = bfhi(pw.x), c2 = bflo(pw.y), c3 = bfhi(pw.y);
    float pm = bf2f(pi[-1]), pp = bf2f(pi[4]); pm = first ? 0.f : pm; pp = last ? 0.f : pp;
    x[0] = bs + w0 * pm + w1 * c0 + w2 * c1; x[1] = bs + w0 * c0 + w1 * c1 + w2 * c2; x[2] = bs + w0 * c1 + w1 * c2 + w2 * c3; x[3] = bs + w0 * c2 + w1 * c3 + w2 * pp;
}
template <int L, int USTR>
__device__ __forceinline__ void hy_fill_u(Frame& F, const bf16* phyT, int col, int rowb0, float w0, float w1, float w2, float bs) {
    const bf16* pc = phyT + (size_t)col * RT + rowb0;
    constexpr int NIT = 16 * L / 8 / 512 > 0 ? 16 * L / 8 / 512 : 1;
#pragma unroll 4
    for (int it = 0; it < NIT; ++it) { const int ch = F.tid + 512 * it; const int b = ch / (L / 8), tb = (ch - b * (L / 8)) * 8; const bf16* p = pc + (size_t)b * L + tb;
        const v4u cw = *(const v4u*)p; float pm = bf2f(p[-1]), pp = bf2f(p[8]); pm = tb == 0 ? 0.f : pm; pp = tb + 8 >= L ? 0.f : pp;
        const float c0 = bflo(cw.x), c1 = bfhi(cw.x), c2 = bflo(cw.y), c3 = bfhi(cw.y), c4 = bflo(cw.z), c5 = bfhi(cw.z), c6 = bflo(cw.w), c7 = bfhi(cw.w);
        v4u o; o.x = pk2(bs + w0 * pm + w1 * c0 + w2 * c1, bs + w0 * c0 + w1 * c1 + w2 * c2); o.y = pk2(bs + w0 * c1 + w1 * c2 + w2 * c3, bs + w0 * c2 + w1 * c3 + w2 * c4);
        o.z = pk2(bs + w0 * c3 + w1 * c4 + w2 * c5, bs + w0 * c4 + w1 * c5 + w2 * c6); o.w = pk2(bs + w0 * c5 + w1 * c6 + w2 * c7, bs + w0 * c6 + w1 * c7 + w2 * pp);
        *(LAS v4u*)(F.lds + HY_U_OFF + b * USTR + tb * 2) = o; }
}
template <int KLEN, int KSTR>
__device__ __forceinline__ void hy_fill_k(Frame& F, const bf16* kr) {
    const bf16* src = kr + (size_t)F.wave * KLEN + F.lane * 8;
#pragma unroll
    for (int i = 0; i < KLEN * 2 / 1024; ++i)
        __builtin_amdgcn_global_load_lds((const unsigned*)(src + i * 512), (LAS unsigned*)(F.lds + HY_K_OFF + F.wave * KSTR + i * 1024), 16, 0, 0);
    VM_WAIT();
}
__device__ __forceinline__ void hyena_unit(Frame& F, int l, int c, bool with_ctx) {
    const bf16* phyT = (const bf16*)(F.ws + WS_PHYT); bf16* z2 = (bf16*)(F.ws + WS_Z2);
    const bf16* KRL = (const bf16*)(F.ws + WS_KRL); const bf16* KRC = (const bf16*)(F.ws + WS_KRC);
    const float* sw = inp(F, I_HSW) + l * 3 * 1536; const float* sb = inp(F, I_HSB) + l * 1536;
    const int lane = F.lane, w = F.wave, r = lane & 15, q = lane >> 4, m = (-r) & 7;
    __syncthreads();
    { const int col = 1024 + c; hy_fill_u<LSEQ, HY_U_STRIDE>(F, phyT, col, 0, sw[col], sw[1536 + col], sw[3072 + col], sb[col]); }
    hy_fill_k<4096, HY_K_STRIDE>(F, KRL + (size_t)((0 * 512 + c) * 8) * 4096);
    __syncthreads();
#pragma unroll 1
    for (int o = 0; o < 2; ++o) {
        f32x4 acc[16];
#pragma unroll 1
        for (int rep_ = 0; rep_ < NREP(15); ++rep_) {
#pragma unroll
        for (int i = 0; i < 16; ++i) acc[i] = (f32x4){0.f, 0.f, 0.f, 0.f};
        const LAS unsigned char* pa = F.lds + HY_K_OFF + m * HY_K_STRIDE + 2 * (8 * q - r - m + 2048 - 256 * w);
        const LAS unsigned char* pb = F.lds + HY_U_OFF + r * HY_U_STRIDE + 16 * q;
        bf16x8 R[16];
#pragma unroll
        for (int i = 0; i < 16; ++i) R[i] = *(const LAS bf16x8*)(pa - 32 * i);
        bf16x8 bcur = *(const LAS bf16x8*)pb;
#pragma unroll 1
        for (int kg = 0; kg < 8; ++kg) {
#pragma unroll
            for (int kk = 0; kk < 8; ++kk) {
                const bf16x8 bnext = *(const LAS bf16x8*)(pb + 64 * (kk + 1));
                const bf16x8 n0 = *(const LAS bf16x8*)(pa + 64 * (kk + 1)), n1 = *(const LAS bf16x8*)(pa + 64 * (kk + 1) - 32);
#pragma unroll
                for (int i = 0; i < 16; ++i) acc[i] = __builtin_amdgcn_mfma_f32_16x16x32_bf16(R[(i - 2 * kk) & 15], bcur, acc[i], 0, 0, 0);
                R[(-2 * (kk + 1)) & 15] = n0; R[(1 - 2 * (kk + 1)) & 15] = n1; bcur = bnext;
                __builtin_amdgcn_sched_barrier(0);
            }
            pa += 512; pb += 512;
        }
        }
        const int col = o * 512 + c; const float w0 = sw[col], w1 = sw[1536 + col], w2 = sw[3072 + col], bs = sb[col];
        int tb0 = 256 * w + 4 * q; asm volatile("" : "+v"(tb0));
        const bf16* p = phyT + (size_t)col * RT + (size_t)r * LSEQ + tb0;
#pragma unroll
        for (int i = 0; i < 16; ++i) { f32x4 x; hy_short4u(p + 16 * i, tb0 + 16 * i == 0, tb0 + 16 * i + 4 >= LSEQ, w0, w1, w2, bs, x); acc[i] = acc[i] * x; }
        if (o == 0) {
            __syncthreads();
#pragma unroll
            for (int i = 0; i < 16; ++i) { v2u zw; zw.x = pk2(acc[i][0], acc[i][1]); zw.y = pk2(acc[i][2], acc[i][3]); *(LAS v2u*)(F.lds + HY_U_OFF + r * HY_U_STRIDE + (tb0 + 16 * i) * 2) = zw; }
            hy_fill_k<4096, HY_K_STRIDE>(F, KRL + (size_t)((1 * 512 + c) * 8) * 4096);
            __syncthreads();
        } else {
#pragma unroll
            for (int i = 0; i < 16; ++i) { bf16* zp = z2 + (size_t)(r * LSEQ + tb0 + 16 * i) * 512 + c; asm volatile("" : "+v"(zp));
#pragma unroll
                for (int e = 0; e < 4; ++e) zp[e * 512] = (bf16)f2bf(acc[i][e]); }
        }
    }
    if (!with_ctx) return;
    __syncthreads();
    { const int col = 1024 + c; hy_fill_u<LCTX, HYC_U_STRIDE>(F, phyT, col, NX, sw[col], sw[1536 + col], sw[3072 + col], sb[col]); }
    hy_fill_k<512, HYC_K_STRIDE>(F, KRC + (size_t)((0 * 512 + c) * 8) * 512);
    __syncthreads();
#pragma unroll 1
    for (int o = 0; o < 2; ++o) {
        f32x4 acc[2];
        acc[0] = (f32x4){0.f, 0.f, 0.f, 0.f}; acc[1] = acc[0];
        const LAS unsigned char* pa = F.lds + HY_K_OFF + m * HYC_K_STRIDE + 2 * (8 * q - r - m + 256 - 32 * w);
        const LAS unsigned char* pb = F.lds + HY_U_OFF + r * HYC_U_STRIDE + 16 * q;
#pragma unroll
        for (int k = 0; k < 8; ++k) { const bf16x8 bfr = *(const LAS bf16x8*)(pb + 64 * k);
#pragma unroll
            for (int i = 0; i < 2; ++i) acc[i] = __builtin_amdgcn_mfma_f32_16x16x32_bf16(*(const LAS bf16x8*)(pa + 64 * k - 32 * i), bfr, acc[i], 0, 0, 0); }
        const int col = o * 512 + c; const float w0 = sw[col], w1 = sw[1536 + col], w2 = sw[3072 + col], bs = sb[col];
        int tb0 = 32 * w + 4 * q; asm volatile("" : "+v"(tb0));
        const bf16* p = phyT + (size_t)col * RT + NX + (size_t)r * LCTX + tb0;
#pragma unroll
        for (int i = 0; i < 2; ++i) { f32x4 x; hy_short4u(p + 16 * i, tb0 + 16 * i == 0, tb0 + 16 * i + 4 >= LCTX, w0, w1, w2, bs, x); acc[i] = acc[i] * x; }
        if (o == 0) {
            __syncthreads();
#pragma unroll
            for (int i = 0; i < 2; ++i) { v2u zw; zw.x = pk2(acc[i][0], acc[i][1]); zw.y = pk2(acc[i][2], acc[i][3]); *(LAS v2u*)(F.lds + HY_U_OFF + r * HYC_U_STRIDE + (tb0 + 16 * i) * 2) = zw; }
            hy_fill_k<512, HYC_K_STRIDE>(F, KRC + (size_t)((1 * 512 + c) * 8) * 512);
            __syncthreads();
        } else {
#pragma unroll
            for (int i = 0; i < 2; ++i)
#pragma unroll
                for (int e = 0; e < 4; ++e) z2[(size_t)(NX + r * LCTX + tb0 + 16 * i + e) * 512 + c] = (bf16)f2bf(acc[i][e]);
        }
    }
}

__device__ __forceinline__ void cf_unit(Frame& F, int l, int seqrow, int seqlen, int t0) {
    LAS bf16* U = (LAS bf16*)F.lds;
    LAS float* O = (LAS float*)(F.lds + 98304);
    const bf16* ucf = (const bf16*)(F.ws + WS_UCF); bf16* out = (bf16*)(F.ws + WS_UCF2);
    __syncthreads();
    for (int pc = F.tid; pc < 94 * 64; pc += 512) { const int i = pc >> 6, ch = pc & 63; const int t = t0 - 15 + i;
        v4u w = (v4u){0u, 0u, 0u, 0u}; if (t >= 0 && t < seqlen) w = *(const v4u*)(ucf + (size_t)(seqrow + t) * 512 + ch * 8);
        *(LAS v4u*)(U + i * 512 + ch * 8) = w; }
    const int c = F.tid;
    float w[31];
#pragma unroll
    for (int k = 0; k < 31; ++k) w[k] = inp(F, I_CFW)[(size_t)l * 31 * 512 + k * 512 + c];
    const float bias = inp(F, I_CFB)[l * 512 + c];
    const f32x4 g0 = *((const f32x4*)(inp(F, I_CFG) + l * 512) + F.lane), g1 = *((const f32x4*)(inp(F, I_CFG) + l * 512) + 64 + F.lane);
    const f32x4 b0 = *((const f32x4*)(inp(F, I_CFLB) + l * 512) + F.lane), b1 = *((const f32x4*)(inp(F, I_CFLB) + l * 512) + 64 + F.lane);
    __syncthreads();
#pragma unroll 1
    for (int r = 0; r < 4; ++r) {
        float v[16];
#pragma unroll
        for (int t = 0; t < 16; ++t) v[t] = bias;
        const LAS bf16* Ur = U + (16 * r) * 512 + c;
#pragma unroll
        for (int ii = 0; ii < 46; ++ii) { const float x = bf2f(Ur[ii * 512]);
#pragma unroll
            for (int t = 0; t < 16; ++t) { if (ii - t >= 0 && ii - t <= 30) v[t] += w[ii - t] * x; } }
#pragma unroll
        for (int t = 0; t < 16; ++t) O[t * 512 + c] = v[t];
        __syncthreads();
#pragma unroll
        for (int q = 0; q < 2; ++q) {
            const int tt = 2 * F.wave + q;
            f32x4 x0 = *((const LAS f32x4*)(O + tt * 512) + F.lane), x1 = *((const LAS f32x4*)(O + tt * 512) + 64 + F.lane);
            const float mean = wave_sum((x0[0] + x0[1]) + (x0[2] + x0[3]) + (x1[0] + x1[1]) + (x1[2] + x1[3])) * (1.f / 512.f);
            x0 = x0 - mean; x1 = x1 - mean;
            const float var = wave_sum((x0[0] * x0[0] + x0[1] * x0[1]) + (x0[2] * x0[2] + x0[3] * x0[3]) + (x1[0] * x1[0] + x1[1] * x1[1]) + (x1[2] * x1[2] + x1[3] * x1[3])) * (1.f / 512.f);
            const float rstd = 1.f / sqrtf(var + LN_EPS);
            f32x4 y0 = x0 * rstd * g0 + b0, y1 = x1 * rstd * g1 + b1;
#pragma unroll
            for (int j = 0; j < 4; ++j) { y0[j] = siluf_(y0[j]); y1[j] = siluf_(y1[j]); }
            bf16* orow = out + (size_t)(seqrow + t0 + 16 * r + tt) * 512;
            v2u o0, o1; o0.x = pk2(y0[0], y0[1]); o0.y = pk2(y0[2], y0[3]); o1.x = pk2(y1[0], y1[1]); o1.y = pk2(y1[2], y1[3]);
            *((v2u*)orow + F.lane) = o0; *((v2u*)orow + 64 + F.lane) = o1;
        }
        __syncthreads();
    }
}

__device__ __forceinline__ void s5_unit(Frame& F, int l, int b, int gp) {
    const int lane = F.lane, w = F.wave;
    bf16* ps5 = (bf16*)(F.ws + WS_PS5); bf16* ydir = (bf16*)(F.ws + WS_YDIR);
    __syncthreads();
#pragma unroll 1
    for (int rep_ = 0; rep_ < NREP(14); ++rep_)
    {
        const int gd = w & 3, role = w >> 2;
        const int g = 2 * gp + (gd >> 1), dir = gd & 1;
        const int r = lane & 15, q = lane >> 4;
        LAS unsigned char* wl = F.lds + gd * 32768;
        LAS unsigned char* uS0 = wl;
        LAS float* BuS0 = (LAS float*)(wl + 2560);
        LAS unsigned char* stS0 = wl + 2560 + 2 * 10240;
        constexpr int NCH = (LCTX + LSEQ) / 16;
        const float* P = (const float*)(F.ws + WS_S5P) + (size_t)((dir * 32 + g) * 64) * 36;
        float abr = 0.f, abi = 0.f; f32x2 s2 = (f32x2){0.f, 0.f}, Aa = s2, Bn = s2;
        bf16x8 Bf[8], Cf[4];
        const int ti = lane >> 2, cq = lane & 3;
        auto urow = [&](int k) -> size_t { const bool isc = k < LCTX / 16; const int kk = isc ? k : k - LCTX / 16; const int Ls = isc ? LCTX : LSEQ; const int rowb = isc ? NX + b * LCTX : b * LSEQ;
            const int st = kk * 16 + ti; const int t = dir ? (Ls - 1 - st) : st; return (size_t)(rowb + t) * 512 + g * 16 + 4 * cq; };
        v2u unext = (v2u){0u, 0u};
        if (role == 0) { abr = P[lane * 36]; abi = P[lane * 36 + 1]; Aa = (f32x2){abr, abr}; Bn = (f32x2){-abi, abi}; }
        else {
#pragma unroll
            for (int blk = 0; blk < 8; ++blk) { const int pp = 16 * blk + r; const float* src = P + (size_t)(pp & 63) * 36 + (pp < 64 ? 2 : 18) + 8 * (q & 1);
                v4u t4; t4.x = pk2(src[0], src[1]); t4.y = pk2(src[2], src[3]); t4.z = pk2(src[4], src[5]); t4.w = pk2(src[6], src[7]);
                if (q >= 2) t4 = (v4u){0u, 0u, 0u, 0u};
                Bf[blk] = __builtin_bit_cast(bf16x8, t4); }
            const float* cre = inp(F, I_SCRE) + (size_t)(((l * 2 + dir) * 32 + g) * 16) * 64; const float* cim = inp(F, I_SCIM) + (size_t)(((l * 2 + dir) * 32 + g) * 16) * 64;
#pragma unroll
            for (int ks = 0; ks < 4; ++ks) { const int p0 = 16 * ks + 4 * q; const f32x4 a = *(const f32x4*)(cre + r * 64 + p0), c4 = *(const f32x4*)(cim + r * 64 + p0);
                v4u t4; t4.x = pk2(a[0], -c4[0]); t4.y = pk2(a[1], -c4[1]); t4.z = pk2(a[2], -c4[2]); t4.w = pk2(a[3], -c4[3]);
                Cf[ks] = __builtin_bit_cast(bf16x8, t4); }
            for (int e = lane; e < 2 * 16 * 20; e += 64) ((LAS unsigned*)uS0)[e] = 0u;
            LDS_WAIT();
            *(LAS v2u*)(uS0 + ti * 80 + 8 * cq) = *(const v2u*)(ps5 + urow(0));
            unext = *(const v2u*)(ps5 + urow(1));
        }
        LDS_WAIT(); __builtin_amdgcn_s_barrier(); asm volatile("" ::: "memory");
#pragma unroll 1
        for (int k = 0; k < NCH + 2; ++k) {
            const int p0 = k & 1, p1 = p0 ^ 1;
            if (role == 1) {
                bf16x8 ua, sf[4];
                if (k < NCH) ua = *(const LAS bf16x8*)(uS0 + p0 * 1280 + r * 80 + 16 * q);
                if (k >= 2) {
#pragma unroll
                    for (int ks = 0; ks < 4; ++ks) sf[ks] = *(const LAS bf16x8*)(stS0 + p0 * 4352 + r * 272 + 64 * ks + 16 * q); }
                if (k + 1 < NCH) { *(LAS v2u*)(uS0 + p1 * 1280 + ti * 80 + 8 * cq) = unext; if (k + 2 < NCH) unext = *(const v2u*)(ps5 + urow(k + 2)); }
                if (k < NCH) {
#pragma unroll
                    for (int blk = 0; blk < 8; ++blk) { const f32x4 d = __builtin_amdgcn_mfma_f32_16x16x32_bf16(ua, Bf[blk], (f32x4){0.f, 0.f, 0.f, 0.f}, 0, 0, 0);
                        *(LAS f32x4*)(BuS0 + p0 * 2560 + (16 * blk + r) * 20 + 4 * q) = d; }
                }
                if (k >= 2) {
                    f32x4 y0 = __builtin_amdgcn_mfma_f32_16x16x32_bf16(sf[0], Cf[0], (f32x4){0.f, 0.f, 0.f, 0.f}, 0, 0, 0), y1 = __builtin_amdgcn_mfma_f32_16x16x32_bf16(sf[1], Cf[1], (f32x4){0.f, 0.f, 0.f, 0.f}, 0, 0, 0);
                    y0 = __builtin_amdgcn_mfma_f32_16x16x32_bf16(sf[2], Cf[2], y0, 0, 0, 0); y1 = __builtin_amdgcn_mfma_f32_16x16x32_bf16(sf[3], Cf[3], y1, 0, 0, 0);
                    const f32x4 y = y0 + y1; const int kc = k - 2;
                    const bool isc = kc < LCTX / 16; const int kk = isc ? kc : kc - LCTX / 16; const int Ls = isc ? LCTX : LSEQ; const int rowb = isc ? NX + b * LCTX : b * LSEQ;
#pragma unroll
                    for (int i = 0; i < 4; ++i) { const int st = kk * 16 + 4 * q + i; const int t = dir ? (Ls - 1 - st) : st;
                        ydir[(size_t)dir * RT * 512 + (size_t)(rowb + t) * 512 + g * 16 + r] = (bf16)f2bf(y[i]); } }
            } else if (k >= 1 && k <= NCH) {
                f32x4 bre[4], bim[4];
#pragma unroll
                for (int j = 0; j < 4; ++j) { bre[j] = *(const LAS f32x4*)(BuS0 + p1 * 2560 + lane * 20 + 4 * j); bim[j] = *(const LAS f32x4*)(BuS0 + p1 * 2560 + (64 + lane) * 20 + 4 * j); }
#pragma unroll
                for (int i = 0; i < 16; ++i) {
                    const f32x2 b2 = (f32x2){bre[i >> 2][i & 3], bim[i >> 2][i & 3]};
                    const float nr = abr * s2[0] - abi * s2[1] + b2[0], ni = abr * s2[1] + abi * s2[0] + b2[1]; s2 = (f32x2){nr, ni};
                    *(LAS unsigned*)(stS0 + p1 * 4352 + i * 272 + 4 * lane) = pk2(s2[0], s2[1]); }
            }
            LDS_WAIT(); __builtin_amdgcn_s_barrier(); asm volatile("" ::: "memory");
        }
    }
    VM_WAIT();
    __syncthreads();
    const float* dsk = inp(F, I_SD) + l * 512 + gp * 32;
    for (int e = F.tid; e < (LCTX + LSEQ) * 4; e += 512) {
        const int rr = e >> 2, pc = e & 3; const int row = rr < LSEQ ? b * LSEQ + rr : NX + b * LCTX + (rr - LSEQ);
        const size_t off = (size_t)row * 512 + gp * 32 + pc * 8;
        const v4u uw = *(const v4u*)(ps5 + off), fw = *(const v4u*)(ydir + off), bw = *(const v4u*)(ydir + (size_t)RT * 512 + off);
        f32x4 u0, u1, f0, f1, b0, b1; unpack8(uw, u0, u1); unpack8(fw, f0, f1); unpack8(bw, b0, b1);
        const f32x4 d0 = *(const f32x4*)(dsk + pc * 8), d1 = *(const f32x4*)(dsk + pc * 8 + 4);
        f32x4 o0, o1;
#pragma unroll
        for (int j = 0; j < 4; ++j) { o0[j] = gelu_tanh(f0[j] + b0[j] + d0[j] * u0[j]); o1[j] = gelu_tanh(f1[j] + b1[j] + d1[j] * u1[j]); }
        *(v4u*)(ps5 + off) = pack8(o0, o1);
    }
}

__device__ __forceinline__ Frame make_frame(const Args& args, LAS unsigned char* lds, int wave_s);
__device__ __forceinline__ void mixers_phase(const Args& args, LAS unsigned char* lds, int wave_s, int l) {
#ifndef MIXMASK
#define MIXMASK 7
#endif
    if (MIXMASK & 1) { Frame F = make_frame(args, lds, wave_s);
#pragma unroll 1
        for (int u = F.vcu; u < NB * 16; u += F.G) s5_unit(F, l, u >> 4, u & 15); }
    if (MIXMASK & 2) { Frame F = make_frame(args, lds, wave_s);
#pragma unroll 1
        for (int u = F.vcu; u < 512; u += F.G) hyena_unit(F, l, u, l == 0);
        if (NREP(10) == 2) {
#pragma unroll 1
            for (int u = F.vcu; u < 512; u += F.G) hyena_unit(F, l, u, l == 0); } }
    if (MIXMASK & 4) { Frame F = make_frame(args, lds, wave_s);
        const int ncf = l == 0 ? NB * 32 + NB * 4 : NB * 32;
#pragma unroll 1
        for (int u = F.vcu; u < ncf; u += F.G) { if (u < NB * 32) cf_unit(F, l, u * 64, 64, 0); else { const int q = u - NB * 32; cf_unit(F, l, NX + (q >> 2) * LCTX, LCTX, (q & 3) * 64); } } }
    __syncthreads();
}

constexpr int PH_P0A = 0, PH_P0B = 1, PH_L0 = 2, PH_L1 = 12, N_PHASES = 27;
__device__ __forceinline__ Frame make_frame(const Args& args, LAS unsigned char* lds, int wave_s) {
    unsigned z0 = 0u; asm volatile("" : "+v"(z0));
    Frame F; int t = wave_s * 64 + (int)__builtin_amdgcn_mbcnt_hi(~0u, __builtin_amdgcn_mbcnt_lo(~0u, z0)); asm volatile("" : "+v"(t));
    unsigned char* ws = args.ws; float* out = args.out;
    F.lds = lds; F.tid = t; F.lane = t & 63; F.wave = wave_s;
    int G = gridDim.x, bx = blockIdx.x; asm volatile("" : "+s"(G), "+s"(bx));
    F.G = G; F.vcu = (G % 8 == 0) ? (bx % 8) * (G / 8) + bx / 8 : bx;
    const float* const* inp = args.in;
    F.in = inp; F.out = out; F.ws = ws; return F;
}
__global__ void __launch_bounds__(NWAVES * 64, 2) mega_fwd(Args args) {
    extern __shared__ __attribute__((aligned(16))) unsigned char lds_raw[];
    LAS unsigned char* const lds = (LAS unsigned char*)lds_raw;
    volatile LAS unsigned* MISC = (volatile LAS unsigned*)(lds + MISC_OFF);
    for (int u = threadIdx.x; u < (LDS_BYTES - MISC_OFF) / 4; u += NWAVES * 64) ((LAS unsigned*)(lds + MISC_OFF))[u] = 0u;
    int wave_s = __builtin_amdgcn_readfirstlane((int)threadIdx.x >> 6); asm volatile("" : "+s"(wave_s));
    __syncthreads();
    const int lo = MK_PER_PHASE_LAUNCH ? args.ph_lo : 0, hi = MK_PER_PHASE_LAUNCH ? args.ph_hi : N_PHASES;
    XcdBarrier bar; bar.bar = (unsigned*)(args.ws + WS_CTL) + CW_BAR; bar.x = 0; bar.st = nullptr;
    if (hi - lo > 1) bar = xcd_barrier_post((unsigned*)(args.ws + WS_CTL) + CW_BAR, MISC + 8);
#ifndef PHMASK
#define PHMASK 0xffffffffu
#endif
#define IN(k) (lo <= (k) && (k) < hi)
#define PM(b) ((PHMASK >> (b)) & 1u)
#define SEAM(k) do { if (IN(k) && IN((k) + 1)) xcd_barrier(bar, wave_s); } while (0)
#define FRAME() Frame F = make_frame(args, lds, wave_s); const char* ws = (const char*)F.ws; const int c = F.G == (int)gridDim.x ? (int)blockIdx.x : 0; (void)ws; (void)c

    if (PM(0) && IN(PH_P0A)) { FRAME(); REPEAT(NREP(12), p0a_prologue(F)); } SEAM(PH_P0A);
    if (PM(1) && IN(PH_P0B)) { FRAME(); p0b_mods(F); } SEAM(PH_P0B);

#pragma unroll 1
    for (int l = 0; l < 2; ++l) {
        const int pb = l == 0 ? PH_L0 : PH_L1;
        const int nMl = l == 0 ? RT / 256 : NX / 256;
        if (PM(2) && IN(pb + 0)) { { FRAME(); REPEAT(NREP(8), lnmod_phase(F, l)); } { FRAME(); h2table_phase(F, l); } { FRAME(); s5params_phase(F, l); } } SEAM(pb + 0);
        if (PM(3) && IN(pb + 1)) { { FRAME(); REPEAT(NREP(9), filter_expand_phase(F, l)); }
            FRAME();
            SchedPlain S; S.R.init(nMl, 12, F.G, c); S.A = ws + WS_HX; S.B = ws + WS_WIN + (size_t)l * 6144 * 1024 * 2; S.tsA = 256 * 1024 * 2; S.tsB = 256 * 1024 * 2;
            S.xM = l == 0 ? 0 : NCX / 256; S.xN0 = 10; S.xNn = 2;
            EpiInproj E{(bf16*)(F.ws + WS_PHYT), (bf16*)(F.ws + WS_UCF), (bf16*)(F.ws + WS_PS5)};
            REPEAT(NREP(0), pg8::gemm_phase<EpiInproj, SchedPlain>(F.lds, F.tid, 2048, S, E));
        } SEAM(pb + 1);
        if (PM(4) && IN(pb + 2)) { mixers_phase(args, lds, wave_s, l); } SEAM(pb + 2);
        if (PM(5) && IN(pb + 3)) {
            { FRAME(); SchedPlain S; S.R.init(nMl, 12, F.G, c); S.A = ws + WS_HX; S.B = ws + WS_WIN + ((size_t)l * 6144 + 3072) * 1024 * 2; S.tsA = 256 * 1024 * 2; S.tsB = 256 * 1024 * 2; S.xM = 0; S.xN0 = 0; S.xNn = 1;
              EpiGates E{(bf16*)(F.ws + WS_G)}; REPEAT(NREP(1), pg8::gemm_phase<EpiGates, SchedPlain>(F.lds, F.tid, 2048, S, E)); }
#ifndef DBG_SKIP_GLU
            { FRAME(); SchedPlain S; S.R.init(nMl, 2, F.G, (c + F.G / 4) % F.G); S.A = ws + WS_PS5; S.B = ws + WS_WGLU + (size_t)l * 512 * 512 * 2; S.tsA = 256 * 512 * 2; S.tsB = 256 * 512 * 2; S.xM = 0; S.xN0 = 0; S.xNn = 1;
              EpiGlu E{(const bf16*)(F.ws + WS_PS5), (bf16*)(F.ws + WS_S5Y), inp(F, I_SBGLU) + l * 512}; REPEAT(NREP(2), pg8::gemm_phase<EpiGlu, SchedPlain>(F.lds, F.tid, 1024, S, E)); }
#endif
        } SEAM(pb + 3);
        if (PM(6) && IN(pb + 4)) { FRAME();
            SchedMerge S; S.R.init(nMl, 4, F.G, c); S.A = ws + WS_Z2; S.sA = WS_UCF2 - WS_Z2; S.B = ws + WS_WOUTS + (size_t)(l * 3) * 1024 * 512 * 2; S.sB = (size_t)1024 * 512 * 2;
            S.tsA = 256 * 512 * 2; S.tsB = 256 * 512 * 2;
            EpiMerge E{(const bf16*)(F.ws + WS_G), (bf16*)(F.ws + WS_HX)};
            REPEAT(NREP(3), pg8::gemm_phase<EpiMerge, SchedMerge>(F.lds, F.tid, 1024, S, E));
        } SEAM(pb + 4);
        if (PM(7) && IN(pb + 5)) { FRAME();
            SchedPlain S; S.R.init(nMl, 4, F.G, c); S.A = ws + WS_HX; S.B = ws + WS_WO + (size_t)l * 1024 * 1024 * 2; S.tsA = 256 * 1024 * 2; S.tsB = 256 * 1024 * 2; S.xM = 0; S.xN0 = 0; S.xNn = 1;
            EpiRes E{l == 0 ? inp(F, I_X) : F.out, l == 0 ? inp(F, I_CTX) : (const float*)(F.ws + WS_XC), F.out, (float*)(F.ws + WS_XC), (const float*)(F.ws + WS_MODS) + (size_t)l * 17 * INC + 2 * 1024, 1.0f};
            REPEAT(((l == 0) ? NREP(4) : 1), pg8::gemm_phase<EpiRes, SchedPlain>(F.lds, F.tid, 2048, S, E));
        } SEAM(pb + 5);
        if (PM(8) && IN(pb + 6)) { { FRAME(); ln1_phase(F, l); } if (l == 1) { FRAME(); REPEAT(NREP(13), moe_convert_phase(F)); } } SEAM(pb + 6);
        if (l == 0) {
            if (PM(9) && IN(pb + 7)) { FRAME();
                SchedPlain S; S.R.init(RT / 256, 22, F.G, c); S.A = ws + WS_HX; S.B = ws + WS_W13; S.tsA = 256 * 1024; S.tsB = 256 * 1024; S.xM = 0; S.xN0 = 0; S.xNn = 1;
                EpiSwigluF8 E{F.ws + WS_G, DFF, 0.03125f}; REPEAT(NREP(5), pg8::gemm_phase<EpiSwigluF8, SchedPlain, true>(F.lds, F.tid, 1024, S, E));
            } SEAM(pb + 7);
            if (PM(10) && IN(pb + 8)) { FRAME();
                SchedPlain S; S.R.init(RT / 256, 4, F.G, c); S.A = ws + WS_G; S.B = ws + WS_W2; S.tsA = (size_t)256 * DFF; S.tsB = (size_t)256 * DFF; S.xM = 0; S.xN0 = 0; S.xNn = 1;
                EpiRes E{F.out, (const float*)(F.ws + WS_XC), F.out, (float*)(F.ws + WS_XC), (const float*)(F.ws + WS_MODS) + 5 * 1024, 0.0078125f};
                pg8::gemm_phase<EpiRes, SchedPlain, true>(F.lds, F.tid, DFF, S, E);
            } SEAM(pb + 8);
            if (PM(11) && IN(pb + 9)) { FRAME(); ln2_phase(F, l); } SEAM(pb + 9);
        } else {
            if (PM(15) && IN(pb + 7)) { FRAME(); moe_setup_phase(F); } SEAM(pb + 7);
#pragma unroll 1
            for (int st = 0; st < 6; ++st) {
                if (PM(13) && IN(pb + 8 + st) && st >= 1) { FRAME(); const int* tile_e = (const int*)(F.ws + WS_META + META_TILE); const int ch = st - 1;
                    const int ntiles = tile_e[511]; int nmc = ntiles - 64 * ch; nmc = nmc < 0 ? 0 : (nmc > 64 ? 64 : nmc);
                    SchedMoe S; S.R.init(nmc, 4, F.G, c); S.A = ws + WS_HID + (size_t)(ch & 1) * HID_BUF; S.B = ws + WS_MW2; S.tsA = (size_t)256 * DEX; S.tsB = (size_t)256 * DEX; S.esB = (size_t)1024 * DEX; S.tile_e = tile_e; S.tile0 = 64 * ch; S.a_global = false;
                    EpiMoeDown E{(bf16*)(F.ws + WS_MOEY), 0.0078125f}; REPEAT(NREP(7), pg8::gemm_phase<EpiMoeDown, SchedMoe, true>(F.lds, F.tid, DEX, S, E));
                }
                if (PM(12) && IN(pb + 8 + st) && st <= 4) { FRAME(); const int* tile_e = (const int*)(F.ws + WS_META + META_TILE); const int ch = st;
                    const int ntiles = tile_e[511]; int nmc = ntiles - 64 * ch; nmc = nmc < 0 ? 0 : (nmc > 64 ? 64 : nmc);
                    SchedMoe S; S.R.init(nmc, 28, F.G, c); S.A = ws + WS_SORT; S.B = ws + WS_MW13; S.tsA = 256 * 1024; S.tsB = 256 * 1024; S.esB = (size_t)7168 * 1024; S.tile_e = tile_e; S.tile0 = 64 * ch; S.a_global = true;
                    EpiSwigluF8 E{F.ws + WS_HID + (size_t)(ch & 1) * HID_BUF, DEX, 0.03125f}; REPEAT(NREP(6), pg8::gemm_phase<EpiSwigluF8, SchedMoe, true>(F.lds, F.tid, 1024, S, E));
                }
                SEAM(pb + 8 + st);
            }
            if (PM(14) && IN(pb + 14)) { FRAME(); moe_combine_phase(F); }
        }
    }
#undef IN
#undef SEAM
#undef FRAME
}


#ifdef DBG_DUMP
__global__ void dbg_dump(const unsigned char* ws, float* out) {
    const size_t NE = (size_t)RT * 512; const bf16* a = (const bf16*)(ws + WS_PS5); const bf16* b = (const bf16*)(ws + WS_Z2); const bf16* c = (const bf16*)(ws + WS_UCF2);
    for (size_t i = (size_t)blockIdx.x * blockDim.x + threadIdx.x; i < (size_t)NX * DM; i += (size_t)gridDim.x * blockDim.x) {
        const size_t j = i % NE; const int k = (int)(i / NE);
        float v;
        if (DBG_DUMP == 8) v = i < (size_t)26 * 1024 * 1024 ? bf2f(((const bf16*)(ws + WS_WIN))[i]) : 0.f;
        else if (DBG_DUMP == 7) v = k == 0 ? bf2f(a[j]) : bf2f(((const bf16*)(ws + WS_UCF))[j]);
        else if (DBG_DUMP == 4) v = bf2f(((const bf16*)(ws + WS_HX))[i]);
        else if (DBG_DUMP == 5) v = bf2f(((const bf16*)(ws + WS_G))[i]);
        else if (DBG_DUMP == 6) v = bf2f(((const bf16*)(ws + WS_S5Y))[i % NE]);
        else if (DBG_DUMP == 1) v = k == 0 ? bf2f(a[j]) : bf2f(b[j]);
        else if (DBG_DUMP == 2) v = k == 0 ? bf2f(b[j]) : bf2f(c[j]);
        else v = k == 0 ? bf2f(c[j]) : bf2f(a[j]);
        out[i] = v;
    }
}
#endif
extern "C" void kernel_launch(void* const* d_in, const int* in_sizes, int n_in, void* d_out, int out_size, void* d_ws, size_t ws_size, hipStream_t stream) {
    static int grid = 0;
    if (grid == 0) {
        if (n_in != N_IN || out_size != NX * DM || ws_size < WS_END2) { fprintf(stderr, "kernel_launch: unexpected shapes (n_in %d, out %d, ws %zu)\n", n_in, out_size, ws_size); grid = -1; return; }
        int dev = 0, cus = 0, per_cu = 0;
        if (hipGetDevice(&dev) != hipSuccess || hipDeviceGetAttribute(&cus, hipDeviceAttributeMultiprocessorCount, dev) != hipSuccess) { grid = -1; return; }
        if (hipFuncSetAttribute((const void*)mega_fwd, hipFuncAttributeMaxDynamicSharedMemorySize, LDS_BYTES) != hipSuccess) { fprintf(stderr, "kernel_launch: hipFuncSetAttribute failed\n"); grid = -1; return; }
        if (hipOccupancyMaxActiveBlocksPerMultiprocessor(&per_cu, (const void*)mega_fwd, NWAVES * 64, LDS_BYTES) != hipSuccess || per_cu < 1) fprintf(stderr, "kernel_launch: occupancy query reports %d\n", per_cu);
        (void)hipGetLastError();
        grid = cus;
    }
    if (grid < 0) return;
    (void)hipMemsetAsync((char*)d_ws + WS_CTL, 0, CTL_ZERO_BYTES, stream);
    Args a{};
    for (int i = 0; i < N_IN; ++i) a.in[i] = (const float*)d_in[i];
    a.out = (float*)d_out; a.ws = (unsigned char*)d_ws;
#if MK_PER_PHASE_LAUNCH
    for (int p = 0; p < DBG_NPH; ++p) { a.ph_lo = p; a.ph_hi = p + 1; hipLaunchKernelGGL(mega_fwd, dim3(grid), dim3(NWAVES * 64), LDS_BYTES, stream, a); }
#ifdef DBG_DUMP
    hipLaunchKernelGGL(dbg_dump, dim3(2048), dim3(256), 0, stream, (const unsigned char*)d_ws, (float*)d_out);
#endif
#else
    a.ph_lo = 0; a.ph_hi = N_PHASES; hipLaunchKernelGGL(mega_fwd, dim3(grid), dim3(NWAVES * 64), LDS_BYTES, stream, a);
#endif
}
```

```cpp
#include <hip/hip_runtime.h>
#include <cstdio>
#include <cstdint>

#ifndef DBG_REP
#define DBG_REP 0
#endif
#define NREP(bit) (((DBG_REP >> (bit)) & 1) ? 2 : 1)
#define REPEAT(n, ...) do { __VA_ARGS__; if ((n) == 2) { __VA_ARGS__; } } while (0)
#ifndef DBG_NPH
#define DBG_NPH N_PHASES
#endif
#ifndef MK_PER_PHASE_LAUNCH
#define MK_PER_PHASE_LAUNCH 0
#endif

#define GAS __attribute__((address_space(1)))
#define LAS __attribute__((address_space(3)))
typedef unsigned short bf16;
typedef unsigned v4u __attribute__((ext_vector_type(4)));
typedef unsigned v2u __attribute__((ext_vector_type(2)));
typedef float f32x4 __attribute__((ext_vector_type(4)));
typedef float f32x2 __attribute__((ext_vector_type(2)));
typedef short bf16x8 __attribute__((ext_vector_type(8)));

constexpr int NB = 16, LSEQ = 2048, LCTX = 256, DM = 1024;
constexpr int NX = NB * LSEQ;
constexpr int NCX = NB * LCTX;
constexpr int RT = NX + NCX;
constexpr int INC = 6144, DFF = 2816, DEX = 3584, NEXP = 8;
constexpr float ALPHA_F = 1.41421356237f;
constexpr float LN_EPS = 1e-5f;

enum { I_X = 0, I_C, I_CTX, I_CCTX, I_WMOD, I_BMOD, I_WIN, I_HSW, I_HSB, I_FW1, I_FB1, I_FW2, I_FB2, I_FW3, I_FB3, I_FREQ, I_DECAY, I_HBIAS, I_WHY,
       I_CFW, I_CFB, I_CFG, I_CFLB, I_WCF, I_SARE, I_SAIM, I_SLDT, I_SBRE, I_SBIM, I_SCRE, I_SCIM, I_SD, I_SWGLU, I_SBGLU, I_WS5, I_WO,
       I_LN1G, I_LN1B, I_LN2G, I_LN2B, I_FFW1, I_FFW3, I_FFW2, I_ROUTER, I_MW1, I_MW3, I_MW2, N_IN };

constexpr size_t MiB = 1u << 20;
constexpr size_t WS_CTL = 0, CTL_ZERO_BYTES = 1 * MiB;
constexpr size_t WS_MODS = 1 * MiB;
constexpr size_t WS_S5P = 2 * MiB;
constexpr size_t WS_META = 3 * MiB;
constexpr size_t WS_FILT = 4 * MiB;
constexpr size_t WS_XC = 22 * MiB;
constexpr size_t WS_WIN = 38 * MiB;
constexpr size_t WS_WOUTS = 62 * MiB;
constexpr size_t WS_WGLU = 68 * MiB;
constexpr size_t WS_WO = 69 * MiB;
constexpr size_t WS_W13 = 73 * MiB;
constexpr size_t WS_W2 = 84 * MiB;
constexpr size_t WS_HX = 90 * MiB;
constexpr size_t WS_G = 162 * MiB;
constexpr size_t WS_PHYT = WS_G, WS_YDIR = WS_G + 108 * MiB, WS_UCF = WS_G + 180 * MiB;
constexpr size_t WS_PS5 = 378 * MiB;
constexpr size_t WS_Z2 = 414 * MiB;
constexpr size_t WS_UCF2 = 450 * MiB;
constexpr size_t WS_S5Y = 486 * MiB;
constexpr size_t WS_KRL = 522 * MiB;
constexpr size_t WS_KRC = 586 * MiB;
constexpr size_t WS_KDUMMY = 594 * MiB;
constexpr size_t WS_END = 595 * MiB;
constexpr size_t WS_SORT = 90 * MiB;
constexpr size_t WS_MOEY = 156 * MiB;
constexpr size_t WS_MW13 = 288 * MiB;
constexpr size_t WS_MW2 = 344 * MiB;
constexpr size_t WS_HID = 372 * MiB;
constexpr size_t HID_BUF = 56 * MiB;
constexpr size_t WS_END2 = 604 * MiB;
static_assert(WS_HID + (size_t)67584 * 3584 <= WS_END2, "moe map");
constexpr size_t META_TOKE = 0, META_TOKW = 256 * 1024, META_POS = 512 * 1024, META_TILE = 768 * 1024;
constexpr int CW_BAR = 4096;
constexpr int CW_CNT = 8192, CW_CUR = 8256;

constexpr int LDS_BYTES = 155648;
constexpr int MISC_OFF = 147456;
constexpr int NWAVES = 8;

typedef __bf16 bf2_t __attribute__((ext_vector_type(2)));
__device__ __forceinline__ unsigned pk2(float lo, float hi) { bf2_t v; v.x = (__bf16)lo; v.y = (__bf16)hi; return __builtin_bit_cast(unsigned, v); }
__device__ __forceinline__ unsigned f2bf(float f) { return (unsigned)__builtin_bit_cast(unsigned short, (__bf16)f); }
__device__ __forceinline__ unsigned pk4_fp8(float a, float b, float c, float d) { int w = 0; w = __builtin_amdgcn_cvt_pk_fp8_f32(a, b, w, false); w = __builtin_amdgcn_cvt_pk_fp8_f32(c, d, w, true); return (unsigned)w; }
__device__ __forceinline__ float bf2f(unsigned short b) { return __builtin_bit_cast(float, ((unsigned)b) << 16); }
__device__ __forceinline__ float bflo(unsigned w) { return __builtin_bit_cast(float, w << 16); }
__device__ __forceinline__ float bfhi(unsigned w) { return __builtin_bit_cast(float, w & 0xffff0000u); }
__device__ __forceinline__ float sigmoidf_(float x) { return __builtin_amdgcn_rcpf(1.0f + __expf(-x)); }
__device__ __forceinline__ float siluf_(float x) { return x * sigmoidf_(x); }
__device__ __forceinline__ float gelu_tanh(float x) { const float y = 0.7978845608028654f * (x + 0.044715f * x * x * x); const float e = __expf(2.0f * y); const float th = 1.0f - 2.0f * __builtin_amdgcn_rcpf(e + 1.0f); return 0.5f * x * (1.0f + th); }
__device__ __forceinline__ float wave_sum(float v) {
    v += __builtin_bit_cast(float, __builtin_amdgcn_mov_dpp(__builtin_bit_cast(int, v), 0xB1, 0xf, 0xf, true));
    v += __builtin_bit_cast(float, __builtin_amdgcn_mov_dpp(__builtin_bit_cast(int, v), 0x4E, 0xf, 0xf, true));
    v += __builtin_bit_cast(float, __builtin_amdgcn_mov_dpp(__builtin_bit_cast(int, v), 0x141, 0xf, 0xf, true));
    v += __builtin_bit_cast(float, __builtin_amdgcn_mov_dpp(__builtin_bit_cast(int, v), 0x140, 0xf, 0xf, true));
    v += __builtin_bit_cast(float, __builtin_amdgcn_ds_swizzle(__builtin_bit_cast(int, v), 0x401F));
    const unsigned u = __builtin_bit_cast(unsigned, v); const auto r = __builtin_amdgcn_permlane32_swap(u, u, false, false);
    return __builtin_bit_cast(float, (unsigned)r[0]) + __builtin_bit_cast(float, (unsigned)r[1]);
}
__device__ __forceinline__ float lane_bcast(float v, int k) { return __builtin_bit_cast(float, __builtin_amdgcn_readlane(__builtin_bit_cast(int, v), k)); }
#define LDS_WAIT() asm volatile("s_waitcnt lgkmcnt(0)" ::: "memory")
#define VM_WAIT() asm volatile("s_waitcnt vmcnt(0)" ::: "memory")

namespace pg8 {
#define PG8_LAS __attribute__((address_space(3)))
constexpr int BM = 256, BK = 64, HALF = 128, HTB = HALF * BK * 2, STAGE_BYTES = 8 * HTB, NXCD = 8, WGM = 8;
__host__ __device__ __forceinline__ int lds_byte(int r, int c) { const int st = (r >> 4) * 2 + (c >> 5), rr = r & 15, cc = c & 31, ob = rr * 64 + cc * 2; return st * 1024 + (ob ^ (((ob >> 9) & 1) << 5)); }
__host__ __device__ __forceinline__ void stage_rc(int b, int& R, int& C) { const int st = b / 1024, sb = b % 1024, swz = sb ^ (((sb >> 9) & 1) << 5); R = (st >> 1) * 16 + swz / 64; C = (st & 1) * 32 + (swz % 64) / 2; }
__host__ __device__ __forceinline__ int perm32(int rho) { const int n = rho >> 4, i = rho & 15; return 8 * (i >> 2) + 4 * n + (i & 3); }

struct Unit { int pm, pn, seg, ex; const char* A; const char* B; };

struct Rect {
    int nM, nN, nwg, G, c;
    __device__ __forceinline__ void init(int nM_, int nN_, int G_, int c_) { nM = nM_; nN = nN_; nwg = nM * nN; G = G_; c = c_; }
    __device__ __forceinline__ bool map(int L, int& pm, int& pn) const {
        if (L >= nwg) return false;
        int wgid = L; { const int q = nwg / NXCD, r = nwg % NXCD, xcd = wgid % NXCD, off = wgid / NXCD; wgid = (xcd < r ? xcd * (q + 1) : r * (q + 1) + (xcd - r) * q) + off; }
        const int nig = WGM * nN, gid = wgid / nig, fm = gid * WGM, gsz = (nM - fm) < WGM ? (nM - fm) : WGM;
        pm = fm + ((wgid % nig) % gsz); pn = (wgid % nig) / gsz; return true;
    }
};

__device__ __forceinline__ unsigned cvt_pk_bf16(float lo, float hi) { return pk2(lo, hi); }

typedef int v8i_t __attribute__((ext_vector_type(8)));
typedef int v4i_t __attribute__((ext_vector_type(4)));
__device__ __forceinline__ v8i_t cat8(const bf16x8 a, const bf16x8 b) { return __builtin_shufflevector(__builtin_bit_cast(v4i_t, a), __builtin_bit_cast(v4i_t, b), 0, 1, 2, 3, 4, 5, 6, 7); }
__device__ __forceinline__ bf16x8 lo8(const v8i_t v) { return __builtin_bit_cast(bf16x8, __builtin_shufflevector(v, v, 0, 1, 2, 3)); }
__device__ __forceinline__ bf16x8 hi8(const v8i_t v) { return __builtin_bit_cast(bf16x8, __builtin_shufflevector(v, v, 4, 5, 6, 7)); }
template <class Epi, class Sched, bool F8 = false, bool ALIGN_EPI = true, bool SP2 = true>
__device__ __forceinline__ void gemm_phase(PG8_LAS unsigned char* lds, const int tid, const int KB, const Sched& S, const Epi& E) {
    const int wid = __builtin_amdgcn_readfirstlane(tid >> 6), lane = tid & 63, wr = wid >> 2, wc = wid & 3, fr = lane & 15, fq = lane >> 4;
    const int nt = KB / (BK * 2);
    unsigned voffA[2], voffB[2];
#pragma unroll
    for (int i = 0; i < 2; ++i) { int R, C; stage_rc(tid * 16 + i * 8192, R, C); const int Rb = Epi::PERM ? ((R & ~31) + perm32(R & 31)) : R;
        voffA[i] = (unsigned)(R * KB + C * 2); voffB[i] = (unsigned)(Rb * KB + C * 2); }
    const size_t kstep = (size_t)(BK * 2);
    const size_t hstep = (size_t)HALF * KB;
    const unsigned ldsw = (unsigned)wid * 1024u;
    const int aoff = lds_byte(wr * 64 + fr, fq * (F8 ? 16 : 8)), boff = lds_byte(wc * 32 + fr, fq * (F8 ? 16 : 8));
    constexpr int KOFF = F8 ? 16 : 1024;
#define PG8_SA(b, h) (((b) * 2 + (h)) * HTB)
#define PG8_SB(b, h) ((4 + (b) * 2 + (h)) * HTB)
#define PG8_STAGE(bufoff, gbase, voff) do { _Pragma("unroll") for (int _i = 0; _i < 2; ++_i) \
        __builtin_amdgcn_global_load_lds((const unsigned*)((const char*)(gbase) + (voff)[_i]), (PG8_LAS unsigned*)(lds + (bufoff) + ldsw + _i * 8192), 16, 0, 0); } while (0)
#define PG8_LDA(dst, b, h) do { _Pragma("unroll") for (int m = 0; m < 4; ++m) dst[m] = cat8(*(const PG8_LAS bf16x8*)(lds + PG8_SA(b, h) + aoff + m * 2048), *(const PG8_LAS bf16x8*)(lds + PG8_SA(b, h) + aoff + m * 2048 + KOFF)); } while (0)
#define PG8_LDB(dst, b, h) do { _Pragma("unroll") for (int n = 0; n < 2; ++n) dst[n] = cat8(*(const PG8_LAS bf16x8*)(lds + PG8_SB(b, h) + boff + n * 2048), *(const PG8_LAS bf16x8*)(lds + PG8_SB(b, h) + boff + n * 2048 + KOFF)); } while (0)
#define PG8_MMA(ai, bj, At, Bt) do { __builtin_amdgcn_s_setprio(1); _Pragma("unroll") for (int m = 0; m < 4; ++m) _Pragma("unroll") for (int n = 0; n < 2; ++n) { \
        if constexpr (F8) asm volatile("v_mfma_scale_f32_16x16x128_f8f6f4 %0, %1, %2, %0, %3, %3 op_sel_hi:[0,0,0]" : "+v"(acc[ai][bj][m][n]) : "v"(Bt[n]), "v"(At[m]), "v"(sc1)); \
        else { acc[ai][bj][m][n] = __builtin_amdgcn_mfma_f32_16x16x32_bf16(lo8(Bt[n]), lo8(At[m]), acc[ai][bj][m][n], 0, 0, 0); \
               acc[ai][bj][m][n] = __builtin_amdgcn_mfma_f32_16x16x32_bf16(hi8(Bt[n]), hi8(At[m]), acc[ai][bj][m][n], 0, 0, 0); } } \
        __builtin_amdgcn_s_setprio(0); } while (0)
#define PG8_WAIT_V(n) asm volatile("s_waitcnt vmcnt(" #n ")" ::: "memory")
#define PG8_WAIT_L(n) asm volatile("s_waitcnt lgkmcnt(" #n ")" ::: "memory")
#define PG8_BAR __builtin_amdgcn_s_barrier()
#define PG8_SCHED __builtin_amdgcn_sched_barrier(0)
    const int sc1 = 0x7f7f7f7f;
    Unit cur, nxt; int ui = 0;
    if (!S.next(0, cur)) return;
    f32x4 acc[2][2][4][2];
#pragma unroll
    for (int a = 0; a < 2; ++a)
#pragma unroll
        for (int b = 0; b < 2; ++b)
#pragma unroll
            for (int m = 0; m < 4; ++m)
#pragma unroll
                for (int n = 0; n < 2; ++n) acc[a][b][m][n] = (f32x4){0.f, 0.f, 0.f, 0.f};
    v8i_t At[4], B0[2], B1[2];
    const char* cA = cur.A; const char* cB = cur.B;
    if constexpr (SP2) {
        PG8_STAGE(PG8_SB(0, 0), cB, voffB); PG8_STAGE(PG8_SB(0, 1), cB + hstep, voffB); PG8_STAGE(PG8_SA(0, 0), cA, voffA); PG8_STAGE(PG8_SA(0, 1), cA + hstep, voffA);
        if (wr == 1) PG8_BAR;
        PG8_WAIT_V(2); PG8_BAR;
        PG8_STAGE(PG8_SB(1, 0), cB + kstep, voffB); PG8_STAGE(PG8_SA(1, 0), cA + kstep, voffA); PG8_STAGE(PG8_SB(1, 1), cB + hstep + kstep, voffB);
        PG8_WAIT_V(6); PG8_BAR;
    } else {
        PG8_STAGE(PG8_SB(0, 0), cB, voffB); PG8_STAGE(PG8_SA(0, 0), cA, voffA); PG8_STAGE(PG8_SB(0, 1), cB + hstep, voffB); PG8_STAGE(PG8_SA(0, 1), cA + hstep, voffA);
        if (wr == 1) PG8_BAR;
        PG8_WAIT_V(4); PG8_BAR;
        PG8_STAGE(PG8_SB(1, 0), cB + kstep, voffB); PG8_STAGE(PG8_SA(1, 0), cA + kstep, voffA); PG8_STAGE(PG8_SB(1, 1), cB + hstep + kstep, voffB);
        PG8_WAIT_V(6); PG8_BAR;
    }
    for (;;) {
        const bool has_next = S.next(ui + 1, nxt);
        const char* nA = has_next ? nxt.A : cA; const char* nB = has_next ? nxt.B : cB;
#pragma unroll 1
        for (int t = 0; t < nt; t += 2) {
            const bool last = (t == nt - 2);
            const char* a1 = cA + (size_t)(t + 1) * kstep;
            const char* a2 = last ? nA : cA + (size_t)(t + 2) * kstep; const char* b2 = last ? nB : cB + (size_t)(t + 2) * kstep;
            const char* a3 = a2 + kstep; const char* b3 = b2 + kstep;
            if constexpr (SP2) {
            PG8_LDB(B0, 0, 0); PG8_LDB(B1, 0, 1); PG8_SCHED; PG8_LDA(At, 0, 0); PG8_STAGE(PG8_SA(1, 1), a1 + hstep, voffA);
            PG8_WAIT_V(8); PG8_WAIT_L(0); PG8_BAR; PG8_MMA(0, 0, At, B0); PG8_MMA(0, 1, At, B1); PG8_BAR; PG8_SCHED;
            PG8_LDA(At, 0, 1); PG8_STAGE(PG8_SB(0, 0), b2, voffB); PG8_STAGE(PG8_SB(0, 1), b2 + hstep, voffB); PG8_STAGE(PG8_SA(0, 0), a2, voffA);
            PG8_WAIT_V(8); PG8_WAIT_L(0); PG8_BAR; PG8_MMA(1, 0, At, B0); PG8_MMA(1, 1, At, B1); PG8_BAR; PG8_SCHED;
            PG8_LDB(B0, 1, 0); PG8_LDB(B1, 1, 1); PG8_SCHED; PG8_LDA(At, 1, 0); PG8_STAGE(PG8_SA(0, 1), a2 + hstep, voffA);
            PG8_WAIT_V(8); PG8_WAIT_L(0); PG8_BAR; PG8_MMA(0, 0, At, B0); PG8_MMA(0, 1, At, B1); PG8_BAR; PG8_SCHED;
            PG8_LDA(At, 1, 1); PG8_STAGE(PG8_SB(1, 0), b3, voffB); PG8_STAGE(PG8_SB(1, 1), b3 + hstep, voffB); PG8_STAGE(PG8_SA(1, 0), a3, voffA);
            PG8_WAIT_V(8); PG8_WAIT_L(0); PG8_BAR; PG8_MMA(1, 0, At, B0); PG8_MMA(1, 1, At, B1); PG8_BAR; PG8_SCHED;
            } else {
            PG8_LDB(B0, 0, 0); PG8_SCHED; PG8_LDA(At, 0, 0); PG8_STAGE(PG8_SA(1, 1), a1 + hstep, voffA);
            PG8_WAIT_L(8); PG8_BAR; PG8_WAIT_L(0); PG8_MMA(0, 0, At, B0); PG8_BAR; PG8_SCHED;
            PG8_LDB(B1, 0, 1); PG8_STAGE(PG8_SB(0, 0), b2, voffB);
            PG8_BAR; PG8_WAIT_L(0); PG8_MMA(0, 1, At, B1); PG8_BAR;
            PG8_LDA(At, 0, 1); PG8_STAGE(PG8_SA(0, 0), a2, voffA);
            PG8_BAR; PG8_WAIT_L(0); PG8_MMA(1, 0, At, B0); PG8_BAR; PG8_SCHED;
            PG8_STAGE(PG8_SB(0, 1), b2 + hstep, voffB);
            PG8_WAIT_V(6); PG8_BAR; PG8_MMA(1, 1, At, B1); PG8_BAR;
            PG8_LDB(B0, 1, 0); PG8_SCHED; PG8_LDA(At, 1, 0); PG8_STAGE(PG8_SA(0, 1), a2 + hstep, voffA);
            PG8_WAIT_L(8); PG8_BAR; PG8_WAIT_L(0); PG8_MMA(0, 0, At, B0); PG8_BAR; PG8_SCHED;
            PG8_LDB(B1, 1, 1); PG8_STAGE(PG8_SB(1, 0), b3, voffB);
            PG8_BAR; PG8_WAIT_L(0); PG8_MMA(0, 1, At, B1); PG8_BAR;
            PG8_LDA(At, 1, 1); PG8_STAGE(PG8_SA(1, 0), a3, voffA);
            PG8_BAR; PG8_WAIT_L(0); PG8_MMA(1, 0, At, B0); PG8_BAR; PG8_SCHED;
            PG8_STAGE(PG8_SB(1, 1), b3 + hstep, voffB);
            PG8_WAIT_V(6); PG8_BAR; PG8_MMA(1, 1, At, B1); PG8_BAR;
            }
        }
        if constexpr (F8) asm volatile("s_nop 15\n\ts_nop 15" ::: "memory");
        if constexpr (ALIGN_EPI) { if (wr == 0) PG8_BAR; }
        E(acc, cur, wr, wc, fr, fq);
        if (!has_next) break;
#pragma unroll
        for (int a = 0; a < 2; ++a)
#pragma unroll
            for (int b = 0; b < 2; ++b)
#pragma unroll
                for (int m = 0; m < 4; ++m)
#pragma unroll
                    for (int n = 0; n < 2; ++n) acc[a][b][m][n] = (f32x4){0.f, 0.f, 0.f, 0.f};
        cur = nxt; cA = nA; cB = nB; ++ui;
        if constexpr (ALIGN_EPI) { if (wr == 1) PG8_BAR; }
    }
    PG8_WAIT_V(0);
    if constexpr (!ALIGN_EPI) { if (wr == 0) PG8_BAR; }
    PG8_BAR;
#undef PG8_SA
#undef PG8_SB
#undef PG8_STAGE
#undef PG8_LDA
#undef PG8_LDB
#undef PG8_MMA
#undef PG8_WAIT_V
#undef PG8_WAIT_L
#undef PG8_BAR
#undef PG8_SCHED
}
}
using pg8::Unit;

#define XB_TMO      128
#define XB_XCNT(j)  (256  + 64 * (j))
#define XB_XSUB(j)  (1280 + 64 * (j))
#define XB_XGEN(j)  (2304 + 64 * (j))
#define XB_TOP      3328
#define XB_TOPGEN   3392
#define XCD_BAR_WORDS 3456
#define XB_SPIN_CAP (1u << 18)
__device__ __forceinline__ unsigned xb_ld(unsigned* p)              { return __hip_atomic_load(p, __ATOMIC_RELAXED, __HIP_MEMORY_SCOPE_AGENT); }
__device__ __forceinline__ unsigned xb_add(unsigned* p, unsigned v) { return __hip_atomic_fetch_add(p, v, __ATOMIC_RELAXED, __HIP_MEMORY_SCOPE_AGENT); }
__device__ __forceinline__ unsigned xb_xcc_id() { return (unsigned)__builtin_amdgcn_s_getreg((3 << 11) | 20) & 0xFu; }
#define XB_SPIN(cond, bar) do { unsigned _sp = 0; while (cond) { __builtin_amdgcn_s_sleep(1); \
    if ((++_sp & 255u) == 0u) { if (xb_ld(&(bar)[XB_TMO])) break; if (_sp > XB_SPIN_CAP) { atomicAdd(&(bar)[XB_TMO], 1u); break; } } } } while (0)
struct XcdBarrier { unsigned* bar; unsigned x; volatile LAS unsigned* st; };
__device__ __forceinline__ XcdBarrier xcd_barrier_post(unsigned* bar, volatile LAS unsigned* st) {
    XcdBarrier b; b.bar = bar; b.x = xb_xcc_id(); b.st = st;
    if (threadIdx.x == 0) (void)xb_add(&bar[XB_XCNT(b.x)], 1u);
    return b;
}
__device__ __forceinline__ void xcd_barrier_complete(unsigned* bar, unsigned x, unsigned& nloc, unsigned& nx) {
    const unsigned G = gridDim.x * gridDim.y * gridDim.z;
    unsigned sum, cnt, mine, sp = 0u;
    for (;;) {
        sum = 0u; cnt = 0u; mine = 0u;
#pragma unroll
        for (unsigned j = 0; j < 16; ++j) { const unsigned c = xb_ld(&bar[XB_XCNT(j)]); sum += c; cnt += (c > 0u) ? 1u : 0u; mine = (j == x) ? c : mine; }
        if (sum == G) break;
        __builtin_amdgcn_s_sleep(1);
        if ((++sp & 255u) == 0u) { if (xb_ld(&bar[XB_TMO])) break; if (sp > XB_SPIN_CAP) { atomicAdd(&bar[XB_TMO], 1u); break; } }
    }
    nloc = mine > 0u ? mine : 1u; nx = cnt > 0u ? cnt : 1u;
}
__device__ __forceinline__ void xcd_barrier(const XcdBarrier& b, const int wave_s) {
    asm volatile("s_waitcnt vmcnt(0)" ::: "memory");
    __syncthreads();
    if (wave_s == 0 && __builtin_amdgcn_mbcnt_hi(~0u, __builtin_amdgcn_mbcnt_lo(~0u, 0u)) == 0u) {
        unsigned* bar = b.bar; asm volatile("" : "+v"(bar));
        __builtin_amdgcn_s_waitcnt(0);
        unsigned nloc = b.st[0], nx = b.st[1];
        if (nloc == 0u) { xcd_barrier_complete(bar, b.x, nloc, nx); b.st[0] = nloc; b.st[1] = nx; }
        const unsigned old = xb_add(&bar[XB_XSUB(b.x)], 1u);
        const unsigned gen = old / nloc;
        if (old + 1u == (gen + 1u) * nloc) {
            __builtin_amdgcn_fence(__ATOMIC_RELEASE, "agent");
            asm volatile("s_waitcnt vmcnt(0)" ::: "memory");
            const unsigned og = xb_add(&bar[XB_TOP], 1u);
            const unsigned tg = og / nx;
            if (og + 1u == (tg + 1u) * nx) xb_add(&bar[XB_TOPGEN], 1u);
            else XB_SPIN(xb_ld(&bar[XB_TOPGEN]) == tg, bar);
            __builtin_amdgcn_fence(__ATOMIC_ACQUIRE, "agent");
            xb_add(&bar[XB_XGEN(b.x)], 1u);
            asm volatile("s_waitcnt vmcnt(0)" ::: "memory");
        } else {
            XB_SPIN(xb_ld(&bar[XB_XGEN(b.x)]) == gen, bar);
            __builtin_amdgcn_fence(__ATOMIC_ACQUIRE, "agent");
            asm volatile("s_waitcnt vmcnt(0)" ::: "memory");
        }
    }
    __syncthreads();
}

struct Args { const float* in[N_IN]; float* out; unsigned char* ws; int ph_lo, ph_hi; };

struct Frame {
    LAS unsigned char* lds;
    int tid, lane, wave, vcu, G;
    const float* const* in; float* out; unsigned char* ws;
};

__device__ __forceinline__ const float* inp(const Frame& F, int k) { const float* p = F.in[k]; asm volatile("" : "+s"(p)); return p; }

struct SchedPlain {
    pg8::Rect R; const char* A; const char* B; size_t tsA, tsB; int xM, xN0, xNn;
    __device__ __forceinline__ bool next(int i, Unit& u) const {
        const int L = i * R.G + R.c;
        if (R.map(L, u.pm, u.pn)) {} else { const int e = L - R.nwg; if (e >= xM * xNn) return false; u.pm = R.nM + e / xNn; u.pn = xN0 + e % xNn; }
        u.seg = 0; u.ex = 0; u.A = A + (size_t)u.pm * tsA; u.B = B + (size_t)u.pn * tsB; return true;
    }
};
struct SchedMerge {
    pg8::Rect R; const char* A; const char* B; size_t tsA, tsB, sA, sB;
    __device__ __forceinline__ bool next(int i, Unit& u) const {
        const int ti = i / 3, sg = i - 3 * ti; const int L = ti * R.G + R.c;
        if (!R.map(L, u.pm, u.pn)) return false;
        u.seg = sg; u.ex = 0;
        u.A = A + (size_t)sg * sA + (size_t)u.pm * tsA; u.B = B + (size_t)sg * sB + (size_t)u.pn * tsB; return true;
    }
};
struct SchedMoe {
    pg8::Rect R; const char* A; const char* B; size_t tsA, tsB, esB; const int* tile_e; int tile0; bool a_global;
    __device__ __forceinline__ bool next(int i, Unit& u) const {
        const int L = i * R.G + R.c;
        if (!R.map(L, u.pm, u.pn)) return false;
        const int gt = tile0 + u.pm; u.ex = gt; u.seg = 0; const int e = tile_e[gt];
        u.A = A + (size_t)(a_global ? gt : u.pm) * tsA; u.B = B + (size_t)e * esB + (size_t)u.pn * tsB; return true;
    }
};

typedef const f32x4 (&AccRef)[2][2][4][2];
__device__ __forceinline__ v4u pack8(const f32x4 a, const f32x4 b) { v4u w; w.x = pg8::cvt_pk_bf16(a[0], a[1]); w.y = pg8::cvt_pk_bf16(a[2], a[3]); w.z = pg8::cvt_pk_bf16(b[0], b[1]); w.w = pg8::cvt_pk_bf16(b[2], b[3]); return w; }
__device__ __forceinline__ void unpack8(const v4u w, f32x4& a, f32x4& b) { a = (f32x4){bflo(w.x), bfhi(w.x), bflo(w.y), bfhi(w.y)}; b = (f32x4){bflo(w.z), bfhi(w.z), bflo(w.w), bfhi(w.w)}; }

struct EpiInproj {
    static constexpr bool PERM = true;
    bf16* phyT; bf16* ucf; bf16* ps5;
    __device__ __forceinline__ void operator()(AccRef acc, const Unit& u, int wr, int wc, int fr, int fq) const {
        const int row0 = u.pm * 256 + wr * 64 + fr;
        if (u.pn < 6) {
#pragma unroll
            for (int ai = 0; ai < 2; ++ai)
#pragma unroll
                for (int m = 0; m < 4; ++m) { const int r = row0 + ai * 128 + m * 16;
#pragma unroll
                    for (int bj = 0; bj < 2; ++bj)
#pragma unroll
                        for (int n = 0; n < 2; ++n)
#pragma unroll
                            for (int j = 0; j < 4; ++j) { const int c = u.pn * 256 + bj * 128 + wc * 32 + 8 * fq + 4 * n + j; phyT[(size_t)c * RT + r] = (bf16)f2bf(acc[ai][bj][m][n][j]); } }
        } else if (u.pn < 10) {
            const int col0 = (u.pn - 6) * 128 + wc * 32 + 8 * fq;
#pragma unroll
            for (int ai = 0; ai < 2; ++ai)
#pragma unroll
                for (int m = 0; m < 4; ++m) { const int r = row0 + ai * 128 + m * 16; f32x4 o[2];
#pragma unroll
                    for (int n = 0; n < 2; ++n)
#pragma unroll
                        for (int j = 0; j < 4; ++j) o[n][j] = acc[ai][0][m][n][j] * sigmoidf_(acc[ai][1][m][n][j]);
                    *(v4u*)(ucf + (size_t)r * 512 + col0) = pack8(o[0], o[1]); }
        } else {
#pragma unroll
            for (int ai = 0; ai < 2; ++ai)
#pragma unroll
                for (int m = 0; m < 4; ++m) { const int r = row0 + ai * 128 + m * 16;
#pragma unroll
                    for (int bj = 0; bj < 2; ++bj) { const int col0 = (u.pn - 10) * 256 + bj * 128 + wc * 32 + 8 * fq; *(v4u*)(ps5 + (size_t)r * 512 + col0) = pack8(acc[ai][bj][m][0], acc[ai][bj][m][1]); } }
        }
    }
};
struct EpiGates {
    static constexpr bool PERM = true;
    bf16* O;
    __device__ __forceinline__ void operator()(AccRef acc, const Unit& u, int wr, int wc, int fr, int fq) const {
        const int row0 = u.pm * 256 + wr * 64 + fr;
#pragma unroll
        for (int ai = 0; ai < 2; ++ai)
#pragma unroll
            for (int m = 0; m < 4; ++m) { const int r = row0 + ai * 128 + m * 16;
#pragma unroll
                for (int bj = 0; bj < 2; ++bj) { const int col0 = u.pn * 256 + bj * 128 + wc * 32 + 8 * fq; f32x4 o[2];
#pragma unroll
                    for (int n = 0; n < 2; ++n)
#pragma unroll
                        for (int j = 0; j < 4; ++j) o[n][j] = sigmoidf_(acc[ai][bj][m][n][j]);
                    *(v4u*)(O + (size_t)r * 3072 + col0) = pack8(o[0], o[1]); } }
    }
};
struct EpiGlu {
    static constexpr bool PERM = true;
    const bf16* SG; bf16* O; const float* bglu;
    __device__ __forceinline__ void operator()(AccRef acc, const Unit& u, int wr, int wc, int fr, int fq) const {
        const int row0 = u.pm * 256 + wr * 64 + fr;
#pragma unroll
        for (int bj = 0; bj < 2; ++bj) { const int col0 = u.pn * 256 + bj * 128 + wc * 32 + 8 * fq;
            const f32x4 b0 = *(const f32x4*)(bglu + col0), b1 = *(const f32x4*)(bglu + col0 + 4);
#pragma unroll
            for (int ai = 0; ai < 2; ++ai)
#pragma unroll
                for (int m = 0; m < 4; ++m) { const int r = row0 + ai * 128 + m * 16;
                    const v4u gw = *(const v4u*)(SG + (size_t)r * 512 + col0); f32x4 g0, g1; unpack8(gw, g0, g1); f32x4 o0, o1;
#pragma unroll
                    for (int j = 0; j < 4; ++j) { o0[j] = g0[j] * sigmoidf_(acc[ai][bj][m][0][j] + b0[j]); o1[j] = g1[j] * sigmoidf_(acc[ai][bj][m][1][j] + b1[j]); }
                    *(v4u*)(O + (size_t)r * 512 + col0) = pack8(o0, o1); } }
    }
};
struct EpiMerge {
    static constexpr bool PERM = true;
    const bf16* GT; bf16* O;
    __device__ __forceinline__ void operator()(AccRef acc, const Unit& u, int wr, int wc, int fr, int fq) const {
        const int row0 = u.pm * 256 + wr * 64 + fr;
#pragma unroll
        for (int ai = 0; ai < 2; ++ai)
#pragma unroll
            for (int m = 0; m < 4; ++m) { const int r = row0 + ai * 128 + m * 16;
#pragma unroll
                for (int bj = 0; bj < 2; ++bj) { const int col0 = u.pn * 256 + bj * 128 + wc * 32 + 8 * fq;
                    const v4u gw = *(const v4u*)(GT + (size_t)r * 3072 + u.seg * 1024 + col0); f32x4 g0, g1; unpack8(gw, g0, g1);
                    f32x4 o0 = g0 * acc[ai][bj][m][0], o1 = g1 * acc[ai][bj][m][1];
                    bf16* dst = O + (size_t)r * 1024 + col0;
                    if (u.seg > 0) { const v4u pw = *(const v4u*)dst; f32x4 p0, p1; unpack8(pw, p0, p1); o0 += p0; o1 += p1; }
                    *(v4u*)dst = pack8(o0, o1); } }
    }
};
struct EpiRes {
    static constexpr bool PERM = false;
    const float* xl; const float* xc; float* ol; float* oc; const float* gbase; float sc;
    __device__ __forceinline__ void operator()(AccRef acc, const Unit& u, int wr, int wc, int fr, int fq) const {
        const bool isl = u.pm < (NX / 256);
        const int prow = isl ? u.pm * 256 : (u.pm - NX / 256) * 256; const int mi = isl ? (u.pm >> 3) : 16;
        const float* xs = isl ? xl : xc; float* os = isl ? ol : oc; const float* gv = gbase + (size_t)mi * INC;
        const int row0 = prow + wr * 64 + fr, col0 = u.pn * 256 + wc * 32 + 4 * fq;
#pragma unroll
        for (int bj = 0; bj < 2; ++bj)
#pragma unroll
            for (int n = 0; n < 2; ++n) { const int c = col0 + bj * 128 + n * 16; const f32x4 g = *(const f32x4*)(gv + c) * sc;
#pragma unroll
                for (int ai = 0; ai < 2; ++ai)
#pragma unroll
                    for (int m = 0; m < 4; ++m) { const size_t off = (size_t)(row0 + ai * 128 + m * 16) * 1024 + c;
                        const f32x4 xr = *(const f32x4*)(xs + off); *(f32x4*)(os + off) = xr * ALPHA_F + g * acc[ai][bj][m][n]; } }
    }
};
struct EpiSwiglu {
    static constexpr bool PERM = true;
    bf16* O; int ldc;
    __device__ __forceinline__ void operator()(AccRef acc, const Unit& u, int wr, int wc, int fr, int fq) const {
        const int row0 = u.pm * 256 + wr * 64 + fr, col0 = u.pn * 128 + wc * 32 + 8 * fq;
#pragma unroll
        for (int ai = 0; ai < 2; ++ai)
#pragma unroll
            for (int m = 0; m < 4; ++m) { const int r = row0 + ai * 128 + m * 16; f32x4 o[2];
#pragma unroll
                for (int n = 0; n < 2; ++n)
#pragma unroll
                    for (int j = 0; j < 4; ++j) o[n][j] = siluf_(acc[ai][0][m][n][j]) * acc[ai][1][m][n][j];
                *(v4u*)(O + (size_t)r * ldc + col0) = pack8(o[0], o[1]); }
    }
};
struct EpiSwigluF8 {
    static constexpr bool PERM = true;
    unsigned char* O; int ldc; float sc;
    __device__ __forceinline__ void operator()(AccRef acc, const Unit& u, int wr, int wc, int fr, int fq) const {
        const int row0 = u.pm * 256 + wr * 64 + fr, col0 = u.pn * 128 + wc * 32 + 8 * fq;
#pragma unroll
        for (int ai = 0; ai < 2; ++ai)
#pragma unroll
            for (int m = 0; m < 4; ++m) { const int r = row0 + ai * 128 + m * 16; f32x4 o[2];
#pragma unroll
                for (int n = 0; n < 2; ++n)
#pragma unroll
                    for (int j = 0; j < 4; ++j) o[n][j] = siluf_(acc[ai][0][m][n][j] * sc) * (acc[ai][1][m][n][j] * sc);
                v2u w; w.x = pk4_fp8(o[0][0], o[0][1], o[0][2], o[0][3]); w.y = pk4_fp8(o[1][0], o[1][1], o[1][2], o[1][3]);
                *(v2u*)(O + (size_t)r * ldc + col0) = w; }
    }
};
struct EpiMoeDown {
    static constexpr bool PERM = true;
    bf16* O; float sc;
    __device__ __forceinline__ void operator()(AccRef acc, const Unit& u, int wr, int wc, int fr, int fq) const {
        const int row0 = u.ex * 256 + wr * 64 + fr;
#pragma unroll
        for (int ai = 0; ai < 2; ++ai)
#pragma unroll
            for (int m = 0; m < 4; ++m) { const int r = row0 + ai * 128 + m * 16;
#pragma unroll
                for (int bj = 0; bj < 2; ++bj) { const int col0 = u.pn * 256 + bj * 128 + wc * 32 + 8 * fq; *(v4u*)(O + (size_t)r * 1024 + col0) = pack8(acc[ai][bj][m][0] * sc, acc[ai][bj][m][1] * sc); } }
    }
};

template <bool F8>
__device__ __forceinline__ void transpose_item64(const float* W, int K, int N, unsigned char* WT, int dst_row0, int k0, int n0, float scale, LAS float* scr, int lane) {
#pragma unroll 4
    for (int i = 0; i < 16; ++i) { const int row = 4 * i + (lane >> 4), nc = 4 * (lane & 15);
        const f32x4 v = *(const f32x4*)(W + (size_t)(k0 + row) * N + n0 + nc); *(LAS f32x4*)(scr + row * 68 + nc) = v * scale; }
    LDS_WAIT(); asm volatile("" ::: "memory");
    const LAS float* sp = scr + lane;
    if constexpr (F8) {
        unsigned char* dst = WT + (size_t)(dst_row0 + lane) * K + k0;
#pragma unroll
        for (int c4 = 0; c4 < 4; ++c4) { v4u o;
#pragma unroll
            for (int e = 0; e < 4; ++e) { const int kk = 16 * c4 + 4 * e; o[e] = pk4_fp8(sp[(kk + 0) * 68], sp[(kk + 1) * 68], sp[(kk + 2) * 68], sp[(kk + 3) * 68]); }
            *(v4u*)(dst + 16 * c4) = o; }
    } else {
        unsigned char* dst = WT + ((size_t)(dst_row0 + lane) * K + k0) * 2;
#pragma unroll
        for (int c8 = 0; c8 < 8; ++c8) { v4u o;
#pragma unroll
            for (int e = 0; e < 4; ++e) { const int kk = 8 * c8 + 2 * e; o[e] = pk2(sp[kk * 68], sp[(kk + 1) * 68]); }
            *(v4u*)(dst + 16 * c8) = o; }
    }
    LDS_WAIT(); asm volatile("" ::: "memory");
}
__device__ __forceinline__ int dst_row_map(int kind, int n0) {
    if (kind == 1) { if (n0 >= 1536 && n0 < 2560) { const int i = (n0 - 1536) & 511, hi = (n0 - 1536) >> 9; return 1536 + 256 * (i >> 7) + 128 * hi + (i & 127); } return n0; }
    if (kind == 2) return 256 * (n0 >> 7) + (n0 & 127);
    if (kind == 3) return 256 * (n0 >> 7) + 128 + (n0 & 127);
    return n0;
}
__device__ __forceinline__ void conv_matrix_item(const float* W, int K, int N, bf16* WT, int kind, int item, LAS float* scr, int lane) {
    const int nblk = N / 64, kb = item / nblk, nb = item - kb * nblk;
    transpose_item64<false>(W, K, N, (unsigned char*)WT, dst_row_map(kind, 64 * nb), 64 * kb, 64 * nb, 1.0f, scr, lane);
}
__device__ __forceinline__ void conv_matrix_item_f8(const float* W, int K, int N, unsigned char* WT, int kind, int item, float scale, LAS float* scr, int lane) {
    const int nblk = N / 64, kb = item / nblk, nb = item - kb * nblk;
    transpose_item64<true>(W, K, N, WT, dst_row_map(kind, 64 * nb), 64 * kb, 64 * nb, scale, scr, lane);
}
__device__ __forceinline__ void p0a_prologue(Frame& F) {
    LAS float* scr = (LAS float*)(F.lds + F.wave * 17408);
    const int gw = F.vcu * NWAVES + F.wave, NGW = F.G * NWAVES;
    bf16* ws_win = (bf16*)(F.ws + WS_WIN); bf16* ws_outs = (bf16*)(F.ws + WS_WOUTS); bf16* ws_glu = (bf16*)(F.ws + WS_WGLU); bf16* ws_wo = (bf16*)(F.ws + WS_WO);
    bf16* ws_w13 = (bf16*)(F.ws + WS_W13); bf16* ws_w2 = (bf16*)(F.ws + WS_W2);
    constexpr int I_IN = (1024 / 64) * (6144 / 64), I_OUT = (512 / 64) * (1024 / 64), I_GLU = (512 / 64) * (512 / 64), I_WOI = (1024 / 64) * (1024 / 64), I_F1 = (1024 / 64) * (2816 / 64), I_F2 = (2816 / 64) * (1024 / 64);
    constexpr int NITEMS = 2 * I_IN + 6 * I_OUT + 2 * I_GLU + 2 * I_WOI + 2 * I_F1 + I_F2;
    for (int it = gw; it < NITEMS; it += NGW) {
        int r = it;
        if (r < 2 * I_IN) { const int l = r / I_IN; conv_matrix_item(inp(F, I_WIN) + (size_t)l * 1024 * 6144, 1024, 6144, ws_win + (size_t)l * 6144 * 1024, 1, r - l * I_IN, scr, F.lane); continue; } r -= 2 * I_IN;
        if (r < 6 * I_OUT) { const int q = r / I_OUT, l = q / 3, s = q - 3 * l; const float* src = inp(F, s == 0 ? I_WHY : (s == 1 ? I_WCF : I_WS5)) + (size_t)l * 512 * 1024;
            conv_matrix_item(src, 512, 1024, ws_outs + (size_t)(l * 3 + s) * 1024 * 512, 0, r - q * I_OUT, scr, F.lane); continue; } r -= 6 * I_OUT;
        if (r < 2 * I_GLU) { const int l = r / I_GLU; conv_matrix_item(inp(F, I_SWGLU) + (size_t)l * 512 * 512, 512, 512, ws_glu + (size_t)l * 512 * 512, 0, r - l * I_GLU, scr, F.lane); continue; } r -= 2 * I_GLU;
        if (r < 2 * I_WOI) { const int l = r / I_WOI; conv_matrix_item(inp(F, I_WO) + (size_t)l * 1024 * 1024, 1024, 1024, ws_wo + (size_t)l * 1024 * 1024, 0, r - l * I_WOI, scr, F.lane); continue; } r -= 2 * I_WOI;
        if (r < I_F1) { conv_matrix_item_f8(inp(F, I_FFW1), 1024, 2816, (unsigned char*)ws_w13, 2, r, 32.f, scr, F.lane); continue; } r -= I_F1;
        if (r < I_F1) { conv_matrix_item_f8(inp(F, I_FFW3), 1024, 2816, (unsigned char*)ws_w13, 3, r, 32.f, scr, F.lane); continue; } r -= I_F1;
        conv_matrix_item_f8(inp(F, I_FFW2), 2816, 1024, (unsigned char*)ws_w2, 0, r, 128.f, scr, F.lane);
    }
    __syncthreads();
    float* part = (float*)(F.ws + WS_HX);
    LAS float* sc = (LAS float*)F.lds;
    for (int it = F.vcu; it < 2 * 8 * 12; it += F.G) {
        const int l = it / 96, r = it - l * 96, ks = r / 12, nb = r - ks * 12;
        __syncthreads();
        for (int e = F.tid; e < 17 * 128; e += 512) { const int i = e >> 7, k = e & 127; const float cv = i < 16 ? inp(F, I_C)[i * 1024 + ks * 128 + k] : inp(F, I_CCTX)[ks * 128 + k]; sc[k * 20 + i] = siluf_(cv); }
        __syncthreads();
        const int n = nb * 512 + F.tid; const float* w = inp(F, I_WMOD) + (size_t)l * 1024 * 6144 + (size_t)(ks * 128) * 6144 + n;
        float acc[17];
#pragma unroll
        for (int i = 0; i < 17; ++i) acc[i] = 0.f;
        for (int k = 0; k < 128; ++k) { const float wv = w[(size_t)k * 6144];
#pragma unroll
            for (int i = 0; i < 17; ++i) acc[i] += sc[k * 20 + i] * wv; }
#pragma unroll
        for (int i = 0; i < 17; ++i) part[((size_t)(ks * 2 + l) * 17 + i) * 6144 + n] = acc[i];
    }
}
__device__ __forceinline__ void p0b_mods(Frame& F) {
    const float* part = (const float*)(F.ws + WS_HX); float* mods = (float*)(F.ws + WS_MODS);
    for (int e = F.vcu * 512 + F.tid; e < 2 * 17 * 6144; e += F.G * 512) {
        const int l = e / (17 * 6144), r = e - l * 17 * 6144, i = r / 6144, n = r - i * 6144;
        float s = inp(F, I_BMOD)[l * 6144 + n];
#pragma unroll
        for (int ks = 0; ks < 8; ++ks) s += part[((size_t)(ks * 2 + l) * 17 + i) * 6144 + n];
        mods[e] = s;
    }
}

__device__ __forceinline__ void h2table_phase(Frame& F, int l) {
    const int gw = F.vcu * NWAVES + F.wave, NGW = F.G * NWAVES, lane = F.lane;
    float* H2 = (float*)(F.ws + WS_FILT);
    const float* w1 = inp(F, I_FW1) + l * 33 * 64; const float* b1 = inp(F, I_FB1) + l * 64; const float* w2 = inp(F, I_FW2) + l * 64 * 64; const float* b2 = inp(F, I_FB2) + l * 64;
    const float* fq = inp(F, I_FREQ) + l * 128;
    for (int pos = gw; pos < LSEQ + LCTX; pos += NGW) {
        const bool isc = pos >= LSEQ; const int L = isc ? LCTX : LSEQ; const int t = isc ? pos - LSEQ : pos;
        const float tn = (float)t / (float)(L - 1);
        float z = 0.f;
        if (lane == 0) z = tn;
        else if (lane <= 32) { const int band = lane <= 16 ? lane : lane - 16; const int ph = (t * band) % L; const float ang = 6.283185307179586f * ((float)ph / (float)L); z = lane <= 16 ? cosf(ang) : sinf(ang); }
        float h = b1[lane];
        for (int k = 0; k < 33; ++k) h += lane_bcast(z, k) * w1[k * 64 + lane];
        h = sinf(fq[lane] * h);
        float h2 = b2[lane];
        for (int k = 0; k < 64; ++k) h2 += lane_bcast(h, k) * w2[k * 64 + lane];
        H2[(size_t)pos * 64 + lane] = sinf(fq[64 + lane] * h2);
    }
}
__device__ __forceinline__ void filter_expand_phase(Frame& F, int l) {
    const int gw = F.vcu * NWAVES + F.wave, NGW = F.G * NWAVES, lane = F.lane;
    const float* H2 = (const float*)(F.ws + WS_FILT);
    const float* w3 = inp(F, I_FW3) + (size_t)l * 64 * 2048; const float* b3 = inp(F, I_FB3) + l * 2048; const float* dec = inp(F, I_DECAY) + l * 2048; const float* hb = inp(F, I_HBIAS) + l * 1024;
    LAS float* W = (LAS float*)(F.lds + F.wave * 17408);
#pragma unroll 1
    for (int it = gw; it < 1024 + 128; it += NGW) {
        const bool isc = it >= 1024; const int ii = isc ? it - 1024 : it; const int chunk = ii >> 5, grp = ii & 31;
        const int L = isc ? LCTX : LSEQ; const int t = chunk * 64 + lane; const int pos = isc ? LSEQ + t : t;
        bf16* KR = isc ? (bf16*)(F.ws + WS_KRC) : (bf16*)(F.ws + WS_KRL); const int KLEN = 2 * L;
        const float tn = (float)t / (float)(L - 1);
#pragma unroll 4
        for (int k = 0; k < 64; ++k) W[lane * 68 + k] = w3[(size_t)k * 2048 + grp * 64 + lane];
        f32x4 h2[16];
#pragma unroll
        for (int k = 0; k < 16; ++k) h2[k] = *(const f32x4*)(H2 + (size_t)pos * 64 + 4 * k);
        const int colL = grp * 64 + lane; const float b3L = b3[colL], decL = fabsf(dec[colL]); const float hbL = ((colL >> 9) & 1) == 0 ? hb[(colL >> 10) * 512 + (colL & 511)] : 0.f;
        LDS_WAIT();
#pragma unroll 1
        for (int cc = 0; cc < 64; ++cc) {
            const int col = grp * 64 + cc; float a = lane_bcast(b3L, cc);
#pragma unroll
            for (int k = 0; k < 16; ++k) { const f32x4 wv = *(const LAS f32x4*)(W + cc * 68 + 4 * k); a += (h2[k][0] * wv[0] + h2[k][1] * wv[1]) + (h2[k][2] * wv[2] + h2[k][3] * wv[3]); }
            const int o = col >> 10, dir = (col >> 9) & 1, c = col & 511;
            float v = a * __expf(-tn * lane_bcast(decL, cc));
            if (t == 0 && dir == 0) v += lane_bcast(hbL, cc);
            const bool valid = !(t == 0 && dir == 1);
            const int i = dir ? L + t : L - t;
            const unsigned short bv = (unsigned short)f2bf(v);
            bf16* base = (valid ? KR + (size_t)((o * 512 + c) * 8) * KLEN : (bf16*)(F.ws + WS_KDUMMY) + 16) + i;
#pragma unroll
            for (int m = 0; m < 8; ++m) base[(ptrdiff_t)m * (KLEN - 1)] = bv;
        }
        LDS_WAIT();
    }
    __syncthreads();
}
__device__ __forceinline__ void s5params_phase(Frame& F, int l) {
    float* P = (float*)(F.ws + WS_S5P);
    for (int e = F.vcu * 512 + F.tid; e < 2 * 32 * 64; e += F.G * 512) {
        const int base = l * 4096 + e;
        const int dg = e >> 6;
        const float lam_re = fminf(inp(F, I_SARE)[base], -1e-4f), lam_im = inp(F, I_SAIM)[base];
        const float dt = expf(inp(F, I_SLDT)[l * 64 + dg]);
        const float mag = expf(lam_re * dt), ang = lam_im * dt; const float abr = mag * cosf(ang), abi = mag * sinf(ang);
        const float den = lam_re * lam_re + lam_im * lam_im;
        const float qre = ((abr - 1.0f) * lam_re + abi * lam_im) / den, qim = (abi * lam_re - (abr - 1.0f) * lam_im) / den;
        float* o = P + (size_t)e * 36; o[0] = abr; o[1] = abi;
        const float* br = inp(F, I_SBRE) + (size_t)base * 16; const float* bi = inp(F, I_SBIM) + (size_t)base * 16;
        for (int c = 0; c < 16; ++c) { o[2 + c] = qre * br[c] - qim * bi[c]; o[18 + c] = qre * bi[c] + qim * br[c]; }
        o[34] = 0.f; o[35] = 0.f;
    }
}

struct Row { f32x4 v[4]; };
__device__ __forceinline__ void row_load(Row& r, const float* p, int lane) { const f32x4* x = (const f32x4*)p + lane;
#pragma unroll
    for (int j = 0; j < 4; ++j) r.v[j] = x[64 * j]; }
__device__ __forceinline__ void row_store(const Row& r, float* p, int lane) { f32x4* x = (f32x4*)p + lane;
#pragma unroll
    for (int j = 0; j < 4; ++j) x[64 * j] = r.v[j]; }
__device__ __forceinline__ void row_norm(Row& r) {
    float s = 0.f;
#pragma unroll
    for (int j = 0; j < 4; ++j) s += (r.v[j][0] + r.v[j][1]) + (r.v[j][2] + r.v[j][3]);
    const float mean = wave_sum(s) * (1.f / DM); float q = 0.f;
#pragma unroll
    for (int j = 0; j < 4; ++j) { r.v[j] = r.v[j] - mean; q += (r.v[j][0] * r.v[j][0] + r.v[j][1] * r.v[j][1]) + (r.v[j][2] * r.v[j][2] + r.v[j][3] * r.v[j][3]); }
    const float rstd = 1.f / sqrtf(wave_sum(q) * (1.f / DM) + LN_EPS);
#pragma unroll
    for (int j = 0; j < 4; ++j) r.v[j] = r.v[j] * rstd;
}
__device__ __forceinline__ void row_affine(Row& r, const float* g, const float* b, int lane, float gadd) {
    const f32x4* gp = (const f32x4*)g + lane; const f32x4* bp = (const f32x4*)b + lane;
#pragma unroll
    for (int j = 0; j < 4; ++j) r.v[j] = r.v[j] * (gp[64 * j] + gadd) + bp[64 * j];
}
struct Vec8 { f32x4 g[4], b[4]; };
__device__ __forceinline__ void vec8_load(Vec8& v, const float* g, const float* b, int lane) { const f32x4* gp = (const f32x4*)g + lane; const f32x4* bp = (const f32x4*)b + lane;
#pragma unroll
    for (int j = 0; j < 4; ++j) { v.g[j] = gp[64 * j]; v.b[j] = bp[64 * j]; } }
__device__ __forceinline__ void row_affine_reg(Row& r, const Vec8& v, float gadd) {
#pragma unroll
    for (int j = 0; j < 4; ++j) r.v[j] = r.v[j] * (v.g[j] + gadd) + v.b[j]; }
__device__ __forceinline__ int row_batch(int row) { return row < NX ? (row >> 11) : 16; }
__device__ __forceinline__ void row_store_bf16(const Row& r, bf16* p, int lane) { unsigned long long* o = (unsigned long long*)p + lane;
#pragma unroll
    for (int j = 0; j < 4; ++j) o[64 * j] = (unsigned long long)pk2(r.v[j][0], r.v[j][1]) | ((unsigned long long)pk2(r.v[j][2], r.v[j][3]) << 32); }

__device__ __forceinline__ const float* mod_vec(Frame& F, int l, int row, int which) { const int i = row < NX ? (row >> 11) : 16; return (const float*)(F.ws + WS_MODS) + ((size_t)l * 17 + i) * INC + which * 1024; }
__device__ __forceinline__ const float* xrow_ptr(Frame& F, int l, int row) {
    if (l == 0) return row < NX ? inp(F, I_X) + (size_t)row * DM : inp(F, I_CTX) + (size_t)(row - NX) * DM;
    return row < NX ? F.out + (size_t)row * DM : (const float*)(F.ws + WS_XC) + (size_t)(row - NX) * DM;
}
__device__ __forceinline__ float* xcur_ptr(Frame& F, int row) { return row < NX ? F.out + (size_t)row * DM : (float*)(F.ws + WS_XC) + (size_t)(row - NX) * DM; }

__device__ __forceinline__ void lnmod_phase(Frame& F, int l) {
    const int gw = F.vcu * NWAVES + F.wave, NGW = F.G * NWAVES; bf16* hx = (bf16*)(F.ws + WS_HX);
    const int m0 = (int)((long)RT * gw / NGW), m1 = (int)((long)RT * (gw + 1) / NGW); Vec8 md; int cb = -1;
    for (int m = m0; m < m1; ++m) { if (row_batch(m) != cb) { cb = row_batch(m); vec8_load(md, mod_vec(F, l, m, 1), mod_vec(F, l, m, 0), F.lane); }
        Row r; row_load(r, xrow_ptr(F, l, m), F.lane); row_norm(r); row_affine_reg(r, md, 1.0f); row_store_bf16(r, hx + (size_t)m * DM, F.lane); }
}
__device__ __forceinline__ void ln1_phase(Frame& F, int l) {
    const int gw = F.vcu * NWAVES + F.wave, NGW = F.G * NWAVES; bf16* hx = (bf16*)(F.ws + WS_HX); const int M = l == 0 ? RT : NX;
    const float* g = inp(F, I_LN1G) + l * DM; const float* b = inp(F, I_LN1B) + l * DM;
    int* toke = (int*)(F.ws + WS_META + META_TOKE); float* tokw = (float*)(F.ws + WS_META + META_TOKW);
    LAS unsigned* lcnt = (LAS unsigned*)(F.lds);
    unsigned c8[8];
#pragma unroll
    for (int e = 0; e < 8; ++e) c8[e] = 0u;
    if (l == 1) { if (F.tid < 8) lcnt[F.tid] = 0u; __syncthreads(); }
    f32x4 rtr[4][4][2];
    if (l == 1) { const float* rt = inp(F, I_ROUTER);
#pragma unroll
        for (int j = 0; j < 4; ++j)
#pragma unroll
            for (int q = 0; q < 4; ++q) { const int k = 256 * j + 4 * F.lane + q; rtr[j][q][0] = *(const f32x4*)(rt + k * 8); rtr[j][q][1] = *(const f32x4*)(rt + k * 8 + 4); } }
    Vec8 ln; vec8_load(ln, g, b, F.lane); Vec8 md; int cb = -1;
    const int m0 = (int)((long)M * gw / NGW), m1 = (int)((long)M * (gw + 1) / NGW);
    for (int m = m0; m < m1; ++m) {
        if (row_batch(m) != cb) { cb = row_batch(m); vec8_load(md, mod_vec(F, l, m, 4), mod_vec(F, l, m, 3), F.lane); }
        float* xp = xcur_ptr(F, m); Row r; row_load(r, xp, F.lane); row_norm(r); row_affine_reg(r, ln, 0.0f); row_store(r, xp, F.lane);
        row_norm(r); row_affine_reg(r, md, 1.0f);
        if (l == 0) { unsigned* d8 = (unsigned*)((unsigned char*)hx + (size_t)m * DM) + F.lane;
#pragma unroll
            for (int j = 0; j < 4; ++j) d8[64 * j] = pk4_fp8(r.v[j][0], r.v[j][1], r.v[j][2], r.v[j][3]); }
        else {
            float lg[8];
#pragma unroll
            for (int e = 0; e < 8; ++e) lg[e] = 0.f;
#pragma unroll
            for (int j = 0; j < 4; ++j)
#pragma unroll
                for (int q = 0; q < 4; ++q) { const f32x4 r0 = rtr[j][q][0], r1 = rtr[j][q][1]; const float hv = r.v[j][q];
                    lg[0] += hv * r0[0]; lg[1] += hv * r0[1]; lg[2] += hv * r0[2]; lg[3] += hv * r0[3]; lg[4] += hv * r1[0]; lg[5] += hv * r1[1]; lg[6] += hv * r1[2]; lg[7] += hv * r1[3]; }
#pragma unroll
            for (int e = 0; e < 8; ++e) lg[e] = wave_sum(lg[e]);
            int e0 = 0; float v0 = lg[0];
#pragma unroll
            for (int e = 1; e < 8; ++e) if (lg[e] > v0) { v0 = lg[e]; e0 = e; }
            int e1 = -1; float v1 = -3.0e38f;
#pragma unroll
            for (int e = 0; e < 8; ++e) if (e != e0 && lg[e] > v1) { v1 = lg[e]; e1 = e; }
            const float ex = __expf(v1 - v0); const float w0 = 1.0f / (1.0f + ex), w1 = ex / (1.0f + ex);
            if (F.lane == 0) { toke[2 * m] = e0; toke[2 * m + 1] = e1; tokw[2 * m] = w0; tokw[2 * m + 1] = w1; }
#pragma unroll
            for (int e = 0; e < 8; ++e) c8[e] += (e0 == e ? 1u : 0u) + (e1 == e ? 1u : 0u);
        }
    }
    if (l == 1) {
        if (F.lane == 0) {
#pragma unroll
            for (int e = 0; e < 8; ++e) if (c8[e]) atomicAdd((unsigned*)&lcnt[e], c8[e]); }
        __syncthreads();
        if (F.tid < 8) { const unsigned v = lcnt[F.tid]; if (v) atomicAdd((unsigned*)(F.ws + WS_CTL) + CW_CNT + F.tid, v); }
        __syncthreads();
    }
}
__device__ __forceinline__ void ln2_phase(Frame& F, int l) {
    const int gw = F.vcu * NWAVES + F.wave, NGW = F.G * NWAVES;
    Vec8 ln; vec8_load(ln, inp(F, I_LN2G) + l * DM, inp(F, I_LN2B) + l * DM, F.lane);
    const int m0 = (int)((long)RT * gw / NGW), m1 = (int)((long)RT * (gw + 1) / NGW);
    for (int m = m0; m < m1; ++m) { float* xp = xcur_ptr(F, m); Row r; row_load(r, xp, F.lane); row_norm(r); row_affine_reg(r, ln, 0.0f); row_store(r, xp, F.lane); }
}

__device__ __forceinline__ void moe_convert_phase(Frame& F) {
    LAS float* scr = (LAS float*)(F.lds + 4096 + F.wave * 17408);
    const int gw = F.vcu * NWAVES + F.wave, NGW = F.G * NWAVES;
    unsigned char* w13 = F.ws + WS_MW13; unsigned char* w2 = F.ws + WS_MW2;
    constexpr int I1 = (1024 / 64) * (3584 / 64), I2 = (3584 / 64) * (1024 / 64);
    for (int it = gw; it < 8 * (2 * I1 + I2); it += NGW) {
        const int e = it / (2 * I1 + I2); int r = it - e * (2 * I1 + I2);
        if (r < I1) { conv_matrix_item_f8(inp(F, I_MW1) + (size_t)e * 1024 * 3584, 1024, 3584, w13 + (size_t)e * 7168 * 1024, 2, r, 32.f, scr, F.lane); continue; } r -= I1;
        if (r < I1) { conv_matrix_item_f8(inp(F, I_MW3) + (size_t)e * 1024 * 3584, 1024, 3584, w13 + (size_t)e * 7168 * 1024, 3, r, 32.f, scr, F.lane); continue; } r -= I1;
        conv_matrix_item_f8(inp(F, I_MW2) + (size_t)e * 3584 * 1024, 3584, 1024, w2 + (size_t)e * 1024 * 3584, 0, r, 128.f, scr, F.lane);
    }
}
__device__ __forceinline__ void moe_offsets(Frame& F, int (&off)[8], int& ntiles) {
    const unsigned* cnt = (const unsigned*)(F.ws + WS_CTL) + CW_CNT; int o = 0;
#pragma unroll
    for (int e = 0; e < 8; ++e) { off[e] = o; o += (int)((cnt[e] + 255u) & ~255u); }
    ntiles = o >> 8;
}
__device__ __forceinline__ void moe_setup_phase(Frame& F) {
    const int gw = F.vcu * NWAVES + F.wave, NGW = F.G * NWAVES, lane = F.lane;
    int off[8], ntiles; moe_offsets(F, off, ntiles);
    const int* toke = (const int*)(F.ws + WS_META + META_TOKE); int* tpos = (int*)(F.ws + WS_META + META_POS); int* tile_e = (int*)(F.ws + WS_META + META_TILE);
    unsigned* cur = (unsigned*)(F.ws + WS_CTL) + CW_CUR; unsigned char* srt = F.ws + WS_SORT;
    if (F.vcu == 0 && F.tid < 8) { const int e = F.tid; const int t0 = off[e] >> 8; const int t1 = (e == 7 ? ntiles : (off[e + 1] >> 8)); for (int t = t0; t < t1; ++t) tile_e[t] = e; if (e == 0) tile_e[511] = ntiles; }
    for (int base = gw; base < NX; base += 64 * NGW) {
        const int m = base + lane * NGW; const bool act = m < NX;
        const int e0 = act ? toke[2 * m] : -1, e1 = act ? toke[2 * m + 1] : -1;
        int p0 = 0, p1 = 0;
        const unsigned long long lt = (1ull << lane) - 1ull;
#pragma unroll
        for (int e = 0; e < 8; ++e) {
            const unsigned long long m0 = __ballot(e0 == e), m1 = __ballot(e1 == e);
            const int c = __popcll(m0) + __popcll(m1); int bs = 0;
            if (lane == 0 && c) bs = (int)atomicAdd(cur + e, (unsigned)c);
            bs = __builtin_amdgcn_readfirstlane(bs) + off[e];
            if (e0 == e) p0 = bs + __popcll(m0 & lt);
            if (e1 == e) p1 = bs + __popcll(m0) + __popcll(m1 & lt);
        }
        if (act) { tpos[2 * m] = p0; tpos[2 * m + 1] = p1; }
        const int nrows = (NX - base + NGW - 1) / NGW;
        for (int i = 0; i < 64 && i < nrows; ++i) {
            const int mi = base + i * NGW; const int q0 = __builtin_amdgcn_readlane(p0, i), q1 = __builtin_amdgcn_readlane(p1, i);
            Row r; row_load(r, F.out + (size_t)mi * DM, lane); row_norm(r); row_affine(r, mod_vec(F, 1, mi, 4), mod_vec(F, 1, mi, 3), lane, 1.0f);
            unsigned* d0 = (unsigned*)(srt + (size_t)q0 * DM) + lane; unsigned* d1 = (unsigned*)(srt + (size_t)q1 * DM) + lane;
#pragma unroll
            for (int j = 0; j < 4; ++j) { const unsigned w8 = pk4_fp8(r.v[j][0], r.v[j][1], r.v[j][2], r.v[j][3]); d0[64 * j] = w8; d1[64 * j] = w8; }
        }
    }
}
__device__ __forceinline__ void moe_combine_phase(Frame& F) {
    const int gw = F.vcu * NWAVES + F.wave, NGW = F.G * NWAVES, lane = F.lane;
    const float* tokw = (const float*)(F.ws + WS_META + META_TOKW); const int* tpos = (const int*)(F.ws + WS_META + META_POS); const bf16* Y = (const bf16*)(F.ws + WS_MOEY);
    const float* g = inp(F, I_LN2G) + DM; const float* b = inp(F, I_LN2B) + DM;
    for (int m = gw; m < NX; m += NGW) {
        const float w0 = tokw[2 * m], w1 = tokw[2 * m + 1]; const int p0 = tpos[2 * m], p1 = tpos[2 * m + 1];
        Row r; row_load(r, F.out + (size_t)m * DM, lane);
        const unsigned long long* y0 = (const unsigned long long*)(Y + (size_t)p0 * DM) + lane; const unsigned long long* y1 = (const unsigned long long*)(Y + (size_t)p1 * DM) + lane;
        const f32x4* g2 = (const f32x4*)mod_vec(F, 1, m, 5) + lane;
#pragma unroll
        for (int j = 0; j < 4; ++j) { const unsigned long long a = y0[64 * j], c = y1[64 * j];
            const f32x4 ya = (f32x4){bflo((unsigned)a), bfhi((unsigned)a), bflo((unsigned)(a >> 32)), bfhi((unsigned)(a >> 32))};
            const f32x4 yc = (f32x4){bflo((unsigned)c), bfhi((unsigned)c), bflo((unsigned)(c >> 32)), bfhi((unsigned)(c >> 32))};
            r.v[j] = r.v[j] * ALPHA_F + g2[64 * j] * (ya * w0 + yc * w1); }
        row_norm(r); row_affine(r, g, b, lane, 0.0f); row_store(r, F.out + (size_t)m * DM, lane);
    }
}

constexpr int HY_U_OFF = 0, HY_U_STRIDE = 4128, HY_K_OFF = 16 * HY_U_STRIDE, HY_K_STRIDE = 8208;
constexpr int HYC_U_STRIDE = 544, HYC_K_STRIDE = 1040;
static_assert(HY_K_OFF + 8 * HY_K_STRIDE + 64 <= MISC_OFF, "hyena LDS map");
__device__ __forceinline__ float hy_short4(const bf16* p, int tb, int L, float w0, float w1, float w2, float bs, f32x4& x) {
    const v2u pw = *(const v2u*)(p + tb); const float c0 = bflo(pw.x), c1 = bfhi(pw.x), c2 = bflo(pw.y), c3 = bfhi(pw.y);
    const float pm = tb > 0 ? bf2f(p[tb - 1]) : 0.f, pp = tb + 4 < L ? bf2f(p[tb + 4]) : 0.f;
    x[0] = bs + w0 * pm + w1 * c0 + w2 * c1; x[1] = bs + w0 * c0 + w1 * c1 + w2 * c2; x[2] = bs + w0 * c1 + w1 * c2 + w2 * c3; x[3] = bs + w0 * c2 + w1 * c3 + w2 * pp; return 0.f;
}
__device__ __forceinline__ void hy_short4u(const bf16* pi, bool first, bool last, float w0, float w1, float w2, float bs, f32x4& x) {
    const v2u pw = *(const v2u*)pi; const float c0 = bflo(pw.x), c1 = bfhi(pw.x), c2 = bflo(pw.y), c3 = bfhi(pw.y);
    float pm = bf2f(pi[-1]), pp = bf2f(pi[4]); pm = first ? 0.f : pm; pp = last ? 0.f : pp;
    x[0] = bs + w0 * pm + w1 * c0 + w2 * c1; x[1] = bs + w0 * c0 + w1 * c1 + w2 * c2; x[2] = bs + w0 * c1 + w1 * c2 + w2 * c3; x[3] = bs + w0 * c2 + w1 * c3 + w2 * pp;
}
template <int L, int USTR>
__device__ __forceinline__ void hy_fill_u(Frame& F, const bf16* phyT, int col, int rowb0, float w0, float w1, float w2, float bs) {
    const bf16* pc = phyT + (size_t)col * RT + rowb0;
    constexpr int NIT = 16 * L / 8 / 512 > 0 ? 16 * L / 8 / 512 : 1;
#pragma unroll 4
    for (int it = 0; it < NIT; ++it) { const int ch = F.tid + 512 * it; const int b = ch / (L / 8), tb = (ch - b * (L / 8)) * 8; const bf16* p = pc + (size_t)b * L + tb;
        const v4u cw = *(const v4u*)p; float pm = bf2f(p[-1]), pp = bf2f(p[8]); pm = tb == 0 ? 0.f : pm; pp = tb + 8 >= L ? 0.f : pp;
        const float c0 = bflo(cw.x), c1 = bfhi(cw.x), c2 = bflo(cw.y), c3 = bfhi(cw.y), c4 = bflo(cw.z), c5 = bfhi(cw.z), c6 = bflo(cw.w), c7 = bfhi(cw.w);
        v4u o; o.x = pk2(bs + w0 * pm + w1 * c0 + w2 * c1, bs + w0 * c0 + w1 * c1 + w2 * c2); o.y = pk2(bs + w0 * c1 + w1 * c2 + w2 * c3, bs + w0 * c2 + w1 * c3 + w2 * c4);
        o.z = pk2(bs + w0 * c3 + w1 * c4 + w2 * c5, bs + w0 * c4 + w1 * c5 + w2 * c6); o.w = pk2(bs + w0 * c5 + w1 * c6 + w2 * c7, bs + w0 * c6 + w1 * c7 + w2 * pp);
        *(LAS v4u*)(F.lds + HY_U_OFF + b * USTR + tb * 2) = o; }
}
template <int KLEN, int KSTR>
__device__ __forceinline__ void hy_fill_k(Frame& F, const bf16* kr) {
    const bf16* src = kr + (size_t)F.wave * KLEN + F.lane * 8;
#pragma unroll
    for (int i = 0; i < KLEN * 2 / 1024; ++i)
        __builtin_amdgcn_global_load_lds((const unsigned*)(src + i * 512), (LAS unsigned*)(F.lds + HY_K_OFF + F.wave * KSTR + i * 1024), 16, 0, 0);
    VM_WAIT();
}
__device__ __forceinline__ void hyena_unit(Frame& F, int l, int c, bool with_ctx) {
    const bf16* phyT = (const bf16*)(F.ws + WS_PHYT); bf16* z2 = (bf16*)(F.ws + WS_Z2);
    const bf16* KRL = (const bf16*)(F.ws + WS_KRL); const bf16* KRC = (const bf16*)(F.ws + WS_KRC);
    const float* sw = inp(F, I_HSW) + l * 3 * 1536; const float* sb = inp(F, I_HSB) + l * 1536;
    const int lane = F.lane, w = F.wave, r = lane & 15, q = lane >> 4, m = (-r) & 7;
    __syncthreads();
    { const int col = 1024 + c; hy_fill_u<LSEQ, HY_U_STRIDE>(F, phyT, col, 0, sw[col], sw[1536 + col], sw[3072 + col], sb[col]); }
    hy_fill_k<4096, HY_K_STRIDE>(F, KRL + (size_t)((0 * 512 + c) * 8) * 4096);
    __syncthreads();
#pragma unroll 1
    for (int o = 0; o < 2; ++o) {
        f32x4 acc[16];
#pragma unroll 1
        for (int rep_ = 0; rep_ < NREP(15); ++rep_) {
#pragma unroll
        for (int i = 0; i < 16; ++i) acc[i] = (f32x4){0.f, 0.f, 0.f, 0.f};
        const LAS unsigned char* pa = F.lds + HY_K_OFF + m * HY_K_STRIDE + 2 * (8 * q - r - m + 2048 - 256 * w);
        const LAS unsigned char* pb = F.lds + HY_U_OFF + r * HY_U_STRIDE + 16 * q;
        bf16x8 R[16];
#pragma unroll
        for (int i = 0; i < 16; ++i) R[i] = *(const LAS bf16x8*)(pa - 32 * i);
        bf16x8 bcur = *(const LAS bf16x8*)pb;
#pragma unroll 1
        for (int kg = 0; kg < 8; ++kg) {
#pragma unroll
            for (int kk = 0; kk < 8; ++kk) {
                const bf16x8 bnext = *(const LAS bf16x8*)(pb + 64 * (kk + 1));
                const bf16x8 n0 = *(const LAS bf16x8*)(pa + 64 * (kk + 1)), n1 = *(const LAS bf16x8*)(pa + 64 * (kk + 1) - 32);
#pragma unroll
                for (int i = 0; i < 16; ++i) acc[i] = __builtin_amdgcn_mfma_f32_16x16x32_bf16(R[(i - 2 * kk) & 15], bcur, acc[i], 0, 0, 0);
                R[(-2 * (kk + 1)) & 15] = n0; R[(1 - 2 * (kk + 1)) & 15] = n1; bcur = bnext;
                __builtin_amdgcn_sched_barrier(0);
            }
            pa += 512; pb += 512;
        }
        }
        const int col = o * 512 + c; const float w0 = sw[col], w1 = sw[1536 + col], w2 = sw[3072 + col], bs = sb[col];
        int tb0 = 256 * w + 4 * q; asm volatile("" : "+v"(tb0));
        const bf16* p = phyT + (size_t)col * RT + (size_t)r * LSEQ + tb0;
#pragma unroll
        for (int i = 0; i < 16; ++i) { f32x4 x; hy_short4u(p + 16 * i, tb0 + 16 * i == 0, tb0 + 16 * i + 4 >= LSEQ, w0, w1, w2, bs, x); acc[i] = acc[i] * x; }
        if (o == 0) {
            __syncthreads();
#pragma unroll
            for (int i = 0; i < 16; ++i) { v2u zw; zw.x = pk2(acc[i][0], acc[i][1]); zw.y = pk2(acc[i][2], acc[i][3]); *(LAS v2u*)(F.lds + HY_U_OFF + r * HY_U_STRIDE + (tb0 + 16 * i) * 2) = zw; }
            hy_fill_k<4096, HY_K_STRIDE>(F, KRL + (size_t)((1 * 512 + c) * 8) * 4096);
            __syncthreads();
        } else {
#pragma unroll
            for (int i = 0; i < 16; ++i) { bf16* zp = z2 + (size_t)(r * LSEQ + tb0 + 16 * i) * 512 + c; asm volatile("" : "+v"(zp));
#pragma unroll
                for (int e = 0; e < 4; ++e) zp[e * 512] = (bf16)f2bf(acc[i][e]); }
        }
    }
    if (!with_ctx) return;
    __syncthreads();
    { const int col = 1024 + c; hy_fill_u<LCTX, HYC_U_STRIDE>(F, phyT, col, NX, sw[col], sw[1536 + col], sw[3072 + col], sb[col]); }
    hy_fill_k<512, HYC_K_STRIDE>(F, KRC + (size_t)((0 * 512 + c) * 8) * 512);
    __syncthreads();
#pragma unroll 1
    for (int o = 0; o < 2; ++o) {
        f32x4 acc[2];
        acc[0] = (f32x4){0.f, 0.f, 0.f, 0.f}; acc[1] = acc[0];
        const LAS unsigned char* pa = F.lds + HY_K_OFF + m * HYC_K_STRIDE + 2 * (8 * q - r - m + 256 - 32 * w);
        const LAS unsigned char* pb = F.lds + HY_U_OFF + r * HYC_U_STRIDE + 16 * q;
#pragma unroll
        for (int k = 0; k < 8; ++k) { const bf16x8 bfr = *(const LAS bf16x8*)(pb + 64 * k);
#pragma unroll
            for (int i = 0; i < 2; ++i) acc[i] = __builtin_amdgcn_mfma_f32_16x16x32_bf16(*(const LAS bf16x8*)(pa + 64 * k - 32 * i), bfr, acc[i], 0, 0, 0); }
        const int col = o * 512 + c; const float w0 = sw[col], w1 = sw[1536 + col], w2 = sw[3072 + col], bs = sb[col];
        int tb0 = 32 * w + 4 * q; asm volatile("" : "+v"(tb0));
        const bf16* p = phyT + (size_t)col * RT + NX + (size_t)r * LCTX + tb0;
#pragma unroll
        for (int i = 0; i < 2; ++i) { f32x4 x; hy_short4u(p + 16 * i, tb0 + 16 * i == 0, tb0 + 16 * i + 4 >= LCTX, w0, w1, w2, bs, x); acc[i] = acc[i] * x; }
        if (o == 0) {
            __syncthreads();
#pragma unroll
            for (int i = 0; i < 2; ++i) { v2u zw; zw.x = pk2(acc[i][0], acc[i][1]); zw.y = pk2(acc[i][2], acc[i][3]); *(LAS v2u*)(F.lds + HY_U_OFF + r * HYC_U_STRIDE + (tb0 + 16 * i) * 2) = zw; }
            hy_fill_k<512, HYC_K_STRIDE>(F, KRC + (size_t)((1 * 512 + c) * 8) * 512);
            __syncthreads();
        } else {
#pragma unroll
            for (int i = 0; i < 2; ++i)
#pragma unroll
                for (int e = 0; e < 4; ++e) z2[(size_t)(NX + r * LCTX + tb0 + 16 * i + e) * 512 + c] = (bf16)f2bf(acc[i][e]);
        }
    }
}

__device__ __forceinline__ void cf_unit(Frame& F, int l, int seqrow, int seqlen, int t0) {
    LAS bf16* U = (LAS bf16*)F.lds;
    LAS float* O = (LAS float*)(F.lds + 98304);
    const bf16* ucf = (const bf16*)(F.ws + WS_UCF); bf16* out = (bf16*)(F.ws + WS_UCF2);
    __syncthreads();
    for (int pc = F.tid; pc < 94 * 64; pc += 512) { const int i = pc >> 6, ch = pc & 63; const int t = t0 - 15 + i;
        v4u w = (v4u){0u, 0u, 0u, 0u}; if (t >= 0 && t < seqlen) w = *(const v4u*)(ucf + (size_t)(seqrow + t) * 512 + ch * 8);
        *(LAS v4u*)(U + i * 512 + ch * 8) = w; }
    const int c = F.tid;
    float w[31];
#pragma unroll
    for (int k = 0; k < 31; ++k) w[k] = inp(F, I_CFW)[(size_t)l * 31 * 512 + k * 512 + c];
    const float bias = inp(F, I_CFB)[l * 512 + c];
    const f32x4 g0 = *((const f32x4*)(inp(F, I_CFG) + l * 512) + F.lane), g1 = *((const f32x4*)(inp(F, I_CFG) + l * 512) + 64 + F.lane);
    const f32x4 b0 = *((const f32x4*)(inp(F, I_CFLB) + l * 512) + F.lane), b1 = *((const f32x4*)(inp(F, I_CFLB) + l * 512) + 64 + F.lane);
    __syncthreads();
#pragma unroll 1
    for (int r = 0; r < 4; ++r) {
        float v[16];
#pragma unroll
        for (int t = 0; t < 16; ++t) v[t] = bias;
        const LAS bf16* Ur = U + (16 * r) * 512 + c;
#pragma unroll
        for (int ii = 0; ii < 46; ++ii) { const float x = bf2f(Ur[ii * 512]);
#pragma unroll
            for (int t = 0; t < 16; ++t) { if (ii - t >= 0 && ii - t <= 30) v[t] += w[ii - t] * x; } }
#pragma unroll
        for (int t = 0; t < 16; ++t) O[t * 512 + c] = v[t];
        __syncthreads();
#pragma unroll
        for (int q = 0; q < 2; ++q) {
            const int tt = 2 * F.wave + q;
            f32x4 x0 = *((const LAS f32x4*)(O + tt * 512) + F.lane), x1 = *((const LAS f32x4*)(O + tt * 512) + 64 + F.lane);
            const float mean = wave_sum((x0[0] + x0[1]) + (x0[2] + x0[3]) + (x1[0] + x1[1]) + (x1[2] + x1[3])) * (1.f / 512.f);
            x0 = x0 - mean; x1 = x1 - mean;
            const float var = wave_sum((x0[0] * x0[0] + x0[1] * x0[1]) + (x0[2] * x0[2] + x0[3] * x0[3]) + (x1[0] * x1[0] + x1[1] * x1[1]) + (x1[2] * x1[2] + x1[3] * x1[3])) * (1.f / 512.f);
            const float rstd = 1.f / sqrtf(var + LN_EPS);
            f32x4 y0 = x0 * rstd * g0 + b0, y1 = x1 * rstd * g1 + b1;
#pragma unroll
            for (int j = 0; j < 4; ++j) { y0[j] = siluf_(y0[j]); y1[j] = siluf_(y1[j]); }
            bf16* orow = out + (size_t)(seqrow + t0 + 16 * r + tt) * 512;
            v2u o0, o1; o0.x = pk2(y0[0], y0[1]); o0.y = pk2(y0[2], y0[3]); o1.x = pk2(y1[0], y1[1]); o1.y = pk2(y1[2], y1[3]);
            *((v2u*)orow + F.lane) = o0; *((v2u*)orow + 64 + F.lane) = o1;
        }
        __syncthreads();
    }
}

__device__ __forceinline__ void s5_unit(Frame& F, int l, int b, int gp) {
    const int lane = F.lane, w = F.wave;
    bf16* ps5 = (bf16*)(F.ws + WS_PS5); bf16* ydir = (bf16*)(F.ws + WS_YDIR);
    __syncthreads();
#pragma unroll 1
    for (int rep_ = 0; rep_ < NREP(14); ++rep_)
    {
        const int gd = w & 3, role = w >> 2;
        const int g = 2 * gp + (gd >> 1), dir = gd & 1;
        const int r = lane & 15, q = lane >> 4;
        LAS unsigned char* wl = F.lds + gd * 32768;
        LAS unsigned char* uS0 = wl;
        LAS float* BuS0 = (LAS float*)(wl + 2560);
        LAS unsigned char* stS0 = wl + 2560 + 2 * 10240;
        constexpr int NCH = (LCTX + LSEQ) / 16;
        const float* P = (const float*)(F.ws + WS_S5P) + (size_t)((dir * 32 + g) * 64) * 36;
        float abr = 0.f, abi = 0.f; f32x2 s2 = (f32x2){0.f, 0.f}, Aa = s2, Bn = s2;
        bf16x8 Bf[8], Cf[4];
        const int ti = lane >> 2, cq = lane & 3;
        auto urow = [&](int k) -> size_t { const bool isc = k < LCTX / 16; const int kk = isc ? k : k - LCTX / 16; const int Ls = isc ? LCTX : LSEQ; const int rowb = isc ? NX + b * LCTX : b * LSEQ;
            const int st = kk * 16 + ti; const int t = dir ? (Ls - 1 - st) : st; return (size_t)(rowb + t) * 512 + g * 16 + 4 * cq; };
        v2u unext = (v2u){0u, 0u};
        if (role == 0) { abr = P[lane * 36]; abi = P[lane * 36 + 1]; Aa = (f32x2){abr, abr}; Bn = (f32x2){-abi, abi}; }
        else {
#pragma unroll
            for (int blk = 0; blk < 8; ++blk) { const int pp = 16 * blk + r; const float* src = P + (size_t)(pp & 63) * 36 + (pp < 64 ? 2 : 18) + 8 * (q & 1);
                v4u t4; t4.x = pk2(src[0], src[1]); t4.y = pk2(src[2], src[3]); t4.z = pk2(src[4], src[5]); t4.w = pk2(src[6], src[7]);
                if (q >= 2) t4 = (v4u){0u, 0u, 0u, 0u};
                Bf[blk] = __builtin_bit_cast(bf16x8, t4); }
            const float* cre = inp(F, I_SCRE) + (size_t)(((l * 2 + dir) * 32 + g) * 16) * 64; const float* cim = inp(F, I_SCIM) + (size_t)(((l * 2 + dir) * 32 + g) * 16) * 64;
#pragma unroll
            for (int ks = 0; ks < 4; ++ks) { const int p0 = 16 * ks + 4 * q; const f32x4 a = *(const f32x4*)(cre + r * 64 + p0), c4 = *(const f32x4*)(cim + r * 64 + p0);
                v4u t4; t4.x = pk2(a[0], -c4[0]); t4.y = pk2(a[1], -c4[1]); t4.z = pk2(a[2], -c4[2]); t4.w = pk2(a[3], -c4[3]);
                Cf[ks] = __builtin_bit_cast(bf16x8, t4); }
            for (int e = lane; e < 2 * 16 * 20; e += 64) ((LAS unsigned*)uS0)[e] = 0u;
            LDS_WAIT();
            *(LAS v2u*)(uS0 + ti * 80 + 8 * cq) = *(const v2u*)(ps5 + urow(0));
            unext = *(const v2u*)(ps5 + urow(1));
        }
        LDS_WAIT(); __builtin_amdgcn_s_barrier(); asm volatile("" ::: "memory");
#pragma unroll 1
        for (int k = 0; k < NCH + 2; ++k) {
            const int p0 = k & 1, p1 = p0 ^ 1;
            if (role == 1) {
                bf16x8 ua, sf[4];
                if (k < NCH) ua = *(const LAS bf16x8*)(uS0 + p0 * 1280 + r * 80 + 16 * q);
                if (k >= 2) {
#pragma unroll
                    for (int ks = 0; ks < 4; ++ks) sf[ks] = *(const LAS bf16x8*)(stS0 + p0 * 4352 + r * 272 + 64 * ks + 16 * q); }
                if (k + 1 < NCH) { *(LAS v2u*)(uS0 + p1 * 1280 + ti * 80 + 8 * cq) = unext; if (k + 2 < NCH) unext = *(const v2u*)(ps5 + urow(k + 2)); }
                if (k < NCH) {
#pragma unroll
                    for (int blk = 0; blk < 8; ++blk) { const f32x4 d = __builtin_amdgcn_mfma_f32_16x16x32_bf16(ua, Bf[blk], (f32x4){0.f, 0.f, 0.f, 0.f}, 0, 0, 0);
                        *(LAS f32x4*)(BuS0 + p0 * 2560 + (16 * blk + r) * 20 + 4 * q) = d; }
                }
                if (k >= 2) {
                    f32x4 y0 = __builtin_amdgcn_mfma_f32_16x16x32_bf16(sf[0], Cf[0], (f32x4){0.f, 0.f, 0.f, 0.f}, 0, 0, 0), y1 = __builtin_amdgcn_mfma_f32_16x16x32_bf16(sf[1], Cf[1], (f32x4){0.f, 0.f, 0.f, 0.f}, 0, 0, 0);
                    y0 = __builtin_amdgcn_mfma_f32_16x16x32_bf16(sf[2], Cf[2], y0, 0, 0, 0); y1 = __builtin_amdgcn_mfma_f32_16x16x32_bf16(sf[3], Cf[3], y1, 0, 0, 0);
                    const f32x4 y = y0 + y1; const int kc = k - 2;
                    const bool isc = kc < LCTX / 16; const int kk = isc ? kc : kc - LCTX / 16; const int Ls = isc ? LCTX : LSEQ; const int rowb = isc ? NX + b * LCTX : b * LSEQ;
#pragma unroll
                    for (int i = 0; i < 4; ++i) { const int st = kk * 16 + 4 * q + i; const int t = dir ? (Ls - 1 - st) : st;
                        ydir[(size_t)dir * RT * 512 + (size_t)(rowb + t) * 512 + g * 16 + r] = (bf16)f2bf(y[i]); } }
            } else if (k >= 1 && k <= NCH) {
                f32x4 bre[4], bim[4];
#pragma unroll
                for (int j = 0; j < 4; ++j) { bre[j] = *(const LAS f32x4*)(BuS0 + p1 * 2560 + lane * 20 + 4 * j); bim[j] = *(const LAS f32x4*)(BuS0 + p1 * 2560 + (64 + lane) * 20 + 4 * j); }
#pragma unroll
                for (int i = 0; i < 16; ++i) {
                    const f32x2 b2 = (f32x2){bre[i >> 2][i & 3], bim[i >> 2][i & 3]};
                    const float nr = abr * s2[0] - abi * s2[1] + b2[0], ni = abr * s2[1] + abi * s2[0] + b2[1]; s2 = (f32x2){nr, ni};
                    *(LAS unsigned*)(stS0 + p1 * 4352 + i * 272 + 4 * lane) = pk2(s2[0], s2[1]); }
            }
            LDS_WAIT(); __builtin_amdgcn_s_barrier(); asm volatile("" ::: "memory");
        }
    }
    VM_WAIT();
    __syncthreads();
    const float* dsk = inp(F, I_SD) + l * 512 + gp * 32;
    for (int e = F.tid; e < (LCTX + LSEQ) * 4; e += 512) {
        const int rr = e >> 2, pc = e & 3; const int row = rr < LSEQ ? b * LSEQ + rr : NX + b * LCTX + (rr - LSEQ);
        const size_t off = (size_t)row * 512 + gp * 32 + pc * 8;
        const v4u uw = *(const v4u*)(ps5 + off), fw = *(const v4u*)(ydir + off), bw = *(const v4u*)(ydir + (size_t)RT * 512 + off);
        f32x4 u0, u1, f0, f1, b0, b1; unpack8(uw, u0, u1); unpack8(fw, f0, f1); unpack8(bw, b0, b1);
        const f32x4 d0 = *(const f32x4*)(dsk + pc * 8), d1 = *(const f32x4*)(dsk + pc * 8 + 4);
        f32x4 o0, o1;
#pragma unroll
        for (int j = 0; j < 4; ++j) { o0[j] = gelu_tanh(f0[j] + b0[j] + d0[j] * u0[j]); o1[j] = gelu_tanh(f1[j] + b1[j] + d1[j] * u1[j]); }
        *(v4u*)(ps5 + off) = pack8(o0, o1);
    }
}

__device__ __forceinline__ Frame make_frame(const Args& args, LAS unsigned char* lds, int wave_s);
__device__ __forceinline__ void mixers_phase(const Args& args, LAS unsigned char* lds, int wave_s, int l) {
#ifndef MIXMASK
#define MIXMASK 7
#endif
    if (MIXMASK & 1) { Frame F = make_frame(args, lds, wave_s);
#pragma unroll 1
        for (int u = F.vcu; u < NB * 16; u += F.G) s5_unit(F, l, u >> 4, u & 15); }
    if (MIXMASK & 2) { Frame F = make_frame(args, lds, wave_s);
#pragma unroll 1
        for (int u = F.vcu; u < 512; u += F.G) hyena_unit(F, l, u, l == 0);
        if (NREP(10) == 2) {
#pragma unroll 1
            for (int u = F.vcu; u < 512; u += F.G) hyena_unit(F, l, u, l == 0); } }
    if (MIXMASK & 4) { Frame F = make_frame(args, lds, wave_s);
        const int ncf = l == 0 ? NB * 32 + NB * 4 : NB * 32;
#pragma unroll 1
        for (int u = F.vcu; u < ncf; u += F.G) { if (u < NB * 32) cf_unit(F, l, u * 64, 64, 0); else { const int q = u - NB * 32; cf_unit(F, l, NX + (q >> 2) * LCTX, LCTX, (q & 3) * 64); } } }
    __syncthreads();
}

constexpr int PH_P0A = 0, PH_P0B = 1, PH_L0 = 2, PH_L1 = 12, N_PHASES = 27;
__device__ __forceinline__ Frame make_frame(const Args& args, LAS unsigned char* lds, int wave_s) {
    unsigned z0 = 0u; asm volatile("" : "+v"(z0));
    Frame F; int t = wave_s * 64 + (int)__builtin_amdgcn_mbcnt_hi(~0u, __builtin_amdgcn_mbcnt_lo(~0u, z0)); asm volatile("" : "+v"(t));
    unsigned char* ws = args.ws; float* out = args.out;
    F.lds = lds; F.tid = t; F.lane = t & 63; F.wave = wave_s;
    int G = gridDim.x, bx = blockIdx.x; asm volatile("" : "+s"(G), "+s"(bx));
    F.G = G; F.vcu = (G % 8 == 0) ? (bx % 8) * (G / 8) + bx / 8 : bx;
    const float* const* inp = args.in;
    F.in = inp; F.out = out; F.ws = ws; return F;
}
__global__ void __launch_bounds__(NWAVES * 64, 2) mega_fwd(Args args) {
    extern __shared__ __attribute__((aligned(16))) unsigned char lds_raw[];
    LAS unsigned char* const lds = (LAS unsigned char*)lds_raw;
    volatile LAS unsigned* MISC = (volatile LAS unsigned*)(lds + MISC_OFF);
    for (int u = threadIdx.x; u < (LDS_BYTES - MISC_OFF) / 4; u += NWAVES * 64) ((LAS unsigned*)(lds + MISC_OFF))[u] = 0u;
    int wave_s = __builtin_amdgcn_readfirstlane((int)threadIdx.x >> 6); asm volatile("" : "+s"(wave_s));
    __syncthreads();
    const int lo = MK_PER_PHASE_LAUNCH ? args.ph_lo : 0, hi = MK_PER_PHASE_LAUNCH ? args.ph_hi : N_PHASES;
    XcdBarrier bar; bar.bar = (unsigned*)(args.ws + WS_CTL) + CW_BAR; bar.x = 0; bar.st = nullptr;
    if (hi - lo > 1) bar = xcd_barrier_post((unsigned*)(args.ws + WS_CTL) + CW_BAR, MISC + 8);
#ifndef PHMASK
#define PHMASK 0xffffffffu
#endif
#define IN(k) (lo <= (k) && (k) < hi)
#define PM(b) ((PHMASK >> (b)) & 1u)
#define SEAM(k) do { if (IN(k) && IN((k) + 1)) xcd_barrier(bar, wave_s); } while (0)
#define FRAME() Frame F = make_frame(args, lds, wave_s); const char* ws = (const char*)F.ws; const int c = F.G == (int)gridDim.x ? (int)blockIdx.x : 0; (void)ws; (void)c

    if (PM(0) && IN(PH_P0A)) { FRAME(); REPEAT(NREP(12), p0a_prologue(F)); } SEAM(PH_P0A);
    if (PM(1) && IN(PH_P0B)) { FRAME(); p0b_mods(F); } SEAM(PH_P0B);

#pragma unroll 1
    for (int l = 0; l < 2; ++l) {
        const int pb = l == 0 ? PH_L0 : PH_L1;
        const int nMl = l == 0 ? RT / 256 : NX / 256;
        if (PM(2) && IN(pb + 0)) { { FRAME(); REPEAT(NREP(8), lnmod_phase(F, l)); } { FRAME(); h2table_phase(F, l); } { FRAME(); s5params_phase(F, l); } } SEAM(pb + 0);
        if (PM(3) && IN(pb + 1)) { { FRAME(); REPEAT(NREP(9), filter_expand_phase(F, l)); }
            FRAME();
            SchedPlain S; S.R.init(nMl, 12, F.G, c); S.A = ws + WS_HX; S.B = ws + WS_WIN + (size_t)l * 6144 * 1024 * 2; S.tsA = 256 * 1024 * 2; S.tsB = 256 * 1024 * 2;
            S.xM = l == 0 ? 0 : NCX / 256; S.xN0 = 10; S.xNn = 2;
            EpiInproj E{(bf16*)(F.ws + WS_PHYT), (bf16*)(F.ws + WS_UCF), (bf16*)(F.ws + WS_PS5)};
            REPEAT(NREP(0), pg8::gemm_phase<EpiInproj, SchedPlain>(F.lds, F.tid, 2048, S, E));
        } SEAM(pb + 1);
        if (PM(4) && IN(pb + 2)) { mixers_phase(args, lds, wave_s, l); } SEAM(pb + 2);
        if (PM(5) && IN(pb + 3)) {
            { FRAME(); SchedPlain S; S.R.init(nMl, 12, F.G, c); S.A = ws + WS_HX; S.B = ws + WS_WIN + ((size_t)l * 6144 + 3072) * 1024 * 2; S.tsA = 256 * 1024 * 2; S.tsB = 256 * 1024 * 2; S.xM = 0; S.xN0 = 0; S.xNn = 1;
              EpiGates E{(bf16*)(F.ws + WS_G)}; REPEAT(NREP(1), pg8::gemm_phase<EpiGates, SchedPlain>(F.lds, F.tid, 2048, S, E)); }
#ifndef DBG_SKIP_GLU
            { FRAME(); SchedPlain S; S.R.init(nMl, 2, F.G, (c + F.G / 4) % F.G); S.A = ws + WS_PS5; S.B = ws + WS_WGLU + (size_t)l * 512 * 512 * 2; S.tsA = 256 * 512 * 2; S.tsB = 256 * 512 * 2; S.xM = 0; S.xN0 = 0; S.xNn = 1;
              EpiGlu E{(const bf16*)(F.ws + WS_PS5), (bf16*)(F.ws + WS_S5Y), inp(F, I_SBGLU) + l * 512}; REPEAT(NREP(2), pg8::gemm_phase<EpiGlu, SchedPlain>(F.lds, F.tid, 1024, S, E)); }
#endif
        } SEAM(pb + 3);
        if (PM(6) && IN(pb + 4)) { FRAME();
            SchedMerge S; S.R.init(nMl, 4, F.G, c); S.A = ws + WS_Z2; S.sA = WS_UCF2 - WS_Z2; S.B = ws + WS_WOUTS + (size_t)(l * 3) * 1024 * 512 * 2; S.sB = (size_t)1024 * 512 * 2;
            S.tsA = 256 * 512 * 2; S.tsB = 256 * 512 * 2;
            EpiMerge E{(const bf16*)(F.ws + WS_G), (bf16*)(F.ws + WS_HX)};
            REPEAT(NREP(3), pg8::gemm_phase<EpiMerge, SchedMerge>(F.lds, F.tid, 1024, S, E));
        } SEAM(pb + 4);
        if (PM(7) && IN(pb + 5)) { FRAME();
            SchedPlain S; S.R.init(nMl, 4, F.G, c); S.A = ws + WS_HX; S.B = ws + WS_WO + (size_t)l * 1024 * 1024 * 2; S.tsA = 256 * 1024 * 2; S.tsB = 256 * 1024 * 2; S.xM = 0; S.xN0 = 0; S.xNn = 1;
            EpiRes E{l == 0 ? inp(F, I_X) : F.out, l == 0 ? inp(F, I_CTX) : (const float*)(F.ws + WS_XC), F.out, (float*)(F.ws + WS_XC), (const float*)(F.ws + WS_MODS) + (size_t)l * 17 * INC + 2 * 1024, 1.0f};
            REPEAT(((l == 0) ? NREP(4) : 1), pg8::gemm_phase<EpiRes, SchedPlain>(F.lds, F.tid, 2048, S, E));
        } SEAM(pb + 5);
        if (PM(8) && IN(pb + 6)) { { FRAME(); ln1_phase(F, l); } if (l == 1) { FRAME(); REPEAT(NREP(13), moe_convert_phase(F)); } } SEAM(pb + 6);
        if (l == 0) {
            if (PM(9) && IN(pb + 7)) { FRAME();
                SchedPlain S; S.R.init(RT / 256, 22, F.G, c); S.A = ws + WS_HX; S.B = ws + WS_W13; S.tsA = 256 * 1024; S.tsB = 256 * 1024; S.xM = 0; S.xN0 = 0; S.xNn = 1;
                EpiSwigluF8 E{F.ws + WS_G, DFF, 0.03125f}; REPEAT(NREP(5), pg8::gemm_phase<EpiSwigluF8, SchedPlain, true>(F.lds, F.tid, 1024, S, E));
            } SEAM(pb + 7);
            if (PM(10) && IN(pb + 8)) { FRAME();
                SchedPlain S; S.R.init(RT / 256, 4, F.G, c); S.A = ws + WS_G; S.B = ws + WS_W2; S.tsA = (size_t)256 * DFF; S.tsB = (size_t)256 * DFF; S.xM = 0; S.xN0 = 0; S.xNn = 1;
                EpiRes E{F.out, (const float*)(F.ws + WS_XC), F.out, (float*)(F.ws + WS_XC), (const float*)(F.ws + WS_MODS) + 5 * 1024, 0.0078125f};
                pg8::gemm_phase<EpiRes, SchedPlain, true>(F.lds, F.tid, DFF, S, E);
            } SEAM(pb + 8);
            if (PM(11) && IN(pb + 9)) { FRAME(); ln2_phase(F, l); } SEAM(pb + 9);
        } else {
            if (PM(15) && IN(pb + 7)) { FRAME(); moe_setup_phase(F); } SEAM(pb + 7);
#pragma unroll 1
            for (int st = 0; st < 6; ++st) {
                if (PM(13) && IN(pb + 8 + st) && st >= 1) { FRAME(); const int* tile_e = (const int*)(F.ws + WS_META + META_TILE); const int ch = st - 1;
                    const int ntiles = tile_e[511]; int nmc = ntiles - 64 * ch; nmc = nmc < 0 ? 0 : (nmc > 64 ? 64 : nmc);
                    SchedMoe S; S.R.init(nmc, 4, F.G, c); S.A = ws + WS_HID + (size_t)(ch & 1) * HID_BUF; S.B = ws + WS_MW2; S.tsA = (size_t)256 * DEX; S.tsB = (size_t)256 * DEX; S.esB = (size_t)1024 * DEX; S.tile_e = tile_e; S.tile0 = 64 * ch; S.a_global = false;
                    EpiMoeDown E{(bf16*)(F.ws + WS_MOEY), 0.0078125f}; REPEAT(NREP(7), pg8::gemm_phase<EpiMoeDown, SchedMoe, true>(F.lds, F.tid, DEX, S, E));
                }
                if (PM(12) && IN(pb + 8 + st) && st <= 4) { FRAME(); const int* tile_e = (const int*)(F.ws + WS_META + META_TILE); const int ch = st;
                    const int ntiles = tile_e[511]; int nmc = ntiles - 64 * ch; nmc = nmc < 0 ? 0 : (nmc > 64 ? 64 : nmc);
                    SchedMoe S; S.R.init(nmc, 28, F.G, c); S.A = ws + WS_SORT; S.B = ws + WS_MW13; S.tsA = 256 * 1024; S.tsB = 256 * 1024; S.esB = (size_t)7168 * 1024; S.tile_e = tile_e; S.tile0 = 64 * ch; S.a_global = true;
                    EpiSwigluF8 E{F.ws + WS_HID + (size_t)(ch & 1) * HID_BUF, DEX, 0.03125f}; REPEAT(NREP(6), pg8::gemm_phase<EpiSwigluF8, SchedMoe, true>(F.lds, F.tid, 1024, S, E));
                }
                SEAM(pb + 8 + st);
            }
            if (PM(14) && IN(pb + 14)) { FRAME(); moe_combine_phase(F); }
        }
    }
#undef IN
#undef SEAM
#undef FRAME
}


#ifdef DBG_DUMP
__global__ void dbg_dump(const unsigned char* ws, float* out) {
    const size_t NE = (size_t)RT * 512; const bf16* a = (const bf16*)(ws + WS_PS5); const bf16* b = (const bf16*)(ws + WS_Z2); const bf16* c = (const bf16*)(ws + WS_UCF2);
    for (size_t i = (size_t)blockIdx.x * blockDim.x + threadIdx.x; i < (size_t)NX * DM; i += (size_t)gridDim.x * blockDim.x) {
        const size_t j = i % NE; const int k = (int)(i / NE);
        float v;
        if (DBG_DUMP == 8) v = i < (size_t)26 * 1024 * 1024 ? bf2f(((const bf16*)(ws + WS_WIN))[i]) : 0.f;
        else if (DBG_DUMP == 7) v = k == 0 ? bf2f(a[j]) : bf2f(((const bf16*)(ws + WS_UCF))[j]);
        else if (DBG_DUMP == 4) v = bf2f(((const bf16*)(ws + WS_HX))[i]);
        else if (DBG_DUMP == 5) v = bf2f(((const bf16*)(ws + WS_G))[i]);
        else if (DBG_DUMP == 6) v = bf2f(((const bf16*)(ws + WS_S5Y))[i % NE]);
        else if (DBG_DUMP == 1) v = k == 0 ? bf2f(a[j]) : bf2f(b[j]);
        else if (DBG_DUMP == 2) v = k == 0 ? bf2f(b[j]) : bf2f(c[j]);
        else v = k == 0 ? bf2f(c[j]) : bf2f(a[j]);
        out[i] = v;
    }
}
#endif
extern "C" void kernel_launch(void* const* d_in, const int* in_sizes, int n_in, void* d_out, int out_size, void* d_ws, size_t ws_size, hipStream_t stream) {
    static int grid = 0;
    if (grid == 0) {
        if (n_in != N_IN || out_size != NX * DM || ws_size < WS_END2) { fprintf(stderr, "kernel_launch: unexpected shapes (n_in %d, out %d, ws %zu)\n", n_in, out_size, ws_size); grid = -1; return; }
        int dev = 0, cus = 0, per_cu = 0;
        if (hipGetDevice(&dev) != hipSuccess || hipDeviceGetAttribute(&cus, hipDeviceAttributeMultiprocessorCount, dev) != hipSuccess) { grid = -1; return; }
        if (hipFuncSetAttribute((const void*)mega_fwd, hipFuncAttributeMaxDynamicSharedMemorySize, LDS_BYTES) != hipSuccess) { fprintf(stderr, "kernel_launch: hipFuncSetAttribute failed\n"); grid = -1; return; }
        if (hipOccupancyMaxActiveBlocksPerMultiprocessor(&per_cu, (const void*)mega_fwd, NWAVES * 64, LDS_BYTES) != hipSuccess || per_cu < 1) fprintf(stderr, "kernel_launch: occupancy query reports %d\n", per_cu);
        (void)hipGetLastError();
        grid = cus;
    }
    if (grid < 0) return;
    (void)hipMemsetAsync((char*)d_ws + WS_CTL, 0, CTL_ZERO_BYTES, stream);
    Args a{};
    for (int i = 0; i < N_IN; ++i) a.in[i] = (const float*)d_in[i];
    a.out = (float*)d_out; a.ws = (unsigned char*)d_ws;
#if MK_PER_PHASE_LAUNCH
    for (int p = 0; p < DBG_NPH; ++p) { a.ph_lo = p; a.ph_hi = p + 1; hipLaunchKernelGGL(mega_fwd, dim3(grid), dim3(NWAVES * 64), LDS_BYTES, stream, a); }
#ifdef DBG_DUMP
    hipLaunchKernelGGL(dbg_dump, dim3(2048), dim3(256), 0, stream, (const unsigned char*)d_ws, (float*)d_out);
#endif
#else
    a.ph_lo = 0; a.ph_hi = N_PHASES; hipLaunchKernelGGL(mega_fwd, dim3(grid), dim3(NWAVES * 64), LDS_BYTES, stream, a);
#endif
}
```

```cpp
#include <hip/hip_runtime.h>
#include <cstdio>
#include <cstdint>

#ifndef DBG_REP
#define DBG_REP 0
#endif
#define NREP(bit) (((DBG_REP >> (bit)) & 1) ? 2 : 1)
#define REPEAT(n, ...) do { __VA_ARGS__; if ((n) == 2) { __VA_ARGS__; } } while (0)
#ifndef DBG_NPH
#define DBG_NPH N_PHASES
#endif
#ifndef MK_PER_PHASE_LAUNCH
#define MK_PER_PHASE_LAUNCH 0
#endif

#define GAS __attribute__((address_space(1)))
#define LAS __attribute__((address_space(3)))
typedef unsigned short bf16;
typedef unsigned v4u __attribute__((ext_vector_type(4)));
typedef unsigned v2u __attribute__((ext_vector_type(2)));
typedef float f32x4 __attribute__((ext_vector_type(4)));
typedef float f32x2 __attribute__((ext_vector_type(2)));
typedef short bf16x8 __attribute__((ext_vector_type(8)));

constexpr int NB = 16, LSEQ = 2048, LCTX = 256, DM = 1024;
constexpr int NX = NB * LSEQ;
constexpr int NCX = NB * LCTX;
constexpr int RT = NX + NCX;
constexpr int INC = 6144, DFF = 2816, DEX = 3584, NEXP = 8;
constexpr float ALPHA_F = 1.41421356237f;
constexpr float LN_EPS = 1e-5f;

enum { I_X = 0, I_C, I_CTX, I_CCTX, I_WMOD, I_BMOD, I_WIN, I_HSW, I_HSB, I_FW1, I_FB1, I_FW2, I_FB2, I_FW3, I_FB3, I_FREQ, I_DECAY, I_HBIAS, I_WHY,
       I_CFW, I_CFB, I_CFG, I_CFLB, I_WCF, I_SARE, I_SAIM, I_SLDT, I_SBRE, I_SBIM, I_SCRE, I_SCIM, I_SD, I_SWGLU, I_SBGLU, I_WS5, I_WO,
       I_LN1G, I_LN1B, I_LN2G, I_LN2B, I_FFW1, I_FFW3, I_FFW2, I_ROUTER, I_MW1, I_MW3, I_MW2, N_IN };

constexpr size_t MiB = 1u << 20;
constexpr size_t WS_CTL = 0, CTL_ZERO_BYTES = 1 * MiB;
constexpr size_t WS_MODS = 1 * MiB;
constexpr size_t WS_S5P = 2 * MiB;
constexpr size_t WS_META = 3 * MiB;
constexpr size_t WS_FILT = 4 * MiB;
constexpr size_t WS_XC = 22 * MiB;
constexpr size_t WS_WIN = 38 * MiB;
constexpr size_t WS_WOUTS = 62 * MiB;
constexpr size_t WS_WGLU = 68 * MiB;
constexpr size_t WS_WO = 69 * MiB;
constexpr size_t WS_W13 = 73 * MiB;
constexpr size_t WS_W2 = 84 * MiB;
constexpr size_t WS_HX = 90 * MiB;
constexpr size_t WS_G = 162 * MiB;
constexpr size_t WS_PHYT = WS_G, WS_YDIR = WS_G + 108 * MiB, WS_UCF = WS_G + 180 * MiB;
constexpr size_t WS_PS5 = 378 * MiB;
constexpr size_t WS_Z2 = 414 * MiB;
constexpr size_t WS_UCF2 = 450 * MiB;
constexpr size_t WS_S5Y = 486 * MiB;
constexpr size_t WS_KRL = 522 * MiB;
constexpr size_t WS_KRC = 586 * MiB;
constexpr size_t WS_SG = 596 * MiB;
constexpr size_t WS_KDUMMY = 594 * MiB;
constexpr size_t WS_END = 595 * MiB;
constexpr size_t WS_SORT = 90 * MiB;
constexpr size_t WS_MOEY = 156 * MiB;
constexpr size_t WS_MW13 = 288 * MiB;
constexpr size_t WS_MW2 = 344 * MiB;
constexpr size_t WS_HID = 372 * MiB;
constexpr size_t HID_BUF = 56 * MiB;
constexpr size_t WS_END2 = 632 * MiB;
static_assert(WS_HID + (size_t)67584 * 3584 <= WS_END2, "moe map");
constexpr size_t META_TOKE = 0, META_TOKW = 256 * 1024, META_POS = 512 * 1024, META_TILE = 768 * 1024;
constexpr int CW_BAR = 4096;
constexpr int CW_CNT = 8192, CW_CUR = 8256;

constexpr int LDS_BYTES = 155648;
constexpr int MISC_OFF = 147456;
constexpr int NWAVES = 8;

typedef __bf16 bf2_t __attribute__((ext_vector_type(2)));
__device__ __forceinline__ unsigned pk2(float lo, float hi) { bf2_t v; v.x = (__bf16)lo; v.y = (__bf16)hi; return __builtin_bit_cast(unsigned, v); }
__device__ __forceinline__ unsigned f2bf(float f) { return (unsigned)__builtin_bit_cast(unsigned short, (__bf16)f); }
__device__ __forceinline__ unsigned pk4_fp8(float a, float b, float c, float d) { int w = 0; w = __builtin_amdgcn_cvt_pk_fp8_f32(a, b, w, false); w = __builtin_amdgcn_cvt_pk_fp8_f32(c, d, w, true); return (unsigned)w; }
__device__ __forceinline__ float bf2f(unsigned short b) { return __builtin_bit_cast(float, ((unsigned)b) << 16); }
__device__ __forceinline__ float bflo(unsigned w) { return __builtin_bit_cast(float, w << 16); }
__device__ __forceinline__ float bfhi(unsigned w) { return __builtin_bit_cast(float, w & 0xffff0000u); }
__device__ __forceinline__ float sigmoidf_(float x) { return __builtin_amdgcn_rcpf(1.0f + __expf(-x)); }
__device__ __forceinline__ float siluf_(float x) { return x * sigmoidf_(x); }
__device__ __forceinline__ float gelu_tanh(float x) { const float y = 0.7978845608028654f * (x + 0.044715f * x * x * x); const float e = __expf(2.0f * y); const float th = 1.0f - 2.0f * __builtin_amdgcn_rcpf(e + 1.0f); return 0.5f * x * (1.0f + th); }
__device__ __forceinline__ float wave_sum(float v) {
    v += __builtin_bit_cast(float, __builtin_amdgcn_mov_dpp(__builtin_bit_cast(int, v), 0xB1, 0xf, 0xf, true));
    v += __builtin_bit_cast(float, __builtin_amdgcn_mov_dpp(__builtin_bit_cast(int, v), 0x4E, 0xf, 0xf, true));
    v += __builtin_bit_cast(float, __builtin_amdgcn_mov_dpp(__builtin_bit_cast(int, v), 0x141, 0xf, 0xf, true));
    v += __builtin_bit_cast(float, __builtin_amdgcn_mov_dpp(__builtin_bit_cast(int, v), 0x140, 0xf, 0xf, true));
    v += __builtin_bit_cast(float, __builtin_amdgcn_ds_swizzle(__builtin_bit_cast(int, v), 0x401F));
    const unsigned u = __builtin_bit_cast(unsigned, v); const auto r = __builtin_amdgcn_permlane32_swap(u, u, false, false);
    return __builtin_bit_cast(float, (unsigned)r[0]) + __builtin_bit_cast(float, (unsigned)r[1]);
}
__device__ __forceinline__ float lane_bcast(float v, int k) { return __builtin_bit_cast(float, __builtin_amdgcn_readlane(__builtin_bit_cast(int, v), k)); }
#define LDS_WAIT() asm volatile("s_waitcnt lgkmcnt(0)" ::: "memory")
#define VM_WAIT() asm volatile("s_waitcnt vmcnt(0)" ::: "memory")

namespace pg8 {
#define PG8_LAS __attribute__((address_space(3)))
constexpr int BM = 256, BK = 64, HALF = 128, HTB = HALF * BK * 2, STAGE_BYTES = 8 * HTB, NXCD = 8, WGM = 8;
__host__ __device__ __forceinline__ int lds_byte(int r, int c) { const int st = (r >> 4) * 2 + (c >> 5), rr = r & 15, cc = c & 31, ob = rr * 64 + cc * 2; return st * 1024 + (ob ^ (((ob >> 9) & 1) << 5)); }
__host__ __device__ __forceinline__ void stage_rc(int b, int& R, int& C) { const int st = b / 1024, sb = b % 1024, swz = sb ^ (((sb >> 9) & 1) << 5); R = (st >> 1) * 16 + swz / 64; C = (st & 1) * 32 + (swz % 64) / 2; }
__host__ __device__ __forceinline__ int perm32(int rho) { const int n = rho >> 4, i = rho & 15; return 8 * (i >> 2) + 4 * n + (i & 3); }

struct Unit { int pm, pn, seg, ex; const char* A; const char* B; };

struct Rect {
    int nM, nN, nwg, G, c;
    __device__ __forceinline__ void init(int nM_, int nN_, int G_, int c_) { nM = nM_; nN = nN_; nwg = nM * nN; G = G_; c = c_; }
    __device__ __forceinline__ bool map(int L, int& pm, int& pn) const {
        if (L >= nwg) return false;
        int wgid = L; { const int q = nwg / NXCD, r = nwg % NXCD, xcd = wgid % NXCD, off = wgid / NXCD; wgid = (xcd < r ? xcd * (q + 1) : r * (q + 1) + (xcd - r) * q) + off; }
        const int nig = WGM * nN, gid = wgid / nig, fm = gid * WGM, gsz = (nM - fm) < WGM ? (nM - fm) : WGM;
        pm = fm + ((wgid % nig) % gsz); pn = (wgid % nig) / gsz; return true;
    }
};

__device__ __forceinline__ unsigned cvt_pk_bf16(float lo, float hi) { return pk2(lo, hi); }

typedef int v8i_t __attribute__((ext_vector_type(8)));
typedef int v4i_t __attribute__((ext_vector_type(4)));
__device__ __forceinline__ v8i_t cat8(const bf16x8 a, const bf16x8 b) { return __builtin_shufflevector(__builtin_bit_cast(v4i_t, a), __builtin_bit_cast(v4i_t, b), 0, 1, 2, 3, 4, 5, 6, 7); }
__device__ __forceinline__ bf16x8 lo8(const v8i_t v) { return __builtin_bit_cast(bf16x8, __builtin_shufflevector(v, v, 0, 1, 2, 3)); }
__device__ __forceinline__ bf16x8 hi8(const v8i_t v) { return __builtin_bit_cast(bf16x8, __builtin_shufflevector(v, v, 4, 5, 6, 7)); }
template <class Epi, class Sched, bool F8 = false, bool ALIGN_EPI = true, bool SP2 = true>
__device__ __forceinline__ void gemm_phase(PG8_LAS unsigned char* lds, const int tid, const int KB, const Sched& S, const Epi& E) {
    const int wid = __builtin_amdgcn_readfirstlane(tid >> 6), lane = tid & 63, wr = wid >> 2, wc = wid & 3, fr = lane & 15, fq = lane >> 4;
    const int nt = KB / (BK * 2);
    unsigned voffA[2], voffB[2];
#pragma unroll
    for (int i = 0; i < 2; ++i) { int R, C; stage_rc(tid * 16 + i * 8192, R, C); const int Rb = Epi::PERM ? ((R & ~31) + perm32(R & 31)) : R;
        voffA[i] = (unsigned)(R * KB + C * 2); voffB[i] = (unsigned)(Rb * KB + C * 2); }
    const size_t kstep = (size_t)(BK * 2);
    const size_t hstep = (size_t)HALF * KB;
    const unsigned ldsw = (unsigned)wid * 1024u;
    const int aoff = lds_byte(wr * 64 + fr, fq * (F8 ? 16 : 8)), boff = lds_byte(wc * 32 + fr, fq * (F8 ? 16 : 8));
    constexpr int KOFF = F8 ? 16 : 1024;
#define PG8_SA(b, h) (((b) * 2 + (h)) * HTB)
#define PG8_SB(b, h) ((4 + (b) * 2 + (h)) * HTB)
#define PG8_STAGE(bufoff, gbase, voff) do { _Pragma("unroll") for (int _i = 0; _i < 2; ++_i) \
        __builtin_amdgcn_global_load_lds((const unsigned*)((const char*)(gbase) + (voff)[_i]), (PG8_LAS unsigned*)(lds + (bufoff) + ldsw + _i * 8192), 16, 0, 0); } while (0)
#define PG8_LDA(dst, b, h) do { _Pragma("unroll") for (int m = 0; m < 4; ++m) dst[m] = cat8(*(const PG8_LAS bf16x8*)(lds + PG8_SA(b, h) + aoff + m * 2048), *(const PG8_LAS bf16x8*)(lds + PG8_SA(b, h) + aoff + m * 2048 + KOFF)); } while (0)
#define PG8_LDB(dst, b, h) do { _Pragma("unroll") for (int n = 0; n < 2; ++n) dst[n] = cat8(*(const PG8_LAS bf16x8*)(lds + PG8_SB(b, h) + boff + n * 2048), *(const PG8_LAS bf16x8*)(lds + PG8_SB(b, h) + boff + n * 2048 + KOFF)); } while (0)
#define PG8_MMA(ai, bj, At, Bt) do { __builtin_amdgcn_s_setprio(1); _Pragma("unroll") for (int m = 0; m < 4; ++m) _Pragma("unroll") for (int n = 0; n < 2; ++n) { \
        if constexpr (F8) asm volatile("v_mfma_scale_f32_16x16x128_f8f6f4 %0, %1, %2, %0, %3, %3 op_sel_hi:[0,0,0]" : "+v"(acc[ai][bj][m][n]) : "v"(Bt[n]), "v"(At[m]), "v"(sc1)); \
        else { acc[ai][bj][m][n] = __builtin_amdgcn_mfma_f32_16x16x32_bf16(lo8(Bt[n]), lo8(At[m]), acc[ai][bj][m][n], 0, 0, 0); \
               acc[ai][bj][m][n] = __builtin_amdgcn_mfma_f32_16x16x32_bf16(hi8(Bt[n]), hi8(At[m]), acc[ai][bj][m][n], 0, 0, 0); } } \
        __builtin_amdgcn_s_setprio(0); } while (0)
#define PG8_WAIT_V(n) asm volatile("s_waitcnt vmcnt(" #n ")" ::: "memory")
#define PG8_WAIT_L(n) asm volatile("s_waitcnt lgkmcnt(" #n ")" ::: "memory")
#define PG8_BAR __builtin_amdgcn_s_barrier()
#define PG8_SCHED __builtin_amdgcn_sched_barrier(0)
    const int sc1 = 0x7f7f7f7f;
    Unit cur, nxt; int ui = 0;
    if (!S.next(0, cur)) return;
    f32x4 acc[2][2][4][2];
#pragma unroll
    for (int a = 0; a < 2; ++a)
#pragma unroll
        for (int b = 0; b < 2; ++b)
#pragma unroll
            for (int m = 0; m < 4; ++m)
#pragma unroll
                for (int n = 0; n < 2; ++n) acc[a][b][m][n] = (f32x4){0.f, 0.f, 0.f, 0.f};
    v8i_t At[4], B0[2], B1[2];
    const char* cA = cur.A; const char* cB = cur.B;
    if constexpr (SP2) {
        PG8_STAGE(PG8_SB(0, 0), cB, voffB); PG8_STAGE(PG8_SB(0, 1), cB + hstep, voffB); PG8_STAGE(PG8_SA(0, 0), cA, voffA); PG8_STAGE(PG8_SA(0, 1), cA + hstep, voffA);
        if (wr == 1) PG8_BAR;
        PG8_WAIT_V(2); PG8_BAR;
        PG8_STAGE(PG8_SB(1, 0), cB + kstep, voffB); PG8_STAGE(PG8_SA(1, 0), cA + kstep, voffA); PG8_STAGE(PG8_SB(1, 1), cB + hstep + kstep, voffB);
        PG8_WAIT_V(6); PG8_BAR;
    } else {
        PG8_STAGE(PG8_SB(0, 0), cB, voffB); PG8_STAGE(PG8_SA(0, 0), cA, voffA); PG8_STAGE(PG8_SB(0, 1), cB + hstep, voffB); PG8_STAGE(PG8_SA(0, 1), cA + hstep, voffA);
        if (wr == 1) PG8_BAR;
        PG8_WAIT_V(4); PG8_BAR;
        PG8_STAGE(PG8_SB(1, 0), cB + kstep, voffB); PG8_STAGE(PG8_SA(1, 0), cA + kstep, voffA); PG8_STAGE(PG8_SB(1, 1), cB + hstep + kstep, voffB);
        PG8_WAIT_V(6); PG8_BAR;
    }
    for (;;) {
        const bool has_next = S.next(ui + 1, nxt);
        const char* nA = has_next ? nxt.A : cA; const char* nB = has_next ? nxt.B : cB;
#pragma unroll 1
        for (int t = 0; t < nt; t += 2) {
            const bool last = (t == nt - 2);
            const char* a1 = cA + (size_t)(t + 1) * kstep;
            const char* a2 = last ? nA : cA + (size_t)(t + 2) * kstep; const char* b2 = last ? nB : cB + (size_t)(t + 2) * kstep;
            const char* a3 = a2 + kstep; const char* b3 = b2 + kstep;
            if constexpr (SP2) {
            PG8_LDB(B0, 0, 0); PG8_LDB(B1, 0, 1); PG8_SCHED; PG8_LDA(At, 0, 0); PG8_STAGE(PG8_SA(1, 1), a1 + hstep, voffA);
            PG8_WAIT_V(8); PG8_WAIT_L(0); PG8_BAR; PG8_MMA(0, 0, At, B0); PG8_MMA(0, 1, At, B1); PG8_BAR; PG8_SCHED;
            PG8_LDA(At, 0, 1); PG8_STAGE(PG8_SB(0, 0), b2, voffB); PG8_STAGE(PG8_SB(0, 1), b2 + hstep, voffB); PG8_STAGE(PG8_SA(0, 0), a2, voffA);
            PG8_WAIT_V(8); PG8_WAIT_L(0); PG8_BAR; PG8_MMA(1, 0, At, B0); PG8_MMA(1, 1, At, B1); PG8_BAR; PG8_SCHED;
            PG8_LDB(B0, 1, 0); PG8_LDB(B1, 1, 1); PG8_SCHED; PG8_LDA(At, 1, 0); PG8_STAGE(PG8_SA(0, 1), a2 + hstep, voffA);
            PG8_WAIT_V(8); PG8_WAIT_L(0); PG8_BAR; PG8_MMA(0, 0, At, B0); PG8_MMA(0, 1, At, B1); PG8_BAR; PG8_SCHED;
            PG8_LDA(At, 1, 1); PG8_STAGE(PG8_SB(1, 0), b3, voffB); PG8_STAGE(PG8_SB(1, 1), b3 + hstep, voffB); PG8_STAGE(PG8_SA(1, 0), a3, voffA);
            PG8_WAIT_V(8); PG8_WAIT_L(0); PG8_BAR; PG8_MMA(1, 0, At, B0); PG8_MMA(1, 1, At, B1); PG8_BAR; PG8_SCHED;
            } else {
            PG8_LDB(B0, 0, 0); PG8_SCHED; PG8_LDA(At, 0, 0); PG8_STAGE(PG8_SA(1, 1), a1 + hstep, voffA);
            PG8_WAIT_L(8); PG8_BAR; PG8_WAIT_L(0); PG8_MMA(0, 0, At, B0); PG8_BAR; PG8_SCHED;
            PG8_LDB(B1, 0, 1); PG8_STAGE(PG8_SB(0, 0), b2, voffB);
            PG8_BAR; PG8_WAIT_L(0); PG8_MMA(0, 1, At, B1); PG8_BAR;
            PG8_LDA(At, 0, 1); PG8_STAGE(PG8_SA(0, 0), a2, voffA);
            PG8_BAR; PG8_WAIT_L(0); PG8_MMA(1, 0, At, B0); PG8_BAR; PG8_SCHED;
            PG8_STAGE(PG8_SB(0, 1), b2 + hstep, voffB);
            PG8_WAIT_V(6); PG8_BAR; PG8_MMA(1, 1, At, B1); PG8_BAR;
            PG8_LDB(B0, 1, 0); PG8_SCHED; PG8_LDA(At, 1, 0); PG8_STAGE(PG8_SA(0, 1), a2 + hstep, voffA);
            PG8_WAIT_L(8); PG8_BAR; PG8_WAIT_L(0); PG8_MMA(0, 0, At, B0); PG8_BAR; PG8_SCHED;
            PG8_LDB(B1, 1, 1); PG8_STAGE(PG8_SB(1, 0), b3, voffB);
            PG8_BAR; PG8_WAIT_L(0); PG8_MMA(0, 1, At, B1); PG8_BAR;
            PG8_LDA(At, 1, 1); PG8_STAGE(PG8_SA(1, 0), a3, voffA);
            PG8_BAR; PG8_WAIT_L(0); PG8_MMA(1, 0, At, B0); PG8_BAR; PG8_SCHED;
            PG8_STAGE(PG8_SB(1, 1), b3 + hstep, voffB);
            PG8_WAIT_V(6); PG8_BAR; PG8_MMA(1, 1, At, B1); PG8_BAR;
            }
        }
        if constexpr (F8) asm volatile("s_nop 15\n\ts_nop 15" ::: "memory");
        if constexpr (ALIGN_EPI) { if (wr == 0) PG8_BAR; }
        E(acc, cur, wr, wc, fr, fq);
        if (!has_next) break;
#pragma unroll
        for (int a = 0; a < 2; ++a)
#pragma unroll
            for (int b = 0; b < 2; ++b)
#pragma unroll
                for (int m = 0; m < 4; ++m)
#pragma unroll
                    for (int n = 0; n < 2; ++n) acc[a][b][m][n] = (f32x4){0.f, 0.f, 0.f, 0.f};
        cur = nxt; cA = nA; cB = nB; ++ui;
        if constexpr (ALIGN_EPI) { if (wr == 1) PG8_BAR; }
    }
    PG8_WAIT_V(0);
    if constexpr (!ALIGN_EPI) { if (wr == 0) PG8_BAR; }
    PG8_BAR;
#undef PG8_SA
#undef PG8_SB
#undef PG8_STAGE
#undef PG8_LDA
#undef PG8_LDB
#undef PG8_MMA
#undef PG8_WAIT_V
#undef PG8_WAIT_L
#undef PG8_BAR
#undef PG8_SCHED
}
}
using pg8::Unit;

#define XB_TMO      128
#define XB_XCNT(j)  (256  + 64 * (j))
#define XB_XSUB(j)  (1280 + 64 * (j))
#define XB_XGEN(j)  (2304 + 64 * (j))
#define XB_TOP      3328
#define XB_TOPGEN   3392
#define XCD_BAR_WORDS 3456
#define XB_SPIN_CAP (1u << 18)
__device__ __forceinline__ unsigned xb_ld(unsigned* p)              { return __hip_atomic_load(p, __ATOMIC_RELAXED, __HIP_MEMORY_SCOPE_AGENT); }
__device__ __forceinline__ unsigned xb_add(unsigned* p, unsigned v) { return __hip_atomic_fetch_add(p, v, __ATOMIC_RELAXED, __HIP_MEMORY_SCOPE_AGENT); }
__device__ __forceinline__ unsigned xb_xcc_id() { return (unsigned)__builtin_amdgcn_s_getreg((3 << 11) | 20) & 0xFu; }
#define XB_SPIN(cond, bar) do { unsigned _sp = 0; while (cond) { __builtin_amdgcn_s_sleep(1); \
    if ((++_sp & 255u) == 0u) { if (xb_ld(&(bar)[XB_TMO])) break; if (_sp > XB_SPIN_CAP) { atomicAdd(&(bar)[XB_TMO], 1u); break; } } } } while (0)
struct XcdBarrier { unsigned* bar; unsigned x; volatile LAS unsigned* st; };
__device__ __forceinline__ XcdBarrier xcd_barrier_post(unsigned* bar, volatile LAS unsigned* st) {
    XcdBarrier b; b.bar = bar; b.x = xb_xcc_id(); b.st = st;
    if (threadIdx.x == 0) (void)xb_add(&bar[XB_XCNT(b.x)], 1u);
    return b;
}
__device__ __forceinline__ void xcd_barrier_complete(unsigned* bar, unsigned x, unsigned& nloc, unsigned& nx) {
    const unsigned G = gridDim.x * gridDim.y * gridDim.z;
    unsigned sum, cnt, mine, sp = 0u;
    for (;;) {
        sum = 0u; cnt = 0u; mine = 0u;
#pragma unroll
        for (unsigned j = 0; j < 16; ++j) { const unsigned c = xb_ld(&bar[XB_XCNT(j)]); sum += c; cnt += (c > 0u) ? 1u : 0u; mine = (j == x) ? c : mine; }
        if (sum == G) break;
        __builtin_amdgcn_s_sleep(1);
        if ((++sp & 255u) == 0u) { if (xb_ld(&bar[XB_TMO])) break; if (sp > XB_SPIN_CAP) { atomicAdd(&bar[XB_TMO], 1u); break; } }
    }
    nloc = mine > 0u ? mine : 1u; nx = cnt > 0u ? cnt : 1u;
}
__device__ __forceinline__ void xcd_barrier(const XcdBarrier& b, const int wave_s) {
    asm volatile("s_waitcnt vmcnt(0)" ::: "memory");
    __syncthreads();
    if (wave_s == 0 && __builtin_amdgcn_mbcnt_hi(~0u, __builtin_amdgcn_mbcnt_lo(~0u, 0u)) == 0u) {
        unsigned* bar = b.bar; asm volatile("" : "+v"(bar));
        __builtin_amdgcn_s_waitcnt(0);
        unsigned nloc = b.st[0], nx = b.st[1];
        if (nloc == 0u) { xcd_barrier_complete(bar, b.x, nloc, nx); b.st[0] = nloc; b.st[1] = nx; }
        const unsigned old = xb_add(&bar[XB_XSUB(b.x)], 1u);
        const unsigned gen = old / nloc;
        if (old + 1u == (gen + 1u) * nloc) {
            __builtin_amdgcn_fence(__ATOMIC_RELEASE, "agent");
            asm volatile("s_waitcnt vmcnt(0)" ::: "memory");
            const unsigned og = xb_add(&bar[XB_TOP], 1u);
            const unsigned tg = og / nx;
            if (og + 1u == (tg + 1u) * nx) xb_add(&bar[XB_TOPGEN], 1u);
            else XB_SPIN(xb_ld(&bar[XB_TOPGEN]) == tg, bar);
            __builtin_amdgcn_fence(__ATOMIC_ACQUIRE, "agent");
            xb_add(&bar[XB_XGEN(b.x)], 1u);
            asm volatile("s_waitcnt vmcnt(0)" ::: "memory");
        } else {
            XB_SPIN(xb_ld(&bar[XB_XGEN(b.x)]) == gen, bar);
            __builtin_amdgcn_fence(__ATOMIC_ACQUIRE, "agent");
            asm volatile("s_waitcnt vmcnt(0)" ::: "memory");
        }
    }
    __syncthreads();
}

struct Args { const float* in[N_IN]; float* out; unsigned char* ws; int ph_lo, ph_hi; };

struct Frame {
    LAS unsigned char* lds;
    int tid, lane, wave, vcu, G;
    const float* const* in; float* out; unsigned char* ws;
};

__device__ __forceinline__ const float* inp(const Frame& F, int k) { const float* p = F.in[k]; asm volatile("" : "+s"(p)); return p; }

struct SchedPlain {
    pg8::Rect R; const char* A; const char* B; size_t tsA, tsB; int xM, xN0, xNn;
    __device__ __forceinline__ bool next(int i, Unit& u) const {
        const int L = i * R.G + R.c;
        if (R.map(L, u.pm, u.pn)) {} else { const int e = L - R.nwg; if (e >= xM * xNn) return false; u.pm = R.nM + e / xNn; u.pn = xN0 + e % xNn; }
        u.seg = 0; u.ex = 0; u.A = A + (size_t)u.pm * tsA; u.B = B + (size_t)u.pn * tsB; return true;
    }
};
struct SchedMerge {
    pg8::Rect R; const char* A; const char* B; size_t tsA, tsB, sA, sB;
    __device__ __forceinline__ bool next(int i, Unit& u) const {
        const int ti = i / 3, sg = i - 3 * ti; const int L = ti * R.G + R.c;
        if (!R.map(L, u.pm, u.pn)) return false;
        u.seg = sg; u.ex = 0;
        u.A = A + (size_t)sg * sA + (size_t)u.pm * tsA; u.B = B + (size_t)sg * sB + (size_t)u.pn * tsB; return true;
    }
};
struct SchedMoe {
    pg8::Rect R; const char* A; const char* B; size_t tsA, tsB, esB; const int* tile_e; int tile0; bool a_global;
    __device__ __forceinline__ bool next(int i, Unit& u) const {
        const int L = i * R.G + R.c;
        if (!R.map(L, u.pm, u.pn)) return false;
        const int gt = tile0 + u.pm; u.ex = gt; u.seg = 0; const int e = tile_e[gt];
        u.A = A + (size_t)(a_global ? gt : u.pm) * tsA; u.B = B + (size_t)e * esB + (size_t)u.pn * tsB; return true;
    }
};

typedef const f32x4 (&AccRef)[2][2][4][2];
__device__ __forceinline__ v4u pack8(const f32x4 a, const f32x4 b) { v4u w; w.x = pg8::cvt_pk_bf16(a[0], a[1]); w.y = pg8::cvt_pk_bf16(a[2], a[3]); w.z = pg8::cvt_pk_bf16(b[0], b[1]); w.w = pg8::cvt_pk_bf16(b[2], b[3]); return w; }
__device__ __forceinline__ void unpack8(const v4u w, f32x4& a, f32x4& b) { a = (f32x4){bflo(w.x), bfhi(w.x), bflo(w.y), bfhi(w.y)}; b = (f32x4){bflo(w.z), bfhi(w.z), bflo(w.w), bfhi(w.w)}; }

struct EpiInproj {
    static constexpr bool PERM = true;
    bf16* phyT; bf16* ucf; bf16* ps5;
    __device__ __forceinline__ void operator()(AccRef acc, const Unit& u, int wr, int wc, int fr, int fq) const {
        const int row0 = u.pm * 256 + wr * 64 + fr;
        if (u.pn < 6) {
#pragma unroll
            for (int ai = 0; ai < 2; ++ai)
#pragma unroll
                for (int m = 0; m < 4; ++m) { const int r = row0 + ai * 128 + m * 16;
#pragma unroll
                    for (int bj = 0; bj < 2; ++bj)
#pragma unroll
                        for (int n = 0; n < 2; ++n)
#pragma unroll
                            for (int j = 0; j < 4; ++j) { const int c = u.pn * 256 + bj * 128 + wc * 32 + 8 * fq + 4 * n + j; phyT[(size_t)c * RT + r] = (bf16)f2bf(acc[ai][bj][m][n][j]); } }
        } else if (u.pn < 10) {
            const int col0 = (u.pn - 6) * 128 + wc * 32 + 8 * fq;
#pragma unroll
            for (int ai = 0; ai < 2; ++ai)
#pragma unroll
                for (int m = 0; m < 4; ++m) { const int r = row0 + ai * 128 + m * 16; f32x4 o[2];
#pragma unroll
                    for (int n = 0; n < 2; ++n)
#pragma unroll
                        for (int j = 0; j < 4; ++j) o[n][j] = acc[ai][0][m][n][j] * sigmoidf_(acc[ai][1][m][n][j]);
                    *(v4u*)(ucf + (size_t)r * 512 + col0) = pack8(o[0], o[1]); }
        } else {
#pragma unroll
            for (int ai = 0; ai < 2; ++ai)
#pragma unroll
                for (int m = 0; m < 4; ++m) { const int r = row0 + ai * 128 + m * 16;
#pragma unroll
                    for (int bj = 0; bj < 2; ++bj) { const int col0 = (u.pn - 10) * 256 + bj * 128 + wc * 32 + 8 * fq; *(v4u*)(ps5 + (size_t)r * 512 + col0) = pack8(acc[ai][bj][m][0], acc[ai][bj][m][1]); } }
        }
    }
};
struct EpiGates {
    static constexpr bool PERM = true;
    bf16* O;
    __device__ __forceinline__ void operator()(AccRef acc, const Unit& u, int wr, int wc, int fr, int fq) const {
        const int row0 = u.pm * 256 + wr * 64 + fr;
#pragma unroll
        for (int ai = 0; ai < 2; ++ai)
#pragma unroll
            for (int m = 0; m < 4; ++m) { const int r = row0 + ai * 128 + m * 16;
#pragma unroll
                for (int bj = 0; bj < 2; ++bj) { const int col0 = u.pn * 256 + bj * 128 + wc * 32 + 8 * fq; f32x4 o[2];
#pragma unroll
                    for (int n = 0; n < 2; ++n)
#pragma unroll
                        for (int j = 0; j < 4; ++j) o[n][j] = sigmoidf_(acc[ai][bj][m][n][j]);
                    *(v4u*)(O + (size_t)r * 3072 + col0) = pack8(o[0], o[1]); } }
    }
};
struct EpiGlu {
    static constexpr bool PERM = true;
    const bf16* SG; bf16* O; const float* bglu;
    __device__ __forceinline__ void operator()(AccRef acc, const Unit& u, int wr, int wc, int fr, int fq) const {
        const int row0 = u.pm * 256 + wr * 64 + fr;
#pragma unroll
        for (int bj = 0; bj < 2; ++bj) { const int col0 = u.pn * 256 + bj * 128 + wc * 32 + 8 * fq;
            const f32x4 b0 = *(const f32x4*)(bglu + col0), b1 = *(const f32x4*)(bglu + col0 + 4);
#pragma unroll
            for (int ai = 0; ai < 2; ++ai)
#pragma unroll
                for (int m = 0; m < 4; ++m) { const int r = row0 + ai * 128 + m * 16;
                    const v4u gw = *(const v4u*)(SG + (size_t)r * 512 + col0); f32x4 g0, g1; unpack8(gw, g0, g1); f32x4 o0, o1;
#pragma unroll
                    for (int j = 0; j < 4; ++j) { o0[j] = g0[j] * sigmoidf_(acc[ai][bj][m][0][j] + b0[j]); o1[j] = g1[j] * sigmoidf_(acc[ai][bj][m][1][j] + b1[j]); }
                    *(v4u*)(O + (size_t)r * 512 + col0) = pack8(o0, o1); } }
    }
};
struct EpiMerge {
    static constexpr bool PERM = true;
    const bf16* GT; bf16* O;
    __device__ __forceinline__ void operator()(AccRef acc, const Unit& u, int wr, int wc, int fr, int fq) const {
        const int row0 = u.pm * 256 + wr * 64 + fr;
#pragma unroll
        for (int ai = 0; ai < 2; ++ai)
#pragma unroll
            for (int m = 0; m < 4; ++m) { const int r = row0 + ai * 128 + m * 16;
#pragma unroll
                for (int bj = 0; bj < 2; ++bj) { const int col0 = u.pn * 256 + bj * 128 + wc * 32 + 8 * fq;
                    const v4u gw = *(const v4u*)(GT + (size_t)r * 3072 + u.seg * 1024 + col0); f32x4 g0, g1; unpack8(gw, g0, g1);
                    f32x4 o0 = g0 * acc[ai][bj][m][0], o1 = g1 * acc[ai][bj][m][1];
                    bf16* dst = O + (size_t)r * 1024 + col0;
                    if (u.seg > 0) { const v4u pw = *(const v4u*)dst; f32x4 p0, p1; unpack8(pw, p0, p1); o0 += p0; o1 += p1; }
                    *(v4u*)dst = pack8(o0, o1); } }
    }
};
struct EpiRes {
    static constexpr bool PERM = false;
    const float* xl; const float* xc; float* ol; float* oc; const float* gbase; float sc;
    __device__ __forceinline__ void operator()(AccRef acc, const Unit& u, int wr, int wc, int fr, int fq) const {
        const bool isl = u.pm < (NX / 256);
        const int prow = isl ? u.pm * 256 : (u.pm - NX / 256) * 256; const int mi = isl ? (u.pm >> 3) : 16;
        const float* xs = isl ? xl : xc; float* os = isl ? ol : oc; const float* gv = gbase + (size_t)mi * INC;
        const int row0 = prow + wr * 64 + fr, col0 = u.pn * 256 + wc * 32 + 4 * fq;
#pragma unroll
        for (int bj = 0; bj < 2; ++bj)
#pragma unroll
            for (int n = 0; n < 2; ++n) { const int c = col0 + bj * 128 + n * 16; const f32x4 g = *(const f32x4*)(gv + c) * sc;
#pragma unroll
                for (int ai = 0; ai < 2; ++ai)
#pragma unroll
                    for (int m = 0; m < 4; ++m) { const size_t off = (size_t)(row0 + ai * 128 + m * 16) * 1024 + c;
                        const f32x4 xr = *(const f32x4*)(xs + off); *(f32x4*)(os + off) = xr * ALPHA_F + g * acc[ai][bj][m][n]; } }
    }
};
struct EpiSwiglu {
    static constexpr bool PERM = true;
    bf16* O; int ldc;
    __device__ __forceinline__ void operator()(AccRef acc, const Unit& u, int wr, int wc, int fr, int fq) const {
        const int row0 = u.pm * 256 + wr * 64 + fr, col0 = u.pn * 128 + wc * 32 + 8 * fq;
#pragma unroll
        for (int ai = 0; ai < 2; ++ai)
#pragma unroll
            for (int m = 0; m < 4; ++m) { const int r = row0 + ai * 128 + m * 16; f32x4 o[2];
#pragma unroll
                for (int n = 0; n < 2; ++n)
#pragma unroll
                    for (int j = 0; j < 4; ++j) o[n][j] = siluf_(acc[ai][0][m][n][j]) * acc[ai][1][m][n][j];
                *(v4u*)(O + (size_t)r * ldc + col0) = pack8(o[0], o[1]); }
    }
};
struct EpiSwigluF8 {
    static constexpr bool PERM = true;
    unsigned char* O; int ldc; float sc;
    __device__ __forceinline__ void operator()(AccRef acc, const Unit& u, int wr, int wc, int fr, int fq) const {
        const int row0 = u.pm * 256 + wr * 64 + fr, col0 = u.pn * 128 + wc * 32 + 8 * fq;
#pragma unroll
        for (int ai = 0; ai < 2; ++ai)
#pragma unroll
            for (int m = 0; m < 4; ++m) { const int r = row0 + ai * 128 + m * 16; f32x4 o[2];
#pragma unroll
                for (int n = 0; n < 2; ++n)
#pragma unroll
                    for (int j = 0; j < 4; ++j) o[n][j] = siluf_(acc[ai][0][m][n][j] * sc) * (acc[ai][1][m][n][j] * sc);
                v2u w; w.x = pk4_fp8(o[0][0], o[0][1], o[0][2], o[0][3]); w.y = pk4_fp8(o[1][0], o[1][1], o[1][2], o[1][3]);
                *(v2u*)(O + (size_t)r * ldc + col0) = w; }
    }
};
struct EpiMoeDown {
    static constexpr bool PERM = true;
    bf16* O; float sc;
    __device__ __forceinline__ void operator()(AccRef acc, const Unit& u, int wr, int wc, int fr, int fq) const {
        const int row0 = u.ex * 256 + wr * 64 + fr;
#pragma unroll
        for (int ai = 0; ai < 2; ++ai)
#pragma unroll
            for (int m = 0; m < 4; ++m) { const int r = row0 + ai * 128 + m * 16;
#pragma unroll
                for (int bj = 0; bj < 2; ++bj) { const int col0 = u.pn * 256 + bj * 128 + wc * 32 + 8 * fq; *(v4u*)(O + (size_t)r * 1024 + col0) = pack8(acc[ai][bj][m][0] * sc, acc[ai][bj][m][1] * sc); } }
    }
};

template <bool F8>
__device__ __forceinline__ void transpose_item64(const float* W, int K, int N, unsigned char* WT, int dst_row0, int k0, int n0, float scale, LAS float* scr, int lane) {
#pragma unroll 4
    for (int i = 0; i < 16; ++i) { const int row = 4 * i + (lane >> 4), nc = 4 * (lane & 15);
        const f32x4 v = *(const f32x4*)(W + (size_t)(k0 + row) * N + n0 + nc); *(LAS f32x4*)(scr + row * 68 + nc) = v * scale; }
    LDS_WAIT(); asm volatile("" ::: "memory");
    const LAS float* sp = scr + lane;
    if constexpr (F8) {
        unsigned char* dst = WT + (size_t)(dst_row0 + lane) * K + k0;
#pragma unroll
        for (int c4 = 0; c4 < 4; ++c4) { v4u o;
#pragma unroll
            for (int e = 0; e < 4; ++e) { const int kk = 16 * c4 + 4 * e; o[e] = pk4_fp8(sp[(kk + 0) * 68], sp[(kk + 1) * 68], sp[(kk + 2) * 68], sp[(kk + 3) * 68]); }
            *(v4u*)(dst + 16 * c4) = o; }
    } else {
        unsigned char* dst = WT + ((size_t)(dst_row0 + lane) * K + k0) * 2;
#pragma unroll
        for (int c8 = 0; c8 < 8; ++c8) { v4u o;
#pragma unroll
            for (int e = 0; e < 4; ++e) { const int kk = 8 * c8 + 2 * e; o[e] = pk2(sp[kk * 68], sp[(kk + 1) * 68]); }
            *(v4u*)(dst + 16 * c8) = o; }
    }
    LDS_WAIT(); asm volatile("" ::: "memory");
}
__device__ __forceinline__ int dst_row_map(int kind, int n0) {
    if (kind == 1) { if (n0 >= 1536 && n0 < 2560) { const int i = (n0 - 1536) & 511, hi = (n0 - 1536) >> 9; return 1536 + 256 * (i >> 7) + 128 * hi + (i & 127); } return n0; }
    if (kind == 2) return 256 * (n0 >> 7) + (n0 & 127);
    if (kind == 3) return 256 * (n0 >> 7) + 128 + (n0 & 127);
    return n0;
}
__device__ __forceinline__ void conv_matrix_item(const float* W, int K, int N, bf16* WT, int kind, int item, LAS float* scr, int lane) {
    const int nblk = N / 64, kb = item / nblk, nb = item - kb * nblk;
    transpose_item64<false>(W, K, N, (unsigned char*)WT, dst_row_map(kind, 64 * nb), 64 * kb, 64 * nb, 1.0f, scr, lane);
}
__device__ __forceinline__ void conv_matrix_item_f8(const float* W, int K, int N, unsigned char* WT, int kind, int item, float scale, LAS float* scr, int lane) {
    const int nblk = N / 64, kb = item / nblk, nb = item - kb * nblk;
    transpose_item64<true>(W, K, N, WT, dst_row_map(kind, 64 * nb), 64 * kb, 64 * nb, scale, scr, lane);
}
__device__ __forceinline__ void p0a_prologue(Frame& F) {
    LAS float* scr = (LAS float*)(F.lds + F.wave * 17408);
    const int gw = F.vcu * NWAVES + F.wave, NGW = F.G * NWAVES;
    bf16* ws_win = (bf16*)(F.ws + WS_WIN); bf16* ws_outs = (bf16*)(F.ws + WS_WOUTS); bf16* ws_glu = (bf16*)(F.ws + WS_WGLU); bf16* ws_wo = (bf16*)(F.ws + WS_WO);
    bf16* ws_w13 = (bf16*)(F.ws + WS_W13); bf16* ws_w2 = (bf16*)(F.ws + WS_W2);
    constexpr int I_IN = (1024 / 64) * (6144 / 64), I_OUT = (512 / 64) * (1024 / 64), I_GLU = (512 / 64) * (512 / 64), I_WOI = (1024 / 64) * (1024 / 64), I_F1 = (1024 / 64) * (2816 / 64), I_F2 = (2816 / 64) * (1024 / 64);
    constexpr int NITEMS = 2 * I_IN + 6 * I_OUT + 2 * I_GLU + 2 * I_WOI + 2 * I_F1 + I_F2;
    for (int it = gw; it < NITEMS; it += NGW) {
        int r = it;
        if (r < 2 * I_IN) { const int l = r / I_IN; conv_matrix_item(inp(F, I_WIN) + (size_t)l * 1024 * 6144, 1024, 6144, ws_win + (size_t)l * 6144 * 1024, 1, r - l * I_IN, scr, F.lane); continue; } r -= 2 * I_IN;
        if (r < 6 * I_OUT) { const int q = r / I_OUT, l = q / 3, s = q - 3 * l; const float* src = inp(F, s == 0 ? I_WHY : (s == 1 ? I_WCF : I_WS5)) + (size_t)l * 512 * 1024;
            conv_matrix_item(src, 512, 1024, ws_outs + (size_t)(l * 3 + s) * 1024 * 512, 0, r - q * I_OUT, scr, F.lane); continue; } r -= 6 * I_OUT;
        if (r < 2 * I_GLU) { const int l = r / I_GLU; conv_matrix_item(inp(F, I_SWGLU) + (size_t)l * 512 * 512, 512, 512, ws_glu + (size_t)l * 512 * 512, 0, r - l * I_GLU, scr, F.lane); continue; } r -= 2 * I_GLU;
        if (r < 2 * I_WOI) { const int l = r / I_WOI; conv_matrix_item(inp(F, I_WO) + (size_t)l * 1024 * 1024, 1024, 1024, ws_wo + (size_t)l * 1024 * 1024, 0, r - l * I_WOI, scr, F.lane); continue; } r -= 2 * I_WOI;
        if (r < I_F1) { conv_matrix_item_f8(inp(F, I_FFW1), 1024, 2816, (unsigned char*)ws_w13, 2, r, 32.f, scr, F.lane); continue; } r -= I_F1;
        if (r < I_F1) { conv_matrix_item_f8(inp(F, I_FFW3), 1024, 2816, (unsigned char*)ws_w13, 3, r, 32.f, scr, F.lane); continue; } r -= I_F1;
        conv_matrix_item_f8(inp(F, I_FFW2), 2816, 1024, (unsigned char*)ws_w2, 0, r, 128.f, scr, F.lane);
    }
    __syncthreads();
    float* part = (float*)(F.ws + WS_HX);
    LAS float* sc = (LAS float*)F.lds;
    for (int it = F.vcu; it < 2 * 8 * 12; it += F.G) {
        const int l = it / 96, r = it - l * 96, ks = r / 12, nb = r - ks * 12;
        __syncthreads();
        for (int e = F.tid; e < 17 * 128; e += 512) { const int i = e >> 7, k = e & 127; const float cv = i < 16 ? inp(F, I_C)[i * 1024 + ks * 128 + k] : inp(F, I_CCTX)[ks * 128 + k]; sc[k * 20 + i] = siluf_(cv); }
        __syncthreads();
        const int n = nb * 512 + F.tid; const float* w = inp(F, I_WMOD) + (size_t)l * 1024 * 6144 + (size_t)(ks * 128) * 6144 + n;
        float acc[17];
#pragma unroll
        for (int i = 0; i < 17; ++i) acc[i] = 0.f;
        for (int k = 0; k < 128; ++k) { const float wv = w[(size_t)k * 6144];
#pragma unroll
            for (int i = 0; i < 17; ++i) acc[i] += sc[k * 20 + i] * wv; }
#pragma unroll
        for (int i = 0; i < 17; ++i) part[((size_t)(ks * 2 + l) * 17 + i) * 6144 + n] = acc[i];
    }
}
__device__ __forceinline__ void p0b_mods(Frame& F) {
    const float* part = (const float*)(F.ws + WS_HX); float* mods = (float*)(F.ws + WS_MODS);
    for (int e = F.vcu * 512 + F.tid; e < 2 * 17 * 6144; e += F.G * 512) {
        const int l = e / (17 * 6144), r = e - l * 17 * 6144, i = r / 6144, n = r - i * 6144;
        float s = inp(F, I_BMOD)[l * 6144 + n];
#pragma unroll
        for (int ks = 0; ks < 8; ++ks) s += part[((size_t)(ks * 2 + l) * 17 + i) * 6144 + n];
        mods[e] = s;
    }
}

__device__ __forceinline__ void h2table_phase(Frame& F, int l) {
    const int gw = F.vcu * NWAVES + F.wave, NGW = F.G * NWAVES, lane = F.lane;
    float* H2 = (float*)(F.ws + WS_FILT);
    const float* w1 = inp(F, I_FW1) + l * 33 * 64; const float* b1 = inp(F, I_FB1) + l * 64; const float* w2 = inp(F, I_FW2) + l * 64 * 64; const float* b2 = inp(F, I_FB2) + l * 64;
    const float* fq = inp(F, I_FREQ) + l * 128;
    for (int pos = gw; pos < LSEQ + LCTX; pos += NGW) {
        const bool isc = pos >= LSEQ; const int L = isc ? LCTX : LSEQ; const int t = isc ? pos - LSEQ : pos;
        const float tn = (float)t / (float)(L - 1);
        float z = 0.f;
        if (lane == 0) z = tn;
        else if (lane <= 32) { const int band = lane <= 16 ? lane : lane - 16; const int ph = (t * band) % L; const float ang = 6.283185307179586f * ((float)ph / (float)L); z = lane <= 16 ? cosf(ang) : sinf(ang); }
        float h = b1[lane];
        for (int k = 0; k < 33; ++k) h += lane_bcast(z, k) * w1[k * 64 + lane];
        h = sinf(fq[lane] * h);
        float h2 = b2[lane];
        for (int k = 0; k < 64; ++k) h2 += lane_bcast(h, k) * w2[k * 64 + lane];
        H2[(size_t)pos * 64 + lane] = sinf(fq[64 + lane] * h2);
    }
}
__device__ __forceinline__ void filter_expand_phase(Frame& F, int l) {
    const int gw = F.vcu * NWAVES + F.wave, NGW = F.G * NWAVES, lane = F.lane;
    const float* H2 = (const float*)(F.ws + WS_FILT);
    const float* w3 = inp(F, I_FW3) + (size_t)l * 64 * 2048; const float* b3 = inp(F, I_FB3) + l * 2048; const float* dec = inp(F, I_DECAY) + l * 2048; const float* hb = inp(F, I_HBIAS) + l * 1024;
    LAS float* W = (LAS float*)(F.lds + F.wave * 17408);
#pragma unroll 1
    for (int it = gw; it < 1024 + 128; it += NGW) {
        const bool isc = it >= 1024; const int ii = isc ? it - 1024 : it; const int chunk = ii >> 5, grp = ii & 31;
        const int L = isc ? LCTX : LSEQ; const int t = chunk * 64 + lane; const int pos = isc ? LSEQ + t : t;
        bf16* KR = isc ? (bf16*)(F.ws + WS_KRC) : (bf16*)(F.ws + WS_KRL); const int KLEN = 2 * L;
        const float tn = (float)t / (float)(L - 1);
#pragma unroll 4
        for (int k = 0; k < 64; ++k) W[lane * 68 + k] = w3[(size_t)k * 2048 + grp * 64 + lane];
        f32x4 h2[16];
#pragma unroll
        for (int k = 0; k < 16; ++k) h2[k] = *(const f32x4*)(H2 + (size_t)pos * 64 + 4 * k);
        const int colL = grp * 64 + lane; const float b3L = b3[colL], decL = fabsf(dec[colL]); const float hbL = ((colL >> 9) & 1) == 0 ? hb[(colL >> 10) * 512 + (colL & 511)] : 0.f;
        LDS_WAIT();
#pragma unroll 1
        for (int cc = 0; cc < 64; ++cc) {
            const int col = grp * 64 + cc; float a = lane_bcast(b3L, cc);
#pragma unroll
            for (int k = 0; k < 16; ++k) { const f32x4 wv = *(const LAS f32x4*)(W + cc * 68 + 4 * k); a += (h2[k][0] * wv[0] + h2[k][1] * wv[1]) + (h2[k][2] * wv[2] + h2[k][3] * wv[3]); }
            const int o = col >> 10, dir = (col >> 9) & 1, c = col & 511;
            float v = a * __expf(-tn * lane_bcast(decL, cc));
            if (t == 0 && dir == 0) v += lane_bcast(hbL, cc);
            const bool valid = !(t == 0 && dir == 1);
            const int i = dir ? L + t : L - t;
            const unsigned short bv = (unsigned short)f2bf(v);
            bf16* base = (valid ? KR + (size_t)((o * 512 + c) * 8) * KLEN : (bf16*)(F.ws + WS_KDUMMY) + 16) + i;
#pragma unroll
            for (int m = 0; m < 8; ++m) base[(ptrdiff_t)m * (KLEN - 1)] = bv;
        }
        LDS_WAIT();
    }
    __syncthreads();
}
__device__ __forceinline__ void s5params_phase(Frame& F, int l) {
    float* P = (float*)(F.ws + WS_S5P);
    for (int e = F.vcu * 512 + F.tid; e < 2 * 32 * 64; e += F.G * 512) {
        const int base = l * 4096 + e;
        const int dg = e >> 6;
        const float lam_re = fminf(inp(F, I_SARE)[base], -1e-4f), lam_im = inp(F, I_SAIM)[base];
        const float dt = expf(inp(F, I_SLDT)[l * 64 + dg]);
        const float mag = expf(lam_re * dt), ang = lam_im * dt; const float abr = mag * cosf(ang), abi = mag * sinf(ang);
        const float den = lam_re * lam_re + lam_im * lam_im;
        const float qre = ((abr - 1.0f) * lam_re + abi * lam_im) / den, qim = (abi * lam_re - (abr - 1.0f) * lam_im) / den;
        float* o = P + (size_t)e * 36; o[0] = abr; o[1] = abi;
        const float* br = inp(F, I_SBRE) + (size_t)base * 16; const float* bi = inp(F, I_SBIM) + (size_t)base * 16;
        for (int c = 0; c < 16; ++c) { o[2 + c] = qre * br[c] - qim * bi[c]; o[18 + c] = qre * bi[c] + qim * br[c]; }
        o[34] = 0.f; o[35] = 0.f;
    }
}

struct Row { f32x4 v[4]; };
__device__ __forceinline__ void row_load(Row& r, const float* p, int lane) { const f32x4* x = (const f32x4*)p + lane;
#pragma unroll
    for (int j = 0; j < 4; ++j) r.v[j] = x[64 * j]; }
__device__ __forceinline__ void row_store(const Row& r, float* p, int lane) { f32x4* x = (f32x4*)p + lane;
#pragma unroll
    for (int j = 0; j < 4; ++j) x[64 * j] = r.v[j]; }
__device__ __forceinline__ void row_norm(Row& r) {
    float s = 0.f;
#pragma unroll
    for (int j = 0; j < 4; ++j) s += (r.v[j][0] + r.v[j][1]) + (r.v[j][2] + r.v[j][3]);
    const float mean = wave_sum(s) * (1.f / DM); float q = 0.f;
#pragma unroll
    for (int j = 0; j < 4; ++j) { r.v[j] = r.v[j] - mean; q += (r.v[j][0] * r.v[j][0] + r.v[j][1] * r.v[j][1]) + (r.v[j][2] * r.v[j][2] + r.v[j][3] * r.v[j][3]); }
    const float rstd = 1.f / sqrtf(wave_sum(q) * (1.f / DM) + LN_EPS);
#pragma unroll
    for (int j = 0; j < 4; ++j) r.v[j] = r.v[j] * rstd;
}
__device__ __forceinline__ void row_affine(Row& r, const float* g, const float* b, int lane, float gadd) {
    const f32x4* gp = (const f32x4*)g + lane; const f32x4* bp = (const f32x4*)b + lane;
#pragma unroll
    for (int j = 0; j < 4; ++j) r.v[j] = r.v[j] * (gp[64 * j] + gadd) + bp[64 * j];
}
struct Vec8 { f32x4 g[4], b[4]; };
__device__ __forceinline__ void vec8_load(Vec8& v, const float* g, const float* b, int lane) { const f32x4* gp = (const f32x4*)g + lane; const f32x4* bp = (const f32x4*)b + lane;
#pragma unroll
    for (int j = 0; j < 4; ++j) { v.g[j] = gp[64 * j]; v.b[j] = bp[64 * j]; } }
__device__ __forceinline__ void row_affine_reg(Row& r, const Vec8& v, float gadd) {
#pragma unroll
    for (int j = 0; j < 4; ++j) r.v[j] = r.v[j] * (v.g[j] + gadd) + v.b[j]; }
__device__ __forceinline__ int row_batch(int row) { return row < NX ? (row >> 11) : 16; }
__device__ __forceinline__ void row_store_bf16(const Row& r, bf16* p, int lane) { unsigned long long* o = (unsigned long long*)p + lane;
#pragma unroll
    for (int j = 0; j < 4; ++j) o[64 * j] = (unsigned long long)pk2(r.v[j][0], r.v[j][1]) | ((unsigned long long)pk2(r.v[j][2], r.v[j][3]) << 32); }

__device__ __forceinline__ const float* mod_vec(Frame& F, int l, int row, int which) { const int i = row < NX ? (row >> 11) : 16; return (const float*)(F.ws + WS_MODS) + ((size_t)l * 17 + i) * INC + which * 1024; }
__device__ __forceinline__ const float* xrow_ptr(Frame& F, int l, int row) {
    if (l == 0) return row < NX ? inp(F, I_X) + (size_t)row * DM : inp(F, I_CTX) + (size_t)(row - NX) * DM;
    return row < NX ? F.out + (size_t)row * DM : (const float*)(F.ws + WS_XC) + (size_t)(row - NX) * DM;
}
__device__ __forceinline__ float* xcur_ptr(Frame& F, int row) { return row < NX ? F.out + (size_t)row * DM : (float*)(F.ws + WS_XC) + (size_t)(row - NX) * DM; }

__device__ __forceinline__ void lnmod_phase(Frame& F, int l) {
    const int gw = F.vcu * NWAVES + F.wave, NGW = F.G * NWAVES; bf16* hx = (bf16*)(F.ws + WS_HX);
    const int m0 = (int)((long)RT * gw / NGW), m1 = (int)((long)RT * (gw + 1) / NGW); Vec8 md; int cb = -1;
    for (int m = m0; m < m1; ++m) { if (row_batch(m) != cb) { cb = row_batch(m); vec8_load(md, mod_vec(F, l, m, 1), mod_vec(F, l, m, 0), F.lane); }
        Row r; row_load(r, xrow_ptr(F, l, m), F.lane); row_norm(r); row_affine_reg(r, md, 1.0f); row_store_bf16(r, hx + (size_t)m * DM, F.lane); }
}
__device__ __forceinline__ void ln1_phase(Frame& F, int l) {
    const int gw = F.vcu * NWAVES + F.wave, NGW = F.G * NWAVES; bf16* hx = (bf16*)(F.ws + WS_HX); const int M = l == 0 ? RT : NX;
    const float* g = inp(F, I_LN1G) + l * DM; const float* b = inp(F, I_LN1B) + l * DM;
    int* toke = (int*)(F.ws + WS_META + META_TOKE); float* tokw = (float*)(F.ws + WS_META + META_TOKW);
    LAS unsigned* lcnt = (LAS unsigned*)(F.lds);
    unsigned c8[8];
#pragma unroll
    for (int e = 0; e < 8; ++e) c8[e] = 0u;
    if (l == 1) { if (F.tid < 8) lcnt[F.tid] = 0u; __syncthreads(); }
    f32x4 rtr[4][4][2];
    if (l == 1) { const float* rt = inp(F, I_ROUTER);
#pragma unroll
        for (int j = 0; j < 4; ++j)
#pragma unroll
            for (int q = 0; q < 4; ++q) { const int k = 256 * j + 4 * F.lane + q; rtr[j][q][0] = *(const f32x4*)(rt + k * 8); rtr[j][q][1] = *(const f32x4*)(rt + k * 8 + 4); } }
    Vec8 ln; vec8_load(ln, g, b, F.lane); Vec8 md; int cb = -1;
    const int m0 = (int)((long)M * gw / NGW), m1 = (int)((long)M * (gw + 1) / NGW);
    for (int m = m0; m < m1; ++m) {
        if (row_batch(m) != cb) { cb = row_batch(m); vec8_load(md, mod_vec(F, l, m, 4), mod_vec(F, l, m, 3), F.lane); }
        float* xp = xcur_ptr(F, m); Row r; row_load(r, xp, F.lane); row_norm(r); row_affine_reg(r, ln, 0.0f); row_store(r, xp, F.lane);
        row_norm(r); row_affine_reg(r, md, 1.0f);
        if (l == 0) { unsigned* d8 = (unsigned*)((unsigned char*)hx + (size_t)m * DM) + F.lane;
#pragma unroll
            for (int j = 0; j < 4; ++j) d8[64 * j] = pk4_fp8(r.v[j][0], r.v[j][1], r.v[j][2], r.v[j][3]); }
        else {
            float lg[8];
#pragma unroll
            for (int e = 0; e < 8; ++e) lg[e] = 0.f;
#pragma unroll
            for (int j = 0; j < 4; ++j)
#pragma unroll
                for (int q = 0; q < 4; ++q) { const f32x4 r0 = rtr[j][q][0], r1 = rtr[j][q][1]; const float hv = r.v[j][q];
                    lg[0] += hv * r0[0]; lg[1] += hv * r0[1]; lg[2] += hv * r0[2]; lg[3] += hv * r0[3]; lg[4] += hv * r1[0]; lg[5] += hv * r1[1]; lg[6] += hv * r1[2]; lg[7] += hv * r1[3]; }
#pragma unroll
            for (int e = 0; e < 8; ++e) lg[e] = wave_sum(lg[e]);
            int e0 = 0; float v0 = lg[0];
#pragma unroll
            for (int e = 1; e < 8; ++e) if (lg[e] > v0) { v0 = lg[e]; e0 = e; }
            int e1 = -1; float v1 = -3.0e38f;
#pragma unroll
            for (int e = 0; e < 8; ++e) if (e != e0 && lg[e] > v1) { v1 = lg[e]; e1 = e; }
            const float ex = __expf(v1 - v0); const float w0 = 1.0f / (1.0f + ex), w1 = ex / (1.0f + ex);
            if (F.lane == 0) { toke[2 * m] = e0; toke[2 * m + 1] = e1; tokw[2 * m] = w0; tokw[2 * m + 1] = w1; }
#pragma unroll
            for (int e = 0; e < 8; ++e) c8[e] += (e0 == e ? 1u : 0u) + (e1 == e ? 1u : 0u);
        }
    }
    if (l == 1) {
        if (F.lane == 0) {
#pragma unroll
            for (int e = 0; e < 8; ++e) if (c8[e]) atomicAdd((unsigned*)&lcnt[e], c8[e]); }
        __syncthreads();
        if (F.tid < 8) { const unsigned v = lcnt[F.tid]; if (v) atomicAdd((unsigned*)(F.ws + WS_CTL) + CW_CNT + F.tid, v); }
        __syncthreads();
    }
}
__device__ __forceinline__ void ln2_phase(Frame& F, int l) {
    const int gw = F.vcu * NWAVES + F.wave, NGW = F.G * NWAVES;
    Vec8 ln; vec8_load(ln, inp(F, I_LN2G) + l * DM, inp(F, I_LN2B) + l * DM, F.lane);
    const int m0 = (int)((long)RT * gw / NGW), m1 = (int)((long)RT * (gw + 1) / NGW);
    for (int m = m0; m < m1; ++m) { float* xp = xcur_ptr(F, m); Row r; row_load(r, xp, F.lane); row_norm(r); row_affine_reg(r, ln, 0.0f); row_store(r, xp, F.lane); }
}

__device__ __forceinline__ void moe_convert_phase(Frame& F) {
    LAS float* scr = (LAS float*)(F.lds + 4096 + F.wave * 17408);
    const int gw = F.vcu * NWAVES + F.wave, NGW = F.G * NWAVES;
    unsigned char* w13 = F.ws + WS_MW13; unsigned char* w2 = F.ws + WS_MW2;
    constexpr int I1 = (1024 / 64) * (3584 / 64), I2 = (3584 / 64) * (1024 / 64);
    for (int it = gw; it < 8 * (2 * I1 + I2); it += NGW) {
        const int e = it / (2 * I1 + I2); int r = it - e * (2 * I1 + I2);
        if (r < I1) { conv_matrix_item_f8(inp(F, I_MW1) + (size_t)e * 1024 * 3584, 1024, 3584, w13 + (size_t)e * 7168 * 1024, 2, r, 32.f, scr, F.lane); continue; } r -= I1;
        if (r < I1) { conv_matrix_item_f8(inp(F, I_MW3) + (size_t)e * 1024 * 3584, 1024, 3584, w13 + (size_t)e * 7168 * 1024, 3, r, 32.f, scr, F.lane); continue; } r -= I1;
        conv_matrix_item_f8(inp(F, I_MW2) + (size_t)e * 3584 * 1024, 3584, 1024, w2 + (size_t)e * 1024 * 3584, 0, r, 128.f, scr, F.lane);
    }
}
__device__ __forceinline__ void moe_offsets(Frame& F, int (&off)[8], int& ntiles) {
    const unsigned* cnt = (const unsigned*)(F.ws + WS_CTL) + CW_CNT; int o = 0;
#pragma unroll
    for (int e = 0; e < 8; ++e) { off[e] = o; o += (int)((cnt[e] + 255u) & ~255u); }
    ntiles = o >> 8;
}
__device__ __forceinline__ void moe_setup_phase(Frame& F) {
    const int gw = F.vcu * NWAVES + F.wave, NGW = F.G * NWAVES, lane = F.lane;
    int off[8], ntiles; moe_offsets(F, off, ntiles);
    const int* toke = (const int*)(F.ws + WS_META + META_TOKE); int* tpos = (int*)(F.ws + WS_META + META_POS); int* tile_e = (int*)(F.ws + WS_META + META_TILE);
    unsigned* cur = (unsigned*)(F.ws + WS_CTL) + CW_CUR; unsigned char* srt = F.ws + WS_SORT;
    if (F.vcu == 0 && F.tid < 8) { const int e = F.tid; const int t0 = off[e] >> 8; const int t1 = (e == 7 ? ntiles : (off[e + 1] >> 8)); for (int t = t0; t < t1; ++t) tile_e[t] = e; if (e == 0) tile_e[511] = ntiles; }
    const int mb = (int)((long)NX * gw / NGW), me = (int)((long)NX * (gw + 1) / NGW);
    for (int base = mb; base < me; base += 64) {
        const int m = base + lane; const bool act = m < me;
        const int e0 = act ? toke[2 * m] : -1, e1 = act ? toke[2 * m + 1] : -1;
        int p0 = 0, p1 = 0;
        const unsigned long long lt = (1ull << lane) - 1ull;
#pragma unroll
        for (int e = 0; e < 8; ++e) {
            const unsigned long long m0 = __ballot(e0 == e), m1 = __ballot(e1 == e);
            const int c = __popcll(m0) + __popcll(m1); int bs = 0;
            if (lane == 0 && c) bs = (int)atomicAdd(cur + e, (unsigned)c);
            bs = __builtin_amdgcn_readfirstlane(bs) + off[e];
            if (e0 == e) p0 = bs + __popcll(m0 & lt);
            if (e1 == e) p1 = bs + __popcll(m0) + __popcll(m1 & lt);
        }
        if (act) { tpos[2 * m] = p0; tpos[2 * m + 1] = p1; }
        const int nrows = me - base < 64 ? me - base : 64; Vec8 md; int cb = -1;
        for (int i = 0; i < nrows; ++i) {
            const int mi = base + i; const int q0 = __builtin_amdgcn_readlane(p0, i), q1 = __builtin_amdgcn_readlane(p1, i);
            if (row_batch(mi) != cb) { cb = row_batch(mi); vec8_load(md, mod_vec(F, 1, mi, 4), mod_vec(F, 1, mi, 3), lane); }
            Row r; row_load(r, F.out + (size_t)mi * DM, lane); row_norm(r); row_affine_reg(r, md, 1.0f);
            unsigned* d0 = (unsigned*)(srt + (size_t)q0 * DM) + lane; unsigned* d1 = (unsigned*)(srt + (size_t)q1 * DM) + lane;
#pragma unroll
            for (int j = 0; j < 4; ++j) { const unsigned w8 = pk4_fp8(r.v[j][0], r.v[j][1], r.v[j][2], r.v[j][3]); d0[64 * j] = w8; d1[64 * j] = w8; }
        }
    }
}
__device__ __forceinline__ void moe_combine_phase(Frame& F) {
    const int gw = F.vcu * NWAVES + F.wave, NGW = F.G * NWAVES, lane = F.lane;
    const float* tokw = (const float*)(F.ws + WS_META + META_TOKW); const int* tpos = (const int*)(F.ws + WS_META + META_POS); const bf16* Y = (const bf16*)(F.ws + WS_MOEY);
    Vec8 ln; vec8_load(ln, inp(F, I_LN2G) + DM, inp(F, I_LN2B) + DM, lane);
    const int mb = (int)((long)NX * gw / NGW), me = (int)((long)NX * (gw + 1) / NGW); f32x4 g2[4]; int cb = -1;
    for (int m = mb; m < me; ++m) {
        if (row_batch(m) != cb) { cb = row_batch(m); const f32x4* gp = (const f32x4*)mod_vec(F, 1, m, 5) + lane;
#pragma unroll
            for (int j = 0; j < 4; ++j) g2[j] = gp[64 * j]; }
        const float w0 = tokw[2 * m], w1 = tokw[2 * m + 1]; const int p0 = tpos[2 * m], p1 = tpos[2 * m + 1];
        Row r; row_load(r, F.out + (size_t)m * DM, lane);
        const unsigned long long* y0 = (const unsigned long long*)(Y + (size_t)p0 * DM) + lane; const unsigned long long* y1 = (const unsigned long long*)(Y + (size_t)p1 * DM) + lane;
#pragma unroll
        for (int j = 0; j < 4; ++j) { const unsigned long long a = y0[64 * j], c = y1[64 * j];
            const f32x4 ya = (f32x4){bflo((unsigned)a), bfhi((unsigned)a), bflo((unsigned)(a >> 32)), bfhi((unsigned)(a >> 32))};
            const f32x4 yc = (f32x4){bflo((unsigned)c), bfhi((unsigned)c), bflo((unsigned)(c >> 32)), bfhi((unsigned)(c >> 32))};
            r.v[j] = r.v[j] * ALPHA_F + g2[j] * (ya * w0 + yc * w1); }
        row_norm(r); row_affine_reg(r, ln, 0.0f); row_store(r, F.out + (size_t)m * DM, lane);
    }
}

constexpr int HY_U_OFF = 0, HY_U_STRIDE = 4128, HY_K_OFF = 16 * HY_U_STRIDE, HY_K_STRIDE = 8208;
constexpr int HYC_U_STRIDE = 544, HYC_K_STRIDE = 1040;
static_assert(HY_K_OFF + 8 * HY_K_STRIDE + 64 <= MISC_OFF, "hyena LDS map");
__device__ __forceinline__ float hy_short4(const bf16* p, int tb, int L, float w0, float w1, float w2, float bs, f32x4& x) {
    const v2u pw = *(const v2u*)(p + tb); const float c0 = bflo(pw.x), c1 = bfhi(pw.x), c2 = bflo(pw.y), c3 = bfhi(pw.y);
    const float pm = tb > 0 ? bf2f(p[tb - 1]) : 0.f, pp = tb + 4 < L ? bf2f(p[tb + 4]) : 0.f;
    x[0] = bs + w0 * pm + w1 * c0 + w2 * c1; x[1] = bs + w0 * c0 + w1 * c1 + w2 * c2; x[2] = bs + w0 * c1 + w1 * c2 + w2 * c3; x[3] = bs + w0 * c2 + w1 * c3 + w2 * pp; return 0.f;
}
__device__ __forceinline__ void hy_short4u(const bf16* pi, bool first, bool last, float w0, float w1, float w2, float bs, f32x4& x) {
    const v2u pw = *(const v2u*)pi; const float c0 = bflo(pw.x), c1 = bfhi(pw.x), c2 = bflo(pw.y), c3 = bfhi(pw.y);
    float pm = bf2f(pi[-1]), pp = bf2f(pi[4]); pm = first ? 0.f : pm; pp = last ? 0.f : pp;
    x[0] = bs + w0 * pm + w1 * c0 + w2 * c1; x[1] = bs + w0 * c0 + w1 * c1 + w2 * c2; x[2] = bs + w0 * c1 + w1 * c2 + w2 * c3; x[3] = bs + w0 * c2 + w1 * c3 + w2 * pp;
}
template <int L, int USTR>
__device__ __forceinline__ void hy_fill_u(Frame& F, const bf16* phyT, int col, int rowb0, float w0, float w1, float w2, float bs) {
    const bf16* pc = phyT + (size_t)col * RT + rowb0;
    constexpr int NIT = 16 * L / 8 / 512 > 0 ? 16 * L / 8 / 512 : 1;
#pragma unroll 4
    for (int it = 0; it < NIT; ++it) { const int ch = F.tid + 512 * it; const int b = ch / (L / 8), tb = (ch - b * (L / 8)) * 8; const bf16* p = pc + (size_t)b * L + tb;
        const v4u cw = *(const v4u*)p; float pm = bf2f(p[-1]), pp = bf2f(p[8]); pm = tb == 0 ? 0.f : pm; pp = tb + 8 >= L ? 0.f : pp;
        const float c0 = bflo(cw.x), c1 = bfhi(cw.x), c2 = bflo(cw.y), c3 = bfhi(cw.y), c4 = bflo(cw.z), c5 = bfhi(cw.z), c6 = bflo(cw.w), c7 = bfhi(cw.w);
        v4u o; o.x = pk2(bs + w0 * pm + w1 * c0 + w2 * c1, bs + w0 * c0 + w1 * c1 + w2 * c2); o.y = pk2(bs + w0 * c1 + w1 * c2 + w2 * c3, bs + w0 * c2 + w1 * c3 + w2 * c4);
        o.z = pk2(bs + w0 * c3 + w1 * c4 + w2 * c5, bs + w0 * c4 + w1 * c5 + w2 * c6); o.w = pk2(bs + w0 * c5 + w1 * c6 + w2 * c7, bs + w0 * c6 + w1 * c7 + w2 * pp);
        *(LAS v4u*)(F.lds + HY_U_OFF + b * USTR + tb * 2) = o; }
}
template <int KLEN, int KSTR>
__device__ __forceinline__ void hy_fill_k(Frame& F, const bf16* kr) {
    const bf16* src = kr + (size_t)F.wave * KLEN + F.lane * 8;
#pragma unroll
    for (int i = 0; i < KLEN * 2 / 1024; ++i)
        __builtin_amdgcn_global_load_lds((const unsigned*)(src + i * 512), (LAS unsigned*)(F.lds + HY_K_OFF + F.wave * KSTR + i * 1024), 16, 0, 0);
    VM_WAIT();
}
__device__ __forceinline__ void hyena_unit(Frame& F, int l, int c, bool with_ctx) {
    const bf16* phyT = (const bf16*)(F.ws + WS_PHYT); bf16* z2 = (bf16*)(F.ws + WS_Z2);
    const bf16* KRL = (const bf16*)(F.ws + WS_KRL); const bf16* KRC = (const bf16*)(F.ws + WS_KRC);
    const float* sw = inp(F, I_HSW) + l * 3 * 1536; const float* sb = inp(F, I_HSB) + l * 1536;
    const int lane = F.lane, w = F.wave, r = lane & 15, q = lane >> 4, m = (-r) & 7;
    __syncthreads();
    { const int col = 1024 + c; hy_fill_u<LSEQ, HY_U_STRIDE>(F, phyT, col, 0, sw[col], sw[1536 + col], sw[3072 + col], sb[col]); }
    hy_fill_k<4096, HY_K_STRIDE>(F, KRL + (size_t)((0 * 512 + c) * 8) * 4096);
    __syncthreads();
#pragma unroll 1
    for (int o = 0; o < 2; ++o) {
        f32x4 acc[16];
#pragma unroll 1
        for (int rep_ = 0; rep_ < NREP(15); ++rep_) {
#pragma unroll
        for (int i = 0; i < 16; ++i) acc[i] = (f32x4){0.f, 0.f, 0.f, 0.f};
        const LAS unsigned char* pa = F.lds + HY_K_OFF + m * HY_K_STRIDE + 2 * (8 * q - r - m + 2048 - 256 * w);
        const LAS unsigned char* pb = F.lds + HY_U_OFF + r * HY_U_STRIDE + 16 * q;
        bf16x8 R[16];
#pragma unroll
        for (int i = 0; i < 16; ++i) R[i] = *(const LAS bf16x8*)(pa - 32 * i);
        bf16x8 bcur = *(const LAS bf16x8*)pb;
#pragma unroll 1
        for (int kg = 0; kg < 8; ++kg) {
#pragma unroll
            for (int kk = 0; kk < 8; ++kk) {
                const bf16x8 bnext = *(const LAS bf16x8*)(pb + 64 * (kk + 1));
                const bf16x8 n0 = *(const LAS bf16x8*)(pa + 64 * (kk + 1)), n1 = *(const LAS bf16x8*)(pa + 64 * (kk + 1) - 32);
#pragma unroll
                for (int i = 0; i < 16; ++i) acc[i] = __builtin_amdgcn_mfma_f32_16x16x32_bf16(R[(i - 2 * kk) & 15], bcur, acc[i], 0, 0, 0);
                R[(-2 * (kk + 1)) & 15] = n0; R[(1 - 2 * (kk + 1)) & 15] = n1; bcur = bnext;
                __builtin_amdgcn_sched_barrier(0);
            }
            pa += 512; pb += 512;
        }
        }
        const int col = o * 512 + c; const float w0 = sw[col], w1 = sw[1536 + col], w2 = sw[3072 + col], bs = sb[col];
        int tb0 = 256 * w + 4 * q; asm volatile("" : "+v"(tb0));
        const bf16* p = phyT + (size_t)col * RT + (size_t)r * LSEQ + tb0;
#pragma unroll
        for (int i = 0; i < 16; ++i) { f32x4 x; hy_short4u(p + 16 * i, tb0 + 16 * i == 0, tb0 + 16 * i + 4 >= LSEQ, w0, w1, w2, bs, x); acc[i] = acc[i] * x; }
        if (o == 0) {
            __syncthreads();
#pragma unroll
            for (int i = 0; i < 16; ++i) { v2u zw; zw.x = pk2(acc[i][0], acc[i][1]); zw.y = pk2(acc[i][2], acc[i][3]); *(LAS v2u*)(F.lds + HY_U_OFF + r * HY_U_STRIDE + (tb0 + 16 * i) * 2) = zw; }
            hy_fill_k<4096, HY_K_STRIDE>(F, KRL + (size_t)((1 * 512 + c) * 8) * 4096);
            __syncthreads();
        } else {
#pragma unroll
            for (int i = 0; i < 16; ++i) { bf16* zp = z2 + (size_t)(r * LSEQ + tb0 + 16 * i) * 512 + c; asm volatile("" : "+v"(zp));
#pragma unroll
                for (int e = 0; e < 4; ++e) zp[e * 512] = (bf16)f2bf(acc[i][e]); }
        }
    }
    if (!with_ctx) return;
    __syncthreads();
    { const int col = 1024 + c; hy_fill_u<LCTX, HYC_U_STRIDE>(F, phyT, col, NX, sw[col], sw[1536 + col], sw[3072 + col], sb[col]); }
    hy_fill_k<512, HYC_K_STRIDE>(F, KRC + (size_t)((0 * 512 + c) * 8) * 512);
    __syncthreads();
#pragma unroll 1
    for (int o = 0; o < 2; ++o) {
        f32x4 acc[2];
        acc[0] = (f32x4){0.f, 0.f, 0.f, 0.f}; acc[1] = acc[0];
        const LAS unsigned char* pa = F.lds + HY_K_OFF + m * HYC_K_STRIDE + 2 * (8 * q - r - m + 256 - 32 * w);
        const LAS unsigned char* pb = F.lds + HY_U_OFF + r * HYC_U_STRIDE + 16 * q;
#pragma unroll
        for (int k = 0; k < 8; ++k) { const bf16x8 bfr = *(const LAS bf16x8*)(pb + 64 * k);
#pragma unroll
            for (int i = 0; i < 2; ++i) acc[i] = __builtin_amdgcn_mfma_f32_16x16x32_bf16(*(const LAS bf16x8*)(pa + 64 * k - 32 * i), bfr, acc[i], 0, 0, 0); }
        const int col = o * 512 + c; const float w0 = sw[col], w1 = sw[1536 + col], w2 = sw[3072 + col], bs = sb[col];
        int tb0 = 32 * w + 4 * q; asm volatile("" : "+v"(tb0));
        const bf16* p = phyT + (size_t)col * RT + NX + (size_t)r * LCTX + tb0;
#pragma unroll
        for (int i = 0; i < 2; ++i) { f32x4 x; hy_short4u(p + 16 * i, tb0 + 16 * i == 0, tb0 + 16 * i + 4 >= LCTX, w0, w1, w2, bs, x); acc[i] = acc[i] * x; }
        if (o == 0) {
            __syncthreads();
#pragma unroll
            for (int i = 0; i < 2; ++i) { v2u zw; zw.x = pk2(acc[i][0], acc[i][1]); zw.y = pk2(acc[i][2], acc[i][3]); *(LAS v2u*)(F.lds + HY_U_OFF + r * HYC_U_STRIDE + (tb0 + 16 * i) * 2) = zw; }
            hy_fill_k<512, HYC_K_STRIDE>(F, KRC + (size_t)((1 * 512 + c) * 8) * 512);
            __syncthreads();
        } else {
#pragma unroll
            for (int i = 0; i < 2; ++i)
#pragma unroll
                for (int e = 0; e < 4; ++e) z2[(size_t)(NX + r * LCTX + tb0 + 16 * i + e) * 512 + c] = (bf16)f2bf(acc[i][e]);
        }
    }
}

__device__ __forceinline__ void cf_unit(Frame& F, int l, int seqrow, int seqlen, int t0) {
    LAS bf16* U = (LAS bf16*)F.lds;
    LAS float* O = (LAS float*)(F.lds + 98304);
    const bf16* ucf = (const bf16*)(F.ws + WS_UCF); bf16* out = (bf16*)(F.ws + WS_UCF2);
    __syncthreads();
    for (int pc = F.tid; pc < 94 * 64; pc += 512) { const int i = pc >> 6, ch = pc & 63; const int t = t0 - 15 + i;
        v4u w = (v4u){0u, 0u, 0u, 0u}; if (t >= 0 && t < seqlen) w = *(const v4u*)(ucf + (size_t)(seqrow + t) * 512 + ch * 8);
        *(LAS v4u*)(U + i * 512 + ch * 8) = w; }
    const int c = F.tid;
    float w[31];
#pragma unroll
    for (int k = 0; k < 31; ++k) w[k] = inp(F, I_CFW)[(size_t)l * 31 * 512 + k * 512 + c];
    const float bias = inp(F, I_CFB)[l * 512 + c];
    const f32x4 g0 = *((const f32x4*)(inp(F, I_CFG) + l * 512) + F.lane), g1 = *((const f32x4*)(inp(F, I_CFG) + l * 512) + 64 + F.lane);
    const f32x4 b0 = *((const f32x4*)(inp(F, I_CFLB) + l * 512) + F.lane), b1 = *((const f32x4*)(inp(F, I_CFLB) + l * 512) + 64 + F.lane);
    __syncthreads();
#pragma unroll 1
    for (int r = 0; r < 4; ++r) {
        float v[16];
#pragma unroll
        for (int t = 0; t < 16; ++t) v[t] = bias;
        const LAS bf16* Ur = U + (16 * r) * 512 + c;
#pragma unroll
        for (int ii = 0; ii < 46; ++ii) { const float x = bf2f(Ur[ii * 512]);
#pragma unroll
            for (int t = 0; t < 16; ++t) { if (ii - t >= 0 && ii - t <= 30) v[t] += w[ii - t] * x; } }
#pragma unroll
        for (int t = 0; t < 16; ++t) O[t * 512 + c] = v[t];
        __syncthreads();
#pragma unroll
        for (int q = 0; q < 2; ++q) {
            const int tt = 2 * F.wave + q;
            f32x4 x0 = *((const LAS f32x4*)(O + tt * 512) + F.lane), x1 = *((const LAS f32x4*)(O + tt * 512) + 64 + F.lane);
            const float mean = wave_sum((x0[0] + x0[1]) + (x0[2] + x0[3]) + (x1[0] + x1[1]) + (x1[2] + x1[3])) * (1.f / 512.f);
            x0 = x0 - mean; x1 = x1 - mean;
            const float var = wave_sum((x0[0] * x0[0] + x0[1] * x0[1]) + (x0[2] * x0[2] + x0[3] * x0[3]) + (x1[0] * x1[0] + x1[1] * x1[1]) + (x1[2] * x1[2] + x1[3] * x1[3])) * (1.f / 512.f);
            const float rstd = 1.f / sqrtf(var + LN_EPS);
            f32x4 y0 = x0 * rstd * g0 + b0, y1 = x1 * rstd * g1 + b1;
#pragma unroll
            for (int j = 0; j < 4; ++j) { y0[j] = siluf_(y0[j]); y1[j] = siluf_(y1[j]); }
            bf16* orow = out + (size_t)(seqrow + t0 + 16 * r + tt) * 512;
            v2u o0, o1; o0.x = pk2(y0[0], y0[1]); o0.y = pk2(y0[2], y0[3]); o1.x = pk2(y1[0], y1[1]); o1.y = pk2(y1[2], y1[3]);
            *((v2u*)orow + F.lane) = o0; *((v2u*)orow + 64 + F.lane) = o1;
        }
        __syncthreads();
    }
}

__device__ __forceinline__ void s5_unit(Frame& F, int l, int b, int gp) {
    const int lane = F.lane, w = F.wave;
    bf16* ps5 = (bf16*)(F.ws + WS_PS5); bf16* ydir = (bf16*)(F.ws + WS_YDIR);
    __syncthreads();
#pragma unroll 1
    for (int rep_ = 0; rep_ < NREP(14); ++rep_)
    {
        const int gd = w & 3, role = w >> 2;
        const int g = 2 * gp + (gd >> 1), dir = gd & 1;
        const int r = lane & 15, q = lane >> 4;
        LAS unsigned char* wl = F.lds + gd * 32768;
        LAS unsigned char* uS0 = wl;
        LAS float* BuS0 = (LAS float*)(wl + 2560);
        LAS unsigned char* stS0 = wl + 2560 + 2 * 10240;
        constexpr int NCH = (LCTX + LSEQ) / 16;
        const float* P = (const float*)(F.ws + WS_S5P) + (size_t)((dir * 32 + g) * 64) * 36;
        float abr = 0.f, abi = 0.f; f32x2 s2 = (f32x2){0.f, 0.f}, Aa = s2, Bn = s2;
        bf16x8 Bf[8], Cf[4];
        const int ti = lane >> 2, cq = lane & 3;
        auto urow = [&](int k) -> size_t { const bool isc = k < LCTX / 16; const int kk = isc ? k : k - LCTX / 16; const int Ls = isc ? LCTX : LSEQ; const int rowb = isc ? NX + b * LCTX : b * LSEQ;
            const int st = kk * 16 + ti; const int t = dir ? (Ls - 1 - st) : st; return (size_t)(rowb + t) * 512 + g * 16 + 4 * cq; };
        v2u unext = (v2u){0u, 0u};
        if (role == 0) { abr = P[lane * 36]; abi = P[lane * 36 + 1]; Aa = (f32x2){abr, abr}; Bn = (f32x2){-abi, abi}; }
        else {
#pragma unroll
            for (int blk = 0; blk < 8; ++blk) { const int pp = 16 * blk + r; const float* src = P + (size_t)(pp & 63) * 36 + (pp < 64 ? 2 : 18) + 8 * (q & 1);
                v4u t4; t4.x = pk2(src[0], src[1]); t4.y = pk2(src[2], src[3]); t4.z = pk2(src[4], src[5]); t4.w = pk2(src[6], src[7]);
                if (q >= 2) t4 = (v4u){0u, 0u, 0u, 0u};
                Bf[blk] = __builtin_bit_cast(bf16x8, t4); }
            const float* cre = inp(F, I_SCRE) + (size_t)(((l * 2 + dir) * 32 + g) * 16) * 64; const float* cim = inp(F, I_SCIM) + (size_t)(((l * 2 + dir) * 32 + g) * 16) * 64;
#pragma unroll
            for (int ks = 0; ks < 4; ++ks) { const int p0 = 16 * ks + 4 * q; const f32x4 a = *(const f32x4*)(cre + r * 64 + p0), c4 = *(const f32x4*)(cim + r * 64 + p0);
                v4u t4; t4.x = pk2(a[0], -c4[0]); t4.y = pk2(a[1], -c4[1]); t4.z = pk2(a[2], -c4[2]); t4.w = pk2(a[3], -c4[3]);
                Cf[ks] = __builtin_bit_cast(bf16x8, t4); }
            for (int e = lane; e < 2 * 16 * 20; e += 64) ((LAS unsigned*)uS0)[e] = 0u;
            LDS_WAIT();
            *(LAS v2u*)(uS0 + ti * 80 + 8 * cq) = *(const v2u*)(ps5 + urow(0));
            unext = *(const v2u*)(ps5 + urow(1));
        }
        LDS_WAIT(); __builtin_amdgcn_s_barrier(); asm volatile("" ::: "memory");
#pragma unroll 1
        for (int k = 0; k < NCH + 2; ++k) {
            const int p0 = k & 1, p1 = p0 ^ 1;
            if (role == 1) {
                bf16x8 ua, sf[4];
                if (k < NCH) ua = *(const LAS bf16x8*)(uS0 + p0 * 1280 + r * 80 + 16 * q);
                if (k >= 2) {
#pragma unroll
                    for (int ks = 0; ks < 4; ++ks) sf[ks] = *(const LAS bf16x8*)(stS0 + p0 * 4352 + r * 272 + 64 * ks + 16 * q); }
                if (k + 1 < NCH) { *(LAS v2u*)(uS0 + p1 * 1280 + ti * 80 + 8 * cq) = unext; if (k + 2 < NCH) unext = *(const v2u*)(ps5 + urow(k + 2)); }
                if (k < NCH) {
#pragma unroll
                    for (int blk = 0; blk < 8; ++blk) { const f32x4 d = __builtin_amdgcn_mfma_f32_16x16x32_bf16(ua, Bf[blk], (f32x4){0.f, 0.f, 0.f, 0.f}, 0, 0, 0);
                        *(LAS f32x4*)(BuS0 + p0 * 2560 + (16 * blk + r) * 20 + 4 * q) = d; }
                }
                if (k >= 2) {
                    f32x4 y0 = __builtin_amdgcn_mfma_f32_16x16x32_bf16(sf[0], Cf[0], (f32x4){0.f, 0.f, 0.f, 0.f}, 0, 0, 0), y1 = __builtin_amdgcn_mfma_f32_16x16x32_bf16(sf[1], Cf[1], (f32x4){0.f, 0.f, 0.f, 0.f}, 0, 0, 0);
                    y0 = __builtin_amdgcn_mfma_f32_16x16x32_bf16(sf[2], Cf[2], y0, 0, 0, 0); y1 = __builtin_amdgcn_mfma_f32_16x16x32_bf16(sf[3], Cf[3], y1, 0, 0, 0);
                    const f32x4 y = y0 + y1; const int kc = k - 2;
                    const bool isc = kc < LCTX / 16; const int kk = isc ? kc : kc - LCTX / 16; const int Ls = isc ? LCTX : LSEQ; const int rowb = isc ? NX + b * LCTX : b * LSEQ;
#pragma unroll
                    for (int i = 0; i < 4; ++i) { const int st = kk * 16 + 4 * q + i; const int t = dir ? (Ls - 1 - st) : st;
                        ydir[(size_t)dir * RT * 512 + (size_t)(rowb + t) * 512 + g * 16 + r] = (bf16)f2bf(y[i]); } }
            } else if (k >= 1 && k <= NCH) {
                f32x4 bre[4], bim[4];
#pragma unroll
                for (int j = 0; j < 4; ++j) { bre[j] = *(const LAS f32x4*)(BuS0 + p1 * 2560 + lane * 20 + 4 * j); bim[j] = *(const LAS f32x4*)(BuS0 + p1 * 2560 + (64 + lane) * 20 + 4 * j); }
#pragma unroll
                for (int i = 0; i < 16; ++i) {
                    const f32x2 b2 = (f32x2){bre[i >> 2][i & 3], bim[i >> 2][i & 3]};
                    const float nr = abr * s2[0] - abi * s2[1] + b2[0], ni = abr * s2[1] + abi * s2[0] + b2[1]; s2 = (f32x2){nr, ni};
                    *(LAS unsigned*)(stS0 + p1 * 4352 + i * 272 + 4 * lane) = pk2(s2[0], s2[1]); }
            }
            LDS_WAIT(); __builtin_amdgcn_s_barrier(); asm volatile("" ::: "memory");
        }
    }
    VM_WAIT();
    __syncthreads();
    const float* dsk = inp(F, I_SD) + l * 512 + gp * 32;
    for (int e = F.tid; e < (LCTX + LSEQ) * 4; e += 512) {
        const int rr = e >> 2, pc = e & 3; const int row = rr < LSEQ ? b * LSEQ + rr : NX + b * LCTX + (rr - LSEQ);
        const size_t off = (size_t)row * 512 + gp * 32 + pc * 8;
        const v4u uw = *(const v4u*)(ps5 + off), fw = *(const v4u*)(ydir + off), bw = *(const v4u*)(ydir + (size_t)RT * 512 + off);
        f32x4 u0, u1, f0, f1, b0, b1; unpack8(uw, u0, u1); unpack8(fw, f0, f1); unpack8(bw, b0, b1);
        const f32x4 d0 = *(const f32x4*)(dsk + pc * 8), d1 = *(const f32x4*)(dsk + pc * 8 + 4);
        f32x4 o0, o1;
#pragma unroll
        for (int j = 0; j < 4; ++j) { o0[j] = gelu_tanh(f0[j] + b0[j] + d0[j] * u0[j]); o1[j] = gelu_tanh(f1[j] + b1[j] + d1[j] * u1[j]); }
        *(v4u*)((bf16*)(F.ws + WS_SG) + off) = pack8(o0, o1);
    }
}

__device__ __forceinline__ Frame make_frame(const Args& args, LAS unsigned char* lds, int wave_s);
__device__ __forceinline__ void mixers_phase(const Args& args, LAS unsigned char* lds, int wave_s, int l) {
#ifndef MIXMASK
#define MIXMASK 7
#endif
    if (MIXMASK & 1) { Frame F = make_frame(args, lds, wave_s);
#pragma unroll 1
        for (int u = F.vcu; u < NB * 16; u += F.G) s5_unit(F, l, u >> 4, u & 15); }
    if (MIXMASK & 2) { Frame F = make_frame(args, lds, wave_s);
#pragma unroll 1
        for (int u = F.vcu; u < 512; u += F.G) hyena_unit(F, l, u, l == 0);
        if (NREP(10) == 2) {
#pragma unroll 1
            for (int u = F.vcu; u < 512; u += F.G) hyena_unit(F, l, u, l == 0); } }
    if (MIXMASK & 4) { Frame F = make_frame(args, lds, wave_s);
        const int ncf = l == 0 ? NB * 32 + NB * 4 : NB * 32;
#pragma unroll 1
        for (int u = F.vcu; u < ncf; u += F.G) { if (u < NB * 32) cf_unit(F, l, u * 64, 64, 0); else { const int q = u - NB * 32; cf_unit(F, l, NX + (q >> 2) * LCTX, LCTX, (q & 3) * 64); } } }
    __syncthreads();
}

constexpr int PH_P0A = 0, PH_P0B = 1, PH_L0 = 2, PH_L1 = 12, N_PHASES = 27;
__device__ __forceinline__ Frame make_frame(const Args& args, LAS unsigned char* lds, int wave_s) {
    unsigned z0 = 0u; asm volatile("" : "+v"(z0));
    Frame F; int t = wave_s * 64 + (int)__builtin_amdgcn_mbcnt_hi(~0u, __builtin_amdgcn_mbcnt_lo(~0u, z0)); asm volatile("" : "+v"(t));
    unsigned char* ws = args.ws; float* out = args.out;
    F.lds = lds; F.tid = t; F.lane = t & 63; F.wave = wave_s;
    int G = gridDim.x, bx = blockIdx.x; asm volatile("" : "+s"(G), "+s"(bx));
    F.G = G; F.vcu = (G % 8 == 0) ? (bx % 8) * (G / 8) + bx / 8 : bx;
    const float* const* inp = args.in;
    F.in = inp; F.out = out; F.ws = ws; return F;
}
__global__ void __launch_bounds__(NWAVES * 64, 2) mega_fwd(Args args) {
    extern __shared__ __attribute__((aligned(16))) unsigned char lds_raw[];
    LAS unsigned char* const lds = (LAS unsigned char*)lds_raw;
    volatile LAS unsigned* MISC = (volatile LAS unsigned*)(lds + MISC_OFF);
    for (int u = threadIdx.x; u < (LDS_BYTES - MISC_OFF) / 4; u += NWAVES * 64) ((LAS unsigned*)(lds + MISC_OFF))[u] = 0u;
    int wave_s = __builtin_amdgcn_readfirstlane((int)threadIdx.x >> 6); asm volatile("" : "+s"(wave_s));
    __syncthreads();
    const int lo = MK_PER_PHASE_LAUNCH ? args.ph_lo : 0, hi = MK_PER_PHASE_LAUNCH ? args.ph_hi : N_PHASES;
    XcdBarrier bar; bar.bar = (unsigned*)(args.ws + WS_CTL) + CW_BAR; bar.x = 0; bar.st = nullptr;
    if (hi - lo > 1) bar = xcd_barrier_post((unsigned*)(args.ws + WS_CTL) + CW_BAR, MISC + 8);
#ifndef PHMASK
#define PHMASK 0xffffffffu
#endif
#define IN(k) (lo <= (k) && (k) < hi)
#define PM(b) ((PHMASK >> (b)) & 1u)
#define SEAM(k) do { if (IN(k) && IN((k) + 1)) xcd_barrier(bar, wave_s); } while (0)
#define FRAME() Frame F = make_frame(args, lds, wave_s); const char* ws = (const char*)F.ws; const int c = F.G == (int)gridDim.x ? (int)blockIdx.x : 0; (void)ws; (void)c

    if (PM(0) && IN(PH_P0A)) { FRAME(); REPEAT(NREP(12), p0a_prologue(F)); } SEAM(PH_P0A);
    if (PM(1) && IN(PH_P0B)) { FRAME(); p0b_mods(F); } SEAM(PH_P0B);

#pragma unroll 1
    for (int l = 0; l < 2; ++l) {
        const int pb = l == 0 ? PH_L0 : PH_L1;
        const int nMl = l == 0 ? RT / 256 : NX / 256;
        if (PM(2) && IN(pb + 0)) { { FRAME(); REPEAT(NREP(8), lnmod_phase(F, l)); } { FRAME(); h2table_phase(F, l); } { FRAME(); s5params_phase(F, l); } } SEAM(pb + 0);
        if (PM(3) && IN(pb + 1)) { { FRAME(); REPEAT(NREP(9), filter_expand_phase(F, l)); }
            FRAME();
            SchedPlain S; S.R.init(nMl, 12, F.G, c); S.A = ws + WS_HX; S.B = ws + WS_WIN + (size_t)l * 6144 * 1024 * 2; S.tsA = 256 * 1024 * 2; S.tsB = 256 * 1024 * 2;
            S.xM = l == 0 ? 0 : NCX / 256; S.xN0 = 10; S.xNn = 2;
            EpiInproj E{(bf16*)(F.ws + WS_PHYT), (bf16*)(F.ws + WS_UCF), (bf16*)(F.ws + WS_PS5)};
            REPEAT(NREP(0), pg8::gemm_phase<EpiInproj, SchedPlain>(F.lds, F.tid, 2048, S, E));
        } SEAM(pb + 1);
        if (PM(4) && IN(pb + 2)) { mixers_phase(args, lds, wave_s, l); } SEAM(pb + 2);
        if (PM(5) && IN(pb + 3)) {
            { FRAME(); SchedPlain S; S.R.init(nMl, 12, F.G, c); S.A = ws + WS_HX; S.B = ws + WS_WIN + ((size_t)l * 6144 + 3072) * 1024 * 2; S.tsA = 256 * 1024 * 2; S.tsB = 256 * 1024 * 2; S.xM = 0; S.xN0 = 0; S.xNn = 1;
              EpiGates E{(bf16*)(F.ws + WS_G)}; REPEAT(NREP(1), pg8::gemm_phase<EpiGates, SchedPlain>(F.lds, F.tid, 2048, S, E)); }
#ifndef DBG_SKIP_GLU
            { FRAME(); SchedPlain S; S.R.init(nMl, 2, F.G, (c + F.G / 4) % F.G); S.A = ws + WS_SG; S.B = ws + WS_WGLU + (size_t)l * 512 * 512 * 2; S.tsA = 256 * 512 * 2; S.tsB = 256 * 512 * 2; S.xM = 0; S.xN0 = 0; S.xNn = 1;
              EpiGlu E{(const bf16*)(F.ws + WS_SG), (bf16*)(F.ws + WS_S5Y), inp(F, I_SBGLU) + l * 512}; REPEAT(NREP(2), pg8::gemm_phase<EpiGlu, SchedPlain>(F.lds, F.tid, 1024, S, E)); }
#endif
        } SEAM(pb + 3);
        if (PM(6) && IN(pb + 4)) { FRAME();
            SchedMerge S; S.R.init(nMl, 4, F.G, c); S.A = ws + WS_Z2; S.sA = WS_UCF2 - WS_Z2; S.B = ws + WS_WOUTS + (size_t)(l * 3) * 1024 * 512 * 2; S.sB = (size_t)1024 * 512 * 2;
            S.tsA = 256 * 512 * 2; S.tsB = 256 * 512 * 2;
            EpiMerge E{(const bf16*)(F.ws + WS_G), (bf16*)(F.ws + WS_HX)};
            REPEAT(NREP(3), pg8::gemm_phase<EpiMerge, SchedMerge>(F.lds, F.tid, 1024, S, E));
        } SEAM(pb + 4);
        if (PM(7) && IN(pb + 5)) { FRAME();
            SchedPlain S; S.R.init(nMl, 4, F.G, c); S.A = ws + WS_HX; S.B = ws + WS_WO + (size_t)l * 1024 * 1024 * 2; S.tsA = 256 * 1024 * 2; S.tsB = 256 * 1024 * 2; S.xM = 0; S.xN0 = 0; S.xNn = 1;
            EpiRes E{l == 0 ? inp(F, I_X) : F.out, l == 0 ? inp(F, I_CTX) : (const float*)(F.ws + WS_XC), F.out, (float*)(F.ws + WS_XC), (const float*)(F.ws + WS_MODS) + (size_t)l * 17 * INC + 2 * 1024, 1.0f};
            REPEAT(((l == 0) ? NREP(4) : 1), pg8::gemm_phase<EpiRes, SchedPlain>(F.lds, F.tid, 2048, S, E));
        } SEAM(pb + 5);
        if (PM(8) && IN(pb + 6)) { { FRAME(); ln1_phase(F, l); } if (l == 1) { FRAME(); REPEAT(NREP(13), moe_convert_phase(F)); } } SEAM(pb + 6);
        if (l == 0) {
            if (PM(9) && IN(pb + 7)) { FRAME();
                SchedPlain S; S.R.init(RT / 256, 22, F.G, c); S.A = ws + WS_HX; S.B = ws + WS_W13; S.tsA = 256 * 1024; S.tsB = 256 * 1024; S.xM = 0; S.xN0 = 0; S.xNn = 1;
                EpiSwigluF8 E{F.ws + WS_G, DFF, 0.03125f}; REPEAT(NREP(5), pg8::gemm_phase<EpiSwigluF8, SchedPlain, true>(F.lds, F.tid, 1024, S, E));
            } SEAM(pb + 7);
            if (PM(10) && IN(pb + 8)) { FRAME();
                SchedPlain S; S.R.init(RT / 256, 4, F.G, c); S.A = ws + WS_G; S.B = ws + WS_W2; S.tsA = (size_t)256 * DFF; S.tsB = (size_t)256 * DFF; S.xM = 0; S.xN0 = 0; S.xNn = 1;
                EpiRes E{F.out, (const float*)(F.ws + WS_XC), F.out, (float*)(F.ws + WS_XC), (const float*)(F.ws + WS_MODS) + 5 * 1024, 0.0078125f};
                pg8::gemm_phase<EpiRes, SchedPlain, true>(F.lds, F.tid, DFF, S, E);
            } SEAM(pb + 8);
            if (PM(11) && IN(pb + 9)) { FRAME(); ln2_phase(F, l); } SEAM(pb + 9);
        } else {
            if (PM(15) && IN(pb + 7)) { FRAME(); moe_setup_phase(F); } SEAM(pb + 7);
#pragma unroll 1
            for (int st = 0; st < 6; ++st) {
                if (PM(13) && IN(pb + 8 + st) && st >= 1) { FRAME(); const int* tile_e = (const int*)(F.ws + WS_META + META_TILE); const int ch = st - 1;
                    const int ntiles = tile_e[511]; int nmc = ntiles - 64 * ch; nmc = nmc < 0 ? 0 : (nmc > 64 ? 64 : nmc);
                    SchedMoe S; S.R.init(nmc, 4, F.G, c); S.A = ws + WS_HID + (size_t)(ch & 1) * HID_BUF; S.B = ws + WS_MW2; S.tsA = (size_t)256 * DEX; S.tsB = (size_t)256 * DEX; S.esB = (size_t)1024 * DEX; S.tile_e = tile_e; S.tile0 = 64 * ch; S.a_global = false;
                    EpiMoeDown E{(bf16*)(F.ws + WS_MOEY), 0.0078125f}; REPEAT(NREP(7), pg8::gemm_phase<EpiMoeDown, SchedMoe, true>(F.lds, F.tid, DEX, S, E));
                }
                if (PM(12) && IN(pb + 8 + st) && st <= 4) { FRAME(); const int* tile_e = (const int*)(F.ws + WS_META + META_TILE); const int ch = st;
                    const int ntiles = tile_e[511]; int nmc = ntiles - 64 * ch; nmc = nmc < 0 ? 0 : (nmc > 64 ? 64 : nmc);
                    SchedMoe S; S.R.init(nmc, 28, F.G, c); S.A = ws + WS_SORT; S.B = ws + WS_MW13; S.tsA = 256 * 1024; S.tsB = 256 * 1024; S.esB = (size_t)7168 * 1024; S.tile_e = tile_e; S.tile0 = 64 * ch; S.a_global = true;
                    EpiSwigluF8 E{F.ws + WS_HID + (size_t)(ch & 1) * HID_BUF, DEX, 0.03125f}; REPEAT(NREP(6), pg8::gemm_phase<EpiSwigluF8, SchedMoe, true>(F.lds, F.tid, 1024, S, E));
                }
                SEAM(pb + 8 + st);
            }
            if (PM(14) && IN(pb + 14)) { FRAME(); moe_combine_phase(F); }
        }
    }
#undef IN
#undef SEAM
#undef FRAME
}


#ifdef DBG_DUMP
__global__ void dbg_dump(const unsigned char* ws, float* out) {
    const size_t NE = (size_t)RT * 512; const bf16* a = (const bf16*)(ws + WS_PS5); const bf16* b = (const bf16*)(ws + WS_Z2); const bf16* c = (const bf16*)(ws + WS_UCF2);
    for (size_t i = (size_t)blockIdx.x * blockDim.x + threadIdx.x; i < (size_t)NX * DM; i += (size_t)gridDim.x * blockDim.x) {
        const size_t j = i % NE; const int k = (int)(i / NE);
        float v;
        if (DBG_DUMP == 8) v = i < (size_t)26 * 1024 * 1024 ? bf2f(((const bf16*)(ws + WS_WIN))[i]) : 0.f;
        else if (DBG_DUMP == 7) v = k == 0 ? bf2f(a[j]) : bf2f(((const bf16*)(ws + WS_UCF))[j]);
        else if (DBG_DUMP == 4) v = bf2f(((const bf16*)(ws + WS_HX))[i]);
        else if (DBG_DUMP == 5) v = bf2f(((const bf16*)(ws + WS_G))[i]);
        else if (DBG_DUMP == 6) v = bf2f(((const bf16*)(ws + WS_S5Y))[i % NE]);
        else if (DBG_DUMP == 1) v = k == 0 ? bf2f(a[j]) : bf2f(b[j]);
        else if (DBG_DUMP == 2) v = k == 0 ? bf2f(b[j]) : bf2f(c[j]);
        else v = k == 0 ? bf2f(c[j]) : bf2f(a[j]);
        out[i] = v;
    }
}
#endif
extern "C" void kernel_launch(void* const* d_in, const int* in_sizes, int n_in, void* d_out, int out_size, void* d_ws, size_t ws_size, hipStream_t stream) {
    static int grid = 0;
    if (grid == 0) {
        if (n_in != N_IN || out_size != NX * DM || ws_size < WS_END2) { fprintf(stderr, "kernel_launch: unexpected shapes (n_in %d, out %d, ws %zu)\n", n_in, out_size, ws_size); grid = -1; return; }
        int dev = 0, cus = 0, per_cu = 0;
        if (hipGetDevice(&dev) != hipSuccess || hipDeviceGetAttribute(&cus, hipDeviceAttributeMultiprocessorCount, dev) != hipSuccess) { grid = -1; return; }
        if (hipFuncSetAttribute((const void*)mega_fwd, hipFuncAttributeMaxDynamicSharedMemorySize, LDS_BYTES) != hipSuccess) { fprintf(stderr, "kernel_launch: hipFuncSetAttribute failed\n"); grid = -1; return; }
        if (hipOccupancyMaxActiveBlocksPerMultiprocessor(&per_cu, (const void*)mega_fwd, NWAVES * 64, LDS_BYTES) != hipSuccess || per_cu < 1) fprintf(stderr, "kernel_launch: occupancy query reports %d\n", per_cu);
        (void)hipGetLastError();
        grid = cus;
    }
    if (grid < 0) return;
    (void)hipMemsetAsync((char*)d_ws + WS_CTL, 0, CTL_ZERO_BYTES, stream);
    Args a{};
    for (int i = 0; i < N_IN; ++i) a.in[i] = (const float*)d_in[i];
    a.out = (float*)d_out; a.ws = (unsigned char*)d_ws;
#if MK_PER_PHASE_LAUNCH
    for (int p = 0; p < DBG_NPH; ++p) { a.ph_lo = p; a.ph_hi = p + 1; hipLaunchKernelGGL(mega_fwd, dim3(grid), dim3(NWAVES * 64), LDS_BYTES, stream, a); }
#ifdef DBG_DUMP
    hipLaunchKernelGGL(dbg_dump, dim3(2048), dim3(256), 0, stream, (const unsigned char*)d_ws, (float*)d_out);
#endif
#else
    a.ph_lo = 0; a.ph_hi = N_PHASES; hipLaunchKernelGGL(mega_fwd, dim3(grid), dim3(NWAVES * 64), LDS_BYTES, stream, a);
#endif
}
```

```cpp
#include <hip/hip_runtime.h>
#include <cstdio>
#include <cstdint>

#ifndef DBG_REP
#define DBG_REP 0
#endif
#define NREP(bit) (((DBG_REP >> (bit)) & 1) ? 2 : 1)
#define REPEAT(n, ...) do { __VA_ARGS__; if ((n) == 2) { __VA_ARGS__; } } while (0)
#ifndef DBG_NPH
#define DBG_NPH N_PHASES
#define DBG_TMASK 0u
#define DBG_TLAYER 3u
#endif
#ifndef MK_PER_PHASE_LAUNCH
#define MK_PER_PHASE_LAUNCH 0
#endif

#define GAS __attribute__((address_space(1)))
#define LAS __attribute__((address_space(3)))
typedef unsigned short bf16;
typedef unsigned v4u __attribute__((ext_vector_type(4)));
typedef unsigned v2u __attribute__((ext_vector_type(2)));
typedef float f32x4 __attribute__((ext_vector_type(4)));
typedef float f32x2 __attribute__((ext_vector_type(2)));
typedef short bf16x8 __attribute__((ext_vector_type(8)));

constexpr int NB = 16, LSEQ = 2048, LCTX = 256, DM = 1024;
constexpr int NX = NB * LSEQ;
constexpr int NCX = NB * LCTX;
constexpr int RT = NX + NCX;
constexpr int INC = 6144, DFF = 2816, DEX = 3584, NEXP = 8;
constexpr float ALPHA_F = 1.41421356237f;
constexpr float LN_EPS = 1e-5f;

enum { I_X = 0, I_C, I_CTX, I_CCTX, I_WMOD, I_BMOD, I_WIN, I_HSW, I_HSB, I_FW1, I_FB1, I_FW2, I_FB2, I_FW3, I_FB3, I_FREQ, I_DECAY, I_HBIAS, I_WHY,
       I_CFW, I_CFB, I_CFG, I_CFLB, I_WCF, I_SARE, I_SAIM, I_SLDT, I_SBRE, I_SBIM, I_SCRE, I_SCIM, I_SD, I_SWGLU, I_SBGLU, I_WS5, I_WO,
       I_LN1G, I_LN1B, I_LN2G, I_LN2B, I_FFW1, I_FFW3, I_FFW2, I_ROUTER, I_MW1, I_MW3, I_MW2, N_IN };

constexpr size_t MiB = 1u << 20;
constexpr size_t WS_CTL = 0, CTL_ZERO_BYTES = 1 * MiB;
constexpr size_t WS_MODS = 1 * MiB;
constexpr size_t WS_S5P = 2 * MiB;
constexpr size_t WS_META = 3 * MiB;
constexpr size_t WS_FILT = 4 * MiB;
constexpr size_t WS_XC = 22 * MiB;
constexpr size_t WS_WIN = 38 * MiB;
constexpr size_t WS_WOUTS = 62 * MiB;
constexpr size_t WS_WGLU = 68 * MiB;
constexpr size_t WS_WO = 69 * MiB;
constexpr size_t WS_W13 = 73 * MiB;
constexpr size_t WS_W2 = 84 * MiB;
constexpr size_t WS_HX = 90 * MiB;
constexpr size_t WS_G = 162 * MiB;
constexpr size_t WS_PHYT = WS_G, WS_YDIR = WS_G + 108 * MiB, WS_UCF = WS_G + 180 * MiB;
constexpr size_t WS_PS5 = 378 * MiB;
constexpr size_t WS_Z2 = 414 * MiB;
constexpr size_t WS_UCF2 = 450 * MiB;
constexpr size_t WS_S5Y = 486 * MiB;
constexpr size_t WS_KRL = 522 * MiB;
constexpr size_t WS_KRC = 586 * MiB;
constexpr size_t WS_SG = 596 * MiB;
constexpr size_t WS_KDUMMY = 594 * MiB;
constexpr size_t WS_END = 595 * MiB;
constexpr size_t WS_SORT = 90 * MiB;
constexpr size_t WS_MOEY = 156 * MiB;
constexpr size_t WS_MW13 = 288 * MiB;
constexpr size_t WS_MW2 = 344 * MiB;
constexpr size_t WS_HID = 372 * MiB;
constexpr size_t HID_BUF = 56 * MiB;
constexpr size_t WS_END2 = 632 * MiB;
static_assert(WS_HID + (size_t)67584 * 3584 <= WS_END2, "moe map");
constexpr size_t META_BCNT = 800 * 1024;
constexpr size_t META_TOKE = 0, META_TOKW = 256 * 1024, META_POS = 512 * 1024, META_TILE = 768 * 1024;
constexpr int CW_BAR = 4096;
constexpr int CW_CNT = 8192, CW_CUR = 8256;

constexpr int LDS_BYTES = 155648;
constexpr int MISC_OFF = 147456;
constexpr int NWAVES = 8;

typedef __bf16 bf2_t __attribute__((ext_vector_type(2)));
__device__ __forceinline__ unsigned pk2(float lo, float hi) { bf2_t v; v.x = (__bf16)lo; v.y = (__bf16)hi; return __builtin_bit_cast(unsigned, v); }
__device__ __forceinline__ unsigned f2bf(float f) { return (unsigned)__builtin_bit_cast(unsigned short, (__bf16)f); }
__device__ __forceinline__ unsigned pk4_fp8(float a, float b, float c, float d) { int w = 0; w = __builtin_amdgcn_cvt_pk_fp8_f32(a, b, w, false); w = __builtin_amdgcn_cvt_pk_fp8_f32(c, d, w, true); return (unsigned)w; }
__device__ __forceinline__ float bf2f(unsigned short b) { return __builtin_bit_cast(float, ((unsigned)b) << 16); }
__device__ __forceinline__ float bflo(unsigned w) { return __builtin_bit_cast(float, w << 16); }
__device__ __forceinline__ float bfhi(unsigned w) { return __builtin_bit_cast(float, w & 0xffff0000u); }
__device__ __forceinline__ float sigmoidf_(float x) { return __builtin_amdgcn_rcpf(1.0f + __expf(-x)); }
__device__ __forceinline__ float siluf_(float x) { return x * sigmoidf_(x); }
__device__ __forceinline__ float gelu_tanh(float x) { const float y = 0.7978845608028654f * (x + 0.044715f * x * x * x); const float e = __expf(2.0f * y); const float th = 1.0f - 2.0f * __builtin_amdgcn_rcpf(e + 1.0f); return 0.5f * x * (1.0f + th); }
__device__ __forceinline__ float wave_sum(float v) {
    v += __builtin_bit_cast(float, __builtin_amdgcn_mov_dpp(__builtin_bit_cast(int, v), 0xB1, 0xf, 0xf, true));
    v += __builtin_bit_cast(float, __builtin_amdgcn_mov_dpp(__builtin_bit_cast(int, v), 0x4E, 0xf, 0xf, true));
    v += __builtin_bit_cast(float, __builtin_amdgcn_mov_dpp(__builtin_bit_cast(int, v), 0x141, 0xf, 0xf, true));
    v += __builtin_bit_cast(float, __builtin_amdgcn_mov_dpp(__builtin_bit_cast(int, v), 0x140, 0xf, 0xf, true));
    v += __builtin_bit_cast(float, __builtin_amdgcn_ds_swizzle(__builtin_bit_cast(int, v), 0x401F));
    const unsigned u = __builtin_bit_cast(unsigned, v); const auto r = __builtin_amdgcn_permlane32_swap(u, u, false, false);
    return __builtin_bit_cast(float, (unsigned)r[0]) + __builtin_bit_cast(float, (unsigned)r[1]);
}
__device__ __forceinline__ float lane_bcast(float v, int k) { return __builtin_bit_cast(float, __builtin_amdgcn_readlane(__builtin_bit_cast(int, v), k)); }
#define LDS_WAIT() asm volatile("s_waitcnt lgkmcnt(0)" ::: "memory")
#define VM_WAIT() asm volatile("s_waitcnt vmcnt(0)" ::: "memory")

namespace pg8 {
#define PG8_LAS __attribute__((address_space(3)))
constexpr int BM = 256, BK = 64, HALF = 128, HTB = HALF * BK * 2, STAGE_BYTES = 8 * HTB, NXCD = 8, WGM = 8;
__host__ __device__ __forceinline__ int lds_byte(int r, int c) { const int st = (r >> 4) * 2 + (c >> 5), rr = r & 15, cc = c & 31, ob = rr * 64 + cc * 2; return st * 1024 + (ob ^ (((ob >> 9) & 1) << 5)); }
__host__ __device__ __forceinline__ void stage_rc(int b, int& R, int& C) { const int st = b / 1024, sb = b % 1024, swz = sb ^ (((sb >> 9) & 1) << 5); R = (st >> 1) * 16 + swz / 64; C = (st & 1) * 32 + (swz % 64) / 2; }
__host__ __device__ __forceinline__ int perm32(int rho) { const int n = rho >> 4, i = rho & 15; return 8 * (i >> 2) + 4 * n + (i & 3); }

struct Unit { int pm, pn, seg, ex; const char* A; const char* B; };

struct Rect {
    int nM, nN, nwg, G, c;
    __device__ __forceinline__ void init(int nM_, int nN_, int G_, int c_) { nM = nM_; nN = nN_; nwg = nM * nN; G = G_; c = c_; }
    __device__ __forceinline__ bool map(int L, int& pm, int& pn) const {
        if (L >= nwg) return false;
        int wgid = L; { const int q = nwg / NXCD, r = nwg % NXCD, xcd = wgid % NXCD, off = wgid / NXCD; wgid = (xcd < r ? xcd * (q + 1) : r * (q + 1) + (xcd - r) * q) + off; }
        const int nig = WGM * nN, gid = wgid / nig, fm = gid * WGM, gsz = (nM - fm) < WGM ? (nM - fm) : WGM;
        pm = fm + ((wgid % nig) % gsz); pn = (wgid % nig) / gsz; return true;
    }
};

__device__ __forceinline__ unsigned cvt_pk_bf16(float lo, float hi) { return pk2(lo, hi); }

typedef int v8i_t __attribute__((ext_vector_type(8)));
typedef int v4i_t __attribute__((ext_vector_type(4)));
__device__ __forceinline__ v8i_t cat8(const bf16x8 a, const bf16x8 b) { return __builtin_shufflevector(__builtin_bit_cast(v4i_t, a), __builtin_bit_cast(v4i_t, b), 0, 1, 2, 3, 4, 5, 6, 7); }
__device__ __forceinline__ bf16x8 lo8(const v8i_t v) { return __builtin_bit_cast(bf16x8, __builtin_shufflevector(v, v, 0, 1, 2, 3)); }
__device__ __forceinline__ bf16x8 hi8(const v8i_t v) { return __builtin_bit_cast(bf16x8, __builtin_shufflevector(v, v, 4, 5, 6, 7)); }
template <class E, class = void> struct epi_chain { static constexpr bool value = false; };
template <class E> struct epi_chain<E, decltype((void)E::CHAIN)> { static constexpr bool value = E::CHAIN; };
template <class Epi, class Sched, bool F8 = false, bool ALIGN_EPI = true, bool SP2 = true>
__device__ __forceinline__ void gemm_phase(PG8_LAS unsigned char* lds, const int tid, const int KB, const Sched& S, const Epi& E, unsigned long long* tm = nullptr) {
    const int wid = __builtin_amdgcn_readfirstlane(tid >> 6), lane = tid & 63, wr = wid >> 2, wc = wid & 3, fr = lane & 15, fq = lane >> 4;
    const int nt = KB / (BK * 2);
    unsigned voffA[2], voffB[2];
#pragma unroll
    for (int i = 0; i < 2; ++i) { int R, C; stage_rc(tid * 16 + i * 8192, R, C); const int Rb = Epi::PERM ? ((R & ~31) + perm32(R & 31)) : R;
        voffA[i] = (unsigned)(R * KB + C * 2); voffB[i] = (unsigned)(Rb * KB + C * 2); }
    const size_t kstep = (size_t)(BK * 2);
    const size_t hstep = (size_t)HALF * KB;
    const unsigned ldsw = (unsigned)wid * 1024u;
    const int aoff = lds_byte(wr * 64 + fr, fq * 8), boff = lds_byte(wc * 32 + fr, fq * 8);
    constexpr int KOFF = 1024;
#define PG8_SA(b, h) (((b) * 2 + (h)) * HTB)
#define PG8_SB(b, h) ((4 + (b) * 2 + (h)) * HTB)
#define PG8_STAGE(bufoff, gbase, voff) do { _Pragma("unroll") for (int _i = 0; _i < 2; ++_i) \
        __builtin_amdgcn_global_load_lds((const unsigned*)((const char*)(gbase) + (voff)[_i]), (PG8_LAS unsigned*)(lds + (bufoff) + ldsw + _i * 8192), 16, 0, 0); } while (0)
#define PG8_LDA(dst, b, h) do { _Pragma("unroll") for (int m = 0; m < 4; ++m) dst[m] = cat8(*(const PG8_LAS bf16x8*)(lds + PG8_SA(b, h) + aoff + m * 2048), *(const PG8_LAS bf16x8*)(lds + PG8_SA(b, h) + aoff + m * 2048 + KOFF)); } while (0)
#define PG8_LDB(dst, b, h) do { _Pragma("unroll") for (int n = 0; n < 2; ++n) dst[n] = cat8(*(const PG8_LAS bf16x8*)(lds + PG8_SB(b, h) + boff + n * 2048), *(const PG8_LAS bf16x8*)(lds + PG8_SB(b, h) + boff + n * 2048 + KOFF)); } while (0)
#define PG8_MMA(ai, bj, At, Bt) do { __builtin_amdgcn_s_setprio(1); _Pragma("unroll") for (int m = 0; m < 4; ++m) _Pragma("unroll") for (int n = 0; n < 2; ++n) { \
        if constexpr (F8) asm volatile("v_mfma_scale_f32_16x16x128_f8f6f4 %0, %1, %2, %0, %3, %3 op_sel_hi:[0,0,0]" : "+v"(acc[ai][bj][m][n]) : "v"(Bt[n]), "v"(At[m]), "v"(sc1)); \
        else { acc[ai][bj][m][n] = __builtin_amdgcn_mfma_f32_16x16x32_bf16(lo8(Bt[n]), lo8(At[m]), acc[ai][bj][m][n], 0, 0, 0); \
               acc[ai][bj][m][n] = __builtin_amdgcn_mfma_f32_16x16x32_bf16(hi8(Bt[n]), hi8(At[m]), acc[ai][bj][m][n], 0, 0, 0); } } \
        __builtin_amdgcn_s_setprio(0); } while (0)
#define PG8_WAIT_V(n) asm volatile("s_waitcnt vmcnt(" #n ")" ::: "memory")
#define PG8_WAIT_L(n) asm volatile("s_waitcnt lgkmcnt(" #n ")" ::: "memory")
#define PG8_BAR __builtin_amdgcn_s_barrier()
#define PG8_SCHED __builtin_amdgcn_sched_barrier(0)
    const int sc1 = 0x7f7f7f7f;
    Unit cur, nxt; int ui = 0;
    if (!S.next(0, cur)) return;
    f32x4 acc[2][2][4][2];
#pragma unroll
    for (int a = 0; a < 2; ++a)
#pragma unroll
        for (int b = 0; b < 2; ++b)
#pragma unroll
            for (int m = 0; m < 4; ++m)
#pragma unroll
                for (int n = 0; n < 2; ++n) acc[a][b][m][n] = (f32x4){0.f, 0.f, 0.f, 0.f};
    v8i_t At[4], B0[2], B1[2];
    const char* cA = cur.A; const char* cB = cur.B;
    if constexpr (SP2) {
        PG8_STAGE(PG8_SB(0, 0), cB, voffB); PG8_STAGE(PG8_SB(0, 1), cB + hstep, voffB); PG8_STAGE(PG8_SA(0, 0), cA, voffA); PG8_STAGE(PG8_SA(0, 1), cA + hstep, voffA);
        if (wr == 1) PG8_BAR;
        PG8_WAIT_V(2); PG8_BAR;
        PG8_STAGE(PG8_SB(1, 0), cB + kstep, voffB); PG8_STAGE(PG8_SA(1, 0), cA + kstep, voffA); PG8_STAGE(PG8_SB(1, 1), cB + hstep + kstep, voffB);
        PG8_WAIT_V(6); PG8_BAR;
    } else {
        PG8_STAGE(PG8_SB(0, 0), cB, voffB); PG8_STAGE(PG8_SA(0, 0), cA, voffA); PG8_STAGE(PG8_SB(0, 1), cB + hstep, voffB); PG8_STAGE(PG8_SA(0, 1), cA + hstep, voffA);
        if (wr == 1) PG8_BAR;
        PG8_WAIT_V(4); PG8_BAR;
        PG8_STAGE(PG8_SB(1, 0), cB + kstep, voffB); PG8_STAGE(PG8_SA(1, 0), cA + kstep, voffA); PG8_STAGE(PG8_SB(1, 1), cB + hstep + kstep, voffB);
        PG8_WAIT_V(6); PG8_BAR;
    }
    for (;;) {
        const bool has_next = S.next(ui + 1, nxt);
        const char* nA = has_next ? nxt.A : cA; const char* nB = has_next ? nxt.B : cB;
        unsigned long long tk0_ = 0; if ((DBG_TMASK & 0x800000u) && tm) tk0_ = wall_clock64();
#pragma unroll 1
        for (int t = 0; t < nt; t += 2) {
            const bool last = (t == nt - 2);
            const char* a1 = cA + (size_t)(t + 1) * kstep;
            const char* a2 = last ? nA : cA + (size_t)(t + 2) * kstep; const char* b2 = last ? nB : cB + (size_t)(t + 2) * kstep;
            const char* a3 = a2 + kstep; const char* b3 = b2 + kstep;
            if constexpr (SP2) {
            PG8_LDB(B0, 0, 0); PG8_LDB(B1, 0, 1); PG8_SCHED; PG8_LDA(At, 0, 0); PG8_STAGE(PG8_SA(1, 1), a1 + hstep, voffA);
            PG8_WAIT_V(8); PG8_WAIT_L(0); PG8_BAR; PG8_MMA(0, 0, At, B0); PG8_MMA(0, 1, At, B1); PG8_BAR; PG8_SCHED;
            PG8_LDA(At, 0, 1); PG8_STAGE(PG8_SB(0, 0), b2, voffB); PG8_STAGE(PG8_SB(0, 1), b2 + hstep, voffB); PG8_STAGE(PG8_SA(0, 0), a2, voffA);
            PG8_WAIT_V(8); PG8_WAIT_L(0); PG8_BAR; PG8_MMA(1, 0, At, B0); PG8_MMA(1, 1, At, B1); PG8_BAR; PG8_SCHED;
            PG8_LDB(B0, 1, 0); PG8_LDB(B1, 1, 1); PG8_SCHED; PG8_LDA(At, 1, 0); PG8_STAGE(PG8_SA(0, 1), a2 + hstep, voffA);
            PG8_WAIT_V(8); PG8_WAIT_L(0); PG8_BAR; PG8_MMA(0, 0, At, B0); PG8_MMA(0, 1, At, B1); PG8_BAR; PG8_SCHED;
            PG8_LDA(At, 1, 1); PG8_STAGE(PG8_SB(1, 0), b3, voffB); PG8_STAGE(PG8_SB(1, 1), b3 + hstep, voffB); PG8_STAGE(PG8_SA(1, 0), a3, voffA);
            PG8_WAIT_V(8); PG8_WAIT_L(0); PG8_BAR; PG8_MMA(1, 0, At, B0); PG8_MMA(1, 1, At, B1); PG8_BAR; PG8_SCHED;
            } else {
            PG8_LDB(B0, 0, 0); PG8_SCHED; PG8_LDA(At, 0, 0); PG8_STAGE(PG8_SA(1, 1), a1 + hstep, voffA);
            PG8_WAIT_L(8); PG8_BAR; PG8_WAIT_L(0); PG8_MMA(0, 0, At, B0); PG8_BAR; PG8_SCHED;
            PG8_LDB(B1, 0, 1); PG8_STAGE(PG8_SB(0, 0), b2, voffB);
            PG8_BAR; PG8_WAIT_L(0); PG8_MMA(0, 1, At, B1); PG8_BAR;
            PG8_LDA(At, 0, 1); PG8_STAGE(PG8_SA(0, 0), a2, voffA);
            PG8_BAR; PG8_WAIT_L(0); PG8_MMA(1, 0, At, B0); PG8_BAR; PG8_SCHED;
            PG8_STAGE(PG8_SB(0, 1), b2 + hstep, voffB);
            PG8_WAIT_V(6); PG8_BAR; PG8_MMA(1, 1, At, B1); PG8_BAR;
            PG8_LDB(B0, 1, 0); PG8_SCHED; PG8_LDA(At, 1, 0); PG8_STAGE(PG8_SA(0, 1), a2 + hstep, voffA);
            PG8_WAIT_L(8); PG8_BAR; PG8_WAIT_L(0); PG8_MMA(0, 0, At, B0); PG8_BAR; PG8_SCHED;
            PG8_LDB(B1, 1, 1); PG8_STAGE(PG8_SB(1, 0), b3, voffB);
            PG8_BAR; PG8_WAIT_L(0); PG8_MMA(0, 1, At, B1); PG8_BAR;
            PG8_LDA(At, 1, 1); PG8_STAGE(PG8_SA(1, 0), a3, voffA);
            PG8_BAR; PG8_WAIT_L(0); PG8_MMA(1, 0, At, B0); PG8_BAR; PG8_SCHED;
            PG8_STAGE(PG8_SB(1, 1), b3 + hstep, voffB);
            PG8_WAIT_V(6); PG8_BAR; PG8_MMA(1, 1, At, B1); PG8_BAR;
            }
        }
        if ((DBG_TMASK & 0x800000u) && tm) *tm += wall_clock64() - tk0_;
        if constexpr (F8) asm volatile("s_nop 15\n\ts_nop 15" ::: "memory");
        if constexpr (ALIGN_EPI) { if (wr == 0) PG8_BAR; }
        bool chained = false;
        if constexpr (epi_chain<Epi>::value) chained = cur.seg < 2;
        if constexpr (epi_chain<Epi>::value) { if (chained) E.mid(acc, cur, wr, wc, fr, fq); else E(acc, cur, wr, wc, fr, fq); }
        else {
        if ((DBG_TMASK & 0x400000u) && tm) { const unsigned long long t0_ = wall_clock64(); E(acc, cur, wr, wc, fr, fq); asm volatile("s_waitcnt vmcnt(0)" ::: "memory"); *tm += wall_clock64() - t0_; }
        else E(acc, cur, wr, wc, fr, fq);
        }
        if (!has_next) break;
#pragma unroll
        for (int a = 0; a < 2; ++a)
#pragma unroll
            for (int b = 0; b < 2; ++b)
#pragma unroll
                for (int m = 0; m < 4; ++m)
#pragma unroll
                    for (int n = 0; n < 2; ++n)
#pragma unroll
                        for (int j = 0; j < 4; ++j) acc[a][b][m][n][j] = chained ? acc[a][b][m][n][j] : 0.f;
        cur = nxt; cA = nA; cB = nB; ++ui;
        if constexpr (ALIGN_EPI) { if (wr == 1) PG8_BAR; }
    }
    PG8_WAIT_V(0);
    if constexpr (!ALIGN_EPI) { if (wr == 0) PG8_BAR; }
    PG8_BAR;
#undef PG8_SA
#undef PG8_SB
#undef PG8_STAGE
#undef PG8_LDA
#undef PG8_LDB
#undef PG8_MMA
#undef PG8_WAIT_V
#undef PG8_WAIT_L
#undef PG8_BAR
#undef PG8_SCHED
}
}
using pg8::Unit;

#define XB_TMO      128
#define XB_XCNT(j)  (256  + 64 * (j))
#define XB_XSUB(j)  (1280 + 64 * (j))
#define XB_XGEN(j)  (2304 + 64 * (j))
#define XB_TOP      3328
#define XB_TOPGEN   3392
#define XCD_BAR_WORDS 3456
#define XB_SPIN_CAP (1u << 18)
__device__ __forceinline__ unsigned xb_ld(unsigned* p)              { return __hip_atomic_load(p, __ATOMIC_RELAXED, __HIP_MEMORY_SCOPE_AGENT); }
__device__ __forceinline__ unsigned xb_add(unsigned* p, unsigned v) { return __hip_atomic_fetch_add(p, v, __ATOMIC_RELAXED, __HIP_MEMORY_SCOPE_AGENT); }
__device__ __forceinline__ unsigned xb_xcc_id() { return (unsigned)__builtin_amdgcn_s_getreg((3 << 11) | 20) & 0xFu; }
#define XB_SPIN(cond, bar) do { unsigned _sp = 0; while (cond) { __builtin_amdgcn_s_sleep(1); \
    if ((++_sp & 255u) == 0u) { if (xb_ld(&(bar)[XB_TMO])) break; if (_sp > XB_SPIN_CAP) { atomicAdd(&(bar)[XB_TMO], 1u); break; } } } } while (0)
struct XcdBarrier { unsigned* bar; unsigned x; volatile LAS unsigned* st; };
__device__ __forceinline__ XcdBarrier xcd_barrier_post(unsigned* bar, volatile LAS unsigned* st) {
    XcdBarrier b; b.bar = bar; b.x = xb_xcc_id(); b.st = st;
    if (threadIdx.x == 0) (void)xb_add(&bar[XB_XCNT(b.x)], 1u);
    return b;
}
__device__ __forceinline__ void xcd_barrier_complete(unsigned* bar, unsigned x, unsigned& nloc, unsigned& nx) {
    const unsigned G = gridDim.x * gridDim.y * gridDim.z;
    unsigned sum, cnt, mine, sp = 0u;
    for (;;) {
        sum = 0u; cnt = 0u; mine = 0u;
#pragma unroll
        for (unsigned j = 0; j < 16; ++j) { const unsigned c = xb_ld(&bar[XB_XCNT(j)]); sum += c; cnt += (c > 0u) ? 1u : 0u; mine = (j == x) ? c : mine; }
        if (sum == G) break;
        __builtin_amdgcn_s_sleep(1);
        if ((++sp & 255u) == 0u) { if (xb_ld(&bar[XB_TMO])) break; if (sp > XB_SPIN_CAP) { atomicAdd(&bar[XB_TMO], 1u); break; } }
    }
    nloc = mine > 0u ? mine : 1u; nx = cnt > 0u ? cnt : 1u;
}
__device__ __forceinline__ void xcd_barrier(const XcdBarrier& b, const int wave_s) {
    asm volatile("s_waitcnt vmcnt(0)" ::: "memory");
    __syncthreads();
    if (wave_s == 0 && __builtin_amdgcn_mbcnt_hi(~0u, __builtin_amdgcn_mbcnt_lo(~0u, 0u)) == 0u) {
        unsigned* bar = b.bar; asm volatile("" : "+v"(bar));
        __builtin_amdgcn_s_waitcnt(0);
        unsigned nloc = b.st[0], nx = b.st[1];
        if (nloc == 0u) { xcd_barrier_complete(bar, b.x, nloc, nx); b.st[0] = nloc; b.st[1] = nx; }
        const unsigned old = xb_add(&bar[XB_XSUB(b.x)], 1u);
        const unsigned gen = old / nloc;
        if (old + 1u == (gen + 1u) * nloc) {
            __builtin_amdgcn_fence(__ATOMIC_RELEASE, "agent");
            asm volatile("s_waitcnt vmcnt(0)" ::: "memory");
            const unsigned og = xb_add(&bar[XB_TOP], 1u);
            const unsigned tg = og / nx;
            if (og + 1u == (tg + 1u) * nx) xb_add(&bar[XB_TOPGEN], 1u);
            else XB_SPIN(xb_ld(&bar[XB_TOPGEN]) == tg, bar);
            __builtin_amdgcn_fence(__ATOMIC_ACQUIRE, "agent");
            xb_add(&bar[XB_XGEN(b.x)], 1u);
            asm volatile("s_waitcnt vmcnt(0)" ::: "memory");
        } else {
            XB_SPIN(xb_ld(&bar[XB_XGEN(b.x)]) == gen, bar);
            __builtin_amdgcn_fence(__ATOMIC_ACQUIRE, "agent");
            asm volatile("s_waitcnt vmcnt(0)" ::: "memory");
        }
    }
    __syncthreads();
}

struct Args { const float* in[N_IN]; float* out; unsigned char* ws; int ph_lo, ph_hi; };

struct Frame {
    LAS unsigned char* lds;
    int tid, lane, wave, vcu, G;
    const float* const* in; float* out; unsigned char* ws;
};

__device__ __forceinline__ const float* inp(const Frame& F, int k) { const GAS float* p = (const GAS float*)F.in[k]; asm volatile("" : "+s"(p)); return (const float*)p; }

struct SchedPlain {
    pg8::Rect R; const char* A; const char* B; size_t tsA, tsB; int xM, xN0, xNn;
    __device__ __forceinline__ bool next(int i, Unit& u) const {
        const int L = i * R.G + R.c;
        if (R.map(L, u.pm, u.pn)) {} else { const int e = L - R.nwg; if (e >= xM * xNn) return false; u.pm = R.nM + e / xNn; u.pn = xN0 + e % xNn; }
        u.seg = 0; u.ex = 0; u.A = A + (size_t)u.pm * tsA; u.B = B + (size_t)u.pn * tsB; return true;
    }
};
struct SchedMerge {
    pg8::Rect R; const char* A; const char* B; size_t tsA, tsB, sA, sB;
    __device__ __forceinline__ bool next(int i, Unit& u) const {
        const int ti = i / 3, sg = i - 3 * ti; const int L = ti * R.G + R.c;
        if (!R.map(L, u.pm, u.pn)) return false;
        u.seg = sg; u.ex = 0;
        u.A = A + (size_t)sg * sA + (size_t)u.pm * tsA; u.B = B + (size_t)sg * sB + (size_t)u.pn * tsB; return true;
    }
};
struct SchedMoe {
    pg8::Rect R; const char* A; const char* B; size_t tsA, tsB, esB; const int* tile_e; int tile0; bool a_global;
    __device__ __forceinline__ bool next(int i, Unit& u) const {
        const int L = i * R.G + R.c;
        if (!R.map(L, u.pm, u.pn)) return false;
        const int gt = tile0 + u.pm; u.ex = gt; u.seg = 0; const int e = tile_e[gt];
        u.A = A + (size_t)(a_global ? gt : u.pm) * tsA; u.B = B + (size_t)e * esB + (size_t)u.pn * tsB; return true;
    }
};

typedef const f32x4 (&AccRef)[2][2][4][2];
__device__ __forceinline__ v4u pack8(const f32x4 a, const f32x4 b) { v4u w; w.x = pg8::cvt_pk_bf16(a[0], a[1]); w.y = pg8::cvt_pk_bf16(a[2], a[3]); w.z = pg8::cvt_pk_bf16(b[0], b[1]); w.w = pg8::cvt_pk_bf16(b[2], b[3]); return w; }
__device__ __forceinline__ void unpack8(const v4u w, f32x4& a, f32x4& b) { a = (f32x4){bflo(w.x), bfhi(w.x), bflo(w.y), bfhi(w.y)}; b = (f32x4){bflo(w.z), bfhi(w.z), bflo(w.w), bfhi(w.w)}; }

struct EpiInproj {
    static constexpr bool PERM = true;
    bf16* phyT; bf16* ucf; bf16* ps5; int pn0;
    __device__ __forceinline__ void operator()(AccRef acc, const Unit& u0, int wr, int wc, int fr, int fq) const {
        Unit u = u0; u.pn += pn0;
        const int row0 = u.pm * 256 + wr * 64 + fr;
        if (u.pn < 6) {
#pragma unroll
            for (int ai = 0; ai < 2; ++ai)
#pragma unroll
                for (int m = 0; m < 4; ++m) { const int r = row0 + ai * 128 + m * 16;
#pragma unroll
                    for (int bj = 0; bj < 2; ++bj)
#pragma unroll
                        for (int n = 0; n < 2; ++n)
#pragma unroll
                            for (int j = 0; j < 4; ++j) { const int c = u.pn * 256 + bj * 128 + wc * 32 + 8 * fq + 4 * n + j; phyT[(size_t)c * RT + r] = (bf16)f2bf(acc[ai][bj][m][n][j]); } }
        } else if (u.pn < 10) {
            const int col0 = (u.pn - 6) * 128 + wc * 32 + 8 * fq;
#pragma unroll
            for (int ai = 0; ai < 2; ++ai)
#pragma unroll
                for (int m = 0; m < 4; ++m) { const int r = row0 + ai * 128 + m * 16; f32x4 o[2];
#pragma unroll
                    for (int n = 0; n < 2; ++n)
#pragma unroll
                        for (int j = 0; j < 4; ++j) o[n][j] = acc[ai][0][m][n][j] * sigmoidf_(acc[ai][1][m][n][j]);
                    *(v4u*)(ucf + (size_t)r * 512 + col0) = pack8(o[0], o[1]); }
        } else {
#pragma unroll
            for (int ai = 0; ai < 2; ++ai)
#pragma unroll
                for (int m = 0; m < 4; ++m) { const int r = row0 + ai * 128 + m * 16;
#pragma unroll
                    for (int bj = 0; bj < 2; ++bj) { const int col0 = (u.pn - 10) * 256 + bj * 128 + wc * 32 + 8 * fq; *(v4u*)(ps5 + (size_t)r * 512 + col0) = pack8(acc[ai][bj][m][0], acc[ai][bj][m][1]); } }
        }
    }
};
struct EpiHyT {
    static constexpr bool PERM = true;
    bf16* phyT;
    __device__ __forceinline__ void operator()(AccRef acc, const Unit& u, int wr, int wc, int fr, int fq) const {
        const int ch0 = u.pm * 256 + wr * 64 + fr, tok0 = u.pn * 256 + wc * 32 + 8 * fq;
#pragma unroll
        for (int ai = 0; ai < 2; ++ai)
#pragma unroll
            for (int m = 0; m < 4; ++m)
#pragma unroll
                for (int bj = 0; bj < 2; ++bj) *(v4u*)(phyT + (size_t)(ch0 + ai * 128 + m * 16) * RT + tok0 + bj * 128) = pack8(acc[ai][bj][m][0], acc[ai][bj][m][1]);
    }
};
struct EpiGates {
    static constexpr bool PERM = true;
    bf16* O; int tid;
    __device__ __forceinline__ void operator()(AccRef acc, const Unit& u, int wr, int wc, int fr, int fq) const {
        v4u* T = (v4u*)O + ((size_t)u.pm * 12 + u.pn) * 8192 + tid;
#pragma unroll
        for (int ai = 0; ai < 2; ++ai)
#pragma unroll
            for (int m = 0; m < 4; ++m)
#pragma unroll
                for (int bj = 0; bj < 2; ++bj) { f32x4 o[2];
#pragma unroll
                    for (int n = 0; n < 2; ++n)
#pragma unroll
                        for (int j = 0; j < 4; ++j) o[n][j] = sigmoidf_(acc[ai][bj][m][n][j]);
                    T[((ai * 4 + m) * 2 + bj) * 512] = pack8(o[0], o[1]); }
    }
};
struct EpiGlu {
    static constexpr bool PERM = true;
    const bf16* SG; bf16* O; const float* bglu;
    __device__ __forceinline__ void operator()(AccRef acc, const Unit& u, int wr, int wc, int fr, int fq) const {
        const int row0 = u.pm * 256 + wr * 64 + fr;
#pragma unroll
        for (int bj = 0; bj < 2; ++bj) { const int col0 = u.pn * 256 + bj * 128 + wc * 32 + 8 * fq;
            const f32x4 b0 = *(const f32x4*)(bglu + col0), b1 = *(const f32x4*)(bglu + col0 + 4);
            v4u gw[2][4];
#pragma unroll
            for (int ai = 0; ai < 2; ++ai)
#pragma unroll
                for (int m = 0; m < 4; ++m) gw[ai][m] = *(const v4u*)(SG + (size_t)(row0 + ai * 128 + m * 16) * 512 + col0);
#pragma unroll
            for (int ai = 0; ai < 2; ++ai)
#pragma unroll
                for (int m = 0; m < 4; ++m) { const int r = row0 + ai * 128 + m * 16;
                    f32x4 g0, g1; unpack8(gw[ai][m], g0, g1); f32x4 o0, o1;
#pragma unroll
                    for (int j = 0; j < 4; ++j) { o0[j] = g0[j] * sigmoidf_(acc[ai][bj][m][0][j] + b0[j]); o1[j] = g1[j] * sigmoidf_(acc[ai][bj][m][1][j] + b1[j]); }
                    *(v4u*)(O + (size_t)r * 512 + col0) = pack8(o0, o1); } }
    }
};
struct EpiMerge {
    static constexpr bool PERM = true, CHAIN = true;
    const bf16* GT; bf16* O; int tid;
    typedef f32x4 (&AccMut)[2][2][4][2];
    __device__ __forceinline__ void mid(AccMut acc, const Unit& u, int wr, int wc, int fr, int fq) const {
        const v4u* T0 = (const v4u*)GT + ((size_t)u.pm * 12 + u.seg * 4 + u.pn) * 8192 + tid; const v4u* T1 = T0 + 4 * 8192;
#pragma unroll
        for (int ai = 0; ai < 2; ++ai)
#pragma unroll
            for (int bj = 0; bj < 2; ++bj) { v4u ga[4], gb[4];
#pragma unroll
                for (int m = 0; m < 4; ++m) { ga[m] = T0[((ai * 4 + m) * 2 + bj) * 512]; gb[m] = T1[((ai * 4 + m) * 2 + bj) * 512]; }
#pragma unroll
                for (int m = 0; m < 4; ++m) { f32x4 a0, a1, b0, b1; unpack8(ga[m], a0, a1); unpack8(gb[m], b0, b1);
#pragma unroll
                    for (int j = 0; j < 4; ++j) { acc[ai][bj][m][0][j] *= fmaxf(a0[j], 1e-30f) * __builtin_amdgcn_rcpf(fmaxf(b0[j], 1e-30f)); acc[ai][bj][m][1][j] *= fmaxf(a1[j], 1e-30f) * __builtin_amdgcn_rcpf(fmaxf(b1[j], 1e-30f)); } }
                asm volatile("" ::: "memory"); }
    }
    __device__ __forceinline__ void operator()(AccRef acc, const Unit& u, int wr, int wc, int fr, int fq) const {
        const int row0 = u.pm * 256 + wr * 64 + fr, col0 = u.pn * 256 + wc * 32 + 8 * fq;
        const v4u* T = (const v4u*)GT + ((size_t)u.pm * 12 + u.seg * 4 + u.pn) * 8192 + tid;
#pragma unroll
        for (int ai = 0; ai < 2; ++ai) { v4u gw[4][2];
#pragma unroll
            for (int m = 0; m < 4; ++m)
#pragma unroll
                for (int bj = 0; bj < 2; ++bj) gw[m][bj] = T[((ai * 4 + m) * 2 + bj) * 512];
#pragma unroll
            for (int m = 0; m < 4; ++m)
#pragma unroll
                for (int bj = 0; bj < 2; ++bj) { f32x4 g0, g1; unpack8(gw[m][bj], g0, g1);
#pragma unroll
                    for (int j = 0; j < 4; ++j) { g0[j] = fmaxf(g0[j], 1e-30f); g1[j] = fmaxf(g1[j], 1e-30f); }
                    *(v4u*)(O + (size_t)(row0 + ai * 128 + m * 16) * 1024 + col0 + bj * 128) = pack8(g0 * acc[ai][bj][m][0], g1 * acc[ai][bj][m][1]); } }
    }
};
struct EpiRes {
    static constexpr bool PERM = true;
    const float* xl; const float* xc; bf16* R; const float* gbase; float sc;
    __device__ __forceinline__ void operator()(AccRef acc, const Unit& u, int wr, int wc, int fr, int fq) const {
        const bool isl = u.pm < (NX / 256);
        const int prow = isl ? u.pm * 256 : (u.pm - NX / 256) * 256; const int mi = isl ? (u.pm >> 3) : 16;
        const float* xs = isl ? xl : xc; const float* gv = gbase + (size_t)mi * INC;
        const int row0 = prow + wr * 64 + fr, grow0 = u.pm * 256 + wr * 64 + fr, col0 = u.pn * 256 + wc * 32 + 8 * fq;
#pragma unroll
        for (int bj = 0; bj < 2; ++bj) { const int c = col0 + bj * 128; const f32x4 g0 = *(const f32x4*)(gv + c) * sc, g1 = *(const f32x4*)(gv + c + 4) * sc;
#pragma unroll
            for (int ai = 0; ai < 2; ++ai) { f32x4 xr[4][2];
#pragma unroll
                for (int m = 0; m < 4; ++m) { const float* xp = xs + (size_t)(row0 + ai * 128 + m * 16) * 1024 + c; xr[m][0] = *(const f32x4*)xp; xr[m][1] = *(const f32x4*)(xp + 4); }
#pragma unroll
                for (int m = 0; m < 4; ++m) *(v4u*)(R + (size_t)(grow0 + ai * 128 + m * 16) * 1024 + c) = pack8(xr[m][0] * ALPHA_F + g0 * acc[ai][bj][m][0], xr[m][1] * ALPHA_F + g1 * acc[ai][bj][m][1]); } }
    }
};
struct EpiSwiglu {
    static constexpr bool PERM = true;
    bf16* O; int ldc;
    __device__ __forceinline__ void operator()(AccRef acc, const Unit& u, int wr, int wc, int fr, int fq) const {
        const int row0 = u.pm * 256 + wr * 64 + fr, col0 = u.pn * 128 + wc * 32 + 8 * fq;
#pragma unroll
        for (int ai = 0; ai < 2; ++ai)
#pragma unroll
            for (int m = 0; m < 4; ++m) { const int r = row0 + ai * 128 + m * 16; f32x4 o[2];
#pragma unroll
                for (int n = 0; n < 2; ++n)
#pragma unroll
                    for (int j = 0; j < 4; ++j) o[n][j] = siluf_(acc[ai][0][m][n][j]) * acc[ai][1][m][n][j];
                *(v4u*)(O + (size_t)r * ldc + col0) = pack8(o[0], o[1]); }
    }
};
struct EpiSwigluF8 {
    static constexpr bool PERM = true;
    unsigned char* O; int ldc; float sc;
    __device__ __forceinline__ void operator()(AccRef acc, const Unit& u, int wr, int wc, int fr, int fq) const {
        const int row0 = u.pm * 256 + wr * 64 + fr, col0 = u.pn * 128 + wc * 32 + 8 * fq;
#pragma unroll
        for (int ai = 0; ai < 2; ++ai)
#pragma unroll
            for (int m = 0; m < 4; ++m) { const int r = row0 + ai * 128 + m * 16; f32x4 o[2];
#pragma unroll
                for (int n = 0; n < 2; ++n) {
                    const f32x4 a = acc[ai][0][m][n], t = a * (-1.4426950408889634f * sc), p = (a * acc[ai][1][m][n]) * (sc * sc);
                    f32x4 e; e[0] = __builtin_amdgcn_exp2f(t[0]); e[1] = __builtin_amdgcn_exp2f(t[1]); e[2] = __builtin_amdgcn_exp2f(t[2]); e[3] = __builtin_amdgcn_exp2f(t[3]);
                    const f32x4 d = e + 1.0f;
                    f32x4 rc; rc[0] = __builtin_amdgcn_rcpf(d[0]); rc[1] = __builtin_amdgcn_rcpf(d[1]); rc[2] = __builtin_amdgcn_rcpf(d[2]); rc[3] = __builtin_amdgcn_rcpf(d[3]);
                    o[n] = p * rc; }
                v2u w; w.x = pk4_fp8(o[0][0], o[0][1], o[0][2], o[0][3]); w.y = pk4_fp8(o[1][0], o[1][1], o[1][2], o[1][3]);
                *(v2u*)(O + (size_t)r * ldc + col0) = w; }
    }
};
struct EpiMoeDown {
    static constexpr bool PERM = true;
    bf16* O; float sc;
    __device__ __forceinline__ void operator()(AccRef acc, const Unit& u, int wr, int wc, int fr, int fq) const {
        const int row0 = u.ex * 256 + wr * 64 + fr;
#pragma unroll
        for (int ai = 0; ai < 2; ++ai)
#pragma unroll
            for (int m = 0; m < 4; ++m) { const int r = row0 + ai * 128 + m * 16;
#pragma unroll
                for (int bj = 0; bj < 2; ++bj) { const int col0 = u.pn * 256 + bj * 128 + wc * 32 + 8 * fq; *(v4u*)(O + (size_t)r * 1024 + col0) = pack8(acc[ai][bj][m][0] * sc, acc[ai][bj][m][1] * sc); } }
    }
};

template <bool F8>
__device__ __forceinline__ void transpose_item64(const float* W, int K, int N, unsigned char* WT, int dst_row0, int k0, int n0, float scale, LAS float* scr, int lane) {
#pragma unroll 4
    for (int i = 0; i < 16; ++i) { const int row = 4 * i + (lane >> 4), nc = 4 * (lane & 15);
        const f32x4 v = __builtin_nontemporal_load((const f32x4*)(W + (size_t)(k0 + row) * N + n0 + nc));     *(LAS f32x4*)(scr + row * 68 + nc) = v * scale; }
    LDS_WAIT(); asm volatile("" ::: "memory");
    const LAS float* sp = scr + lane;
    if constexpr (F8) {
        unsigned char* dst = WT + (size_t)(dst_row0 + lane) * K + k0;
#pragma unroll
        for (int c4 = 0; c4 < 4; ++c4) { v4u o;
#pragma unroll
            for (int e = 0; e < 4; ++e) { const int kk = 16 * c4 + 4 * e; o[e] = pk4_fp8(sp[(kk + 0) * 68], sp[(kk + 1) * 68], sp[(kk + 2) * 68], sp[(kk + 3) * 68]); }
            *(v4u*)(dst + 16 * c4) = o; }
    } else {
        unsigned char* dst = WT + ((size_t)(dst_row0 + lane) * K + k0) * 2;
#pragma unroll
        for (int c8 = 0; c8 < 8; ++c8) { v4u o;
#pragma unroll
            for (int e = 0; e < 4; ++e) { const int kk = 8 * c8 + 2 * e; o[e] = pk2(sp[kk * 68], sp[(kk + 1) * 68]); }
            *(v4u*)(dst + 16 * c8) = o; }
    }
    LDS_WAIT(); asm volatile("" ::: "memory");
}
__device__ __forceinline__ int dst_row_map(int kind, int n0) {
    if (kind == 1) { if (n0 >= 1536 && n0 < 2560) { const int i = (n0 - 1536) & 511, hi = (n0 - 1536) >> 9; return 1536 + 256 * (i >> 7) + 128 * hi + (i & 127); } return n0; }
    if (kind == 2) return 256 * (n0 >> 7) + (n0 & 127);
    if (kind == 3) return 256 * (n0 >> 7) + 128 + (n0 & 127);
    return n0;
}
__device__ __forceinline__ void conv_matrix_item(const float* W, int K, int N, bf16* WT, int kind, int item, LAS float* scr, int lane) {
    const int nblk = N / 64, kb = item / nblk, nb = item - kb * nblk;
    transpose_item64<false>(W, K, N, (unsigned char*)WT, dst_row_map(kind, 64 * nb), 64 * kb, 64 * nb, 1.0f, scr, lane);
}
__device__ __forceinline__ void conv_matrix_item_f8(const float* W, int K, int N, unsigned char* WT, int kind, int item, float scale, LAS float* scr, int lane) {
    const int nblk = N / 64, kb = item / nblk, nb = item - kb * nblk;
    transpose_item64<true>(W, K, N, WT, dst_row_map(kind, 64 * nb), 64 * kb, 64 * nb, scale, scr, lane);
}
__device__ __forceinline__ void p0a_prologue(Frame& F) {
    LAS float* scr = (LAS float*)(F.lds + F.wave * 17408);
    const int gw = F.wave * F.G + F.vcu  , NGW = F.G * NWAVES;
    bf16* ws_win = (bf16*)(F.ws + WS_WIN); bf16* ws_outs = (bf16*)(F.ws + WS_WOUTS); bf16* ws_glu = (bf16*)(F.ws + WS_WGLU); bf16* ws_wo = (bf16*)(F.ws + WS_WO);
    bf16* ws_w13 = (bf16*)(F.ws + WS_W13); bf16* ws_w2 = (bf16*)(F.ws + WS_W2);
    constexpr int I_IN = (1024 / 64) * (6144 / 64), I_OUT = (512 / 64) * (1024 / 64), I_GLU = (512 / 64) * (512 / 64), I_WOI = (1024 / 64) * (1024 / 64), I_F1 = (1024 / 64) * (2816 / 64), I_F2 = (2816 / 64) * (1024 / 64);
    constexpr int NITEMS = 2 * I_IN + 6 * I_OUT + 2 * I_GLU + 2 * I_WOI + 2 * I_F1 + I_F2;
    for (int it = gw; it < NITEMS; it += NGW) {
        int r = it;
        if (r < 2 * I_IN) { const int l = r / I_IN; conv_matrix_item(inp(F, I_WIN) + (size_t)l * 1024 * 6144, 1024, 6144, ws_win + (size_t)l * 6144 * 1024, 1, r - l * I_IN, scr, F.lane); continue; } r -= 2 * I_IN;
        if (r < 6 * I_OUT) { const int q = r / I_OUT, l = q / 3, s = q - 3 * l; const float* src = inp(F, s == 0 ? I_WHY : (s == 1 ? I_WCF : I_WS5)) + (size_t)l * 512 * 1024;
            conv_matrix_item(src, 512, 1024, ws_outs + (size_t)(l * 3 + s) * 1024 * 512, 0, r - q * I_OUT, scr, F.lane); continue; } r -= 6 * I_OUT;
        if (r < 2 * I_GLU) { const int l = r / I_GLU; conv_matrix_item(inp(F, I_SWGLU) + (size_t)l * 512 * 512, 512, 512, ws_glu + (size_t)l * 512 * 512, 0, r - l * I_GLU, scr, F.lane); continue; } r -= 2 * I_GLU;
        if (r < 2 * I_WOI) { const int l = r / I_WOI; conv_matrix_item(inp(F, I_WO) + (size_t)l * 1024 * 1024, 1024, 1024, ws_wo + (size_t)l * 1024 * 1024, 0, r - l * I_WOI, scr, F.lane); continue; } r -= 2 * I_WOI;
        if (r < I_F1) { conv_matrix_item_f8(inp(F, I_FFW1), 1024, 2816, (unsigned char*)ws_w13, 2, r, 32.f, scr, F.lane); continue; } r -= I_F1;
        if (r < I_F1) { conv_matrix_item_f8(inp(F, I_FFW3), 1024, 2816, (unsigned char*)ws_w13, 3, r, 32.f, scr, F.lane); continue; } r -= I_F1;
        conv_matrix_item_f8(inp(F, I_FFW2), 2816, 1024, (unsigned char*)ws_w2, 0, r, 128.f, scr, F.lane);
    }
    __syncthreads();
    float* mods = (float*)(F.ws + WS_MODS);
    LAS float* sc = (LAS float*)F.lds;
    LAS float* red = sc + 1024 * 20;
    for (int e = F.tid; e < 17 * 1024; e += 512) { const int i = e >> 10, k = e & 1023; const float cv = i < 16 ? inp(F, I_C)[i * 1024 + k] : inp(F, I_CCTX)[k]; sc[k * 20 + i] = siluf_(cv); }
    __syncthreads();
    for (int it = F.vcu; it < 2 * 128; it += F.G) {
        const int l = it >> 7, nb = it & 127; const int kg = F.tid / 48, col = F.tid - kg * 48;
        if (kg < 10) { const float* w = inp(F, I_WMOD) + (size_t)l * 1024 * 6144 + nb * 48 + col;
            float acc[17];
#pragma unroll
            for (int i = 0; i < 17; ++i) acc[i] = 0.f;
#pragma unroll 4
            for (int k = kg; k < 1024; k += 10) { const float wv = __builtin_nontemporal_load(w + (size_t)k * 6144);
                const f32x4 s0 = *(const LAS f32x4*)(sc + k * 20), s1 = *(const LAS f32x4*)(sc + k * 20 + 4), s2 = *(const LAS f32x4*)(sc + k * 20 + 8), s3 = *(const LAS f32x4*)(sc + k * 20 + 12); const float s4 = sc[k * 20 + 16];
#pragma unroll
                for (int j = 0; j < 4; ++j) { acc[j] += s0[j] * wv; acc[4 + j] += s1[j] * wv; acc[8 + j] += s2[j] * wv; acc[12 + j] += s3[j] * wv; }
                acc[16] += s4 * wv; }
#pragma unroll
            for (int i = 0; i < 17; ++i) red[(kg * 17 + i) * 48 + col] = acc[i]; }
        __syncthreads();
        for (int e = F.tid; e < 17 * 48; e += 512) { const int i = e / 48, c = e - i * 48; float sum = inp(F, I_BMOD)[l * 6144 + nb * 48 + c];
#pragma unroll
            for (int g = 0; g < 10; ++g) sum += red[(g * 17 + i) * 48 + c];
            mods[(size_t)(l * 17 + i) * 6144 + nb * 48 + c] = sum; }
        __syncthreads();
    }
}

__device__ __forceinline__ void h2table_phase(Frame& F, int l) {
    const int gw = F.wave * F.G + F.vcu  , NGW = F.G * NWAVES, lane = F.lane;
    float* H2 = (float*)(F.ws + WS_FILT);
    const float* w1 = inp(F, I_FW1) + l * 33 * 64; const float* b1 = inp(F, I_FB1) + l * 64; const float* w2 = inp(F, I_FW2) + l * 64 * 64; const float* b2 = inp(F, I_FB2) + l * 64;
    const float* fq = inp(F, I_FREQ) + l * 128;
    for (int pos = gw; pos < LSEQ + LCTX; pos += NGW) {
        const bool isc = pos >= LSEQ; const int L = isc ? LCTX : LSEQ; const int t = isc ? pos - LSEQ : pos;
        const float tn = (float)t / (float)(L - 1);
        float z = 0.f;
        if (lane == 0) z = tn;
        else if (lane <= 32) { const int band = lane <= 16 ? lane : lane - 16; const int ph = (t * band) % L; const float ang = 6.283185307179586f * ((float)ph / (float)L); z = lane <= 16 ? cosf(ang) : sinf(ang); }
        float h = b1[lane];
        for (int k = 0; k < 33; ++k) h += lane_bcast(z, k) * w1[k * 64 + lane];
        h = sinf(fq[lane] * h);
        float h2 = b2[lane];
        for (int k = 0; k < 64; ++k) h2 += lane_bcast(h, k) * w2[k * 64 + lane];
        H2[(size_t)pos * 64 + lane] = sinf(fq[64 + lane] * h2);
    }
}
__device__ __forceinline__ void filter_expand_phase(Frame& F, int l) {
    const int gw = F.wave * F.G + F.vcu  , NGW = F.G * NWAVES, lane = F.lane;
    const float* H2 = (const float*)(F.ws + WS_FILT);
    const float* w3 = inp(F, I_FW3) + (size_t)l * 64 * 2048; const float* b3 = inp(F, I_FB3) + l * 2048; const float* dec = inp(F, I_DECAY) + l * 2048; const float* hb = inp(F, I_HBIAS) + l * 1024;
    LAS float* W = (LAS float*)(F.lds + F.wave * 17408);
#pragma unroll 1
    for (int it = gw; it < 1024 + 128; it += NGW) {
        const bool isc = it >= 1024; const int ii = isc ? it - 1024 : it; const int chunk = ii >> 5, grp = ii & 31;
        const int L = isc ? LCTX : LSEQ; const int t = chunk * 64 + lane; const int pos = isc ? LSEQ + t : t;
        bf16* KR = isc ? (bf16*)(F.ws + WS_KRC) : (bf16*)(F.ws + WS_KRL); const int KLEN = 2 * L;
        const float tn = (float)t / (float)(L - 1);
#pragma unroll 4
        for (int k = 0; k < 64; ++k) W[lane * 68 + k] = w3[(size_t)k * 2048 + grp * 64 + lane];
        f32x4 h2[16];
#pragma unroll
        for (int k = 0; k < 16; ++k) h2[k] = *(const f32x4*)(H2 + (size_t)pos * 64 + 4 * k);
        const int colL = grp * 64 + lane; const float b3L = b3[colL], decL = fabsf(dec[colL]); const float hbL = ((colL >> 9) & 1) == 0 ? hb[(colL >> 10) * 512 + (colL & 511)] : 0.f;
        LDS_WAIT();
#pragma unroll 1
        for (int cc = 0; cc < 64; ++cc) {
            const int col = grp * 64 + cc; float a = lane_bcast(b3L, cc);
#pragma unroll
            for (int k = 0; k < 16; ++k) { const f32x4 wv = *(const LAS f32x4*)(W + cc * 68 + 4 * k); a += (h2[k][0] * wv[0] + h2[k][1] * wv[1]) + (h2[k][2] * wv[2] + h2[k][3] * wv[3]); }
            const int o = col >> 10, dir = (col >> 9) & 1, c = col & 511;
            float v = a * __expf(-tn * lane_bcast(decL, cc));
            if (t == 0 && dir == 0) v += lane_bcast(hbL, cc);
            const bool valid = !(t == 0 && dir == 1);
            const int i = dir ? L + t : L - t;
            const unsigned short bv = (unsigned short)f2bf(v);
            bf16* base = (valid ? KR + (size_t)((o * 512 + c) * 8) * KLEN : (bf16*)(F.ws + WS_KDUMMY) + 16) + i;
#pragma unroll
            for (int m = 0; m < 8; ++m) base[(ptrdiff_t)m * (KLEN - 1)] = bv;
        }
        LDS_WAIT();
    }
    __syncthreads();
}
__device__ __forceinline__ void s5params_phase(Frame& F, int l) {
    float* P = (float*)(F.ws + WS_S5P);
    for (int e = F.vcu * 512 + F.tid; e < 2 * 32 * 64; e += F.G * 512) {
        const int base = l * 4096 + e;
        const int dg = e >> 6;
        const float lam_re = fminf(inp(F, I_SARE)[base], -1e-4f), lam_im = inp(F, I_SAIM)[base];
        const float dt = expf(inp(F, I_SLDT)[l * 64 + dg]);
        const float mag = expf(lam_re * dt), ang = lam_im * dt; const float abr = mag * cosf(ang), abi = mag * sinf(ang);
        const float den = lam_re * lam_re + lam_im * lam_im;
        const float qre = ((abr - 1.0f) * lam_re + abi * lam_im) / den, qim = (abi * lam_re - (abr - 1.0f) * lam_im) / den;
        float* o = P + (size_t)e * 36; o[0] = abr; o[1] = abi;
        const float* br = inp(F, I_SBRE) + (size_t)base * 16; const float* bi = inp(F, I_SBIM) + (size_t)base * 16;
        for (int c = 0; c < 16; ++c) { o[2 + c] = qre * br[c] - qim * bi[c]; o[18 + c] = qre * bi[c] + qim * br[c]; }
        o[34] = 0.f; o[35] = 0.f;
    }
}

struct Row { f32x4 v[4]; };
__device__ __forceinline__ void row_load(Row& r, const float* p, int lane) { const f32x4* x = (const f32x4*)p + lane;
#pragma unroll
    for (int j = 0; j < 4; ++j) r.v[j] = x[64 * j]; }
__device__ __forceinline__ void row_load_nt(Row& r, const float* p, int lane) { const f32x4* x = (const f32x4*)p + lane;
#pragma unroll
    for (int j = 0; j < 4; ++j) r.v[j] = __builtin_nontemporal_load(x + 64 * j); }
__device__ __forceinline__ void row_load_bf16(Row& r, const bf16* p, int lane) { const v2u* x = (const v2u*)p + lane;
#pragma unroll
    for (int j = 0; j < 4; ++j) { const v2u w = x[64 * j]; r.v[j] = (f32x4){bflo(w.x), bfhi(w.x), bflo(w.y), bfhi(w.y)}; } }
__device__ __forceinline__ void row_store(const Row& r, float* p, int lane) { f32x4* x = (f32x4*)p + lane;
#pragma unroll
    for (int j = 0; j < 4; ++j) x[64 * j] = r.v[j]; }
__device__ __forceinline__ void row_norm(Row& r) {
    float s = 0.f;
#pragma unroll
    for (int j = 0; j < 4; ++j) s += (r.v[j][0] + r.v[j][1]) + (r.v[j][2] + r.v[j][3]);
    const float mean = wave_sum(s) * (1.f / DM); float q = 0.f;
#pragma unroll
    for (int j = 0; j < 4; ++j) { r.v[j] = r.v[j] - mean; q += (r.v[j][0] * r.v[j][0] + r.v[j][1] * r.v[j][1]) + (r.v[j][2] * r.v[j][2] + r.v[j][3] * r.v[j][3]); }
    const float rstd = 1.f / sqrtf(wave_sum(q) * (1.f / DM) + LN_EPS);
#pragma unroll
    for (int j = 0; j < 4; ++j) r.v[j] = r.v[j] * rstd;
}
__device__ __forceinline__ void row_affine(Row& r, const float* g, const float* b, int lane, float gadd) {
    const f32x4* gp = (const f32x4*)g + lane; const f32x4* bp = (const f32x4*)b + lane;
#pragma unroll
    for (int j = 0; j < 4; ++j) r.v[j] = r.v[j] * (gp[64 * j] + gadd) + bp[64 * j];
}
struct Vec8 { f32x4 g[4], b[4]; };
__device__ __forceinline__ void vec8_load(Vec8& v, const float* g, const float* b, int lane) { const f32x4* gp = (const f32x4*)g + lane; const f32x4* bp = (const f32x4*)b + lane;
#pragma unroll
    for (int j = 0; j < 4; ++j) { v.g[j] = gp[64 * j]; v.b[j] = bp[64 * j]; } }
__device__ __forceinline__ void row_affine_reg(Row& r, const Vec8& v, float gadd) {
#pragma unroll
    for (int j = 0; j < 4; ++j) r.v[j] = r.v[j] * (v.g[j] + gadd) + v.b[j]; }
__device__ __forceinline__ int row_batch(int row) { return row < NX ? (row >> 11) : 16; }
__device__ __forceinline__ void row_store_bf16(const Row& r, bf16* p, int lane) { unsigned long long* o = (unsigned long long*)p + lane;
#pragma unroll
    for (int j = 0; j < 4; ++j) o[64 * j] = (unsigned long long)pk2(r.v[j][0], r.v[j][1]) | ((unsigned long long)pk2(r.v[j][2], r.v[j][3]) << 32); }

__device__ __forceinline__ const float* mod_vec(Frame& F, int l, int row, int which) { const int i = row < NX ? (row >> 11) : 16; return (const float*)(F.ws + WS_MODS) + ((size_t)l * 17 + i) * INC + which * 1024; }
__device__ __forceinline__ const float* xrow_ptr(Frame& F, int l, int row) {
    if (l == 0) return row < NX ? inp(F, I_X) + (size_t)row * DM : inp(F, I_CTX) + (size_t)(row - NX) * DM;
    return row < NX ? F.out + (size_t)row * DM : (const float*)(F.ws + WS_XC) + (size_t)(row - NX) * DM;
}
__device__ __forceinline__ float* xcur_ptr(Frame& F, int row) { return row < NX ? F.out + (size_t)row * DM : (float*)(F.ws + WS_XC) + (size_t)(row - NX) * DM; }

__device__ __forceinline__ void lnmod_phase(Frame& F, int l) {
    const int gw = F.vcu * NWAVES + F.wave, NGW = F.G * NWAVES; bf16* hx = (bf16*)(F.ws + WS_HX);
    const int m0 = (int)((long)RT * gw / NGW), m1 = (int)((long)RT * (gw + 1) / NGW); Vec8 md; int cb = -1;
    Row nx; if (m0 < m1) row_load_nt(nx, xrow_ptr(F, l, m0), F.lane);
    for (int m = m0; m < m1; ++m) { if (row_batch(m) != cb) { cb = row_batch(m); vec8_load(md, mod_vec(F, l, m, 1), mod_vec(F, l, m, 0), F.lane); }
        Row r = nx; if (m + 1 < m1) row_load_nt(nx, xrow_ptr(F, l, m + 1), F.lane);
        row_norm(r); row_affine_reg(r, md, 1.0f); row_store_bf16(r, hx + (size_t)m * DM, F.lane); }
}
template <bool MOE>
__device__ __forceinline__ void ln1_phase(Frame& F, int l) {
    const int gw = F.vcu * NWAVES + F.wave, NGW = F.G * NWAVES; bf16* hx = (bf16*)(F.ws + WS_HX); const int M = MOE ? NX : RT;
    const float* g = inp(F, I_LN1G) + l * DM; const float* b = inp(F, I_LN1B) + l * DM;
    int* toke = (int*)(F.ws + WS_META + META_TOKE); float* tokw = (float*)(F.ws + WS_META + META_TOKW);
    LAS unsigned* lcnt = (LAS unsigned*)(F.lds);
    unsigned c8[8];
#pragma unroll
    for (int e = 0; e < 8; ++e) c8[e] = 0u;
    if (MOE) { if (F.tid < 8) lcnt[F.tid] = 0u; __syncthreads(); }
    f32x4 rtr[4][4][2];
    if (MOE) { const float* rt = inp(F, I_ROUTER);
#pragma unroll
        for (int j = 0; j < 4; ++j)
#pragma unroll
            for (int q = 0; q < 4; ++q) { const int k = 256 * j + 4 * F.lane + q; rtr[j][q][0] = *(const f32x4*)(rt + k * 8); rtr[j][q][1] = *(const f32x4*)(rt + k * 8 + 4); } }
    Vec8 ln; if (!MOE) vec8_load(ln, g, b, F.lane); Vec8 md; int cb = -1;
    const int m0 = (int)((long)M * gw / NGW), m1 = (int)((long)M * (gw + 1) / NGW);
    for (int m = m0; m < m1; ++m) {
        if (row_batch(m) != cb) { cb = row_batch(m); vec8_load(md, mod_vec(F, l, m, 4), mod_vec(F, l, m, 3), F.lane); }
        float* xp = xcur_ptr(F, m); Row r; row_load_bf16(r, (const bf16*)(F.ws + WS_KRL) + (size_t)m * DM, F.lane); row_norm(r); if (MOE) row_affine(r, g, b, F.lane, 0.0f); else row_affine_reg(r, ln, 0.0f); row_store(r, xp, F.lane);
        row_norm(r); row_affine_reg(r, md, 1.0f);
        if (!MOE) { unsigned* d8 = (unsigned*)((unsigned char*)hx + (size_t)m * DM) + F.lane;
#pragma unroll
            for (int j = 0; j < 4; ++j) d8[64 * j] = pk4_fp8(r.v[j][0], r.v[j][1], r.v[j][2], r.v[j][3]); }
        else {
            float lg[8];
#pragma unroll
            for (int e = 0; e < 8; ++e) lg[e] = 0.f;
#pragma unroll
            for (int j = 0; j < 4; ++j)
#pragma unroll
                for (int q = 0; q < 4; ++q) { const f32x4 r0 = rtr[j][q][0], r1 = rtr[j][q][1]; const float hv = r.v[j][q];
                    lg[0] += hv * r0[0]; lg[1] += hv * r0[1]; lg[2] += hv * r0[2]; lg[3] += hv * r0[3]; lg[4] += hv * r1[0]; lg[5] += hv * r1[1]; lg[6] += hv * r1[2]; lg[7] += hv * r1[3]; }
#pragma unroll
            for (int e = 0; e < 8; ++e) lg[e] = wave_sum(lg[e]);
            int e0 = 0; float v0 = lg[0];
#pragma unroll
            for (int e = 1; e < 8; ++e) if (lg[e] > v0) { v0 = lg[e]; e0 = e; }
            int e1 = -1; float v1 = -3.0e38f;
#pragma unroll
            for (int e = 0; e < 8; ++e) if (e != e0 && lg[e] > v1) { v1 = lg[e]; e1 = e; }
            const float ex = __expf(v1 - v0); const float w0 = 1.0f / (1.0f + ex), w1 = ex / (1.0f + ex);
            if (F.lane == 0) { toke[2 * m] = e0; toke[2 * m + 1] = e1; tokw[2 * m] = w0; tokw[2 * m + 1] = w1; }
#pragma unroll
            for (int e = 0; e < 8; ++e) c8[e] += (e0 == e ? 1u : 0u) + (e1 == e ? 1u : 0u);
        }
    }
    if (MOE) {
        if (F.lane == 0) {
#pragma unroll
            for (int e = 0; e < 8; ++e) if (c8[e]) atomicAdd((unsigned*)&lcnt[e], c8[e]); }
        __syncthreads();
        if (F.tid < 8) ((unsigned*)(F.ws + WS_META + META_BCNT))[F.vcu * 8 + F.tid] = lcnt[F.tid];
        __syncthreads();
    }
}
__device__ __forceinline__ void ln2_phase(Frame& F, int l) {
    const int gw = F.vcu * NWAVES + F.wave, NGW = F.G * NWAVES;
    Vec8 ln; vec8_load(ln, inp(F, I_LN2G) + l * DM, inp(F, I_LN2B) + l * DM, F.lane);
    const int m0 = (int)((long)RT * gw / NGW), m1 = (int)((long)RT * (gw + 1) / NGW);
    const bf16* R16 = (const bf16*)(F.ws + WS_KRL);
    Row nx; if (m0 < m1) row_load_bf16(nx, R16 + (size_t)m0 * DM, F.lane);
    bf16* hx = (bf16*)(F.ws + WS_HX); Vec8 md; int cb = -1;
    for (int m = m0; m < m1; ++m) { float* xp = xcur_ptr(F, m); Row r = nx; if (m + 1 < m1) row_load_bf16(nx, R16 + (size_t)(m + 1) * DM, F.lane);
        if (row_batch(m) != cb) { cb = row_batch(m); vec8_load(md, mod_vec(F, l + 1, m, 1), mod_vec(F, l + 1, m, 0), F.lane); }
        row_norm(r); row_affine_reg(r, ln, 0.0f); row_store(r, xp, F.lane);
        row_norm(r); row_affine_reg(r, md, 1.0f); row_store_bf16(r, hx + (size_t)m * DM, F.lane); }
}

__device__ __forceinline__ void moe_convert_phase(Frame& F) {
    LAS float* scr = (LAS float*)(F.lds + 4096 + F.wave * 17408);
    const int gw = F.wave * F.G + F.vcu  , NGW = F.G * NWAVES;
    unsigned char* w13 = F.ws + WS_MW13; unsigned char* w2 = F.ws + WS_MW2;
    constexpr int I1 = (1024 / 64) * (3584 / 64), I2 = (3584 / 64) * (1024 / 64);
    for (int it = gw; it < 8 * (2 * I1 + I2); it += NGW) {
        const int e = it / (2 * I1 + I2); int r = it - e * (2 * I1 + I2);
        if (r < I1) { conv_matrix_item_f8(inp(F, I_MW1) + (size_t)e * 1024 * 3584, 1024, 3584, w13 + (size_t)e * 7168 * 1024, 2, r, 32.f, scr, F.lane); continue; } r -= I1;
        if (r < I1) { conv_matrix_item_f8(inp(F, I_MW3) + (size_t)e * 1024 * 3584, 1024, 3584, w13 + (size_t)e * 7168 * 1024, 3, r, 32.f, scr, F.lane); continue; } r -= I1;
        conv_matrix_item_f8(inp(F, I_MW2) + (size_t)e * 3584 * 1024, 3584, 1024, w2 + (size_t)e * 1024 * 3584, 0, r, 128.f, scr, F.lane);
    }
}
__device__ __forceinline__ void moe_setup_phase(Frame& F) {
    const int gw = F.vcu * NWAVES + F.wave, NGW = F.G * NWAVES, lane = F.lane;
    const int* toke = (const int*)(F.ws + WS_META + META_TOKE); int* tpos = (int*)(F.ws + WS_META + META_POS); int* tile_e = (int*)(F.ws + WS_META + META_TILE);
    const unsigned* bcnt = (const unsigned*)(F.ws + WS_META + META_BCNT); unsigned char* srt = F.ws + WS_SORT;
    LAS int* sh = (LAS int*)F.lds;
    const int mb = (int)((long)NX * gw / NGW), me = (int)((long)NX * (gw + 1) / NGW);
    __syncthreads();
    {
        const int e = F.wave; int tot = 0, pre = 0;
        for (int bk = lane; bk < F.G; bk += 64) { const int v = (int)bcnt[bk * 8 + e]; tot += v; pre += bk < F.vcu ? v : 0; }
#pragma unroll
        for (int o = 32; o >= 1; o >>= 1) { tot += __shfl_xor(tot, o); pre += __shfl_xor(pre, o); }
        if (lane == 0) { sh[e] = tot; sh[8 + e] = pre; }
        int c8[8];
#pragma unroll
        for (int q = 0; q < 8; ++q) c8[q] = 0;
        for (int base = mb; base < me; base += 64) { const int m = base + lane; const bool act = m < me;
            const int e0 = act ? toke[2 * m] : -1, e1 = act ? toke[2 * m + 1] : -1;
#pragma unroll
            for (int q = 0; q < 8; ++q) c8[q] += __popcll(__ballot(e0 == q)) + __popcll(__ballot(e1 == q)); }
        if (lane == 0) {
#pragma unroll
            for (int q = 0; q < 8; ++q) sh[16 + 8 * F.wave + q] = c8[q]; }
    }
    __syncthreads();
    int off[8], wbase[8], ntiles; { int o = 0;
#pragma unroll
        for (int e = 0; e < 8; ++e) { off[e] = o; o += (sh[e] + 255) & ~255; int wb = off[e] + sh[8 + e];
            for (int w2 = 0; w2 < F.wave; ++w2) wb += sh[16 + 8 * w2 + e];
            wbase[e] = wb; }
        ntiles = o >> 8; }
    if (F.vcu == 0 && F.tid < 8) { const int e = F.tid; const int t0 = off[e] >> 8; const int t1 = (e == 7 ? ntiles : (off[e + 1] >> 8)); for (int t = t0; t < t1; ++t) tile_e[t] = e; if (e == 0) tile_e[511] = ntiles; }
    for (int base = mb; base < me; base += 64) {
        const int m = base + lane; const bool act = m < me;
        const int e0 = act ? toke[2 * m] : -1, e1 = act ? toke[2 * m + 1] : -1;
        int p0 = 0, p1 = 0;
        const unsigned long long lt = (1ull << lane) - 1ull;
#pragma unroll
        for (int e = 0; e < 8; ++e) {
            const unsigned long long m0 = __ballot(e0 == e), m1 = __ballot(e1 == e);
            if (e0 == e) p0 = wbase[e] + __popcll(m0 & lt);
            if (e1 == e) p1 = wbase[e] + __popcll(m0) + __popcll(m1 & lt);
            wbase[e] += __popcll(m0) + __popcll(m1);
        }
        if (act) { tpos[2 * m] = p0; tpos[2 * m + 1] = p1; }
        const int nrows = me - base < 64 ? me - base : 64; Vec8 md; int cb = -1;
        for (int i = 0; i < nrows; ++i) {
            const int mi = base + i; const int q0 = __builtin_amdgcn_readlane(p0, i), q1 = __builtin_amdgcn_readlane(p1, i);
            if (row_batch(mi) != cb) { cb = row_batch(mi); vec8_load(md, mod_vec(F, 1, mi, 4), mod_vec(F, 1, mi, 3), lane); }
            Row r; row_load(r, F.out + (size_t)mi * DM, lane); row_norm(r); row_affine_reg(r, md, 1.0f);
            unsigned* d0 = (unsigned*)(srt + (size_t)q0 * DM) + lane; unsigned* d1 = (unsigned*)(srt + (size_t)q1 * DM) + lane;
#pragma unroll
            for (int j = 0; j < 4; ++j) { const unsigned w8 = pk4_fp8(r.v[j][0], r.v[j][1], r.v[j][2], r.v[j][3]); d0[64 * j] = w8; d1[64 * j] = w8; }
        }
    }
}
__device__ __forceinline__ void moe_combine_phase(Frame& F) {
    const int gw = F.vcu * NWAVES + F.wave, NGW = F.G * NWAVES, lane = F.lane;
    const float* tokw = (const float*)(F.ws + WS_META + META_TOKW); const int* tpos = (const int*)(F.ws + WS_META + META_POS); const bf16* Y = (const bf16*)(F.ws + WS_MOEY);
    Vec8 ln; vec8_load(ln, inp(F, I_LN2G) + DM, inp(F, I_LN2B) + DM, lane);
    const int mb = (int)((long)NX * gw / NGW), me = (int)((long)NX * (gw + 1) / NGW); f32x4 g2[4]; int cb = -1;
    for (int m = mb; m < me; ++m) {
        if (row_batch(m) != cb) { cb = row_batch(m); const f32x4* gp = (const f32x4*)mod_vec(F, 1, m, 5) + lane;
#pragma unroll
            for (int j = 0; j < 4; ++j) g2[j] = gp[64 * j]; }
        const float w0 = tokw[2 * m], w1 = tokw[2 * m + 1]; const int p0 = tpos[2 * m], p1 = tpos[2 * m + 1];
        Row r; row_load(r, F.out + (size_t)m * DM, lane);
        const unsigned long long* y0 = (const unsigned long long*)(Y + (size_t)p0 * DM) + lane; const unsigned long long* y1 = (const unsigned long long*)(Y + (size_t)p1 * DM) + lane;
#pragma unroll
        for (int j = 0; j < 4; ++j) { const unsigned long long a = y0[64 * j], c = y1[64 * j];
            const f32x4 ya = (f32x4){bflo((unsigned)a), bfhi((unsigned)a), bflo((unsigned)(a >> 32)), bfhi((unsigned)(a >> 32))};
            const f32x4 yc = (f32x4){bflo((unsigned)c), bfhi((unsigned)c), bflo((unsigned)(c >> 32)), bfhi((unsigned)(c >> 32))};
            r.v[j] = r.v[j] * ALPHA_F + g2[j] * (ya * w0 + yc * w1); }
        row_norm(r); row_affine_reg(r, ln, 0.0f); row_store(r, F.out + (size_t)m * DM, lane);
    }
}

constexpr int HY_U_OFF = 0, HY_U_STRIDE = 4128, HY_K_OFF = 16 * HY_U_STRIDE, HY_K_STRIDE = 8448;
__device__ __forceinline__ int hy_kcopy_off(int m) { return m * HY_K_STRIDE + 16 * (int)((0xD25BAF50u >> (4 * m)) & 15u); }
constexpr int HYC_U_STRIDE = 544, HYC_K_STRIDE = 1040;
static_assert(HY_K_OFF + 8 * HY_K_STRIDE + 256 + 64 <= MISC_OFF, "hyena LDS map");
__device__ __forceinline__ float hy_short4(const bf16* p, int tb, int L, float w0, float w1, float w2, float bs, f32x4& x) {
    const v2u pw = *(const v2u*)(p + tb); const float c0 = bflo(pw.x), c1 = bfhi(pw.x), c2 = bflo(pw.y), c3 = bfhi(pw.y);
    const float pm = tb > 0 ? bf2f(p[tb - 1]) : 0.f, pp = tb + 4 < L ? bf2f(p[tb + 4]) : 0.f;
    x[0] = bs + w0 * pm + w1 * c0 + w2 * c1; x[1] = bs + w0 * c0 + w1 * c1 + w2 * c2; x[2] = bs + w0 * c1 + w1 * c2 + w2 * c3; x[3] = bs + w0 * c2 + w1 * c3 + w2 * pp; return 0.f;
}
__device__ __forceinline__ void hy_short4u(const bf16* pi, bool first, bool last, float w0, float w1, float w2, float bs, f32x4& x) {
    const v2u pw = *(const v2u*)pi; const float c0 = bflo(pw.x), c1 = bfhi(pw.x), c2 = bflo(pw.y), c3 = bfhi(pw.y);
    float pm = bf2f(pi[-1]), pp = bf2f(pi[4]); pm = first ? 0.f : pm; pp = last ? 0.f : pp;
    x[0] = bs + w0 * pm + w1 * c0 + w2 * c1; x[1] = bs + w0 * c0 + w1 * c1 + w2 * c2; x[2] = bs + w0 * c1 + w1 * c2 + w2 * c3; x[3] = bs + w0 * c2 + w1 * c3 + w2 * pp;
}
template <int L, int USTR>
__device__ __forceinline__ void hy_fill_u(Frame& F, const bf16* phyT, int col, int rowb0, float w0, float w1, float w2, float bs) {
    const bf16* pc = phyT + (size_t)col * RT + rowb0;
    constexpr int NIT = 16 * L / 8 / 512 > 0 ? 16 * L / 8 / 512 : 1;
#pragma unroll 4
    for (int it = 0; it < NIT; ++it) { const int ch = F.tid + 512 * it; const int b = ch / (L / 8), tb = (ch - b * (L / 8)) * 8; const bf16* p = pc + (size_t)b * L + tb;
        const v4u cw = *(const v4u*)p; float pm = bf2f(p[-1]), pp = bf2f(p[8]); pm = tb == 0 ? 0.f : pm; pp = tb + 8 >= L ? 0.f : pp;
        const float c0 = bflo(cw.x), c1 = bfhi(cw.x), c2 = bflo(cw.y), c3 = bfhi(cw.y), c4 = bflo(cw.z), c5 = bfhi(cw.z), c6 = bflo(cw.w), c7 = bfhi(cw.w);
        v4u o; o.x = pk2(bs + w0 * pm + w1 * c0 + w2 * c1, bs + w0 * c0 + w1 * c1 + w2 * c2); o.y = pk2(bs + w0 * c1 + w1 * c2 + w2 * c3, bs + w0 * c2 + w1 * c3 + w2 * c4);
        o.z = pk2(bs + w0 * c3 + w1 * c4 + w2 * c5, bs + w0 * c4 + w1 * c5 + w2 * c6); o.w = pk2(bs + w0 * c5 + w1 * c6 + w2 * c7, bs + w0 * c6 + w1 * c7 + w2 * pp);
        *(LAS v4u*)(F.lds + HY_U_OFF + b * USTR + tb * 2) = o; }
}
template <int KLEN, int KSTR>
__device__ __forceinline__ void hy_fill_k(Frame& F, const bf16* kr) {
    const bf16* src = kr + (size_t)F.wave * KLEN + F.lane * 8;
#pragma unroll
    for (int i = 0; i < KLEN * 2 / 1024; ++i)
        __builtin_amdgcn_global_load_lds((const unsigned*)(src + i * 512), (LAS unsigned*)(F.lds + HY_K_OFF + (KSTR == HY_K_STRIDE ? hy_kcopy_off(F.wave) : F.wave * KSTR) + i * 1024), 16, 0, 0);
    VM_WAIT();
}
__device__ __forceinline__ void hyena_unit(Frame& F, int l, int c, bool with_ctx) {
    const bf16* phyT = (const bf16*)(F.ws + WS_PHYT);
    const bf16* KRL = (const bf16*)(F.ws + WS_KRL); const bf16* KRC = (const bf16*)(F.ws + WS_KRC);
    const float* sw = inp(F, I_HSW) + l * 3 * 1536; const float* sb = inp(F, I_HSB) + l * 1536;
    const int lane = F.lane, w = F.wave, r = lane & 15, q = lane >> 4, m = (-r) & 7;
    __syncthreads();
    { const int col = 1024 + c; hy_fill_u<LSEQ, HY_U_STRIDE>(F, phyT, col, 0, sw[col], sw[1536 + col], sw[3072 + col], sb[col]); }
    hy_fill_k<4096, HY_K_STRIDE>(F, KRL + (size_t)((0 * 512 + c) * 8) * 4096);
    __syncthreads();
#pragma unroll 1
    for (int o = 0; o < 2; ++o) {
        f32x4 acc[16];
#pragma unroll 1
        for (int rep_ = 0; rep_ < NREP(15); ++rep_) {
#pragma unroll
        for (int i = 0; i < 16; ++i) acc[i] = (f32x4){0.f, 0.f, 0.f, 0.f};
        const LAS unsigned char* pa = F.lds + HY_K_OFF + hy_kcopy_off(m) + 2 * (8 * q - r - m + 2048 - 256 * w);
        const LAS unsigned char* pb = F.lds + HY_U_OFF + r * HY_U_STRIDE + 16 * q;
        bf16x8 R[16];
#pragma unroll
        for (int i = 0; i < 16; ++i) R[i] = *(const LAS bf16x8*)(pa - 32 * i);
        bf16x8 bcur = *(const LAS bf16x8*)pb;
#pragma unroll 1
        for (int kg = 0; kg < 8; ++kg) {
#pragma unroll
            for (int kk = 0; kk < 8; ++kk) {
                const bf16x8 bnext = *(const LAS bf16x8*)(pb + 64 * (kk + 1));
                const bf16x8 n0 = *(const LAS bf16x8*)(pa + 64 * (kk + 1)), n1 = *(const LAS bf16x8*)(pa + 64 * (kk + 1) - 32);
#pragma unroll
                for (int i = 0; i < 16; ++i) acc[i] = __builtin_amdgcn_mfma_f32_16x16x32_bf16(R[(i - 2 * kk) & 15], bcur, acc[i], 0, 0, 0);
                R[(-2 * (kk + 1)) & 15] = n0; R[(1 - 2 * (kk + 1)) & 15] = n1; bcur = bnext;
                __builtin_amdgcn_sched_barrier(0);
            }
            pa += 512; pb += 512;
        }
        }
        const int col = o * 512 + c; const float w0 = sw[col], w1 = sw[1536 + col], w2 = sw[3072 + col], bs = sb[col];
        int tb0 = 256 * w + 4 * q; asm volatile("" : "+v"(tb0));
        const bf16* p = phyT + (size_t)col * RT + (size_t)r * LSEQ + tb0;
#pragma unroll
        for (int i = 0; i < 16; ++i) { f32x4 x; hy_short4u(p + 16 * i, tb0 + 16 * i == 0, tb0 + 16 * i + 4 >= LSEQ, w0, w1, w2, bs, x); acc[i] = acc[i] * x; }
        if (o == 0) {
            __syncthreads();
#pragma unroll
            for (int i = 0; i < 16; ++i) { v2u zw; zw.x = pk2(acc[i][0], acc[i][1]); zw.y = pk2(acc[i][2], acc[i][3]); *(LAS v2u*)(F.lds + HY_U_OFF + r * HY_U_STRIDE + (tb0 + 16 * i) * 2) = zw; }
            hy_fill_k<4096, HY_K_STRIDE>(F, KRL + (size_t)((1 * 512 + c) * 8) * 4096);
            __syncthreads();
        } else {
            GAS bf16* zt = (GAS bf16*)(F.ws + WS_PHYT) + (size_t)(1024 + c) * RT + (size_t)r * LSEQ + tb0; asm volatile("" : "+v"(zt));
#pragma unroll
            for (int i = 0; i < 16; ++i) { v2u zw; zw.x = pk2(acc[i][0], acc[i][1]); zw.y = pk2(acc[i][2], acc[i][3]); *(GAS v2u*)(zt + 16 * i) = zw; }
        }
    }
    if (!with_ctx) return;
    __syncthreads();
    { const int col = 1024 + c; hy_fill_u<LCTX, HYC_U_STRIDE>(F, phyT, col, NX, sw[col], sw[1536 + col], sw[3072 + col], sb[col]); }
    hy_fill_k<512, HYC_K_STRIDE>(F, KRC + (size_t)((0 * 512 + c) * 8) * 512);
    __syncthreads();
#pragma unroll 1
    for (int o = 0; o < 2; ++o) {
        f32x4 acc[2];
        acc[0] = (f32x4){0.f, 0.f, 0.f, 0.f}; acc[1] = acc[0];
        const LAS unsigned char* pa = F.lds + HY_K_OFF + m * HYC_K_STRIDE + 2 * (8 * q - r - m + 256 - 32 * w);
        const LAS unsigned char* pb = F.lds + HY_U_OFF + r * HYC_U_STRIDE + 16 * q;
#pragma unroll
        for (int k = 0; k < 8; ++k) { const bf16x8 bfr = *(const LAS bf16x8*)(pb + 64 * k);
#pragma unroll
            for (int i = 0; i < 2; ++i) acc[i] = __builtin_amdgcn_mfma_f32_16x16x32_bf16(*(const LAS bf16x8*)(pa + 64 * k - 32 * i), bfr, acc[i], 0, 0, 0); }
        const int col = o * 512 + c; const float w0 = sw[col], w1 = sw[1536 + col], w2 = sw[3072 + col], bs = sb[col];
        int tb0 = 32 * w + 4 * q; asm volatile("" : "+v"(tb0));
        const bf16* p = phyT + (size_t)col * RT + NX + (size_t)r * LCTX + tb0;
#pragma unroll
        for (int i = 0; i < 2; ++i) { f32x4 x; hy_short4u(p + 16 * i, tb0 + 16 * i == 0, tb0 + 16 * i + 4 >= LCTX, w0, w1, w2, bs, x); acc[i] = acc[i] * x; }
        if (o == 0) {
            __syncthreads();
#pragma unroll
            for (int i = 0; i < 2; ++i) { v2u zw; zw.x = pk2(acc[i][0], acc[i][1]); zw.y = pk2(acc[i][2], acc[i][3]); *(LAS v2u*)(F.lds + HY_U_OFF + r * HYC_U_STRIDE + (tb0 + 16 * i) * 2) = zw; }
            hy_fill_k<512, HYC_K_STRIDE>(F, KRC + (size_t)((1 * 512 + c) * 8) * 512);
            __syncthreads();
        } else {
            GAS bf16* zt = (GAS bf16*)(F.ws + WS_PHYT) + (size_t)(1024 + c) * RT + NX + (size_t)r * LCTX + tb0;
#pragma unroll
            for (int i = 0; i < 2; ++i) { v2u zw; zw.x = pk2(acc[i][0], acc[i][1]); zw.y = pk2(acc[i][2], acc[i][3]); *(GAS v2u*)(zt + 16 * i) = zw; }
        }
    }
}

__device__ __forceinline__ void zt_transpose_phase(Frame& F, int ntok) {
    const bf16* zT = (const bf16*)(F.ws + WS_PHYT) + (size_t)1024 * RT; bf16* z2 = (bf16*)(F.ws + WS_Z2);
    LAS unsigned char* scr = F.lds + F.wave * 8448;
    const int gw = F.wave * F.G + F.vcu  , NGW = F.G * NWAVES, lane = F.lane, nblk = ntok / 64;
    const int lr = lane >> 3, pc = lane & 7;
    __syncthreads();
    for (int it = gw; it < 8 * nblk; it += NGW) {
        const int cb = it / nblk, tbk = it - cb * nblk;
        v4u in[8];
#pragma unroll
        for (int j = 0; j < 8; ++j) in[j] = *(const v4u*)(zT + (size_t)(cb * 64 + 8 * j + lr) * RT + tbk * 64 + pc * 8);
#pragma unroll
        for (int j = 0; j < 8; ++j) { LAS unsigned* d = (LAS unsigned*)(scr + (8 * j + lr) * 132 + pc * 16); d[0] = in[j].x; d[1] = in[j].y; d[2] = in[j].z; d[3] = in[j].w; }
        LDS_WAIT();
#pragma unroll
        for (int j = 0; j < 8; ++j) {
            const LAS unsigned short* sp = (const LAS unsigned short*)(scr + (pc * 8) * 132 + (8 * j + lr) * 2);
            unsigned hv[8];
#pragma unroll
            for (int k = 0; k < 8; ++k) hv[k] = sp[k * 66];
            v4u o; o.x = hv[0] | (hv[1] << 16); o.y = hv[2] | (hv[3] << 16); o.z = hv[4] | (hv[5] << 16); o.w = hv[6] | (hv[7] << 16);
            *(v4u*)(z2 + (size_t)(tbk * 64 + 8 * j + lr) * 512 + cb * 64 + pc * 8) = o; }
        LDS_WAIT();
    }
    __syncthreads();
}

__device__ __forceinline__ void cf_unit(Frame& F, int l, int seqrow, int seqlen, int t0) {
    LAS bf16* U = (LAS bf16*)F.lds;
    LAS float* O = (LAS float*)(F.lds + 98304);
    const bf16* ucf = (const bf16*)(F.ws + WS_UCF); bf16* out = (bf16*)(F.ws + WS_UCF2);
    __syncthreads();
    { v4u wv[12];
#pragma unroll
        for (int j = 0; j < 12; ++j) { const int pc = F.tid + 512 * j; const int i = pc >> 6, ch = pc & 63; const int t = t0 - 15 + i;
            wv[j] = (v4u){0u, 0u, 0u, 0u}; if (pc < 94 * 64 && t >= 0 && t < seqlen) wv[j] = *(const v4u*)(ucf + (size_t)(seqrow + t) * 512 + ch * 8); }
#pragma unroll
        for (int j = 0; j < 12; ++j) { const int pc = F.tid + 512 * j; const int i = pc >> 6, ch = pc & 63; if (pc < 94 * 64) *(LAS v4u*)(U + i * 512 + ch * 8) = wv[j]; } }
    const int c = F.tid;
    float w[31];
#pragma unroll
    for (int k = 0; k < 31; ++k) w[k] = inp(F, I_CFW)[(size_t)l * 31 * 512 + k * 512 + c];
    const float bias = inp(F, I_CFB)[l * 512 + c];
    const f32x4 g0 = *((const f32x4*)(inp(F, I_CFG) + l * 512) + F.lane), g1 = *((const f32x4*)(inp(F, I_CFG) + l * 512) + 64 + F.lane);
    const f32x4 b0 = *((const f32x4*)(inp(F, I_CFLB) + l * 512) + F.lane), b1 = *((const f32x4*)(inp(F, I_CFLB) + l * 512) + 64 + F.lane);
    __syncthreads();
#pragma unroll 1
    for (int r = 0; r < 4; ++r) {
        float v[16];
#pragma unroll
        for (int t = 0; t < 16; ++t) v[t] = bias;
        const LAS bf16* Ur = U + (16 * r) * 512 + c;
#pragma unroll
        for (int ii = 0; ii < 46; ++ii) { const float x = bf2f(Ur[ii * 512]);
#pragma unroll
            for (int t = 0; t < 16; ++t) { if (ii - t >= 0 && ii - t <= 30) v[t] += w[ii - t] * x; } }
#pragma unroll
        for (int t = 0; t < 16; ++t) O[t * 512 + c] = v[t];
        __syncthreads();
#pragma unroll
        for (int q = 0; q < 2; ++q) {
            const int tt = 2 * F.wave + q;
            f32x4 x0 = *((const LAS f32x4*)(O + tt * 512) + F.lane), x1 = *((const LAS f32x4*)(O + tt * 512) + 64 + F.lane);
            const float mean = wave_sum((x0[0] + x0[1]) + (x0[2] + x0[3]) + (x1[0] + x1[1]) + (x1[2] + x1[3])) * (1.f / 512.f);
            x0 = x0 - mean; x1 = x1 - mean;
            const float var = wave_sum((x0[0] * x0[0] + x0[1] * x0[1]) + (x0[2] * x0[2] + x0[3] * x0[3]) + (x1[0] * x1[0] + x1[1] * x1[1]) + (x1[2] * x1[2] + x1[3] * x1[3])) * (1.f / 512.f);
            const float rstd = 1.f / sqrtf(var + LN_EPS);
            f32x4 y0 = x0 * rstd * g0 + b0, y1 = x1 * rstd * g1 + b1;
#pragma unroll
            for (int j = 0; j < 4; ++j) { y0[j] = siluf_(y0[j]); y1[j] = siluf_(y1[j]); }
            bf16* orow = out + (size_t)(seqrow + t0 + 16 * r + tt) * 512;
            v2u o0, o1; o0.x = pk2(y0[0], y0[1]); o0.y = pk2(y0[2], y0[3]); o1.x = pk2(y1[0], y1[1]); o1.y = pk2(y1[2], y1[3]);
            *((v2u*)orow + F.lane) = o0; *((v2u*)orow + 64 + F.lane) = o1;
        }
        __syncthreads();
    }
}

#define TSUB(slot) do { if (DBG_TMASK) { const unsigned long long now_ = wall_clock64(); if (((DBG_TMASK >> (slot)) & 1u) && ((DBG_TLAYER >> l) & 1u)) t_acc += now_ - t_prev; t_prev = now_; } } while (0)
__device__ __forceinline__ void s5_unit(Frame& F, int l, int b, int gp, unsigned long long& t_acc, unsigned long long& t_prev) {
    const int lane = F.lane, w = F.wave;
    bf16* ps5 = (bf16*)(F.ws + WS_PS5); bf16* ydir = (bf16*)(F.ws + WS_YDIR);
    __syncthreads();
#pragma unroll 1
    for (int rep_ = 0; rep_ < NREP(14); ++rep_)
    {
        const int gd = w & 3, role = w >> 2;
        const int g = 2 * gp + (gd >> 1), dir = gd & 1;
        const int r = lane & 15, q = lane >> 4;
        LAS unsigned char* wl = F.lds + gd * 33280;
        LAS unsigned char* uS0 = wl;
        LAS float* BuS0 = (LAS float*)(wl + 4096);
        LAS unsigned char* stS0 = wl + 4096 + 2 * 10240;
        constexpr int NCH = (LCTX + LSEQ) / 16;
        const float* P = (const float*)(F.ws + WS_S5P) + (size_t)((dir * 32 + g) * 64) * 36;
        float abr = 0.f, abi = 0.f; f32x2 s2 = (f32x2){0.f, 0.f}, Aa = s2, Bn = s2;
        bf16x8 Bf[8], Cf[4];
        const int ti = lane >> 2, cq = lane & 3;
        auto urow = [&](int k) -> size_t { const bool isc = k < LCTX / 16; const int kk = isc ? k : k - LCTX / 16; const int Ls = isc ? LCTX : LSEQ; const int rowb = isc ? NX + b * LCTX : b * LSEQ;
            const int st = kk * 16 + ti; const int t = dir ? (Ls - 1 - st) : st; return (size_t)(rowb + t) * 512 + g * 16 + 4 * cq; };
        v2u ublk[8];
#pragma unroll
        for (int j = 0; j < 8; ++j) ublk[j] = (v2u){0u, 0u};
        static_assert(((LCTX + LSEQ) / 16) % 8 == 0, "s5 input blocks");
        if (role == 0) { abr = P[lane * 36]; abi = P[lane * 36 + 1]; Aa = (f32x2){abr, abr}; Bn = (f32x2){-abi, abi}; }
        else {
#pragma unroll
            for (int blk = 0; blk < 8; ++blk) { const int pp = 16 * blk + r; const float* src = P + (size_t)(pp & 63) * 36 + (pp < 64 ? 2 : 18) + 8 * (q & 1);
                v4u t4; t4.x = pk2(src[0], src[1]); t4.y = pk2(src[2], src[3]); t4.z = pk2(src[4], src[5]); t4.w = pk2(src[6], src[7]);
                if (q >= 2) t4 = (v4u){0u, 0u, 0u, 0u};
                Bf[blk] = __builtin_bit_cast(bf16x8, t4); }
            const float* cre = inp(F, I_SCRE) + (size_t)(((l * 2 + dir) * 32 + g) * 16) * 64; const float* cim = inp(F, I_SCIM) + (size_t)(((l * 2 + dir) * 32 + g) * 16) * 64;
#pragma unroll
            for (int ks = 0; ks < 4; ++ks) { const int p0 = 16 * ks + 4 * q; const f32x4 a = *(const f32x4*)(cre + r * 64 + p0), c4 = *(const f32x4*)(cim + r * 64 + p0);
                v4u t4; t4.x = pk2(a[0], -c4[0]); t4.y = pk2(a[1], -c4[1]); t4.z = pk2(a[2], -c4[2]); t4.w = pk2(a[3], -c4[3]);
                Cf[ks] = __builtin_bit_cast(bf16x8, t4); }
#pragma unroll
            for (int j = 0; j < 8; ++j) ublk[j] = *(const v2u*)(ps5 + urow(j));
#pragma unroll
            for (int j = 0; j < 8; ++j) *(LAS v2u*)(uS0 + j * 512 + ti * 32 + 8 * cq) = ublk[j];
#pragma unroll
            for (int j = 0; j < 8; ++j) ublk[j] = *(const v2u*)(ps5 + urow(8 + j));
        }
        LDS_WAIT(); __builtin_amdgcn_s_barrier(); asm volatile("" ::: "memory");
#pragma unroll 1
        for (int k = 0; k < NCH + 2; ++k) {
            const int p0 = k & 1, p1 = p0 ^ 1;
            unsigned long long tb0_ = 0; if (DBG_TMASK & 0x300000u) tb0_ = wall_clock64();
            if (role == 1) {
                bf16x8 ua, sf[4];
                if (k < NCH) { const v4u t4 = *(const LAS v4u*)(uS0 + (k & 7) * 512 + r * 32 + 16 * (q & 1)); ua = __builtin_bit_cast(bf16x8, q < 2 ? t4 : (v4u){0u, 0u, 0u, 0u}); }
                if (k < NCH) {
#pragma unroll
                    for (int blk = 0; blk < 8; ++blk) { const f32x4 d = __builtin_amdgcn_mfma_f32_16x16x32_bf16(ua, Bf[blk], (f32x4){0.f, 0.f, 0.f, 0.f}, 0, 0, 0);
                        *(LAS f32x4*)(BuS0 + p0 * 2560 + (16 * blk + r) * 20 + 4 * q) = d; }
                }
                if (k >= 2) {
#pragma unroll
                    for (int ks = 0; ks < 4; ++ks) sf[ks] = *(const LAS bf16x8*)(stS0 + p0 * 4352 + r * 272 + 64 * ks + 16 * q); }
                if ((k & 7) == 7 && k + 1 < NCH) {
#pragma unroll
                    for (int j = 0; j < 8; ++j) *(LAS v2u*)(uS0 + j * 512 + ti * 32 + 8 * cq) = ublk[j];
                    if (k + 9 < NCH) {
#pragma unroll
                        for (int j = 0; j < 8; ++j) ublk[j] = *(const v2u*)(ps5 + urow(k + 9 + j)); } }
                if (k >= 2) {
                    f32x4 y0 = __builtin_amdgcn_mfma_f32_16x16x32_bf16(sf[0], Cf[0], (f32x4){0.f, 0.f, 0.f, 0.f}, 0, 0, 0), y1 = __builtin_amdgcn_mfma_f32_16x16x32_bf16(sf[1], Cf[1], (f32x4){0.f, 0.f, 0.f, 0.f}, 0, 0, 0);
                    y0 = __builtin_amdgcn_mfma_f32_16x16x32_bf16(sf[2], Cf[2], y0, 0, 0, 0); y1 = __builtin_amdgcn_mfma_f32_16x16x32_bf16(sf[3], Cf[3], y1, 0, 0, 0);
                    const f32x4 y = y0 + y1; const int kc = k - 2;
                    const bool isc = kc < LCTX / 16; const int kk = isc ? kc : kc - LCTX / 16; const int Ls = isc ? LCTX : LSEQ; const int rowb = isc ? NX + b * LCTX : b * LSEQ;
#pragma unroll
                    for (int i = 0; i < 4; ++i) { const int st = kk * 16 + 4 * q + i; const int t = dir ? (Ls - 1 - st) : st;
                        ydir[(size_t)dir * RT * 512 + (size_t)(rowb + t) * 512 + g * 16 + r] = (bf16)f2bf(y[i]); } }
            } else if (k >= 1 && k <= NCH) {
                __builtin_amdgcn_s_setprio(3);
                f32x4 bre[4], bim[4];
#pragma unroll
                for (int j = 0; j < 4; ++j) { bre[j] = *(const LAS f32x4*)(BuS0 + p1 * 2560 + lane * 20 + 4 * j); bim[j] = *(const LAS f32x4*)(BuS0 + p1 * 2560 + (64 + lane) * 20 + 4 * j); }
                float sr = s2[0], si = s2[1];
#pragma unroll
                for (int i = 0; i < 16; ++i) {
                    const float tr = __builtin_fmaf(-abi, si, bre[i >> 2][i & 3]), ti = __builtin_fmaf(abi, sr, bim[i >> 2][i & 3]);
                    sr = __builtin_fmaf(abr, sr, tr); si = __builtin_fmaf(abr, si, ti);
                    asm volatile("" : "+v"(sr), "+v"(si));
                    *(LAS unsigned*)(stS0 + p1 * 4352 + i * 272 + 4 * lane) = pk2(sr, si); }
                s2 = (f32x2){sr, si};
                __builtin_amdgcn_s_setprio(0);
            }
            if ((DBG_TMASK & 0x300000u) && ((DBG_TLAYER >> l) & 1u) && role == (int)((DBG_TMASK >> 21) & 1u)) { LDS_WAIT(); t_acc += wall_clock64() - tb0_; }
            LDS_WAIT(); __builtin_amdgcn_s_barrier(); asm volatile("" ::: "memory");
        }
    }
    VM_WAIT();
    __syncthreads();
    TSUB(19);
    const float* dsk = inp(F, I_SD) + l * 512 + gp * 32;
    static_assert((LCTX + LSEQ) * 4 % (512 * 3) == 0, "combine batches");
#pragma unroll 1
    for (int e0 = F.tid; e0 < (LCTX + LSEQ) * 4; e0 += 512 * 3) {
        const int pc = e0 & 3; size_t off[3]; v4u uw[3], fw[3], bw[3];
#pragma unroll
        for (int j = 0; j < 3; ++j) { const int rr = (e0 + 512 * j) >> 2; const int row = rr < LSEQ ? b * LSEQ + rr : NX + b * LCTX + (rr - LSEQ);
            off[j] = (size_t)row * 512 + gp * 32 + pc * 8;
            uw[j] = *(const v4u*)(ps5 + off[j]); fw[j] = *(const v4u*)(ydir + off[j]); bw[j] = *(const v4u*)(ydir + (size_t)RT * 512 + off[j]); }
        const f32x4 d0 = *(const f32x4*)(dsk + pc * 8), d1 = *(const f32x4*)(dsk + pc * 8 + 4);
#pragma unroll
        for (int j = 0; j < 3; ++j) {
            f32x4 u0, u1, f0, f1, b0, b1; unpack8(uw[j], u0, u1); unpack8(fw[j], f0, f1); unpack8(bw[j], b0, b1);
            f32x4 o0, o1;
#pragma unroll
            for (int i = 0; i < 4; ++i) { o0[i] = gelu_tanh(f0[i] + b0[i] + d0[i] * u0[i]); o1[i] = gelu_tanh(f1[i] + b1[i] + d1[i] * u1[i]); }
            *(v4u*)((bf16*)(F.ws + WS_SG) + off[j]) = pack8(o0, o1); }
    }
}

__device__ __forceinline__ Frame make_frame(const Args& args, LAS unsigned char* lds, int wave_s);
__device__ __forceinline__ void mixers_phase(const Args& args, LAS unsigned char* lds, int wave_s, int l, unsigned long long& t_acc, unsigned long long& t_prev) {
#ifndef MIXMASK
#define MIXMASK 7
#endif
    if (MIXMASK & 1) { Frame F = make_frame(args, lds, wave_s);
#pragma unroll 1
        for (int u = F.vcu; u < NB * 16; u += F.G) s5_unit(F, l, u >> 4, u & 15, t_acc, t_prev); }
    TSUB(16);
    if (MIXMASK & 2) { Frame F = make_frame(args, lds, wave_s);
#pragma unroll 1
        for (int u = F.vcu; u < 512; u += F.G) hyena_unit(F, l, u, l == 0);
        if (NREP(10) == 2) {
#pragma unroll 1
            for (int u = F.vcu; u < 512; u += F.G) hyena_unit(F, l, u, l == 0); } }
    TSUB(17);
    if (MIXMASK & 4) { Frame F = make_frame(args, lds, wave_s);
        const int ncf = l == 0 ? NB * 32 + NB * 4 : NB * 32;
#pragma unroll 1
        for (int u = F.vcu; u < ncf; u += F.G) { if (u < NB * 32) cf_unit(F, l, u * 64, 64, 0); else { const int q = u - NB * 32; cf_unit(F, l, NX + (q >> 2) * LCTX, LCTX, (q & 3) * 64); } } }
    TSUB(18);
    __syncthreads();
}

constexpr int PH_P0A = 0, PH_P0B = 1, PH_L0 = 2, PH_L1 = 12, N_PHASES = 27;
__device__ __forceinline__ Frame make_frame(const Args& args, LAS unsigned char* lds, int wave_s) {
    unsigned z0 = 0u; asm volatile("" : "+v"(z0));
    Frame F; int t = wave_s * 64 + (int)__builtin_amdgcn_mbcnt_hi(~0u, __builtin_amdgcn_mbcnt_lo(~0u, z0)); asm volatile("" : "+v"(t));
    unsigned char* ws = args.ws; float* out = args.out;
    F.lds = lds; F.tid = t; F.lane = t & 63; F.wave = wave_s;
    int G = gridDim.x, bx = blockIdx.x; asm volatile("" : "+s"(G), "+s"(bx));
    F.G = G; F.vcu = (G % 8 == 0) ? (bx % 8) * (G / 8) + bx / 8 : bx;
    const float* const* inp = args.in;
    F.in = inp; F.out = out; F.ws = ws; return F;
}
__global__ void __launch_bounds__(NWAVES * 64, 2) mega_fwd(Args args) {
    extern __shared__ __attribute__((aligned(16))) unsigned char lds_raw[];
    LAS unsigned char* const lds = (LAS unsigned char*)lds_raw;
    volatile LAS unsigned* MISC = (volatile LAS unsigned*)(lds + MISC_OFF);
    for (int u = threadIdx.x; u < (LDS_BYTES - MISC_OFF) / 4; u += NWAVES * 64) ((LAS unsigned*)(lds + MISC_OFF))[u] = 0u;
    int wave_s = __builtin_amdgcn_readfirstlane((int)threadIdx.x >> 6); asm volatile("" : "+s"(wave_s));
    __syncthreads();
    const int lo = MK_PER_PHASE_LAUNCH ? args.ph_lo : 0, hi = MK_PER_PHASE_LAUNCH ? args.ph_hi : N_PHASES;
    XcdBarrier bar; bar.bar = (unsigned*)(args.ws + WS_CTL) + CW_BAR; bar.x = 0; bar.st = nullptr;
    if (hi - lo > 1) bar = xcd_barrier_post((unsigned*)(args.ws + WS_CTL) + CW_BAR, MISC + 8);
#ifndef PHMASK
#define PHMASK 0xffffffffu
#endif
#define IN(k) (lo <= (k) && (k) < hi)
#define PM(b) ((PHMASK >> (b)) & 1u)
#define SEAM(k) do { if (IN(k) && IN((k) + 1)) xcd_barrier(bar, wave_s); } while (0)
    unsigned long long t_acc = 0, t_prev = DBG_TMASK ? wall_clock64() : 0ull;
#define TSLOT(slot, lyr) do { if (DBG_TMASK) { const unsigned long long now_ = wall_clock64(); if (((DBG_TMASK >> (slot)) & 1u) && ((DBG_TLAYER >> (lyr)) & 1u)) t_acc += now_ - t_prev; t_prev = now_; } } while (0)
#define FRAME() Frame F = make_frame(args, lds, wave_s); const char* ws = (const char*)F.ws; const int c = F.G == (int)gridDim.x ? (int)blockIdx.x : 0; (void)ws; (void)c

    if (PM(0) && IN(PH_P0A)) { FRAME(); REPEAT(NREP(12), p0a_prologue(F)); } SEAM(PH_P0A); TSLOT(0, 0);

#pragma unroll 1
    for (int l = 0; l < 2; ++l) {
        const int pb = l == 0 ? PH_L0 : PH_L1;
        const int nMl = l == 0 ? RT / 256 : NX / 256;
        if (l == 0) {
        if (PM(2) && IN(pb + 0)) { { FRAME(); REPEAT(NREP(8), lnmod_phase(F, l)); } { FRAME(); h2table_phase(F, l); } { FRAME(); s5params_phase(F, l); } } SEAM(pb + 0); TSLOT(2, l); }
        if (PM(3) && IN(pb + 1)) { { FRAME(); REPEAT(NREP(9), filter_expand_phase(F, l)); }
            { FRAME(); SchedPlain S; S.R.init(6, nMl, F.G, c); S.A = ws + WS_WIN + (size_t)l * 6144 * 1024 * 2; S.B = ws + WS_HX; S.tsA = 256 * 1024 * 2; S.tsB = 256 * 1024 * 2; S.xM = 0; S.xN0 = 0; S.xNn = 1;
              EpiHyT E{(bf16*)(F.ws + WS_PHYT)}; pg8::gemm_phase<EpiHyT, SchedPlain>(F.lds, F.tid, 2048, S, E); }
            { FRAME(); SchedPlain S; S.R.init(nMl, 6, F.G, (c + (F.G * 3) / 8) % F.G); S.A = ws + WS_HX; S.B = ws + WS_WIN + ((size_t)l * 6144 + 1536) * 1024 * 2; S.tsA = 256 * 1024 * 2; S.tsB = 256 * 1024 * 2;
              S.xM = l == 0 ? 0 : NCX / 256; S.xN0 = 4; S.xNn = 2;
              EpiInproj E{(bf16*)(F.ws + WS_PHYT), (bf16*)(F.ws + WS_UCF), (bf16*)(F.ws + WS_PS5), 6};
              pg8::gemm_phase<EpiInproj, SchedPlain>(F.lds, F.tid, 2048, S, E); }
        } SEAM(pb + 1); TSLOT(3, l);
        if (PM(4) && IN(pb + 2)) { mixers_phase(args, lds, wave_s, l, t_acc, t_prev); } SEAM(pb + 2); TSLOT(4, l);
        if (PM(5) && IN(pb + 3)) {
            { FRAME(); zt_transpose_phase(F, l == 0 ? RT : NX); }
            { FRAME(); SchedPlain S; S.R.init(nMl, 12, F.G, c); S.A = ws + WS_HX; S.B = ws + WS_WIN + ((size_t)l * 6144 + 3072) * 1024 * 2; S.tsA = 256 * 1024 * 2; S.tsB = 256 * 1024 * 2; S.xM = 0; S.xN0 = 0; S.xNn = 1;
              EpiGates E{(bf16*)(F.ws + WS_G), F.tid}; REPEAT(NREP(1), pg8::gemm_phase<EpiGates, SchedPlain>(F.lds, F.tid, 2048, S, E, (DBG_TMASK & 0x1000000u) && l == 0 ? &t_acc : nullptr)); }
#ifndef DBG_SKIP_GLU
            { FRAME(); SchedPlain S; S.R.init(nMl, 2, F.G, (c + F.G / 4) % F.G); S.A = ws + WS_SG; S.B = ws + WS_WGLU + (size_t)l * 512 * 512 * 2; S.tsA = 256 * 512 * 2; S.tsB = 256 * 512 * 2; S.xM = 0; S.xN0 = 0; S.xNn = 1;
              EpiGlu E{(const bf16*)(F.ws + WS_SG), (bf16*)(F.ws + WS_S5Y), inp(F, I_SBGLU) + l * 512}; REPEAT(NREP(2), pg8::gemm_phase<EpiGlu, SchedPlain>(F.lds, F.tid, 1024, S, E)); }
#endif
        } SEAM(pb + 3); TSLOT(5, l);
        if (PM(6) && IN(pb + 4)) { FRAME();
            SchedMerge S; S.R.init(nMl, 4, F.G, c); S.A = ws + WS_Z2; S.sA = WS_UCF2 - WS_Z2; S.B = ws + WS_WOUTS + (size_t)(l * 3) * 1024 * 512 * 2; S.sB = (size_t)1024 * 512 * 2;
            S.tsA = 256 * 512 * 2; S.tsB = 256 * 512 * 2;
            EpiMerge E{(const bf16*)(F.ws + WS_G), (bf16*)(F.ws + WS_HX), F.tid};
            REPEAT(NREP(3), pg8::gemm_phase<EpiMerge, SchedMerge>(F.lds, F.tid, 1024, S, E));
        } SEAM(pb + 4); TSLOT(6, l);
        if (PM(7) && IN(pb + 5)) { FRAME();
            SchedPlain S; S.R.init(nMl, 4, F.G, c); S.A = ws + WS_HX; S.B = ws + WS_WO + (size_t)l * 1024 * 1024 * 2; S.tsA = 256 * 1024 * 2; S.tsB = 256 * 1024 * 2; S.xM = 0; S.xN0 = 0; S.xNn = 1;
            EpiRes E{l == 0 ? inp(F, I_X) : F.out, l == 0 ? inp(F, I_CTX) : (const float*)(F.ws + WS_XC), (bf16*)(F.ws + WS_KRL), (const float*)(F.ws + WS_MODS) + (size_t)l * 17 * INC + 2 * 1024, 1.0f};
            REPEAT(((l == 0) ? NREP(4) : 1), pg8::gemm_phase<EpiRes, SchedPlain>(F.lds, F.tid, 2048, S, E));
        } SEAM(pb + 5); TSLOT(7, l);
        if (PM(8) && IN(pb + 6)) { { FRAME(); if (l == 0) ln1_phase<false>(F, l); else ln1_phase<true>(F, l); } if (l == 1) { FRAME(); REPEAT(NREP(13), moe_convert_phase(F)); } } SEAM(pb + 6); TSLOT(8, l);
        if (l == 0) {
            if (PM(9) && IN(pb + 7)) { FRAME();
                SchedPlain S; S.R.init(RT / 256, 22, F.G, c); S.A = ws + WS_HX; S.B = ws + WS_W13; S.tsA = 256 * 1024; S.tsB = 256 * 1024; S.xM = 0; S.xN0 = 0; S.xNn = 1;
                EpiSwigluF8 E{F.ws + WS_G, DFF, 0.03125f}; REPEAT(NREP(5), pg8::gemm_phase<EpiSwigluF8, SchedPlain, true>(F.lds, F.tid, 1024, S, E, (DBG_TMASK & 0x1000000u) ? nullptr : &t_acc));
            } SEAM(pb + 7); TSLOT(9, 0);
            if (PM(10) && IN(pb + 8)) { FRAME();
                SchedPlain S; S.R.init(RT / 256, 4, F.G, c); S.A = ws + WS_G; S.B = ws + WS_W2; S.tsA = (size_t)256 * DFF; S.tsB = (size_t)256 * DFF; S.xM = 0; S.xN0 = 0; S.xNn = 1;
                EpiRes E{F.out, (const float*)(F.ws + WS_XC), (bf16*)(F.ws + WS_KRL), (const float*)(F.ws + WS_MODS) + 5 * 1024, 0.0078125f};
                pg8::gemm_phase<EpiRes, SchedPlain, true>(F.lds, F.tid, DFF, S, E);
            } SEAM(pb + 8); TSLOT(10, 0);
            if (PM(11) && IN(pb + 9)) { { FRAME(); ln2_phase(F, l); } { FRAME(); h2table_phase(F, 1); } { FRAME(); s5params_phase(F, 1); } } SEAM(pb + 9); TSLOT(11, 0);
        } else {
            if (PM(15) && IN(pb + 7)) { FRAME(); moe_setup_phase(F); } SEAM(pb + 7); TSLOT(12, 1);
#pragma unroll 1
            for (int st = 0; st < 6; ++st) {
                if (PM(13) && IN(pb + 8 + st) && st >= 1) { FRAME(); const int* tile_e = (const int*)(F.ws + WS_META + META_TILE); const int ch = st - 1;
                    const int ntiles = tile_e[511]; int nmc = ntiles - 64 * ch; nmc = nmc < 0 ? 0 : (nmc > 64 ? 64 : nmc);
                    SchedMoe S; S.R.init(nmc, 4, F.G, c); S.A = ws + WS_HID + (size_t)(ch & 1) * HID_BUF; S.B = ws + WS_MW2; S.tsA = (size_t)256 * DEX; S.tsB = (size_t)256 * DEX; S.esB = (size_t)1024 * DEX; S.tile_e = tile_e; S.tile0 = 64 * ch; S.a_global = false;
                    EpiMoeDown E{(bf16*)(F.ws + WS_MOEY), 0.0078125f}; REPEAT(NREP(7), pg8::gemm_phase<EpiMoeDown, SchedMoe, true>(F.lds, F.tid, DEX, S, E));
                }
                if (PM(12) && IN(pb + 8 + st) && st <= 4) { FRAME(); const int* tile_e = (const int*)(F.ws + WS_META + META_TILE); const int ch = st;
                    const int ntiles = tile_e[511]; int nmc = ntiles - 64 * ch; nmc = nmc < 0 ? 0 : (nmc > 64 ? 64 : nmc);
                    SchedMoe S; S.R.init(nmc, 28, F.G, c); S.A = ws + WS_SORT; S.B = ws + WS_MW13; S.tsA = 256 * 1024; S.tsB = 256 * 1024; S.esB = (size_t)7168 * 1024; S.tile_e = tile_e; S.tile0 = 64 * ch; S.a_global = true;
                    EpiSwigluF8 E{F.ws + WS_HID + (size_t)(ch & 1) * HID_BUF, DEX, 0.03125f}; REPEAT(NREP(6), pg8::gemm_phase<EpiSwigluF8, SchedMoe, true>(F.lds, F.tid, 1024, S, E));
                }
                SEAM(pb + 8 + st); TSLOT(13, 1);
            }
            if (PM(14) && IN(pb + 14)) { FRAME(); moe_combine_phase(F); } TSLOT(14, 1);
        }
    }
    if (DBG_TMASK) { const unsigned long long t0_ = wall_clock64(); while (wall_clock64() - t0_ < t_acc) __builtin_amdgcn_s_sleep(16); }
#undef IN
#undef SEAM
#undef FRAME
}


#ifdef DBG_DUMP
__global__ void dbg_dump(const unsigned char* ws, float* out) {
    const size_t NE = (size_t)RT * 512; const bf16* a = (const bf16*)(ws + WS_PS5); const bf16* b = (const bf16*)(ws + WS_Z2); const bf16* c = (const bf16*)(ws + WS_UCF2);
    for (size_t i = (size_t)blockIdx.x * blockDim.x + threadIdx.x; i < (size_t)NX * DM; i += (size_t)gridDim.x * blockDim.x) {
        const size_t j = i % NE; const int k = (int)(i / NE);
        float v;
        if (DBG_DUMP == 8) v = i < (size_t)26 * 1024 * 1024 ? bf2f(((const bf16*)(ws + WS_WIN))[i]) : 0.f;
        else if (DBG_DUMP == 7) v = k == 0 ? bf2f(a[j]) : bf2f(((const bf16*)(ws + WS_UCF))[j]);
        else if (DBG_DUMP == 4) v = bf2f(((const bf16*)(ws + WS_HX))[i]);
        else if (DBG_DUMP == 5) v = bf2f(((const bf16*)(ws + WS_G))[i]);
        else if (DBG_DUMP == 6) v = bf2f(((const bf16*)(ws + WS_S5Y))[i % NE]);
        else if (DBG_DUMP == 1) v = k == 0 ? bf2f(a[j]) : bf2f(b[j]);
        else if (DBG_DUMP == 2) v = k == 0 ? bf2f(b[j]) : bf2f(c[j]);
        else v = k == 0 ? bf2f(c[j]) : bf2f(a[j]);
        out[i] = v;
    }
}
#endif
extern "C" void kernel_launch(void* const* d_in, const int* in_sizes, int n_in, void* d_out, int out_size, void* d_ws, size_t ws_size, hipStream_t stream) {
    static int grid = 0;
    if (grid == 0) {
        if (n_in != N_IN || out_size != NX * DM || ws_size < WS_END2) { fprintf(stderr, "kernel_launch: unexpected shapes (n_in %d, out %d, ws %zu)\n", n_in, out_size, ws_size); grid = -1; return; }
        int dev = 0, cus = 0, per_cu = 0;
        if (hipGetDevice(&dev) != hipSuccess || hipDeviceGetAttribute(&cus, hipDeviceAttributeMultiprocessorCount, dev) != hipSuccess) { grid = -1; return; }
        if (hipFuncSetAttribute((const void*)mega_fwd, hipFuncAttributeMaxDynamicSharedMemorySize, LDS_BYTES) != hipSuccess) { fprintf(stderr, "kernel_launch: hipFuncSetAttribute failed\n"); grid = -1; return; }
        if (hipOccupancyMaxActiveBlocksPerMultiprocessor(&per_cu, (const void*)mega_fwd, NWAVES * 64, LDS_BYTES) != hipSuccess || per_cu < 1) fprintf(stderr, "kernel_launch: occupancy query reports %d\n", per_cu);
        (void)hipGetLastError();
        grid = cus;
    }
    if (grid < 0) return;
    (void)hipMemsetAsync((char*)d_ws + WS_CTL, 0, CTL_ZERO_BYTES, stream);
    Args a{};
    for (int i = 0; i < N_IN; ++i) a.in[i] = (const float*)d_in[i];
    a.out = (float*)d_out; a.ws = (unsigned char*)d_ws;
#if MK_PER_PHASE_LAUNCH
    for (int p = 0; p < DBG_NPH; ++p) { a.ph_lo = p; a.ph_hi = p + 1; hipLaunchKernelGGL(mega_fwd, dim3(grid), dim3(NWAVES * 64), LDS_BYTES, stream, a); }
#ifdef DBG_DUMP
    hipLaunchKernelGGL(dbg_dump, dim3(2048), dim3(256), 0, stream, (const unsigned char*)d_ws, (float*)d_out);
#endif
#else
    a.ph_lo = 0; a.ph_hi = N_PHASES; hipLaunchKernelGGL(mega_fwd, dim3(grid), dim3(NWAVES * 64), LDS_BYTES, stream, a);
#endif
}
```

```cpp
#include <hip/hip_runtime.h>
#include <cstdio>
#include <cstdint>

#ifndef DBG_REP
#define DBG_REP 0
#endif
#define NREP(bit) (((DBG_REP >> (bit)) & 1) ? 2 : 1)
#define REPEAT(n, ...) do { __VA_ARGS__; if ((n) == 2) { __VA_ARGS__; } } while (0)
#ifndef DBG_NPH
#define DBG_NPH N_PHASES
#define DBG_TMASK 0u
#define DBG_TLAYER 3u
#endif
#ifndef MK_PER_PHASE_LAUNCH
#define MK_PER_PHASE_LAUNCH 0
#endif

#define GAS __attribute__((address_space(1)))
#define LAS __attribute__((address_space(3)))
typedef unsigned short bf16;
typedef unsigned v4u __attribute__((ext_vector_type(4)));
typedef unsigned v2u __attribute__((ext_vector_type(2)));
typedef float f32x4 __attribute__((ext_vector_type(4)));
typedef float f32x2 __attribute__((ext_vector_type(2)));
typedef short bf16x8 __attribute__((ext_vector_type(8)));

constexpr int NB = 16, LSEQ = 2048, LCTX = 256, DM = 1024;
constexpr int NX = NB * LSEQ;
constexpr int NCX = NB * LCTX;
constexpr int RT = NX + NCX;
constexpr int INC = 6144, DFF = 2816, DEX = 3584, NEXP = 8;
constexpr float ALPHA_F = 1.41421356237f;
constexpr float LN_EPS = 1e-5f;

enum { I_X = 0, I_C, I_CTX, I_CCTX, I_WMOD, I_BMOD, I_WIN, I_HSW, I_HSB, I_FW1, I_FB1, I_FW2, I_FB2, I_FW3, I_FB3, I_FREQ, I_DECAY, I_HBIAS, I_WHY,
       I_CFW, I_CFB, I_CFG, I_CFLB, I_WCF, I_SARE, I_SAIM, I_SLDT, I_SBRE, I_SBIM, I_SCRE, I_SCIM, I_SD, I_SWGLU, I_SBGLU, I_WS5, I_WO,
       I_LN1G, I_LN1B, I_LN2G, I_LN2B, I_FFW1, I_FFW3, I_FFW2, I_ROUTER, I_MW1, I_MW3, I_MW2, N_IN };

constexpr size_t MiB = 1u << 20;
constexpr size_t WS_CTL = 0, CTL_ZERO_BYTES = 1 * MiB;
constexpr size_t WS_MODS = 1 * MiB;
constexpr size_t WS_S5P = 2 * MiB;
constexpr size_t WS_META = 3 * MiB;
constexpr size_t WS_FILT = 4 * MiB;
constexpr size_t WS_XC = 22 * MiB;
constexpr size_t WS_WIN = 38 * MiB;
constexpr size_t WS_WOUTS = 62 * MiB;
constexpr size_t WS_WGLU = 68 * MiB;
constexpr size_t WS_WO = 69 * MiB;
constexpr size_t WS_W13 = 73 * MiB;
constexpr size_t WS_W2 = 84 * MiB;
constexpr size_t WS_HX = 90 * MiB;
constexpr size_t WS_G = 162 * MiB;
constexpr size_t WS_PHYT = WS_G, WS_YDIR = WS_G + 108 * MiB, WS_UCF = WS_G + 180 * MiB;
constexpr size_t WS_PS5 = 378 * MiB;
constexpr size_t WS_Z2 = 414 * MiB;
constexpr size_t WS_UCF2 = 450 * MiB;
constexpr size_t WS_S5Y = 486 * MiB;
constexpr size_t WS_KRL = 522 * MiB;
constexpr size_t WS_KRC = 586 * MiB;
constexpr size_t WS_SG = 596 * MiB;
constexpr size_t WS_KDUMMY = 594 * MiB;
constexpr size_t WS_END = 595 * MiB;
constexpr size_t WS_SORT = 90 * MiB;
constexpr size_t WS_MOEY = 156 * MiB;
constexpr size_t WS_MW13 = 288 * MiB;
constexpr size_t WS_MW2 = 344 * MiB;
constexpr size_t WS_HID = 372 * MiB;
constexpr size_t HID_BUF = 56 * MiB;
constexpr size_t WS_END2 = 632 * MiB;
static_assert(WS_HID + (size_t)67584 * 3584 <= WS_END2, "moe map");
constexpr size_t META_BCNT = 800 * 1024;
constexpr size_t META_TOKE = 0, META_TOKW = 256 * 1024, META_POS = 512 * 1024, META_TILE = 768 * 1024;
constexpr int CW_BAR = 4096;
constexpr int CW_CNT = 8192, CW_CUR = 8256;

constexpr int LDS_BYTES = 155648;
constexpr int MISC_OFF = 147456;
constexpr int NWAVES = 8;

typedef __bf16 bf2_t __attribute__((ext_vector_type(2)));
__device__ __forceinline__ unsigned pk2(float lo, float hi) { bf2_t v; v.x = (__bf16)lo; v.y = (__bf16)hi; return __builtin_bit_cast(unsigned, v); }
__device__ __forceinline__ unsigned f2bf(float f) { return (unsigned)__builtin_bit_cast(unsigned short, (__bf16)f); }
__device__ __forceinline__ unsigned pk4_fp8(float a, float b, float c, float d) { int w = 0; w = __builtin_amdgcn_cvt_pk_fp8_f32(a, b, w, false); w = __builtin_amdgcn_cvt_pk_fp8_f32(c, d, w, true); return (unsigned)w; }
__device__ __forceinline__ float bf2f(unsigned short b) { return __builtin_bit_cast(float, ((unsigned)b) << 16); }
__device__ __forceinline__ float bflo(unsigned w) { return __builtin_bit_cast(float, w << 16); }
__device__ __forceinline__ float bfhi(unsigned w) { return __builtin_bit_cast(float, w & 0xffff0000u); }
__device__ __forceinline__ float sigmoidf_(float x) { return __builtin_amdgcn_rcpf(1.0f + __expf(-x)); }
__device__ __forceinline__ float siluf_(float x) { return x * sigmoidf_(x); }
__device__ __forceinline__ float gelu_tanh(float x) { const float y = 0.7978845608028654f * (x + 0.044715f * x * x * x); const float e = __expf(2.0f * y); const float th = 1.0f - 2.0f * __builtin_amdgcn_rcpf(e + 1.0f); return 0.5f * x * (1.0f + th); }
__device__ __forceinline__ float wave_sum(float v) {
    v += __builtin_bit_cast(float, __builtin_amdgcn_mov_dpp(__builtin_bit_cast(int, v), 0xB1, 0xf, 0xf, true));
    v += __builtin_bit_cast(float, __builtin_amdgcn_mov_dpp(__builtin_bit_cast(int, v), 0x4E, 0xf, 0xf, true));
    v += __builtin_bit_cast(float, __builtin_amdgcn_mov_dpp(__builtin_bit_cast(int, v), 0x141, 0xf, 0xf, true));
    v += __builtin_bit_cast(float, __builtin_amdgcn_mov_dpp(__builtin_bit_cast(int, v), 0x140, 0xf, 0xf, true));
    v += __builtin_bit_cast(float, __builtin_amdgcn_ds_swizzle(__builtin_bit_cast(int, v), 0x401F));
    const unsigned u = __builtin_bit_cast(unsigned, v); const auto r = __builtin_amdgcn_permlane32_swap(u, u, false, false);
    return __builtin_bit_cast(float, (unsigned)r[0]) + __builtin_bit_cast(float, (unsigned)r[1]);
}
__device__ __forceinline__ float lane_bcast(float v, int k) { return __builtin_bit_cast(float, __builtin_amdgcn_readlane(__builtin_bit_cast(int, v), k)); }
#define LDS_WAIT() asm volatile("s_waitcnt lgkmcnt(0)" ::: "memory")
#define VM_WAIT() asm volatile("s_waitcnt vmcnt(0)" ::: "memory")

namespace pg8 {
#define PG8_LAS __attribute__((address_space(3)))
constexpr int BM = 256, BK = 64, HALF = 128, HTB = HALF * BK * 2, STAGE_BYTES = 8 * HTB, NXCD = 8, WGM = 8;
__host__ __device__ __forceinline__ int lds_byte(int r, int c) { const int st = (r >> 4) * 2 + (c >> 5), rr = r & 15, cc = c & 31, ob = rr * 64 + cc * 2; return st * 1024 + (ob ^ (((ob >> 9) & 1) << 5)); }
__host__ __device__ __forceinline__ void stage_rc(int b, int& R, int& C) { const int st = b / 1024, sb = b % 1024, swz = sb ^ (((sb >> 9) & 1) << 5); R = (st >> 1) * 16 + swz / 64; C = (st & 1) * 32 + (swz % 64) / 2; }
__host__ __device__ __forceinline__ int perm32(int rho) { const int n = rho >> 4, i = rho & 15; return 8 * (i >> 2) + 4 * n + (i & 3); }

struct Unit { int pm, pn, seg, ex; const char* A; const char* B; };

struct Rect {
    int nM, nN, nwg, G, c;
    __device__ __forceinline__ void init(int nM_, int nN_, int G_, int c_) { nM = nM_; nN = nN_; nwg = nM * nN; G = G_; c = c_; }
    __device__ __forceinline__ bool map(int L, int& pm, int& pn) const {
        if (L >= nwg) return false;
        int wgid = L; { const int q = nwg / NXCD, r = nwg % NXCD, xcd = wgid % NXCD, off = wgid / NXCD; wgid = (xcd < r ? xcd * (q + 1) : r * (q + 1) + (xcd - r) * q) + off; }
        const int nig = WGM * nN, gid = wgid / nig, fm = gid * WGM, gsz = (nM - fm) < WGM ? (nM - fm) : WGM;
        pm = fm + ((wgid % nig) % gsz); pn = (wgid % nig) / gsz; return true;
    }
};

__device__ __forceinline__ unsigned cvt_pk_bf16(float lo, float hi) { return pk2(lo, hi); }

typedef int v8i_t __attribute__((ext_vector_type(8)));
typedef int v4i_t __attribute__((ext_vector_type(4)));
__device__ __forceinline__ v8i_t cat8(const bf16x8 a, const bf16x8 b) { return __builtin_shufflevector(__builtin_bit_cast(v4i_t, a), __builtin_bit_cast(v4i_t, b), 0, 1, 2, 3, 4, 5, 6, 7); }
__device__ __forceinline__ bf16x8 lo8(const v8i_t v) { return __builtin_bit_cast(bf16x8, __builtin_shufflevector(v, v, 0, 1, 2, 3)); }
__device__ __forceinline__ bf16x8 hi8(const v8i_t v) { return __builtin_bit_cast(bf16x8, __builtin_shufflevector(v, v, 4, 5, 6, 7)); }
template <class E, class = void> struct epi_chain { static constexpr bool value = false; };
template <class E> struct epi_chain<E, decltype((void)E::CHAIN)> { static constexpr bool value = E::CHAIN; };
template <class Epi, class Sched, bool F8 = false, bool ALIGN_EPI = true, bool SP2 = true>
__device__ __forceinline__ void gemm_phase(PG8_LAS unsigned char* lds, const int tid, const int KB, const Sched& S, const Epi& E, unsigned long long* tm = nullptr) {
    const int wid = __builtin_amdgcn_readfirstlane(tid >> 6), lane = tid & 63, wr = wid >> 2, wc = wid & 3, fr = lane & 15, fq = lane >> 4;
    const int nt = KB / (BK * 2);
    unsigned voffA[2], voffB[2];
#pragma unroll
    for (int i = 0; i < 2; ++i) { int R, C; stage_rc(tid * 16 + i * 8192, R, C); const int Rb = Epi::PERM ? ((R & ~31) + perm32(R & 31)) : R;
        voffA[i] = (unsigned)(R * KB + C * 2); voffB[i] = (unsigned)(Rb * KB + C * 2); }
    const size_t kstep = (size_t)(BK * 2);
    const size_t hstep = (size_t)HALF * KB;
    const unsigned ldsw = (unsigned)wid * 1024u;
    const int aoff = lds_byte(wr * 64 + fr, fq * 8), boff = lds_byte(wc * 32 + fr, fq * 8);
    constexpr int KOFF = 1024;
#define PG8_SA(b, h) (((b) * 2 + (h)) * HTB)
#define PG8_SB(b, h) ((4 + (b) * 2 + (h)) * HTB)
#define PG8_STAGE(bufoff, gbase, voff) do { _Pragma("unroll") for (int _i = 0; _i < 2; ++_i) \
        __builtin_amdgcn_global_load_lds((const unsigned*)((const char*)(gbase) + (voff)[_i]), (PG8_LAS unsigned*)(lds + (bufoff) + ldsw + _i * 8192), 16, 0, 0); } while (0)
#define PG8_LDA(dst, b, h) do { _Pragma("unroll") for (int m = 0; m < 4; ++m) dst[m] = cat8(*(const PG8_LAS bf16x8*)(lds + PG8_SA(b, h) + aoff + m * 2048), *(const PG8_LAS bf16x8*)(lds + PG8_SA(b, h) + aoff + m * 2048 + KOFF)); } while (0)
#define PG8_LDB(dst, b, h) do { _Pragma("unroll") for (int n = 0; n < 2; ++n) dst[n] = cat8(*(const PG8_LAS bf16x8*)(lds + PG8_SB(b, h) + boff + n * 2048), *(const PG8_LAS bf16x8*)(lds + PG8_SB(b, h) + boff + n * 2048 + KOFF)); } while (0)
#define PG8_MMA(ai, bj, At, Bt) do { __builtin_amdgcn_s_setprio(1); _Pragma("unroll") for (int m = 0; m < 4; ++m) _Pragma("unroll") for (int n = 0; n < 2; ++n) { \
        if constexpr (F8) asm volatile("v_mfma_scale_f32_16x16x128_f8f6f4 %0, %1, %2, %0, %3, %3 op_sel_hi:[0,0,0]" : "+v"(acc[ai][bj][m][n]) : "v"(Bt[n]), "v"(At[m]), "v"(sc1)); \
        else { acc[ai][bj][m][n] = __builtin_amdgcn_mfma_f32_16x16x32_bf16(lo8(Bt[n]), lo8(At[m]), acc[ai][bj][m][n], 0, 0, 0); \
               acc[ai][bj][m][n] = __builtin_amdgcn_mfma_f32_16x16x32_bf16(hi8(Bt[n]), hi8(At[m]), acc[ai][bj][m][n], 0, 0, 0); } } \
        __builtin_amdgcn_s_setprio(0); } while (0)
#define PG8_WAIT_V(n) asm volatile("s_waitcnt vmcnt(" #n ")" ::: "memory")
#define PG8_WAIT_L(n) asm volatile("s_waitcnt lgkmcnt(" #n ")" ::: "memory")
#define PG8_BAR __builtin_amdgcn_s_barrier()
#define PG8_SCHED __builtin_amdgcn_sched_barrier(0)
    const int sc1 = 0x7f7f7f7f;
    Unit cur, nxt; int ui = 0;
    if (!S.next(0, cur)) return;
    f32x4 acc[2][2][4][2];
#pragma unroll
    for (int a = 0; a < 2; ++a)
#pragma unroll
        for (int b = 0; b < 2; ++b)
#pragma unroll
            for (int m = 0; m < 4; ++m)
#pragma unroll
                for (int n = 0; n < 2; ++n) acc[a][b][m][n] = (f32x4){0.f, 0.f, 0.f, 0.f};
    v8i_t At[4], B0[2], B1[2];
    const char* cA = cur.A; const char* cB = cur.B;
    if constexpr (SP2) {
        PG8_STAGE(PG8_SB(0, 0), cB, voffB); PG8_STAGE(PG8_SB(0, 1), cB + hstep, voffB); PG8_STAGE(PG8_SA(0, 0), cA, voffA); PG8_STAGE(PG8_SA(0, 1), cA + hstep, voffA);
        if (wr == 1) PG8_BAR;
        PG8_WAIT_V(2); PG8_BAR;
        PG8_STAGE(PG8_SB(1, 0), cB + kstep, voffB); PG8_STAGE(PG8_SA(1, 0), cA + kstep, voffA); PG8_STAGE(PG8_SB(1, 1), cB + hstep + kstep, voffB);
        PG8_WAIT_V(6); PG8_BAR;
    } else {
        PG8_STAGE(PG8_SB(0, 0), cB, voffB); PG8_STAGE(PG8_SA(0, 0), cA, voffA); PG8_STAGE(PG8_SB(0, 1), cB + hstep, voffB); PG8_STAGE(PG8_SA(0, 1), cA + hstep, voffA);
        if (wr == 1) PG8_BAR;
        PG8_WAIT_V(4); PG8_BAR;
        PG8_STAGE(PG8_SB(1, 0), cB + kstep, voffB); PG8_STAGE(PG8_SA(1, 0), cA + kstep, voffA); PG8_STAGE(PG8_SB(1, 1), cB + hstep + kstep, voffB);
        PG8_WAIT_V(6); PG8_BAR;
    }
    for (;;) {
        const bool has_next = S.next(ui + 1, nxt);
        const char* nA = has_next ? nxt.A : cA; const char* nB = has_next ? nxt.B : cB;
        unsigned long long tk0_ = 0; if ((DBG_TMASK & 0x800000u) && tm) tk0_ = wall_clock64();
#pragma unroll 1
        for (int t = 0; t < nt; t += 2) {
            const bool last = (t == nt - 2);
            const char* a1 = cA + (size_t)(t + 1) * kstep;
            const char* a2 = last ? nA : cA + (size_t)(t + 2) * kstep; const char* b2 = last ? nB : cB + (size_t)(t + 2) * kstep;
            const char* a3 = a2 + kstep; const char* b3 = b2 + kstep;
            if constexpr (SP2) {
            PG8_LDB(B0, 0, 0); PG8_LDB(B1, 0, 1); PG8_SCHED; PG8_LDA(At, 0, 0); PG8_STAGE(PG8_SA(1, 1), a1 + hstep, voffA);
            PG8_WAIT_V(8); PG8_WAIT_L(0); PG8_BAR; PG8_MMA(0, 0, At, B0); PG8_MMA(0, 1, At, B1); PG8_BAR; PG8_SCHED;
            PG8_LDA(At, 0, 1); PG8_STAGE(PG8_SB(0, 0), b2, voffB); PG8_STAGE(PG8_SB(0, 1), b2 + hstep, voffB); PG8_STAGE(PG8_SA(0, 0), a2, voffA);
            PG8_WAIT_V(8); PG8_WAIT_L(0); PG8_BAR; PG8_MMA(1, 0, At, B0); PG8_MMA(1, 1, At, B1); PG8_BAR; PG8_SCHED;
            PG8_LDB(B0, 1, 0); PG8_LDB(B1, 1, 1); PG8_SCHED; PG8_LDA(At, 1, 0); PG8_STAGE(PG8_SA(0, 1), a2 + hstep, voffA);
            PG8_WAIT_V(8); PG8_WAIT_L(0); PG8_BAR; PG8_MMA(0, 0, At, B0); PG8_MMA(0, 1, At, B1); PG8_BAR; PG8_SCHED;
            PG8_LDA(At, 1, 1); PG8_STAGE(PG8_SB(1, 0), b3, voffB); PG8_STAGE(PG8_SB(1, 1), b3 + hstep, voffB); PG8_STAGE(PG8_SA(1, 0), a3, voffA);
            PG8_WAIT_V(8); PG8_WAIT_L(0); PG8_BAR; PG8_MMA(1, 0, At, B0); PG8_MMA(1, 1, At, B1); PG8_BAR; PG8_SCHED;
            } else {
            PG8_LDB(B0, 0, 0); PG8_SCHED; PG8_LDA(At, 0, 0); PG8_STAGE(PG8_SA(1, 1), a1 + hstep, voffA);
            PG8_WAIT_L(8); PG8_BAR; PG8_WAIT_L(0); PG8_MMA(0, 0, At, B0); PG8_BAR; PG8_SCHED;
            PG8_LDB(B1, 0, 1); PG8_STAGE(PG8_SB(0, 0), b2, voffB);
            PG8_BAR; PG8_WAIT_L(0); PG8_MMA(0, 1, At, B1); PG8_BAR;
            PG8_LDA(At, 0, 1); PG8_STAGE(PG8_SA(0, 0), a2, voffA);
            PG8_BAR; PG8_WAIT_L(0); PG8_MMA(1, 0, At, B0); PG8_BAR; PG8_SCHED;
            PG8_STAGE(PG8_SB(0, 1), b2 + hstep, voffB);
            PG8_WAIT_V(6); PG8_BAR; PG8_MMA(1, 1, At, B1); PG8_BAR;
            PG8_LDB(B0, 1, 0); PG8_SCHED; PG8_LDA(At, 1, 0); PG8_STAGE(PG8_SA(0, 1), a2 + hstep, voffA);
            PG8_WAIT_L(8); PG8_BAR; PG8_WAIT_L(0); PG8_MMA(0, 0, At, B0); PG8_BAR; PG8_SCHED;
            PG8_LDB(B1, 1, 1); PG8_STAGE(PG8_SB(1, 0), b3, voffB);
            PG8_BAR; PG8_WAIT_L(0); PG8_MMA(0, 1, At, B1); PG8_BAR;
            PG8_LDA(At, 1, 1); PG8_STAGE(PG8_SA(1, 0), a3, voffA);
            PG8_BAR; PG8_WAIT_L(0); PG8_MMA(1, 0, At, B0); PG8_BAR; PG8_SCHED;
            PG8_STAGE(PG8_SB(1, 1), b3 + hstep, voffB);
            PG8_WAIT_V(6); PG8_BAR; PG8_MMA(1, 1, At, B1); PG8_BAR;
            }
        }
        if ((DBG_TMASK & 0x800000u) && tm) *tm += wall_clock64() - tk0_;
        if constexpr (F8) asm volatile("s_nop 15\n\ts_nop 15" ::: "memory");
        if constexpr (ALIGN_EPI) { if (wr == 0) PG8_BAR; }
        bool chained = false;
        if constexpr (epi_chain<Epi>::value) chained = cur.seg < 2;
        if constexpr (epi_chain<Epi>::value) { if (chained) E.mid(acc, cur, wr, wc, fr, fq); else E(acc, cur, wr, wc, fr, fq); }
        else {
        if ((DBG_TMASK & 0x400000u) && tm) { const unsigned long long t0_ = wall_clock64(); E(acc, cur, wr, wc, fr, fq); asm volatile("s_waitcnt vmcnt(0)" ::: "memory"); *tm += wall_clock64() - t0_; }
        else E(acc, cur, wr, wc, fr, fq);
        }
        if (!has_next) break;
#pragma unroll
        for (int a = 0; a < 2; ++a)
#pragma unroll
            for (int b = 0; b < 2; ++b)
#pragma unroll
                for (int m = 0; m < 4; ++m)
#pragma unroll
                    for (int n = 0; n < 2; ++n)
#pragma unroll
                        for (int j = 0; j < 4; ++j) acc[a][b][m][n][j] = chained ? acc[a][b][m][n][j] : 0.f;
        cur = nxt; cA = nA; cB = nB; ++ui;
        if constexpr (ALIGN_EPI) { if (wr == 1) PG8_BAR; }
    }
    PG8_WAIT_V(0);
    if constexpr (!ALIGN_EPI) { if (wr == 0) PG8_BAR; }
    PG8_BAR;
#undef PG8_SA
#undef PG8_SB
#undef PG8_STAGE
#undef PG8_LDA
#undef PG8_LDB
#undef PG8_MMA
#undef PG8_WAIT_V
#undef PG8_WAIT_L
#undef PG8_BAR
#undef PG8_SCHED
}
}
using pg8::Unit;

#define XB_TMO      128
#define XB_XCNT(j)  (256  + 64 * (j))
#define XB_XSUB(j)  (1280 + 64 * (j))
#define XB_XGEN(j)  (2304 + 64 * (j))
#define XB_TOP      3328
#define XB_TOPGEN   3392
#define XCD_BAR_WORDS 3456
#define XB_SPIN_CAP (1u << 18)
__device__ __forceinline__ unsigned xb_ld(unsigned* p)              { return __hip_atomic_load(p, __ATOMIC_RELAXED, __HIP_MEMORY_SCOPE_AGENT); }
__device__ __forceinline__ unsigned xb_add(unsigned* p, unsigned v) { return __hip_atomic_fetch_add(p, v, __ATOMIC_RELAXED, __HIP_MEMORY_SCOPE_AGENT); }
__device__ __forceinline__ unsigned xb_xcc_id() { return (unsigned)__builtin_amdgcn_s_getreg((3 << 11) | 20) & 0xFu; }
#define XB_SPIN(cond, bar) do { unsigned _sp = 0; while (cond) { __builtin_amdgcn_s_sleep(1); \
    if ((++_sp & 255u) == 0u) { if (xb_ld(&(bar)[XB_TMO])) break; if (_sp > XB_SPIN_CAP) { atomicAdd(&(bar)[XB_TMO], 1u); break; } } } } while (0)
struct XcdBarrier { unsigned* bar; unsigned x; volatile LAS unsigned* st; };
__device__ __forceinline__ XcdBarrier xcd_barrier_post(unsigned* bar, volatile LAS unsigned* st) {
    XcdBarrier b; b.bar = bar; b.x = xb_xcc_id(); b.st = st;
    if (threadIdx.x == 0) (void)xb_add(&bar[XB_XCNT(b.x)], 1u);
    return b;
}
__device__ __forceinline__ void xcd_barrier_complete(unsigned* bar, unsigned x, unsigned& nloc, unsigned& nx) {
    const unsigned G = gridDim.x * gridDim.y * gridDim.z;
    unsigned sum, cnt, mine, sp = 0u;
    for (;;) {
        sum = 0u; cnt = 0u; mine = 0u;
#pragma unroll
        for (unsigned j = 0; j < 16; ++j) { const unsigned c = xb_ld(&bar[XB_XCNT(j)]); sum += c; cnt += (c > 0u) ? 1u : 0u; mine = (j == x) ? c : mine; }
        if (sum == G) break;
        __builtin_amdgcn_s_sleep(1);
        if ((++sp & 255u) == 0u) { if (xb_ld(&bar[XB_TMO])) break; if (sp > XB_SPIN_CAP) { atomicAdd(&bar[XB_TMO], 1u); break; } }
    }
    nloc = mine > 0u ? mine : 1u; nx = cnt > 0u ? cnt : 1u;
}
__device__ __forceinline__ void xcd_barrier(const XcdBarrier& b, const int wave_s) {
    asm volatile("s_waitcnt vmcnt(0)" ::: "memory");
    __syncthreads();
    if (wave_s == 0 && __builtin_amdgcn_mbcnt_hi(~0u, __builtin_amdgcn_mbcnt_lo(~0u, 0u)) == 0u) {
        unsigned* bar = b.bar; asm volatile("" : "+v"(bar));
        __builtin_amdgcn_s_waitcnt(0);
        unsigned nloc = b.st[0], nx = b.st[1];
        if (nloc == 0u) { xcd_barrier_complete(bar, b.x, nloc, nx); b.st[0] = nloc; b.st[1] = nx; }
        const unsigned old = xb_add(&bar[XB_XSUB(b.x)], 1u);
        const unsigned gen = old / nloc;
        if (old + 1u == (gen + 1u) * nloc) {
            __builtin_amdgcn_fence(__ATOMIC_RELEASE, "agent");
            asm volatile("s_waitcnt vmcnt(0)" ::: "memory");
            const unsigned og = xb_add(&bar[XB_TOP], 1u);
            const unsigned tg = og / nx;
            if (og + 1u == (tg + 1u) * nx) xb_add(&bar[XB_TOPGEN], 1u);
            else XB_SPIN(xb_ld(&bar[XB_TOPGEN]) == tg, bar);
            __builtin_amdgcn_fence(__ATOMIC_ACQUIRE, "agent");
            xb_add(&bar[XB_XGEN(b.x)], 1u);
            asm volatile("s_waitcnt vmcnt(0)" ::: "memory");
        } else {
            XB_SPIN(xb_ld(&bar[XB_XGEN(b.x)]) == gen, bar);
            __builtin_amdgcn_fence(__ATOMIC_ACQUIRE, "agent");
            asm volatile("s_waitcnt vmcnt(0)" ::: "memory");
        }
    }
    __syncthreads();
}

struct Args { const float* in[N_IN]; float* out; unsigned char* ws; int ph_lo, ph_hi; };

struct Frame {
    LAS unsigned char* lds;
    int tid, lane, wave, vcu, G;
    const float* const* in; float* out; unsigned char* ws;
};

__device__ __forceinline__ const float* inp(const Frame& F, int k) { const GAS float* p = (const GAS float*)F.in[k]; asm volatile("" : "+s"(p)); return (const float*)p; }

struct SchedPlain {
    pg8::Rect R; const char* A; const char* B; size_t tsA, tsB; int xM, xN0, xNn;
    __device__ __forceinline__ bool next(int i, Unit& u) const {
        const int L = i * R.G + R.c;
        if (R.map(L, u.pm, u.pn)) {} else { const int e = L - R.nwg; if (e >= xM * xNn) return false; u.pm = R.nM + e / xNn; u.pn = xN0 + e % xNn; }
        u.seg = 0; u.ex = 0; u.A = A + (size_t)u.pm * tsA; u.B = B + (size_t)u.pn * tsB; return true;
    }
};
struct SchedMerge {
    pg8::Rect R; const char* A; const char* B; size_t tsA, tsB, sA, sB;
    __device__ __forceinline__ bool next(int i, Unit& u) const {
        const int ti = i / 3, sg = i - 3 * ti; const int L = ti * R.G + R.c;
        if (L >= R.nwg || !R.map(R.nwg - 1 - L, u.pm, u.pn)) return false;
        u.seg = sg; u.ex = 0;
        u.A = A + (size_t)sg * sA + (size_t)u.pm * tsA; u.B = B + (size_t)sg * sB + (size_t)u.pn * tsB; return true;
    }
};
struct SchedMoe {
    pg8::Rect R; const char* A; const char* B; size_t tsA, tsB, esB; const int* tile_e; int tile0; bool a_global;
    __device__ __forceinline__ bool next(int i, Unit& u) const {
        const int L = i * R.G + R.c;
        if (!R.map(L, u.pm, u.pn)) return false;
        const int gt = tile0 + u.pm; u.ex = gt; u.seg = 0; const int e = tile_e[gt];
        u.A = A + (size_t)(a_global ? gt : u.pm) * tsA; u.B = B + (size_t)e * esB + (size_t)u.pn * tsB; return true;
    }
};

typedef const f32x4 (&AccRef)[2][2][4][2];
__device__ __forceinline__ v4u pack8(const f32x4 a, const f32x4 b) { v4u w; w.x = pg8::cvt_pk_bf16(a[0], a[1]); w.y = pg8::cvt_pk_bf16(a[2], a[3]); w.z = pg8::cvt_pk_bf16(b[0], b[1]); w.w = pg8::cvt_pk_bf16(b[2], b[3]); return w; }
__device__ __forceinline__ void unpack8(const v4u w, f32x4& a, f32x4& b) { a = (f32x4){bflo(w.x), bfhi(w.x), bflo(w.y), bfhi(w.y)}; b = (f32x4){bflo(w.z), bfhi(w.z), bflo(w.w), bfhi(w.w)}; }

struct EpiInproj {
    static constexpr bool PERM = true;
    bf16* phyT; bf16* ucf; bf16* ps5; int pn0;
    __device__ __forceinline__ void operator()(AccRef acc, const Unit& u0, int wr, int wc, int fr, int fq) const {
        Unit u = u0; u.pn += pn0;
        const int row0 = u.pm * 256 + wr * 64 + fr;
        if (u.pn < 6) {
#pragma unroll
            for (int ai = 0; ai < 2; ++ai)
#pragma unroll
                for (int m = 0; m < 4; ++m) { const int r = row0 + ai * 128 + m * 16;
#pragma unroll
                    for (int bj = 0; bj < 2; ++bj)
#pragma unroll
                        for (int n = 0; n < 2; ++n)
#pragma unroll
                            for (int j = 0; j < 4; ++j) { const int c = u.pn * 256 + bj * 128 + wc * 32 + 8 * fq + 4 * n + j; phyT[(size_t)c * RT + r] = (bf16)f2bf(acc[ai][bj][m][n][j]); } }
        } else if (u.pn < 10) {
            const int col0 = (u.pn - 6) * 128 + wc * 32 + 8 * fq;
#pragma unroll
            for (int ai = 0; ai < 2; ++ai)
#pragma unroll
                for (int m = 0; m < 4; ++m) { const int r = row0 + ai * 128 + m * 16; f32x4 o[2];
#pragma unroll
                    for (int n = 0; n < 2; ++n)
#pragma unroll
                        for (int j = 0; j < 4; ++j) o[n][j] = acc[ai][0][m][n][j] * sigmoidf_(acc[ai][1][m][n][j]);
                    *(v4u*)(ucf + (size_t)r * 512 + col0) = pack8(o[0], o[1]); }
        } else {
#pragma unroll
            for (int ai = 0; ai < 2; ++ai)
#pragma unroll
                for (int m = 0; m < 4; ++m) { const int r = row0 + ai * 128 + m * 16;
#pragma unroll
                    for (int bj = 0; bj < 2; ++bj) { const int col0 = (u.pn - 10) * 256 + bj * 128 + wc * 32 + 8 * fq; *(v4u*)(ps5 + (size_t)r * 512 + col0) = pack8(acc[ai][bj][m][0], acc[ai][bj][m][1]); } }
        }
    }
};
struct EpiHyT {
    static constexpr bool PERM = true;
    bf16* phyT;
    __device__ __forceinline__ void operator()(AccRef acc, const Unit& u, int wr, int wc, int fr, int fq) const {
        const int ch0 = u.pm * 256 + wr * 64 + fr, tok0 = u.pn * 256 + wc * 32 + 8 * fq;
#pragma unroll
        for (int ai = 0; ai < 2; ++ai)
#pragma unroll
            for (int m = 0; m < 4; ++m)
#pragma unroll
                for (int bj = 0; bj < 2; ++bj) *(v4u*)(phyT + (size_t)(ch0 + ai * 128 + m * 16) * RT + tok0 + bj * 128) = pack8(acc[ai][bj][m][0], acc[ai][bj][m][1]);
    }
};
struct EpiGates {
    static constexpr bool PERM = true;
    bf16* O; int tid;
    __device__ __forceinline__ void operator()(AccRef acc, const Unit& u, int wr, int wc, int fr, int fq) const {
        v4u* T = (v4u*)O + ((size_t)u.pm * 12 + u.pn) * 8192 + tid;
#pragma unroll
        for (int ai = 0; ai < 2; ++ai)
#pragma unroll
            for (int m = 0; m < 4; ++m)
#pragma unroll
                for (int bj = 0; bj < 2; ++bj) { f32x4 o[2];
#pragma unroll
                    for (int n = 0; n < 2; ++n)
#pragma unroll
                        for (int j = 0; j < 4; ++j) o[n][j] = sigmoidf_(acc[ai][bj][m][n][j]);
                    T[((ai * 4 + m) * 2 + bj) * 512] = pack8(o[0], o[1]); }
    }
};
struct EpiGlu {
    static constexpr bool PERM = true;
    const bf16* SG; bf16* O; const float* bglu;
    __device__ __forceinline__ void operator()(AccRef acc, const Unit& u, int wr, int wc, int fr, int fq) const {
        const int row0 = u.pm * 256 + wr * 64 + fr;
#pragma unroll
        for (int bj = 0; bj < 2; ++bj) { const int col0 = u.pn * 256 + bj * 128 + wc * 32 + 8 * fq;
            const f32x4 b0 = *(const f32x4*)(bglu + col0), b1 = *(const f32x4*)(bglu + col0 + 4);
            v4u gw[2][4];
#pragma unroll
            for (int ai = 0; ai < 2; ++ai)
#pragma unroll
                for (int m = 0; m < 4; ++m) gw[ai][m] = *(const v4u*)(SG + (size_t)(row0 + ai * 128 + m * 16) * 512 + col0);
#pragma unroll
            for (int ai = 0; ai < 2; ++ai)
#pragma unroll
                for (int m = 0; m < 4; ++m) { const int r = row0 + ai * 128 + m * 16;
                    f32x4 g0, g1; unpack8(gw[ai][m], g0, g1); f32x4 o0, o1;
#pragma unroll
                    for (int j = 0; j < 4; ++j) { o0[j] = g0[j] * sigmoidf_(acc[ai][bj][m][0][j] + b0[j]); o1[j] = g1[j] * sigmoidf_(acc[ai][bj][m][1][j] + b1[j]); }
                    *(v4u*)(O + (size_t)r * 512 + col0) = pack8(o0, o1); } }
    }
};
struct EpiMerge {
    static constexpr bool PERM = true, CHAIN = true;
    const bf16* GT; bf16* O; int tid;
    typedef f32x4 (&AccMut)[2][2][4][2];
    __device__ __forceinline__ void mid(AccMut acc, const Unit& u, int wr, int wc, int fr, int fq) const {
        const v4u* T0 = (const v4u*)GT + ((size_t)u.pm * 12 + u.seg * 4 + u.pn) * 8192 + tid; const v4u* T1 = T0 + 4 * 8192;
#pragma unroll
        for (int ai = 0; ai < 2; ++ai)
#pragma unroll
            for (int bj = 0; bj < 2; ++bj) { v4u ga[4], gb[4];
#pragma unroll
                for (int m = 0; m < 4; ++m) { ga[m] = T0[((ai * 4 + m) * 2 + bj) * 512]; gb[m] = T1[((ai * 4 + m) * 2 + bj) * 512]; }
#pragma unroll
                for (int m = 0; m < 4; ++m) { f32x4 a0, a1, b0, b1; unpack8(ga[m], a0, a1); unpack8(gb[m], b0, b1);
#pragma unroll
                    for (int j = 0; j < 4; ++j) { acc[ai][bj][m][0][j] *= fmaxf(a0[j], 1e-30f) * __builtin_amdgcn_rcpf(fmaxf(b0[j], 1e-30f)); acc[ai][bj][m][1][j] *= fmaxf(a1[j], 1e-30f) * __builtin_amdgcn_rcpf(fmaxf(b1[j], 1e-30f)); } }
                asm volatile("" ::: "memory"); }
    }
    __device__ __forceinline__ void operator()(AccRef acc, const Unit& u, int wr, int wc, int fr, int fq) const {
        const int row0 = u.pm * 256 + wr * 64 + fr, col0 = u.pn * 256 + wc * 32 + 8 * fq;
        const v4u* T = (const v4u*)GT + ((size_t)u.pm * 12 + u.seg * 4 + u.pn) * 8192 + tid;
#pragma unroll
        for (int ai = 0; ai < 2; ++ai) { v4u gw[4][2];
#pragma unroll
            for (int m = 0; m < 4; ++m)
#pragma unroll
                for (int bj = 0; bj < 2; ++bj) gw[m][bj] = T[((ai * 4 + m) * 2 + bj) * 512];
#pragma unroll
            for (int m = 0; m < 4; ++m)
#pragma unroll
                for (int bj = 0; bj < 2; ++bj) { f32x4 g0, g1; unpack8(gw[m][bj], g0, g1);
#pragma unroll
                    for (int j = 0; j < 4; ++j) { g0[j] = fmaxf(g0[j], 1e-30f); g1[j] = fmaxf(g1[j], 1e-30f); }
                    *(v4u*)(O + (size_t)(row0 + ai * 128 + m * 16) * 1024 + col0 + bj * 128) = pack8(g0 * acc[ai][bj][m][0], g1 * acc[ai][bj][m][1]); } }
    }
};
struct EpiRes {
    static constexpr bool PERM = true;
    const float* xl; const float* xc; bf16* R; const float* gbase; float sc;
    __device__ __forceinline__ void operator()(AccRef acc, const Unit& u, int wr, int wc, int fr, int fq) const {
        const bool isl = u.pm < (NX / 256);
        const int prow = isl ? u.pm * 256 : (u.pm - NX / 256) * 256; const int mi = isl ? (u.pm >> 3) : 16;
        const float* xs = isl ? xl : xc; const float* gv = gbase + (size_t)mi * INC;
        const int row0 = prow + wr * 64 + fr, grow0 = u.pm * 256 + wr * 64 + fr, col0 = u.pn * 256 + wc * 32 + 8 * fq;
#pragma unroll
        for (int bj = 0; bj < 2; ++bj) { const int c = col0 + bj * 128; const f32x4 g0 = *(const f32x4*)(gv + c) * sc, g1 = *(const f32x4*)(gv + c + 4) * sc;
#pragma unroll
            for (int ai = 0; ai < 2; ++ai) { f32x4 xr[4][2];
#pragma unroll
                for (int m = 0; m < 4; ++m) { const float* xp = xs + (size_t)(row0 + ai * 128 + m * 16) * 1024 + c; xr[m][0] = *(const f32x4*)xp; xr[m][1] = *(const f32x4*)(xp + 4); }
#pragma unroll
                for (int m = 0; m < 4; ++m) *(v4u*)(R + (size_t)(grow0 + ai * 128 + m * 16) * 1024 + c) = pack8(xr[m][0] * ALPHA_F + g0 * acc[ai][bj][m][0], xr[m][1] * ALPHA_F + g1 * acc[ai][bj][m][1]); } }
    }
};
struct EpiSwiglu {
    static constexpr bool PERM = true;
    bf16* O; int ldc;
    __device__ __forceinline__ void operator()(AccRef acc, const Unit& u, int wr, int wc, int fr, int fq) const {
        const int row0 = u.pm * 256 + wr * 64 + fr, col0 = u.pn * 128 + wc * 32 + 8 * fq;
#pragma unroll
        for (int ai = 0; ai < 2; ++ai)
#pragma unroll
            for (int m = 0; m < 4; ++m) { const int r = row0 + ai * 128 + m * 16; f32x4 o[2];
#pragma unroll
                for (int n = 0; n < 2; ++n)
#pragma unroll
                    for (int j = 0; j < 4; ++j) o[n][j] = siluf_(acc[ai][0][m][n][j]) * acc[ai][1][m][n][j];
                *(v4u*)(O + (size_t)r * ldc + col0) = pack8(o[0], o[1]); }
    }
};
struct EpiSwigluF8 {
    static constexpr bool PERM = true;
    unsigned char* O; int ldc; float sc;
    __device__ __forceinline__ void operator()(AccRef acc, const Unit& u, int wr, int wc, int fr, int fq) const {
        const int row0 = u.pm * 256 + wr * 64 + fr, col0 = u.pn * 128 + wc * 32 + 8 * fq;
#pragma unroll
        for (int ai = 0; ai < 2; ++ai)
#pragma unroll
            for (int m = 0; m < 4; ++m) { const int r = row0 + ai * 128 + m * 16; f32x4 o[2];
#pragma unroll
                for (int n = 0; n < 2; ++n) {
                    const f32x4 a = acc[ai][0][m][n], t = a * (-1.4426950408889634f * sc), p = (a * acc[ai][1][m][n]) * (sc * sc);
                    f32x4 e; e[0] = __builtin_amdgcn_exp2f(t[0]); e[1] = __builtin_amdgcn_exp2f(t[1]); e[2] = __builtin_amdgcn_exp2f(t[2]); e[3] = __builtin_amdgcn_exp2f(t[3]);
                    const f32x4 d = e + 1.0f;
                    f32x4 rc; rc[0] = __builtin_amdgcn_rcpf(d[0]); rc[1] = __builtin_amdgcn_rcpf(d[1]); rc[2] = __builtin_amdgcn_rcpf(d[2]); rc[3] = __builtin_amdgcn_rcpf(d[3]);
                    o[n] = p * rc; }
                v2u w; w.x = pk4_fp8(o[0][0], o[0][1], o[0][2], o[0][3]); w.y = pk4_fp8(o[1][0], o[1][1], o[1][2], o[1][3]);
                *(v2u*)(O + (size_t)r * ldc + col0) = w; }
    }
};
struct EpiMoeDown {
    static constexpr bool PERM = true;
    bf16* O; float sc;
    __device__ __forceinline__ void operator()(AccRef acc, const Unit& u, int wr, int wc, int fr, int fq) const {
        const int row0 = u.ex * 256 + wr * 64 + fr;
#pragma unroll
        for (int ai = 0; ai < 2; ++ai)
#pragma unroll
            for (int m = 0; m < 4; ++m) { const int r = row0 + ai * 128 + m * 16;
#pragma unroll
                for (int bj = 0; bj < 2; ++bj) { const int col0 = u.pn * 256 + bj * 128 + wc * 32 + 8 * fq; *(v4u*)(O + (size_t)r * 1024 + col0) = pack8(acc[ai][bj][m][0] * sc, acc[ai][bj][m][1] * sc); } }
    }
};

template <bool F8>
__device__ __forceinline__ void transpose_item64(const float* W, int K, int N, unsigned char* WT, int dst_row0, int k0, int n0, float scale, LAS float* scr, int lane) {
#pragma unroll 4
    for (int i = 0; i < 16; ++i) { const int row = 4 * i + (lane >> 4), nc = 4 * (lane & 15);
        const f32x4 v = __builtin_nontemporal_load((const f32x4*)(W + (size_t)(k0 + row) * N + n0 + nc));     *(LAS f32x4*)(scr + row * 68 + nc) = v * scale; }
    LDS_WAIT(); asm volatile("" ::: "memory");
    const LAS float* sp = scr + lane;
    if constexpr (F8) {
        unsigned char* dst = WT + (size_t)(dst_row0 + lane) * K + k0;
#pragma unroll
        for (int c4 = 0; c4 < 4; ++c4) { v4u o;
#pragma unroll
            for (int e = 0; e < 4; ++e) { const int kk = 16 * c4 + 4 * e; o[e] = pk4_fp8(sp[(kk + 0) * 68], sp[(kk + 1) * 68], sp[(kk + 2) * 68], sp[(kk + 3) * 68]); }
            *(v4u*)(dst + 16 * c4) = o; }
    } else {
        unsigned char* dst = WT + ((size_t)(dst_row0 + lane) * K + k0) * 2;
#pragma unroll
        for (int c8 = 0; c8 < 8; ++c8) { v4u o;
#pragma unroll
            for (int e = 0; e < 4; ++e) { const int kk = 8 * c8 + 2 * e; o[e] = pk2(sp[kk * 68], sp[(kk + 1) * 68]); }
            *(v4u*)(dst + 16 * c8) = o; }
    }
    LDS_WAIT(); asm volatile("" ::: "memory");
}
__device__ __forceinline__ int dst_row_map(int kind, int n0) {
    if (kind == 1) { if (n0 >= 1536 && n0 < 2560) { const int i = (n0 - 1536) & 511, hi = (n0 - 1536) >> 9; return 1536 + 256 * (i >> 7) + 128 * hi + (i & 127); } return n0; }
    if (kind == 2) return 256 * (n0 >> 7) + (n0 & 127);
    if (kind == 3) return 256 * (n0 >> 7) + 128 + (n0 & 127);
    return n0;
}
__device__ __forceinline__ void conv_matrix_item(const float* W, int K, int N, bf16* WT, int kind, int item, LAS float* scr, int lane) {
    const int nblk = N / 64, kb = item / nblk, nb = item - kb * nblk;
    transpose_item64<false>(W, K, N, (unsigned char*)WT, dst_row_map(kind, 64 * nb), 64 * kb, 64 * nb, 1.0f, scr, lane);
}
__device__ __forceinline__ void conv_matrix_item_f8(const float* W, int K, int N, unsigned char* WT, int kind, int item, float scale, LAS float* scr, int lane) {
    const int nblk = N / 64, kb = item / nblk, nb = item - kb * nblk;
    transpose_item64<true>(W, K, N, WT, dst_row_map(kind, 64 * nb), 64 * kb, 64 * nb, scale, scr, lane);
}
__device__ __forceinline__ void p0a_prologue(Frame& F) {
    LAS float* scr = (LAS float*)(F.lds + F.wave * 17408);
    const int gw = F.wave * F.G + F.vcu  , NGW = F.G * NWAVES;
    bf16* ws_win = (bf16*)(F.ws + WS_WIN); bf16* ws_outs = (bf16*)(F.ws + WS_WOUTS); bf16* ws_glu = (bf16*)(F.ws + WS_WGLU); bf16* ws_wo = (bf16*)(F.ws + WS_WO);
    bf16* ws_w13 = (bf16*)(F.ws + WS_W13); bf16* ws_w2 = (bf16*)(F.ws + WS_W2);
    constexpr int I_IN = (1024 / 64) * (6144 / 64), I_OUT = (512 / 64) * (1024 / 64), I_GLU = (512 / 64) * (512 / 64), I_WOI = (1024 / 64) * (1024 / 64), I_F1 = (1024 / 64) * (2816 / 64), I_F2 = (2816 / 64) * (1024 / 64);
    constexpr int NITEMS = 2 * I_IN + 6 * I_OUT + 2 * I_GLU + 2 * I_WOI + 2 * I_F1 + I_F2;
    for (int it = gw; it < NITEMS; it += NGW) {
        int r = it;
        if (r < 2 * I_IN) { const int l = r / I_IN; conv_matrix_item(inp(F, I_WIN) + (size_t)l * 1024 * 6144, 1024, 6144, ws_win + (size_t)l * 6144 * 1024, 1, r - l * I_IN, scr, F.lane); continue; } r -= 2 * I_IN;
        if (r < 6 * I_OUT) { const int q = r / I_OUT, l = q / 3, s = q - 3 * l; const float* src = inp(F, s == 0 ? I_WHY : (s == 1 ? I_WCF : I_WS5)) + (size_t)l * 512 * 1024;
            conv_matrix_item(src, 512, 1024, ws_outs + (size_t)(l * 3 + s) * 1024 * 512, 0, r - q * I_OUT, scr, F.lane); continue; } r -= 6 * I_OUT;
        if (r < 2 * I_GLU) { const int l = r / I_GLU; conv_matrix_item(inp(F, I_SWGLU) + (size_t)l * 512 * 512, 512, 512, ws_glu + (size_t)l * 512 * 512, 0, r - l * I_GLU, scr, F.lane); continue; } r -= 2 * I_GLU;
        if (r < 2 * I_WOI) { const int l = r / I_WOI; conv_matrix_item(inp(F, I_WO) + (size_t)l * 1024 * 1024, 1024, 1024, ws_wo + (size_t)l * 1024 * 1024, 0, r - l * I_WOI, scr, F.lane); continue; } r -= 2 * I_WOI;
        if (r < I_F1) { conv_matrix_item_f8(inp(F, I_FFW1), 1024, 2816, (unsigned char*)ws_w13, 2, r, 32.f, scr, F.lane); continue; } r -= I_F1;
        if (r < I_F1) { conv_matrix_item_f8(inp(F, I_FFW3), 1024, 2816, (unsigned char*)ws_w13, 3, r, 32.f, scr, F.lane); continue; } r -= I_F1;
        conv_matrix_item_f8(inp(F, I_FFW2), 2816, 1024, (unsigned char*)ws_w2, 0, r, 128.f, scr, F.lane);
    }
    __syncthreads();
    float* mods = (float*)(F.ws + WS_MODS);
    LAS float* sc = (LAS float*)F.lds;
    LAS float* red = sc + 1024 * 20;
    for (int e = F.tid; e < 17 * 1024; e += 512) { const int i = e >> 10, k = e & 1023; const float cv = i < 16 ? inp(F, I_C)[i * 1024 + k] : inp(F, I_CCTX)[k]; sc[k * 20 + i] = siluf_(cv); }
    __syncthreads();
    for (int it = F.vcu; it < 2 * 128; it += F.G) {
        const int l = it >> 7, nb = it & 127; const int kg = F.tid / 48, col = F.tid - kg * 48;
        if (kg < 10) { const float* w = inp(F, I_WMOD) + (size_t)l * 1024 * 6144 + nb * 48 + col;
            float acc[17];
#pragma unroll
            for (int i = 0; i < 17; ++i) acc[i] = 0.f;
#pragma unroll 4
            for (int k = kg; k < 1024; k += 10) { const float wv = __builtin_nontemporal_load(w + (size_t)k * 6144);
                const f32x4 s0 = *(const LAS f32x4*)(sc + k * 20), s1 = *(const LAS f32x4*)(sc + k * 20 + 4), s2 = *(const LAS f32x4*)(sc + k * 20 + 8), s3 = *(const LAS f32x4*)(sc + k * 20 + 12); const float s4 = sc[k * 20 + 16];
#pragma unroll
                for (int j = 0; j < 4; ++j) { acc[j] += s0[j] * wv; acc[4 + j] += s1[j] * wv; acc[8 + j] += s2[j] * wv; acc[12 + j] += s3[j] * wv; }
                acc[16] += s4 * wv; }
#pragma unroll
            for (int i = 0; i < 17; ++i) red[(kg * 17 + i) * 48 + col] = acc[i]; }
        __syncthreads();
        for (int e = F.tid; e < 17 * 48; e += 512) { const int i = e / 48, c = e - i * 48; float sum = inp(F, I_BMOD)[l * 6144 + nb * 48 + c];
#pragma unroll
            for (int g = 0; g < 10; ++g) sum += red[(g * 17 + i) * 48 + c];
            mods[(size_t)(l * 17 + i) * 6144 + nb * 48 + c] = sum; }
        __syncthreads();
    }
}

__device__ __forceinline__ void h2table_phase(Frame& F, int l) {
    const int gw = F.wave * F.G + F.vcu  , NGW = F.G * NWAVES, lane = F.lane;
    float* H2 = (float*)(F.ws + WS_FILT);
    const float* w1 = inp(F, I_FW1) + l * 33 * 64; const float* b1 = inp(F, I_FB1) + l * 64; const float* w2 = inp(F, I_FW2) + l * 64 * 64; const float* b2 = inp(F, I_FB2) + l * 64;
    const float* fq = inp(F, I_FREQ) + l * 128;
    for (int pos = gw; pos < LSEQ + LCTX; pos += NGW) {
        const bool isc = pos >= LSEQ; const int L = isc ? LCTX : LSEQ; const int t = isc ? pos - LSEQ : pos;
        const float tn = (float)t / (float)(L - 1);
        float z = 0.f;
        if (lane == 0) z = tn;
        else if (lane <= 32) { const int band = lane <= 16 ? lane : lane - 16; const int ph = (t * band) % L; const float ang = 6.283185307179586f * ((float)ph / (float)L); z = lane <= 16 ? cosf(ang) : sinf(ang); }
        float h = b1[lane];
        for (int k = 0; k < 33; ++k) h += lane_bcast(z, k) * w1[k * 64 + lane];
        h = sinf(fq[lane] * h);
        float h2 = b2[lane];
        for (int k = 0; k < 64; ++k) h2 += lane_bcast(h, k) * w2[k * 64 + lane];
        H2[(size_t)pos * 64 + lane] = sinf(fq[64 + lane] * h2);
    }
}
__device__ __forceinline__ void filter_expand_phase(Frame& F, int l) {
    const int gw = F.wave * F.G + F.vcu  , NGW = F.G * NWAVES, lane = F.lane;
    const float* H2 = (const float*)(F.ws + WS_FILT);
    const float* w3 = inp(F, I_FW3) + (size_t)l * 64 * 2048; const float* b3 = inp(F, I_FB3) + l * 2048; const float* dec = inp(F, I_DECAY) + l * 2048; const float* hb = inp(F, I_HBIAS) + l * 1024;
    LAS float* W = (LAS float*)(F.lds + F.wave * 17408);
#pragma unroll 1
    for (int it = gw; it < 1024 + 128; it += NGW) {
        const bool isc = it >= 1024; const int ii = isc ? it - 1024 : it; const int chunk = ii >> 5, grp = ii & 31;
        const int L = isc ? LCTX : LSEQ; const int t = chunk * 64 + lane; const int pos = isc ? LSEQ + t : t;
        bf16* KR = isc ? (bf16*)(F.ws + WS_KRC) : (bf16*)(F.ws + WS_KRL); const int KLEN = 2 * L;
        const float tn = (float)t / (float)(L - 1);
#pragma unroll 4
        for (int k = 0; k < 64; ++k) W[lane * 68 + k] = w3[(size_t)k * 2048 + grp * 64 + lane];
        f32x4 h2[16];
#pragma unroll
        for (int k = 0; k < 16; ++k) h2[k] = *(const f32x4*)(H2 + (size_t)pos * 64 + 4 * k);
        const int colL = grp * 64 + lane; const float b3L = b3[colL], decL = fabsf(dec[colL]); const float hbL = ((colL >> 9) & 1) == 0 ? hb[(colL >> 10) * 512 + (colL & 511)] : 0.f;
        LDS_WAIT();
#pragma unroll 1
        for (int cc = 0; cc < 64; ++cc) {
            const int col = grp * 64 + cc; float a = lane_bcast(b3L, cc);
#pragma unroll
            for (int k = 0; k < 16; ++k) { const f32x4 wv = *(const LAS f32x4*)(W + cc * 68 + 4 * k); a += (h2[k][0] * wv[0] + h2[k][1] * wv[1]) + (h2[k][2] * wv[2] + h2[k][3] * wv[3]); }
            const int o = col >> 10, dir = (col >> 9) & 1, c = col & 511;
            float v = a * __expf(-tn * lane_bcast(decL, cc));
            if (t == 0 && dir == 0) v += lane_bcast(hbL, cc);
            const bool valid = !(t == 0 && dir == 1);
            const int i = dir ? L + t : L - t;
            const unsigned short bv = (unsigned short)f2bf(v);
            bf16* base = (valid ? KR + (size_t)((o * 512 + c) * 8) * KLEN : (bf16*)(F.ws + WS_KDUMMY) + 16) + i;
#pragma unroll
            for (int m = 0; m < 8; ++m) base[(ptrdiff_t)m * (KLEN - 1)] = bv;
        }
        LDS_WAIT();
    }
    __syncthreads();
}
__device__ __forceinline__ void s5params_phase(Frame& F, int l) {
    float* P = (float*)(F.ws + WS_S5P);
    for (int e = F.vcu * 512 + F.tid; e < 2 * 32 * 64; e += F.G * 512) {
        const int base = l * 4096 + e;
        const int dg = e >> 6;
        const float lam_re = fminf(inp(F, I_SARE)[base], -1e-4f), lam_im = inp(F, I_SAIM)[base];
        const float dt = expf(inp(F, I_SLDT)[l * 64 + dg]);
        const float mag = expf(lam_re * dt), ang = lam_im * dt; const float abr = mag * cosf(ang), abi = mag * sinf(ang);
        const float den = lam_re * lam_re + lam_im * lam_im;
        const float qre = ((abr - 1.0f) * lam_re + abi * lam_im) / den, qim = (abi * lam_re - (abr - 1.0f) * lam_im) / den;
        float* o = P + (size_t)e * 36; o[0] = abr; o[1] = abi;
        const float* br = inp(F, I_SBRE) + (size_t)base * 16; const float* bi = inp(F, I_SBIM) + (size_t)base * 16;
        for (int c = 0; c < 16; ++c) { o[2 + c] = qre * br[c] - qim * bi[c]; o[18 + c] = qre * bi[c] + qim * br[c]; }
        o[34] = 0.f; o[35] = 0.f;
    }
}

struct Row { f32x4 v[4]; };
__device__ __forceinline__ void row_load(Row& r, const float* p, int lane) { const f32x4* x = (const f32x4*)p + lane;
#pragma unroll
    for (int j = 0; j < 4; ++j) r.v[j] = x[64 * j]; }
__device__ __forceinline__ void row_load_nt(Row& r, const float* p, int lane) { const f32x4* x = (const f32x4*)p + lane;
#pragma unroll
    for (int j = 0; j < 4; ++j) r.v[j] = __builtin_nontemporal_load(x + 64 * j); }
__device__ __forceinline__ void row_load_bf16(Row& r, const bf16* p, int lane) { const v2u* x = (const v2u*)p + lane;
#pragma unroll
    for (int j = 0; j < 4; ++j) { const v2u w = x[64 * j]; r.v[j] = (f32x4){bflo(w.x), bfhi(w.x), bflo(w.y), bfhi(w.y)}; } }
__device__ __forceinline__ void row_store(const Row& r, float* p, int lane) { f32x4* x = (f32x4*)p + lane;
#pragma unroll
    for (int j = 0; j < 4; ++j) x[64 * j] = r.v[j]; }
__device__ __forceinline__ void row_norm(Row& r) {
    float s = 0.f;
#pragma unroll
    for (int j = 0; j < 4; ++j) s += (r.v[j][0] + r.v[j][1]) + (r.v[j][2] + r.v[j][3]);
    const float mean = wave_sum(s) * (1.f / DM); float q = 0.f;
#pragma unroll
    for (int j = 0; j < 4; ++j) { r.v[j] = r.v[j] - mean; q += (r.v[j][0] * r.v[j][0] + r.v[j][1] * r.v[j][1]) + (r.v[j][2] * r.v[j][2] + r.v[j][3] * r.v[j][3]); }
    const float rstd = 1.f / sqrtf(wave_sum(q) * (1.f / DM) + LN_EPS);
#pragma unroll
    for (int j = 0; j < 4; ++j) r.v[j] = r.v[j] * rstd;
}
__device__ __forceinline__ void row_affine(Row& r, const float* g, const float* b, int lane, float gadd) {
    const f32x4* gp = (const f32x4*)g + lane; const f32x4* bp = (const f32x4*)b + lane;
#pragma unroll
    for (int j = 0; j < 4; ++j) r.v[j] = r.v[j] * (gp[64 * j] + gadd) + bp[64 * j];
}
struct Vec8 { f32x4 g[4], b[4]; };
__device__ __forceinline__ void vec8_load(Vec8& v, const float* g, const float* b, int lane) { const f32x4* gp = (const f32x4*)g + lane; const f32x4* bp = (const f32x4*)b + lane;
#pragma unroll
    for (int j = 0; j < 4; ++j) { v.g[j] = gp[64 * j]; v.b[j] = bp[64 * j]; } }
__device__ __forceinline__ void row_affine_reg(Row& r, const Vec8& v, float gadd) {
#pragma unroll
    for (int j = 0; j < 4; ++j) r.v[j] = r.v[j] * (v.g[j] + gadd) + v.b[j]; }
__device__ __forceinline__ int row_batch(int row) { return row < NX ? (row >> 11) : 16; }
__device__ __forceinline__ void row_store_bf16(const Row& r, bf16* p, int lane) { unsigned long long* o = (unsigned long long*)p + lane;
#pragma unroll
    for (int j = 0; j < 4; ++j) o[64 * j] = (unsigned long long)pk2(r.v[j][0], r.v[j][1]) | ((unsigned long long)pk2(r.v[j][2], r.v[j][3]) << 32); }

__device__ __forceinline__ const float* mod_vec(Frame& F, int l, int row, int which) { const int i = row < NX ? (row >> 11) : 16; return (const float*)(F.ws + WS_MODS) + ((size_t)l * 17 + i) * INC + which * 1024; }
__device__ __forceinline__ const float* xrow_ptr(Frame& F, int l, int row) {
    if (l == 0) return row < NX ? inp(F, I_X) + (size_t)row * DM : inp(F, I_CTX) + (size_t)(row - NX) * DM;
    return row < NX ? F.out + (size_t)row * DM : (const float*)(F.ws + WS_XC) + (size_t)(row - NX) * DM;
}
__device__ __forceinline__ float* xcur_ptr(Frame& F, int row) { return row < NX ? F.out + (size_t)row * DM : (float*)(F.ws + WS_XC) + (size_t)(row - NX) * DM; }

__device__ __forceinline__ void lnmod_phase(Frame& F, int l) {
    const int gw = F.vcu * NWAVES + F.wave, NGW = F.G * NWAVES; bf16* hx = (bf16*)(F.ws + WS_HX);
    const int m0 = (int)((long)RT * gw / NGW), m1 = (int)((long)RT * (gw + 1) / NGW); Vec8 md; int cb = -1;
    Row nx; if (m0 < m1) row_load_nt(nx, xrow_ptr(F, l, m0), F.lane);
    for (int m = m0; m < m1; ++m) { if (row_batch(m) != cb) { cb = row_batch(m); vec8_load(md, mod_vec(F, l, m, 1), mod_vec(F, l, m, 0), F.lane); }
        Row r = nx; if (m + 1 < m1) row_load_nt(nx, xrow_ptr(F, l, m + 1), F.lane);
        row_norm(r); row_affine_reg(r, md, 1.0f); row_store_bf16(r, hx + (size_t)m * DM, F.lane); }
}
template <bool MOE>
__device__ __forceinline__ void ln1_phase(Frame& F, int l) {
    const int gw = F.vcu * NWAVES + F.wave, NGW = F.G * NWAVES; bf16* hx = (bf16*)(F.ws + WS_HX); const int M = MOE ? NX : RT;
    const float* g = inp(F, I_LN1G) + l * DM; const float* b = inp(F, I_LN1B) + l * DM;
    int* toke = (int*)(F.ws + WS_META + META_TOKE); float* tokw = (float*)(F.ws + WS_META + META_TOKW);
    LAS unsigned* lcnt = (LAS unsigned*)(F.lds);
    unsigned c8[8];
#pragma unroll
    for (int e = 0; e < 8; ++e) c8[e] = 0u;
    if (MOE) { if (F.tid < 8) lcnt[F.tid] = 0u; __syncthreads(); }
    f32x4 rtr[4][4][2];
    if (MOE) { const float* rt = inp(F, I_ROUTER);
#pragma unroll
        for (int j = 0; j < 4; ++j)
#pragma unroll
            for (int q = 0; q < 4; ++q) { const int k = 256 * j + 4 * F.lane + q; rtr[j][q][0] = *(const f32x4*)(rt + k * 8); rtr[j][q][1] = *(const f32x4*)(rt + k * 8 + 4); } }
    Vec8 ln; if (!MOE) vec8_load(ln, g, b, F.lane); Vec8 md; int cb = -1;
    const int m0 = (int)((long)M * gw / NGW), m1 = (int)((long)M * (gw + 1) / NGW);
    for (int m = m0; m < m1; ++m) {
        if (row_batch(m) != cb) { cb = row_batch(m); vec8_load(md, mod_vec(F, l, m, 4), mod_vec(F, l, m, 3), F.lane); }
        float* xp = xcur_ptr(F, m); Row r; row_load_bf16(r, (const bf16*)(F.ws + WS_KRL) + (size_t)m * DM, F.lane); row_norm(r); if (MOE) row_affine(r, g, b, F.lane, 0.0f); else row_affine_reg(r, ln, 0.0f); row_store(r, xp, F.lane);
        row_norm(r); row_affine_reg(r, md, 1.0f);
        if (!MOE) { unsigned* d8 = (unsigned*)((unsigned char*)hx + (size_t)m * DM) + F.lane;
#pragma unroll
            for (int j = 0; j < 4; ++j) d8[64 * j] = pk4_fp8(r.v[j][0], r.v[j][1], r.v[j][2], r.v[j][3]); }
        else {
            float lg[8];
#pragma unroll
            for (int e = 0; e < 8; ++e) lg[e] = 0.f;
#pragma unroll
            for (int j = 0; j < 4; ++j)
#pragma unroll
                for (int q = 0; q < 4; ++q) { const f32x4 r0 = rtr[j][q][0], r1 = rtr[j][q][1]; const float hv = r.v[j][q];
                    lg[0] += hv * r0[0]; lg[1] += hv * r0[1]; lg[2] += hv * r0[2]; lg[3] += hv * r0[3]; lg[4] += hv * r1[0]; lg[5] += hv * r1[1]; lg[6] += hv * r1[2]; lg[7] += hv * r1[3]; }
#pragma unroll
            for (int e = 0; e < 8; ++e) lg[e] = wave_sum(lg[e]);
            int e0 = 0; float v0 = lg[0];
#pragma unroll
            for (int e = 1; e < 8; ++e) if (lg[e] > v0) { v0 = lg[e]; e0 = e; }
            int e1 = -1; float v1 = -3.0e38f;
#pragma unroll
            for (int e = 0; e < 8; ++e) if (e != e0 && lg[e] > v1) { v1 = lg[e]; e1 = e; }
            const float ex = __expf(v1 - v0); const float w0 = 1.0f / (1.0f + ex), w1 = ex / (1.0f + ex);
            if (F.lane == 0) { toke[2 * m] = e0; toke[2 * m + 1] = e1; tokw[2 * m] = w0; tokw[2 * m + 1] = w1; }
#pragma unroll
            for (int e = 0; e < 8; ++e) c8[e] += (e0 == e ? 1u : 0u) + (e1 == e ? 1u : 0u);
        }
    }
    if (MOE) {
        if (F.lane == 0) {
#pragma unroll
            for (int e = 0; e < 8; ++e) if (c8[e]) atomicAdd((unsigned*)&lcnt[e], c8[e]); }
        __syncthreads();
        if (F.tid < 8) ((unsigned*)(F.ws + WS_META + META_BCNT))[F.vcu * 8 + F.tid] = lcnt[F.tid];
        __syncthreads();
    }
}
__device__ __forceinline__ void ln2_phase(Frame& F, int l) {
    const int gw = F.vcu * NWAVES + F.wave, NGW = F.G * NWAVES;
    Vec8 ln; vec8_load(ln, inp(F, I_LN2G) + l * DM, inp(F, I_LN2B) + l * DM, F.lane);
    const int m0 = (int)((long)RT * gw / NGW), m1 = (int)((long)RT * (gw + 1) / NGW);
    const bf16* R16 = (const bf16*)(F.ws + WS_KRL);
    Row nx; if (m0 < m1) row_load_bf16(nx, R16 + (size_t)m0 * DM, F.lane);
    bf16* hx = (bf16*)(F.ws + WS_HX); Vec8 md; int cb = -1;
    for (int m = m0; m < m1; ++m) { float* xp = xcur_ptr(F, m); Row r = nx; if (m + 1 < m1) row_load_bf16(nx, R16 + (size_t)(m + 1) * DM, F.lane);
        if (row_batch(m) != cb) { cb = row_batch(m); vec8_load(md, mod_vec(F, l + 1, m, 1), mod_vec(F, l + 1, m, 0), F.lane); }
        row_norm(r); row_affine_reg(r, ln, 0.0f); row_store(r, xp, F.lane);
        row_norm(r); row_affine_reg(r, md, 1.0f); row_store_bf16(r, hx + (size_t)m * DM, F.lane); }
}

__device__ __forceinline__ void moe_convert_phase(Frame& F) {
    LAS float* scr = (LAS float*)(F.lds + 4096 + F.wave * 17408);
    const int gw = F.wave * F.G + F.vcu  , NGW = F.G * NWAVES;
    unsigned char* w13 = F.ws + WS_MW13; unsigned char* w2 = F.ws + WS_MW2;
    constexpr int I1 = (1024 / 64) * (3584 / 64), I2 = (3584 / 64) * (1024 / 64);
    for (int it = gw; it < 8 * (2 * I1 + I2); it += NGW) {
        const int e = it / (2 * I1 + I2); int r = it - e * (2 * I1 + I2);
        if (r < I1) { conv_matrix_item_f8(inp(F, I_MW1) + (size_t)e * 1024 * 3584, 1024, 3584, w13 + (size_t)e * 7168 * 1024, 2, r, 32.f, scr, F.lane); continue; } r -= I1;
        if (r < I1) { conv_matrix_item_f8(inp(F, I_MW3) + (size_t)e * 1024 * 3584, 1024, 3584, w13 + (size_t)e * 7168 * 1024, 3, r, 32.f, scr, F.lane); continue; } r -= I1;
        conv_matrix_item_f8(inp(F, I_MW2) + (size_t)e * 3584 * 1024, 3584, 1024, w2 + (size_t)e * 1024 * 3584, 0, r, 128.f, scr, F.lane);
    }
}
__device__ __forceinline__ void moe_setup_phase(Frame& F) {
    const int gw = F.vcu * NWAVES + F.wave, NGW = F.G * NWAVES, lane = F.lane;
    const int* toke = (const int*)(F.ws + WS_META + META_TOKE); int* tpos = (int*)(F.ws + WS_META + META_POS); int* tile_e = (int*)(F.ws + WS_META + META_TILE);
    const unsigned* bcnt = (const unsigned*)(F.ws + WS_META + META_BCNT); unsigned char* srt = F.ws + WS_SORT;
    LAS int* sh = (LAS int*)F.lds;
    const int mb = (int)((long)NX * gw / NGW), me = (int)((long)NX * (gw + 1) / NGW);
    __syncthreads();
    {
        const int e = F.wave; int tot = 0, pre = 0;
        for (int bk = lane; bk < F.G; bk += 64) { const int v = (int)bcnt[bk * 8 + e]; tot += v; pre += bk < F.vcu ? v : 0; }
#pragma unroll
        for (int o = 32; o >= 1; o >>= 1) { tot += __shfl_xor(tot, o); pre += __shfl_xor(pre, o); }
        if (lane == 0) { sh[e] = tot; sh[8 + e] = pre; }
        int c8[8];
#pragma unroll
        for (int q = 0; q < 8; ++q) c8[q] = 0;
        for (int base = mb; base < me; base += 64) { const int m = base + lane; const bool act = m < me;
            const int e0 = act ? toke[2 * m] : -1, e1 = act ? toke[2 * m + 1] : -1;
#pragma unroll
            for (int q = 0; q < 8; ++q) c8[q] += __popcll(__ballot(e0 == q)) + __popcll(__ballot(e1 == q)); }
        if (lane == 0) {
#pragma unroll
            for (int q = 0; q < 8; ++q) sh[16 + 8 * F.wave + q] = c8[q]; }
    }
    __syncthreads();
    int off[8], wbase[8], ntiles; { int o = 0;
#pragma unroll
        for (int e = 0; e < 8; ++e) { off[e] = o; o += (sh[e] + 255) & ~255; int wb = off[e] + sh[8 + e];
            for (int w2 = 0; w2 < F.wave; ++w2) wb += sh[16 + 8 * w2 + e];
            wbase[e] = wb; }
        ntiles = o >> 8; }
    if (F.vcu == 0 && F.tid < 8) { const int e = F.tid; const int t0 = off[e] >> 8; const int t1 = (e == 7 ? ntiles : (off[e + 1] >> 8)); for (int t = t0; t < t1; ++t) tile_e[t] = e; if (e == 0) tile_e[511] = ntiles; }
    for (int base = mb; base < me; base += 64) {
        const int m = base + lane; const bool act = m < me;
        const int e0 = act ? toke[2 * m] : -1, e1 = act ? toke[2 * m + 1] : -1;
        int p0 = 0, p1 = 0;
        const unsigned long long lt = (1ull << lane) - 1ull;
#pragma unroll
        for (int e = 0; e < 8; ++e) {
            const unsigned long long m0 = __ballot(e0 == e), m1 = __ballot(e1 == e);
            if (e0 == e) p0 = wbase[e] + __popcll(m0 & lt);
            if (e1 == e) p1 = wbase[e] + __popcll(m0) + __popcll(m1 & lt);
            wbase[e] += __popcll(m0) + __popcll(m1);
        }
        if (act) { tpos[2 * m] = p0; tpos[2 * m + 1] = p1; }
        const int nrows = me - base < 64 ? me - base : 64; Vec8 md; int cb = -1;
        for (int i = 0; i < nrows; ++i) {
            const int mi = base + i; const int q0 = __builtin_amdgcn_readlane(p0, i), q1 = __builtin_amdgcn_readlane(p1, i);
            if (row_batch(mi) != cb) { cb = row_batch(mi); vec8_load(md, mod_vec(F, 1, mi, 4), mod_vec(F, 1, mi, 3), lane); }
            Row r; row_load(r, F.out + (size_t)mi * DM, lane); row_norm(r); row_affine_reg(r, md, 1.0f);
            unsigned* d0 = (unsigned*)(srt + (size_t)q0 * DM) + lane; unsigned* d1 = (unsigned*)(srt + (size_t)q1 * DM) + lane;
#pragma unroll
            for (int j = 0; j < 4; ++j) { const unsigned w8 = pk4_fp8(r.v[j][0], r.v[j][1], r.v[j][2], r.v[j][3]); d0[64 * j] = w8; d1[64 * j] = w8; }
        }
    }
}
__device__ __forceinline__ void moe_combine_phase(Frame& F) {
    const int gw = F.vcu * NWAVES + F.wave, NGW = F.G * NWAVES, lane = F.lane;
    const float* tokw = (const float*)(F.ws + WS_META + META_TOKW); const int* tpos = (const int*)(F.ws + WS_META + META_POS); const bf16* Y = (const bf16*)(F.ws + WS_MOEY);
    Vec8 ln; vec8_load(ln, inp(F, I_LN2G) + DM, inp(F, I_LN2B) + DM, lane);
    const int mb = (int)((long)NX * gw / NGW), me = (int)((long)NX * (gw + 1) / NGW); f32x4 g2[4]; int cb = -1;
    for (int m = mb; m < me; ++m) {
        if (row_batch(m) != cb) { cb = row_batch(m); const f32x4* gp = (const f32x4*)mod_vec(F, 1, m, 5) + lane;
#pragma unroll
            for (int j = 0; j < 4; ++j) g2[j] = gp[64 * j]; }
        const float w0 = tokw[2 * m], w1 = tokw[2 * m + 1]; const int p0 = tpos[2 * m], p1 = tpos[2 * m + 1];
        Row r; row_load(r, F.out + (size_t)m * DM, lane);
        const unsigned long long* y0 = (const unsigned long long*)(Y + (size_t)p0 * DM) + lane; const unsigned long long* y1 = (const unsigned long long*)(Y + (size_t)p1 * DM) + lane;
#pragma unroll
        for (int j = 0; j < 4; ++j) { const unsigned long long a = y0[64 * j], c = y1[64 * j];
            const f32x4 ya = (f32x4){bflo((unsigned)a), bfhi((unsigned)a), bflo((unsigned)(a >> 32)), bfhi((unsigned)(a >> 32))};
            const f32x4 yc = (f32x4){bflo((unsigned)c), bfhi((unsigned)c), bflo((unsigned)(c >> 32)), bfhi((unsigned)(c >> 32))};
            r.v[j] = r.v[j] * ALPHA_F + g2[j] * (ya * w0 + yc * w1); }
        row_norm(r); row_affine_reg(r, ln, 0.0f); row_store(r, F.out + (size_t)m * DM, lane);
    }
}

constexpr int HY_U_OFF = 0, HY_U_STRIDE = 4128, HY_K_OFF = 16 * HY_U_STRIDE, HY_K_STRIDE = 8448;
__device__ __forceinline__ int hy_kcopy_off(int m) { return m * HY_K_STRIDE + 16 * (int)((0xD25BAF50u >> (4 * m)) & 15u); }
constexpr int HYC_U_STRIDE = 544, HYC_K_STRIDE = 1040;
static_assert(HY_K_OFF + 8 * HY_K_STRIDE + 256 + 64 <= MISC_OFF, "hyena LDS map");
__device__ __forceinline__ float hy_short4(const bf16* p, int tb, int L, float w0, float w1, float w2, float bs, f32x4& x) {
    const v2u pw = *(const v2u*)(p + tb); const float c0 = bflo(pw.x), c1 = bfhi(pw.x), c2 = bflo(pw.y), c3 = bfhi(pw.y);
    const float pm = tb > 0 ? bf2f(p[tb - 1]) : 0.f, pp = tb + 4 < L ? bf2f(p[tb + 4]) : 0.f;
    x[0] = bs + w0 * pm + w1 * c0 + w2 * c1; x[1] = bs + w0 * c0 + w1 * c1 + w2 * c2; x[2] = bs + w0 * c1 + w1 * c2 + w2 * c3; x[3] = bs + w0 * c2 + w1 * c3 + w2 * pp; return 0.f;
}
__device__ __forceinline__ void hy_short4u(const bf16* pi, bool first, bool last, float w0, float w1, float w2, float bs, f32x4& x) {
    const v2u pw = *(const v2u*)pi; const float c0 = bflo(pw.x), c1 = bfhi(pw.x), c2 = bflo(pw.y), c3 = bfhi(pw.y);
    float pm = bf2f(pi[-1]), pp = bf2f(pi[4]); pm = first ? 0.f : pm; pp = last ? 0.f : pp;
    x[0] = bs + w0 * pm + w1 * c0 + w2 * c1; x[1] = bs + w0 * c0 + w1 * c1 + w2 * c2; x[2] = bs + w0 * c1 + w1 * c2 + w2 * c3; x[3] = bs + w0 * c2 + w1 * c3 + w2 * pp;
}
template <int L, int USTR>
__device__ __forceinline__ void hy_fill_u(Frame& F, const bf16* phyT, int col, int rowb0, float w0, float w1, float w2, float bs) {
    const bf16* pc = phyT + (size_t)col * RT + rowb0;
    constexpr int NIT = 16 * L / 8 / 512 > 0 ? 16 * L / 8 / 512 : 1;
#pragma unroll 4
    for (int it = 0; it < NIT; ++it) { const int ch = F.tid + 512 * it; const int b = ch / (L / 8), tb = (ch - b * (L / 8)) * 8; const bf16* p = pc + (size_t)b * L + tb;
        const v4u cw = *(const v4u*)p; float pm = bf2f(p[-1]), pp = bf2f(p[8]); pm = tb == 0 ? 0.f : pm; pp = tb + 8 >= L ? 0.f : pp;
        const float c0 = bflo(cw.x), c1 = bfhi(cw.x), c2 = bflo(cw.y), c3 = bfhi(cw.y), c4 = bflo(cw.z), c5 = bfhi(cw.z), c6 = bflo(cw.w), c7 = bfhi(cw.w);
        v4u o; o.x = pk2(bs + w0 * pm + w1 * c0 + w2 * c1, bs + w0 * c0 + w1 * c1 + w2 * c2); o.y = pk2(bs + w0 * c1 + w1 * c2 + w2 * c3, bs + w0 * c2 + w1 * c3 + w2 * c4);
        o.z = pk2(bs + w0 * c3 + w1 * c4 + w2 * c5, bs + w0 * c4 + w1 * c5 + w2 * c6); o.w = pk2(bs + w0 * c5 + w1 * c6 + w2 * c7, bs + w0 * c6 + w1 * c7 + w2 * pp);
        *(LAS v4u*)(F.lds + HY_U_OFF + b * USTR + tb * 2) = o; }
}
template <int KLEN, int KSTR, bool WAIT = true>
__device__ __forceinline__ void hy_fill_k(Frame& F, const bf16* kr) {
    const bf16* src = kr + (size_t)F.wave * KLEN + F.lane * 8;
#pragma unroll
    for (int i = 0; i < KLEN * 2 / 1024; ++i)
        __builtin_amdgcn_global_load_lds((const unsigned*)(src + i * 512), (LAS unsigned*)(F.lds + HY_K_OFF + (KSTR == HY_K_STRIDE ? hy_kcopy_off(F.wave) : F.wave * KSTR) + i * 1024), 16, 0, 0);
    if (WAIT) VM_WAIT();
}
__device__ __forceinline__ void hyena_unit(Frame& F, int l, int c, bool with_ctx) {
    const bf16* phyT = (const bf16*)(F.ws + WS_PHYT);
    const bf16* KRL = (const bf16*)(F.ws + WS_KRL); const bf16* KRC = (const bf16*)(F.ws + WS_KRC);
    const float* sw = inp(F, I_HSW) + l * 3 * 1536; const float* sb = inp(F, I_HSB) + l * 1536;
    const int lane = F.lane, w = F.wave, r = lane & 15, q = lane >> 4, m = (-r) & 7;
    __syncthreads();
    { const int col = 1024 + c; hy_fill_u<LSEQ, HY_U_STRIDE>(F, phyT, col, 0, sw[col], sw[1536 + col], sw[3072 + col], sb[col]); }
    hy_fill_k<4096, HY_K_STRIDE>(F, KRL + (size_t)((0 * 512 + c) * 8) * 4096);
    __syncthreads();
#pragma unroll 1
    for (int o = 0; o < 2; ++o) {
        f32x4 acc[16];
#pragma unroll 1
        for (int rep_ = 0; rep_ < NREP(15); ++rep_) {
#pragma unroll
        for (int i = 0; i < 16; ++i) acc[i] = (f32x4){0.f, 0.f, 0.f, 0.f};
        const LAS unsigned char* pa = F.lds + HY_K_OFF + hy_kcopy_off(m) + 2 * (8 * q - r - m + 2048 - 256 * w);
        const LAS unsigned char* pb = F.lds + HY_U_OFF + r * HY_U_STRIDE + 16 * q;
        bf16x8 R[16];
#pragma unroll
        for (int i = 0; i < 16; ++i) R[i] = *(const LAS bf16x8*)(pa - 32 * i);
        bf16x8 bcur = *(const LAS bf16x8*)pb;
#pragma unroll 1
        for (int kg = 0; kg < 8; ++kg) {
#pragma unroll
            for (int kk = 0; kk < 8; ++kk) {
                const bf16x8 bnext = *(const LAS bf16x8*)(pb + 64 * (kk + 1));
                const bf16x8 n0 = *(const LAS bf16x8*)(pa + 64 * (kk + 1)), n1 = *(const LAS bf16x8*)(pa + 64 * (kk + 1) - 32);
#pragma unroll
                for (int i = 0; i < 16; ++i) acc[i] = __builtin_amdgcn_mfma_f32_16x16x32_bf16(R[(i - 2 * kk) & 15], bcur, acc[i], 0, 0, 0);
                R[(-2 * (kk + 1)) & 15] = n0; R[(1 - 2 * (kk + 1)) & 15] = n1; bcur = bnext;
                __builtin_amdgcn_sched_barrier(0);
            }
            pa += 512; pb += 512;
        }
        }
        if (o == 0) { __syncthreads();
            hy_fill_k<4096, HY_K_STRIDE, false>(F, KRL + (size_t)((1 * 512 + c) * 8) * 4096); }
        const int col = o * 512 + c; const float w0 = sw[col], w1 = sw[1536 + col], w2 = sw[3072 + col], bs = sb[col];
        int tb0 = 256 * w + 4 * q; asm volatile("" : "+v"(tb0));
        const bf16* p = phyT + (size_t)col * RT + (size_t)r * LSEQ + tb0;
#pragma unroll
        for (int i = 0; i < 16; ++i) { f32x4 x; hy_short4u(p + 16 * i, tb0 + 16 * i == 0, tb0 + 16 * i + 4 >= LSEQ, w0, w1, w2, bs, x); acc[i] = acc[i] * x; }
        if (o == 0) {
#pragma unroll
            for (int i = 0; i < 16; ++i) { v2u zw; zw.x = pk2(acc[i][0], acc[i][1]); zw.y = pk2(acc[i][2], acc[i][3]); *(LAS v2u*)(F.lds + HY_U_OFF + r * HY_U_STRIDE + (tb0 + 16 * i) * 2) = zw; }
            VM_WAIT();
            __syncthreads();
        } else {
            GAS bf16* zt = (GAS bf16*)(F.ws + WS_PHYT) + (size_t)(1024 + c) * RT + (size_t)r * LSEQ + tb0; asm volatile("" : "+v"(zt));
#pragma unroll
            for (int i = 0; i < 16; ++i) { v2u zw; zw.x = pk2(acc[i][0], acc[i][1]); zw.y = pk2(acc[i][2], acc[i][3]); *(GAS v2u*)(zt + 16 * i) = zw; }
        }
    }
    if (!with_ctx) return;
    __syncthreads();
    { const int col = 1024 + c; hy_fill_u<LCTX, HYC_U_STRIDE>(F, phyT, col, NX, sw[col], sw[1536 + col], sw[3072 + col], sb[col]); }
    hy_fill_k<512, HYC_K_STRIDE>(F, KRC + (size_t)((0 * 512 + c) * 8) * 512);
    __syncthreads();
#pragma unroll 1
    for (int o = 0; o < 2; ++o) {
        f32x4 acc[2];
        acc[0] = (f32x4){0.f, 0.f, 0.f, 0.f}; acc[1] = acc[0];
        const LAS unsigned char* pa = F.lds + HY_K_OFF + m * HYC_K_STRIDE + 2 * (8 * q - r - m + 256 - 32 * w);
        const LAS unsigned char* pb = F.lds + HY_U_OFF + r * HYC_U_STRIDE + 16 * q;
#pragma unroll
        for (int k = 0; k < 8; ++k) { const bf16x8 bfr = *(const LAS bf16x8*)(pb + 64 * k);
#pragma unroll
            for (int i = 0; i < 2; ++i) acc[i] = __builtin_amdgcn_mfma_f32_16x16x32_bf16(*(const LAS bf16x8*)(pa + 64 * k - 32 * i), bfr, acc[i], 0, 0, 0); }
        const int col = o * 512 + c; const float w0 = sw[col], w1 = sw[1536 + col], w2 = sw[3072 + col], bs = sb[col];
        int tb0 = 32 * w + 4 * q; asm volatile("" : "+v"(tb0));
        const bf16* p = phyT + (size_t)col * RT + NX + (size_t)r * LCTX + tb0;
#pragma unroll
        for (int i = 0; i < 2; ++i) { f32x4 x; hy_short4u(p + 16 * i, tb0 + 16 * i == 0, tb0 + 16 * i + 4 >= LCTX, w0, w1, w2, bs, x); acc[i] = acc[i] * x; }
        if (o == 0) {
            __syncthreads();
#pragma unroll
            for (int i = 0; i < 2; ++i) { v2u zw; zw.x = pk2(acc[i][0], acc[i][1]); zw.y = pk2(acc[i][2], acc[i][3]); *(LAS v2u*)(F.lds + HY_U_OFF + r * HYC_U_STRIDE + (tb0 + 16 * i) * 2) = zw; }
            hy_fill_k<512, HYC_K_STRIDE>(F, KRC + (size_t)((1 * 512 + c) * 8) * 512);
            __syncthreads();
        } else {
            GAS bf16* zt = (GAS bf16*)(F.ws + WS_PHYT) + (size_t)(1024 + c) * RT + NX + (size_t)r * LCTX + tb0;
#pragma unroll
            for (int i = 0; i < 2; ++i) { v2u zw; zw.x = pk2(acc[i][0], acc[i][1]); zw.y = pk2(acc[i][2], acc[i][3]); *(GAS v2u*)(zt + 16 * i) = zw; }
        }
    }
}

__device__ __forceinline__ void zt_transpose_phase(Frame& F, int ntok) {
    const bf16* zT = (const bf16*)(F.ws + WS_PHYT) + (size_t)1024 * RT; bf16* z2 = (bf16*)(F.ws + WS_Z2);
    LAS unsigned char* scr = F.lds + F.wave * 8448;
    const int gw = F.wave * F.G + F.vcu  , NGW = F.G * NWAVES, lane = F.lane, nblk = ntok / 64;
    const int lr = lane >> 3, pc = lane & 7;
    __syncthreads();
    for (int it = gw; it < 8 * nblk; it += NGW) {
        const int cb = it / nblk, tbk = it - cb * nblk;
        v4u in[8];
#pragma unroll
        for (int j = 0; j < 8; ++j) in[j] = *(const v4u*)(zT + (size_t)(cb * 64 + 8 * j + lr) * RT + tbk * 64 + pc * 8);
#pragma unroll
        for (int j = 0; j < 8; ++j) { LAS unsigned* d = (LAS unsigned*)(scr + (8 * j + lr) * 132 + pc * 16); d[0] = in[j].x; d[1] = in[j].y; d[2] = in[j].z; d[3] = in[j].w; }
        LDS_WAIT();
#pragma unroll
        for (int j = 0; j < 8; ++j) {
            const LAS unsigned short* sp = (const LAS unsigned short*)(scr + (pc * 8) * 132 + (8 * j + lr) * 2);
            unsigned hv[8];
#pragma unroll
            for (int k = 0; k < 8; ++k) hv[k] = sp[k * 66];
            v4u o; o.x = hv[0] | (hv[1] << 16); o.y = hv[2] | (hv[3] << 16); o.z = hv[4] | (hv[5] << 16); o.w = hv[6] | (hv[7] << 16);
            *(v4u*)(z2 + (size_t)(tbk * 64 + 8 * j + lr) * 512 + cb * 64 + pc * 8) = o; }
        LDS_WAIT();
    }
    __syncthreads();
}

__device__ __forceinline__ void cf_unit(Frame& F, int l, int seqrow, int seqlen, int t0) {
    LAS bf16* U = (LAS bf16*)F.lds;
    LAS float* O = (LAS float*)(F.lds + 98304);
    const bf16* ucf = (const bf16*)(F.ws + WS_UCF); bf16* out = (bf16*)(F.ws + WS_UCF2);
    __syncthreads();
    { v4u wv[12];
#pragma unroll
        for (int j = 0; j < 12; ++j) { const int pc = F.tid + 512 * j; const int i = pc >> 6, ch = pc & 63; const int t = t0 - 15 + i;
            wv[j] = (v4u){0u, 0u, 0u, 0u}; if (pc < 94 * 64 && t >= 0 && t < seqlen) wv[j] = *(const v4u*)(ucf + (size_t)(seqrow + t) * 512 + ch * 8); }
#pragma unroll
        for (int j = 0; j < 12; ++j) { const int pc = F.tid + 512 * j; const int i = pc >> 6, ch = pc & 63; if (pc < 94 * 64) *(LAS v4u*)(U + i * 512 + ch * 8) = wv[j]; } }
    const int c = F.tid;
    float w[31];
#pragma unroll
    for (int k = 0; k < 31; ++k) w[k] = inp(F, I_CFW)[(size_t)l * 31 * 512 + k * 512 + c];
    const float bias = inp(F, I_CFB)[l * 512 + c];
    const f32x4 g0 = *((const f32x4*)(inp(F, I_CFG) + l * 512) + F.lane), g1 = *((const f32x4*)(inp(F, I_CFG) + l * 512) + 64 + F.lane);
    const f32x4 b0 = *((const f32x4*)(inp(F, I_CFLB) + l * 512) + F.lane), b1 = *((const f32x4*)(inp(F, I_CFLB) + l * 512) + 64 + F.lane);
    __syncthreads();
#pragma unroll 1
    for (int r = 0; r < 4; ++r) {
        float v[16];
#pragma unroll
        for (int t = 0; t < 16; ++t) v[t] = bias;
        const LAS bf16* Ur = U + (16 * r) * 512 + c;
#pragma unroll
        for (int ii = 0; ii < 46; ++ii) { const float x = bf2f(Ur[ii * 512]);
#pragma unroll
            for (int t = 0; t < 16; ++t) { if (ii - t >= 0 && ii - t <= 30) v[t] += w[ii - t] * x; } }
#pragma unroll
        for (int t = 0; t < 16; ++t) O[t * 512 + c] = v[t];
        __syncthreads();
#pragma unroll
        for (int q = 0; q < 2; ++q) {
            const int tt = 2 * F.wave + q;
            f32x4 x0 = *((const LAS f32x4*)(O + tt * 512) + F.lane), x1 = *((const LAS f32x4*)(O + tt * 512) + 64 + F.lane);
            const float mean = wave_sum((x0[0] + x0[1]) + (x0[2] + x0[3]) + (x1[0] + x1[1]) + (x1[2] + x1[3])) * (1.f / 512.f);
            x0 = x0 - mean; x1 = x1 - mean;
            const float var = wave_sum((x0[0] * x0[0] + x0[1] * x0[1]) + (x0[2] * x0[2] + x0[3] * x0[3]) + (x1[0] * x1[0] + x1[1] * x1[1]) + (x1[2] * x1[2] + x1[3] * x1[3])) * (1.f / 512.f);
            const float rstd = 1.f / sqrtf(var + LN_EPS);
            f32x4 y0 = x0 * rstd * g0 + b0, y1 = x1 * rstd * g1 + b1;
#pragma unroll
            for (int j = 0; j < 4; ++j) { y0[j] = siluf_(y0[j]); y1[j] = siluf_(y1[j]); }
            bf16* orow = out + (size_t)(seqrow + t0 + 16 * r + tt) * 512;
            v2u o0, o1; o0.x = pk2(y0[0], y0[1]); o0.y = pk2(y0[2], y0[3]); o1.x = pk2(y1[0], y1[1]); o1.y = pk2(y1[2], y1[3]);
            *((v2u*)orow + F.lane) = o0; *((v2u*)orow + 64 + F.lane) = o1;
        }
        __syncthreads();
    }
}

#define TSUB(slot) do { if (DBG_TMASK) { const unsigned long long now_ = wall_clock64(); if (((DBG_TMASK >> (slot)) & 1u) && ((DBG_TLAYER >> l) & 1u)) t_acc += now_ - t_prev; t_prev = now_; } } while (0)
__device__ __forceinline__ void s5_unit(Frame& F, int l, int b, int gp, unsigned long long& t_acc, unsigned long long& t_prev) {
    const int lane = F.lane, w = F.wave;
    bf16* ps5 = (bf16*)(F.ws + WS_PS5); bf16* ydir = (bf16*)(F.ws + WS_YDIR);
    __syncthreads();
#pragma unroll 1
    for (int rep_ = 0; rep_ < NREP(14); ++rep_)
    {
        const int gd = w & 3, role = w >> 2;
        const int g = 2 * gp + (gd >> 1), dir = gd & 1;
        const int r = lane & 15, q = lane >> 4;
        LAS unsigned char* wl = F.lds + gd * 33280;
        LAS unsigned char* uS0 = wl;
        LAS float* BuS0 = (LAS float*)(wl + 4096);
        LAS unsigned char* stS0 = wl + 4096 + 2 * 10240;
        constexpr int NCH = (LCTX + LSEQ) / 16;
        const float* P = (const float*)(F.ws + WS_S5P) + (size_t)((dir * 32 + g) * 64) * 36;
        float abr = 0.f, abi = 0.f; f32x2 s2 = (f32x2){0.f, 0.f}, Aa = s2, Bn = s2;
        bf16x8 Bf[8], Cf[4];
        const int ti = lane >> 2, cq = lane & 3;
        auto urow = [&](int k) -> size_t { const bool isc = k < LCTX / 16; const int kk = isc ? k : k - LCTX / 16; const int Ls = isc ? LCTX : LSEQ; const int rowb = isc ? NX + b * LCTX : b * LSEQ;
            const int st = kk * 16 + ti; const int t = dir ? (Ls - 1 - st) : st; return (size_t)(rowb + t) * 512 + g * 16 + 4 * cq; };
        v2u ublk[8];
#pragma unroll
        for (int j = 0; j < 8; ++j) ublk[j] = (v2u){0u, 0u};
        static_assert(((LCTX + LSEQ) / 16) % 8 == 0, "s5 input blocks");
        if (role == 0) { abr = P[lane * 36]; abi = P[lane * 36 + 1]; Aa = (f32x2){abr, abr}; Bn = (f32x2){-abi, abi}; }
        else {
#pragma unroll
            for (int blk = 0; blk < 8; ++blk) { const int pp = 16 * blk + r; const float* src = P + (size_t)(pp & 63) * 36 + (pp < 64 ? 2 : 18) + 8 * (q & 1);
                v4u t4; t4.x = pk2(src[0], src[1]); t4.y = pk2(src[2], src[3]); t4.z = pk2(src[4], src[5]); t4.w = pk2(src[6], src[7]);
                if (q >= 2) t4 = (v4u){0u, 0u, 0u, 0u};
                Bf[blk] = __builtin_bit_cast(bf16x8, t4); }
            const float* cre = inp(F, I_SCRE) + (size_t)(((l * 2 + dir) * 32 + g) * 16) * 64; const float* cim = inp(F, I_SCIM) + (size_t)(((l * 2 + dir) * 32 + g) * 16) * 64;
#pragma unroll
            for (int ks = 0; ks < 4; ++ks) { const int p0 = 16 * ks + 4 * q; const f32x4 a = *(const f32x4*)(cre + r * 64 + p0), c4 = *(const f32x4*)(cim + r * 64 + p0);
                v4u t4; t4.x = pk2(a[0], -c4[0]); t4.y = pk2(a[1], -c4[1]); t4.z = pk2(a[2], -c4[2]); t4.w = pk2(a[3], -c4[3]);
                Cf[ks] = __builtin_bit_cast(bf16x8, t4); }
#pragma unroll
            for (int j = 0; j < 8; ++j) ublk[j] = *(const v2u*)(ps5 + urow(j));
#pragma unroll
            for (int j = 0; j < 8; ++j) *(LAS v2u*)(uS0 + j * 512 + ti * 32 + 8 * cq) = ublk[j];
#pragma unroll
            for (int j = 0; j < 8; ++j) ublk[j] = *(const v2u*)(ps5 + urow(8 + j));
        }
        LDS_WAIT(); __builtin_amdgcn_s_barrier(); asm volatile("" ::: "memory");
#pragma unroll 1
        for (int k = 0; k < NCH + 2; ++k) {
            const int p0 = k & 1, p1 = p0 ^ 1;
            unsigned long long tb0_ = 0; if (DBG_TMASK & 0x300000u) tb0_ = wall_clock64();
            if (role == 1) {
                bf16x8 ua, sf[4];
                if (k < NCH) { const v4u t4 = *(const LAS v4u*)(uS0 + (k & 7) * 512 + r * 32 + 16 * (q & 1)); ua = __builtin_bit_cast(bf16x8, q < 2 ? t4 : (v4u){0u, 0u, 0u, 0u}); }
                if (k < NCH) {
#pragma unroll
                    for (int blk = 0; blk < 8; ++blk) { const f32x4 d = __builtin_amdgcn_mfma_f32_16x16x32_bf16(ua, Bf[blk], (f32x4){0.f, 0.f, 0.f, 0.f}, 0, 0, 0);
                        *(LAS f32x4*)(BuS0 + p0 * 2560 + (16 * blk + r) * 20 + 4 * q) = d; }
                }
                if (k >= 2) {
#pragma unroll
                    for (int ks = 0; ks < 4; ++ks) sf[ks] = *(const LAS bf16x8*)(stS0 + p0 * 4352 + r * 272 + 64 * ks + 16 * q); }
                if ((k & 7) == 7 && k + 1 < NCH) {
#pragma unroll
                    for (int j = 0; j < 8; ++j) *(LAS v2u*)(uS0 + j * 512 + ti * 32 + 8 * cq) = ublk[j];
                    if (k + 9 < NCH) {
#pragma unroll
                        for (int j = 0; j < 8; ++j) ublk[j] = *(const v2u*)(ps5 + urow(k + 9 + j)); } }
                if (k >= 2) {
                    f32x4 y0 = __builtin_amdgcn_mfma_f32_16x16x32_bf16(sf[0], Cf[0], (f32x4){0.f, 0.f, 0.f, 0.f}, 0, 0, 0), y1 = __builtin_amdgcn_mfma_f32_16x16x32_bf16(sf[1], Cf[1], (f32x4){0.f, 0.f, 0.f, 0.f}, 0, 0, 0);
                    y0 = __builtin_amdgcn_mfma_f32_16x16x32_bf16(sf[2], Cf[2], y0, 0, 0, 0); y1 = __builtin_amdgcn_mfma_f32_16x16x32_bf16(sf[3], Cf[3], y1, 0, 0, 0);
                    const f32x4 y = y0 + y1; const int kc = k - 2;
                    const bool isc = kc < LCTX / 16; const int kk = isc ? kc : kc - LCTX / 16; const int Ls = isc ? LCTX : LSEQ; const int rowb = isc ? NX + b * LCTX : b * LSEQ;
#pragma unroll
                    for (int i = 0; i < 4; ++i) { const int st = kk * 16 + 4 * q + i; const int t = dir ? (Ls - 1 - st) : st;
                        ydir[(size_t)dir * RT * 512 + (size_t)(rowb + t) * 512 + g * 16 + r] = (bf16)f2bf(y[i]); } }
            } else if (k >= 1 && k <= NCH) {
                __builtin_amdgcn_s_setprio(3);
                f32x4 bre[4], bim[4];
#pragma unroll
                for (int j = 0; j < 4; ++j) { bre[j] = *(const LAS f32x4*)(BuS0 + p1 * 2560 + lane * 20 + 4 * j); bim[j] = *(const LAS f32x4*)(BuS0 + p1 * 2560 + (64 + lane) * 20 + 4 * j); }
                float sr = s2[0], si = s2[1];
#pragma unroll
                for (int i = 0; i < 16; ++i) {
                    const float tr = __builtin_fmaf(-abi, si, bre[i >> 2][i & 3]), ti = __builtin_fmaf(abi, sr, bim[i >> 2][i & 3]);
                    sr = __builtin_fmaf(abr, sr, tr); si = __builtin_fmaf(abr, si, ti);
                    asm volatile("" : "+v"(sr), "+v"(si));
                    *(LAS unsigned*)(stS0 + p1 * 4352 + i * 272 + 4 * lane) = pk2(sr, si); }
                s2 = (f32x2){sr, si};
                __builtin_amdgcn_s_setprio(0);
            }
            if ((DBG_TMASK & 0x300000u) && ((DBG_TLAYER >> l) & 1u) && role == (int)((DBG_TMASK >> 21) & 1u)) { LDS_WAIT(); t_acc += wall_clock64() - tb0_; }
            LDS_WAIT(); __builtin_amdgcn_s_barrier(); asm volatile("" ::: "memory");
        }
    }
    VM_WAIT();
    __syncthreads();
    TSUB(19);
    const float* dsk = inp(F, I_SD) + l * 512 + gp * 32;
    static_assert((LCTX + LSEQ) * 4 % (512 * 3) == 0, "combine batches");
#pragma unroll 1
    for (int e0 = F.tid; e0 < (LCTX + LSEQ) * 4; e0 += 512 * 3) {
        const int pc = e0 & 3; size_t off[3]; v4u uw[3], fw[3], bw[3];
#pragma unroll
        for (int j = 0; j < 3; ++j) { const int rr = (e0 + 512 * j) >> 2; const int row = rr < LSEQ ? b * LSEQ + rr : NX + b * LCTX + (rr - LSEQ);
            off[j] = (size_t)row * 512 + gp * 32 + pc * 8;
            uw[j] = *(const v4u*)(ps5 + off[j]); fw[j] = *(const v4u*)(ydir + off[j]); bw[j] = *(const v4u*)(ydir + (size_t)RT * 512 + off[j]); }
        const f32x4 d0 = *(const f32x4*)(dsk + pc * 8), d1 = *(const f32x4*)(dsk + pc * 8 + 4);
#pragma unroll
        for (int j = 0; j < 3; ++j) {
            f32x4 u0, u1, f0, f1, b0, b1; unpack8(uw[j], u0, u1); unpack8(fw[j], f0, f1); unpack8(bw[j], b0, b1);
            f32x4 o0, o1;
#pragma unroll
            for (int i = 0; i < 4; ++i) { o0[i] = gelu_tanh(f0[i] + b0[i] + d0[i] * u0[i]); o1[i] = gelu_tanh(f1[i] + b1[i] + d1[i] * u1[i]); }
            *(v4u*)((bf16*)(F.ws + WS_SG) + off[j]) = pack8(o0, o1); }
    }
}

__device__ __forceinline__ Frame make_frame(const Args& args, LAS unsigned char* lds, int wave_s);
__device__ __forceinline__ void mixers_phase(const Args& args, LAS unsigned char* lds, int wave_s, int l, unsigned long long& t_acc, unsigned long long& t_prev) {
#ifndef MIXMASK
#define MIXMASK 7
#endif
    if (MIXMASK & 1) { Frame F = make_frame(args, lds, wave_s);
#pragma unroll 1
        for (int u = F.vcu; u < NB * 16; u += F.G) s5_unit(F, l, u >> 4, u & 15, t_acc, t_prev); }
    TSUB(16);
    if (MIXMASK & 2) { Frame F = make_frame(args, lds, wave_s);
#pragma unroll 1
        for (int u = F.vcu; u < 512; u += F.G) hyena_unit(F, l, u, l == 0);
        if (NREP(10) == 2) {
#pragma unroll 1
            for (int u = F.vcu; u < 512; u += F.G) hyena_unit(F, l, u, l == 0); } }
    TSUB(17);
    if (MIXMASK & 4) { Frame F = make_frame(args, lds, wave_s);
        const int ncf = l == 0 ? NB * 32 + NB * 4 : NB * 32;
#pragma unroll 1
        for (int u = F.vcu; u < ncf; u += F.G) { if (u < NB * 32) cf_unit(F, l, u * 64, 64, 0); else { const int q = u - NB * 32; cf_unit(F, l, NX + (q >> 2) * LCTX, LCTX, (q & 3) * 64); } } }
    TSUB(18);
    __syncthreads();
}

constexpr int PH_P0A = 0, PH_P0B = 1, PH_L0 = 2, PH_L1 = 12, N_PHASES = 27;
__device__ __forceinline__ Frame make_frame(const Args& args, LAS unsigned char* lds, int wave_s) {
    unsigned z0 = 0u; asm volatile("" : "+v"(z0));
    Frame F; int t = wave_s * 64 + (int)__builtin_amdgcn_mbcnt_hi(~0u, __builtin_amdgcn_mbcnt_lo(~0u, z0)); asm volatile("" : "+v"(t));
    unsigned char* ws = args.ws; float* out = args.out;
    F.lds = lds; F.tid = t; F.lane = t & 63; F.wave = wave_s;
    int G = gridDim.x, bx = blockIdx.x; asm volatile("" : "+s"(G), "+s"(bx));
    F.G = G; F.vcu = (G % 8 == 0) ? (bx % 8) * (G / 8) + bx / 8 : bx;
    const float* const* inp = args.in;
    F.in = inp; F.out = out; F.ws = ws; return F;
}
__global__ void __launch_bounds__(NWAVES * 64, 2) mega_fwd(Args args) {
    extern __shared__ __attribute__((aligned(16))) unsigned char lds_raw[];
    LAS unsigned char* const lds = (LAS unsigned char*)lds_raw;
    volatile LAS unsigned* MISC = (volatile LAS unsigned*)(lds + MISC_OFF);
    for (int u = threadIdx.x; u < (LDS_BYTES - MISC_OFF) / 4; u += NWAVES * 64) ((LAS unsigned*)(lds + MISC_OFF))[u] = 0u;
    int wave_s = __builtin_amdgcn_readfirstlane((int)threadIdx.x >> 6); asm volatile("" : "+s"(wave_s));
    __syncthreads();
    const int lo = MK_PER_PHASE_LAUNCH ? args.ph_lo : 0, hi = MK_PER_PHASE_LAUNCH ? args.ph_hi : N_PHASES;
    XcdBarrier bar; bar.bar = (unsigned*)(args.ws + WS_CTL) + CW_BAR; bar.x = 0; bar.st = nullptr;
    if (hi - lo > 1) bar = xcd_barrier_post((unsigned*)(args.ws + WS_CTL) + CW_BAR, MISC + 8);
#ifndef PHMASK
#define PHMASK 0xffffffffu
#endif
#define IN(k) (lo <= (k) && (k) < hi)
#define PM(b) ((PHMASK >> (b)) & 1u)
#define SEAM(k) do { if (IN(k) && IN((k) + 1)) xcd_barrier(bar, wave_s); } while (0)
    unsigned long long t_acc = 0, t_prev = DBG_TMASK ? wall_clock64() : 0ull;
#define TSLOT(slot, lyr) do { if (DBG_TMASK) { const unsigned long long now_ = wall_clock64(); if (((DBG_TMASK >> (slot)) & 1u) && ((DBG_TLAYER >> (lyr)) & 1u)) t_acc += now_ - t_prev; t_prev = now_; } } while (0)
#define FRAME() Frame F = make_frame(args, lds, wave_s); const char* ws = (const char*)F.ws; const int c = F.G == (int)gridDim.x ? (int)blockIdx.x : 0; (void)ws; (void)c

    if (PM(0) && IN(PH_P0A)) { FRAME(); REPEAT(NREP(12), p0a_prologue(F)); } SEAM(PH_P0A); TSLOT(0, 0);

#pragma unroll 1
    for (int l = 0; l < 2; ++l) {
        const int pb = l == 0 ? PH_L0 : PH_L1;
        const int nMl = l == 0 ? RT / 256 : NX / 256;
        if (l == 0) {
        if (PM(2) && IN(pb + 0)) { { FRAME(); REPEAT(NREP(8), lnmod_phase(F, l)); } { FRAME(); h2table_phase(F, l); } { FRAME(); s5params_phase(F, l); } } SEAM(pb + 0); TSLOT(2, l); }
        if (PM(3) && IN(pb + 1)) { { FRAME(); REPEAT(NREP(9), filter_expand_phase(F, l)); }
            { FRAME(); SchedPlain S; S.R.init(6, nMl, F.G, c); S.A = ws + WS_WIN + (size_t)l * 6144 * 1024 * 2; S.B = ws + WS_HX; S.tsA = 256 * 1024 * 2; S.tsB = 256 * 1024 * 2; S.xM = 0; S.xN0 = 0; S.xNn = 1;
              EpiHyT E{(bf16*)(F.ws + WS_PHYT)}; pg8::gemm_phase<EpiHyT, SchedPlain>(F.lds, F.tid, 2048, S, E); }
            { FRAME(); SchedPlain S; S.R.init(nMl, 6, F.G, (c + (F.G * 3) / 8) % F.G); S.A = ws + WS_HX; S.B = ws + WS_WIN + ((size_t)l * 6144 + 1536) * 1024 * 2; S.tsA = 256 * 1024 * 2; S.tsB = 256 * 1024 * 2;
              S.xM = l == 0 ? 0 : NCX / 256; S.xN0 = 4; S.xNn = 2;
              EpiInproj E{(bf16*)(F.ws + WS_PHYT), (bf16*)(F.ws + WS_UCF), (bf16*)(F.ws + WS_PS5), 6};
              pg8::gemm_phase<EpiInproj, SchedPlain>(F.lds, F.tid, 2048, S, E); }
        } SEAM(pb + 1); TSLOT(3, l);
        if (PM(4) && IN(pb + 2)) { mixers_phase(args, lds, wave_s, l, t_acc, t_prev); } SEAM(pb + 2); TSLOT(4, l);
        if (PM(5) && IN(pb + 3)) {
            { FRAME(); zt_transpose_phase(F, l == 0 ? RT : NX); }
            { FRAME(); SchedPlain S; S.R.init(nMl, 12, F.G, c); S.A = ws + WS_HX; S.B = ws + WS_WIN + ((size_t)l * 6144 + 3072) * 1024 * 2; S.tsA = 256 * 1024 * 2; S.tsB = 256 * 1024 * 2; S.xM = 0; S.xN0 = 0; S.xNn = 1;
              EpiGates E{(bf16*)(F.ws + WS_G), F.tid}; REPEAT(NREP(1), pg8::gemm_phase<EpiGates, SchedPlain>(F.lds, F.tid, 2048, S, E, (DBG_TMASK & 0x1000000u) && l == 0 ? &t_acc : nullptr)); }
#ifndef DBG_SKIP_GLU
            { FRAME(); SchedPlain S; S.R.init(nMl, 2, F.G, (c + F.G / 4) % F.G); S.A = ws + WS_SG; S.B = ws + WS_WGLU + (size_t)l * 512 * 512 * 2; S.tsA = 256 * 512 * 2; S.tsB = 256 * 512 * 2; S.xM = 0; S.xN0 = 0; S.xNn = 1;
              EpiGlu E{(const bf16*)(F.ws + WS_SG), (bf16*)(F.ws + WS_S5Y), inp(F, I_SBGLU) + l * 512}; REPEAT(NREP(2), pg8::gemm_phase<EpiGlu, SchedPlain>(F.lds, F.tid, 1024, S, E)); }
#endif
        } SEAM(pb + 3); TSLOT(5, l);
        if (PM(6) && IN(pb + 4)) { FRAME();
            SchedMerge S; S.R.init(nMl, 4, F.G, c); S.A = ws + WS_Z2; S.sA = WS_UCF2 - WS_Z2; S.B = ws + WS_WOUTS + (size_t)(l * 3) * 1024 * 512 * 2; S.sB = (size_t)1024 * 512 * 2;
            S.tsA = 256 * 512 * 2; S.tsB = 256 * 512 * 2;
            EpiMerge E{(const bf16*)(F.ws + WS_G), (bf16*)(F.ws + WS_HX), F.tid};
            REPEAT(NREP(3), pg8::gemm_phase<EpiMerge, SchedMerge>(F.lds, F.tid, 1024, S, E));
        } SEAM(pb + 4); TSLOT(6, l);
        if (PM(7) && IN(pb + 5)) { FRAME();
            SchedPlain S; S.R.init(nMl, 4, F.G, c); S.A = ws + WS_HX; S.B = ws + WS_WO + (size_t)l * 1024 * 1024 * 2; S.tsA = 256 * 1024 * 2; S.tsB = 256 * 1024 * 2; S.xM = 0; S.xN0 = 0; S.xNn = 1;
            EpiRes E{l == 0 ? inp(F, I_X) : F.out, l == 0 ? inp(F, I_CTX) : (const float*)(F.ws + WS_XC), (bf16*)(F.ws + WS_KRL), (const float*)(F.ws + WS_MODS) + (size_t)l * 17 * INC + 2 * 1024, 1.0f};
            REPEAT(((l == 0) ? NREP(4) : 1), pg8::gemm_phase<EpiRes, SchedPlain>(F.lds, F.tid, 2048, S, E));
        } SEAM(pb + 5); TSLOT(7, l);
        if (PM(8) && IN(pb + 6)) { { FRAME(); if (l == 0) ln1_phase<false>(F, l); else ln1_phase<true>(F, l); } if (l == 1) { FRAME(); REPEAT(NREP(13), moe_convert_phase(F)); } } SEAM(pb + 6); TSLOT(8, l);
        if (l == 0) {
            if (PM(9) && IN(pb + 7)) { FRAME();
                SchedPlain S; S.R.init(RT / 256, 22, F.G, c); S.A = ws + WS_HX; S.B = ws + WS_W13; S.tsA = 256 * 1024; S.tsB = 256 * 1024; S.xM = 0; S.xN0 = 0; S.xNn = 1;
                EpiSwigluF8 E{F.ws + WS_G, DFF, 0.03125f}; REPEAT(NREP(5), pg8::gemm_phase<EpiSwigluF8, SchedPlain, true>(F.lds, F.tid, 1024, S, E, (DBG_TMASK & 0x1000000u) ? nullptr : &t_acc));
            } SEAM(pb + 7); TSLOT(9, 0);
            if (PM(10) && IN(pb + 8)) { FRAME();
                SchedPlain S; S.R.init(RT / 256, 4, F.G, c); S.A = ws + WS_G; S.B = ws + WS_W2; S.tsA = (size_t)256 * DFF; S.tsB = (size_t)256 * DFF; S.xM = 0; S.xN0 = 0; S.xNn = 1;
                EpiRes E{F.out, (const float*)(F.ws + WS_XC), (bf16*)(F.ws + WS_KRL), (const float*)(F.ws + WS_MODS) + 5 * 1024, 0.0078125f};
                pg8::gemm_phase<EpiRes, SchedPlain, true>(F.lds, F.tid, DFF, S, E);
            } SEAM(pb + 8); TSLOT(10, 0);
            if (PM(11) && IN(pb + 9)) { { FRAME(); ln2_phase(F, l); } { FRAME(); h2table_phase(F, 1); } { FRAME(); s5params_phase(F, 1); } } SEAM(pb + 9); TSLOT(11, 0);
        } else {
            if (PM(15) && IN(pb + 7)) { FRAME(); moe_setup_phase(F); } SEAM(pb + 7); TSLOT(12, 1);
#pragma unroll 1
            for (int st = 0; st < 6; ++st) {
                if (PM(13) && IN(pb + 8 + st) && st >= 1) { FRAME(); const int* tile_e = (const int*)(F.ws + WS_META + META_TILE); const int ch = st - 1;
                    const int ntiles = tile_e[511]; int nmc = ntiles - 64 * ch; nmc = nmc < 0 ? 0 : (nmc > 64 ? 64 : nmc);
                    SchedMoe S; S.R.init(nmc, 4, F.G, c); S.A = ws + WS_HID + (size_t)(ch & 1) * HID_BUF; S.B = ws + WS_MW2; S.tsA = (size_t)256 * DEX; S.tsB = (size_t)256 * DEX; S.esB = (size_t)1024 * DEX; S.tile_e = tile_e; S.tile0 = 64 * ch; S.a_global = false;
                    EpiMoeDown E{(bf16*)(F.ws + WS_MOEY), 0.0078125f}; REPEAT(NREP(7), pg8::gemm_phase<EpiMoeDown, SchedMoe, true>(F.lds, F.tid, DEX, S, E));
                }
                if (PM(12) && IN(pb + 8 + st) && st <= 4) { FRAME(); const int* tile_e = (const int*)(F.ws + WS_META + META_TILE); const int ch = st;
                    const int ntiles = tile_e[511]; int nmc = ntiles - 64 * ch; nmc = nmc < 0 ? 0 : (nmc > 64 ? 64 : nmc);
                    SchedMoe S; S.R.init(nmc, 28, F.G, c); S.A = ws + WS_SORT; S.B = ws + WS_MW13; S.tsA = 256 * 1024; S.tsB = 256 * 1024; S.esB = (size_t)7168 * 1024; S.tile_e = tile_e; S.tile0 = 64 * ch; S.a_global = true;
                    EpiSwigluF8 E{F.ws + WS_HID + (size_t)(ch & 1) * HID_BUF, DEX, 0.03125f}; REPEAT(NREP(6), pg8::gemm_phase<EpiSwigluF8, SchedMoe, true>(F.lds, F.tid, 1024, S, E));
                }
                SEAM(pb + 8 + st); TSLOT(13, 1);
            }
            if (PM(14) && IN(pb + 14)) { FRAME(); moe_combine_phase(F); } TSLOT(14, 1);
        }
    }
    if (DBG_TMASK) { const unsigned long long t0_ = wall_clock64(); while (wall_clock64() - t0_ < t_acc) __builtin_amdgcn_s_sleep(16); }
#undef IN
#undef SEAM
#undef FRAME
}


#ifdef DBG_DUMP
__global__ void dbg_dump(const unsigned char* ws, float* out) {
    const size_t NE = (size_t)RT * 512; const bf16* a = (const bf16*)(ws + WS_PS5); const bf16* b = (const bf16*)(ws + WS_Z2); const bf16* c = (const bf16*)(ws + WS_UCF2);
    for (size_t i = (size_t)blockIdx.x * blockDim.x + threadIdx.x; i < (size_t)NX * DM; i += (size_t)gridDim.x * blockDim.x) {
        const size_t j = i % NE; const int k = (int)(i / NE);
        float v;
        if (DBG_DUMP == 8) v = i < (size_t)26 * 1024 * 1024 ? bf2f(((const bf16*)(ws + WS_WIN))[i]) : 0.f;
        else if (DBG_DUMP == 7) v = k == 0 ? bf2f(a[j]) : bf2f(((const bf16*)(ws + WS_UCF))[j]);
        else if (DBG_DUMP == 4) v = bf2f(((const bf16*)(ws + WS_HX))[i]);
        else if (DBG_DUMP == 5) v = bf2f(((const bf16*)(ws + WS_G))[i]);
        else if (DBG_DUMP == 6) v = bf2f(((const bf16*)(ws + WS_S5Y))[i % NE]);
        else if (DBG_DUMP == 1) v = k == 0 ? bf2f(a[j]) : bf2f(b[j]);
        else if (DBG_DUMP == 2) v = k == 0 ? bf2f(b[j]) : bf2f(c[j]);
        else v = k == 0 ? bf2f(c[j]) : bf2f(a[j]);
        out[i] = v;
    }
}
#endif
extern "C" void kernel_launch(void* const* d_in, const int* in_sizes, int n_in, void* d_out, int out_size, void* d_ws, size_t ws_size, hipStream_t stream) {
    static int grid = 0;
    if (grid == 0) {
        if (n_in != N_IN || out_size != NX * DM || ws_size < WS_END2) { fprintf(stderr, "kernel_launch: unexpected shapes (n_in %d, out %d, ws %zu)\n", n_in, out_size, ws_size); grid = -1; return; }
        int dev = 0, cus = 0, per_cu = 0;
        if (hipGetDevice(&dev) != hipSuccess || hipDeviceGetAttribute(&cus, hipDeviceAttributeMultiprocessorCount, dev) != hipSuccess) { grid = -1; return; }
        if (hipFuncSetAttribute((const void*)mega_fwd, hipFuncAttributeMaxDynamicSharedMemorySize, LDS_BYTES) != hipSuccess) { fprintf(stderr, "kernel_launch: hipFuncSetAttribute failed\n"); grid = -1; return; }
        if (hipOccupancyMaxActiveBlocksPerMultiprocessor(&per_cu, (const void*)mega_fwd, NWAVES * 64, LDS_BYTES) != hipSuccess || per_cu < 1) fprintf(stderr, "kernel_launch: occupancy query reports %d\n", per_cu);
        (void)hipGetLastError();
        grid = cus;
    }
    if (grid < 0) return;
    (void)hipMemsetAsync((char*)d_ws + WS_CTL, 0, CTL_ZERO_BYTES, stream);
    Args a{};
    for (int i = 0; i < N_IN; ++i) a.in[i] = (const float*)d_in[i];
    a.out = (float*)d_out; a.ws = (unsigned char*)d_ws;
#if MK_PER_PHASE_LAUNCH
    for (int p = 0; p < DBG_NPH; ++p) { a.ph_lo = p; a.ph_hi = p + 1; hipLaunchKernelGGL(mega_fwd, dim3(grid), dim3(NWAVES * 64), LDS_BYTES, stream, a); }
#ifdef DBG_DUMP
    hipLaunchKernelGGL(dbg_dump, dim3(2048), dim3(256), 0, stream, (const unsigned char*)d_ws, (float*)d_out);
#endif
#else
    a.ph_lo = 0; a.ph_hi = N_PHASES; hipLaunchKernelGGL(mega_fwd, dim3(grid), dim3(NWAVES * 64), LDS_BYTES, stream, a);
#endif
}
```

```cpp
#include <hip/hip_runtime.h>
#include <cstdio>
#include <cstdint>

#ifndef DBG_REP
#define DBG_REP 0
#endif
#define NREP(bit) (((DBG_REP >> (bit)) & 1) ? 2 : 1)
#define REPEAT(n, ...) do { __VA_ARGS__; if ((n) == 2) { __VA_ARGS__; } } while (0)
#ifndef DBG_NPH
#define DBG_NPH N_PHASES
#define DBG_TMASK 0u
#define DBG_TLAYER 3u
#endif
#ifndef MK_PER_PHASE_LAUNCH
#define MK_PER_PHASE_LAUNCH 0
#endif

#define GAS __attribute__((address_space(1)))
#define LAS __attribute__((address_space(3)))
typedef unsigned short bf16;
typedef unsigned v4u __attribute__((ext_vector_type(4)));
typedef unsigned v2u __attribute__((ext_vector_type(2)));
typedef float f32x4 __attribute__((ext_vector_type(4)));
typedef float f32x2 __attribute__((ext_vector_type(2)));
typedef short bf16x8 __attribute__((ext_vector_type(8)));

constexpr int NB = 16, LSEQ = 2048, LCTX = 256, DM = 1024;
constexpr int NX = NB * LSEQ;
constexpr int NCX = NB * LCTX;
constexpr int RT = NX + NCX;
constexpr int INC = 6144, DFF = 2816, DEX = 3584, NEXP = 8;
constexpr float ALPHA_F = 1.41421356237f;
constexpr float LN_EPS = 1e-5f;

enum { I_X = 0, I_C, I_CTX, I_CCTX, I_WMOD, I_BMOD, I_WIN, I_HSW, I_HSB, I_FW1, I_FB1, I_FW2, I_FB2, I_FW3, I_FB3, I_FREQ, I_DECAY, I_HBIAS, I_WHY,
       I_CFW, I_CFB, I_CFG, I_CFLB, I_WCF, I_SARE, I_SAIM, I_SLDT, I_SBRE, I_SBIM, I_SCRE, I_SCIM, I_SD, I_SWGLU, I_SBGLU, I_WS5, I_WO,
       I_LN1G, I_LN1B, I_LN2G, I_LN2B, I_FFW1, I_FFW3, I_FFW2, I_ROUTER, I_MW1, I_MW3, I_MW2, N_IN };

constexpr size_t MiB = 1u << 20;
constexpr size_t WS_CTL = 0, CTL_ZERO_BYTES = 1 * MiB;
constexpr size_t WS_MODS = 1 * MiB;
constexpr size_t WS_S5P = 2 * MiB;
constexpr size_t WS_META = 3 * MiB;
constexpr size_t WS_FILT = 4 * MiB;
constexpr size_t WS_XC = 22 * MiB;
constexpr size_t WS_WIN = 38 * MiB;
constexpr size_t WS_WOUTS = 62 * MiB;
constexpr size_t WS_WGLU = 68 * MiB;
constexpr size_t WS_WO = 69 * MiB;
constexpr size_t WS_W13 = 73 * MiB;
constexpr size_t WS_W2 = 84 * MiB;
constexpr size_t WS_HX = 90 * MiB;
constexpr size_t WS_G = 162 * MiB;
constexpr size_t WS_PHYT = WS_G, WS_YDIR = WS_G + 108 * MiB, WS_UCF = WS_G + 180 * MiB;
constexpr size_t WS_PS5 = 378 * MiB;
constexpr size_t WS_Z2 = 414 * MiB;
constexpr size_t WS_UCF2 = 450 * MiB;
constexpr size_t WS_S5Y = 486 * MiB;
constexpr size_t WS_KRL = 522 * MiB;
constexpr size_t WS_KRC = 586 * MiB;
constexpr size_t WS_SG = 596 * MiB;
constexpr size_t WS_KDUMMY = 594 * MiB;
constexpr size_t WS_END = 595 * MiB;
constexpr size_t WS_SORT = 90 * MiB;
constexpr size_t WS_MOEY = 156 * MiB;
constexpr size_t WS_MW13 = 288 * MiB;
constexpr size_t WS_MW2 = 344 * MiB;
constexpr size_t WS_HID = 372 * MiB;
constexpr size_t HID_BUF = 56 * MiB;
constexpr size_t WS_END2 = 632 * MiB;
static_assert(WS_HID + (size_t)67584 * 3584 <= WS_END2, "moe map");
constexpr size_t META_BCNT = 800 * 1024;
constexpr size_t META_TOKE = 0, META_TOKW = 256 * 1024, META_POS = 512 * 1024, META_TILE = 768 * 1024;
constexpr int CW_BAR = 4096;
constexpr int CW_CNT = 8192, CW_CUR = 8256;

constexpr int LDS_BYTES = 155648;
constexpr int MISC_OFF = 147456;
constexpr int NWAVES = 8;

typedef __bf16 bf2_t __attribute__((ext_vector_type(2)));
__device__ __forceinline__ unsigned pk2(float lo, float hi) { bf2_t v; v.x = (__bf16)lo; v.y = (__bf16)hi; return __builtin_bit_cast(unsigned, v); }
__device__ __forceinline__ unsigned f2bf(float f) { return (unsigned)__builtin_bit_cast(unsigned short, (__bf16)f); }
__device__ __forceinline__ unsigned pk4_fp8(float a, float b, float c, float d) { int w = 0; w = __builtin_amdgcn_cvt_pk_fp8_f32(a, b, w, false); w = __builtin_amdgcn_cvt_pk_fp8_f32(c, d, w, true); return (unsigned)w; }
__device__ __forceinline__ float bf2f(unsigned short b) { return __builtin_bit_cast(float, ((unsigned)b) << 16); }
__device__ __forceinline__ float bflo(unsigned w) { return __builtin_bit_cast(float, w << 16); }
__device__ __forceinline__ float bfhi(unsigned w) { return __builtin_bit_cast(float, w & 0xffff0000u); }
__device__ __forceinline__ float sigmoidf_(float x) { return __builtin_amdgcn_rcpf(1.0f + __expf(-x)); }
__device__ __forceinline__ float siluf_(float x) { return x * sigmoidf_(x); }
__device__ __forceinline__ float gelu_tanh(float x) { const float y = 0.7978845608028654f * (x + 0.044715f * x * x * x); const float e = __expf(2.0f * y); const float th = 1.0f - 2.0f * __builtin_amdgcn_rcpf(e + 1.0f); return 0.5f * x * (1.0f + th); }
__device__ __forceinline__ float wave_sum(float v) {
    v += __builtin_bit_cast(float, __builtin_amdgcn_mov_dpp(__builtin_bit_cast(int, v), 0xB1, 0xf, 0xf, true));
    v += __builtin_bit_cast(float, __builtin_amdgcn_mov_dpp(__builtin_bit_cast(int, v), 0x4E, 0xf, 0xf, true));
    v += __builtin_bit_cast(float, __builtin_amdgcn_mov_dpp(__builtin_bit_cast(int, v), 0x141, 0xf, 0xf, true));
    v += __builtin_bit_cast(float, __builtin_amdgcn_mov_dpp(__builtin_bit_cast(int, v), 0x140, 0xf, 0xf, true));
    v += __builtin_bit_cast(float, __builtin_amdgcn_ds_swizzle(__builtin_bit_cast(int, v), 0x401F));
    const unsigned u = __builtin_bit_cast(unsigned, v); const auto r = __builtin_amdgcn_permlane32_swap(u, u, false, false);
    return __builtin_bit_cast(float, (unsigned)r[0]) + __builtin_bit_cast(float, (unsigned)r[1]);
}
__device__ __forceinline__ float lane_bcast(float v, int k) { return __builtin_bit_cast(float, __builtin_amdgcn_readlane(__builtin_bit_cast(int, v), k)); }
#define LDS_WAIT() asm volatile("s_waitcnt lgkmcnt(0)" ::: "memory")
#define VM_WAIT() asm volatile("s_waitcnt vmcnt(0)" ::: "memory")

namespace pg8 {
#define PG8_LAS __attribute__((address_space(3)))
constexpr int BM = 256, BK = 64, HALF = 128, HTB = HALF * BK * 2, STAGE_BYTES = 8 * HTB, NXCD = 8, WGM = 8;
__host__ __device__ __forceinline__ int lds_byte(int r, int c) { const int st = (r >> 4) * 2 + (c >> 5), rr = r & 15, cc = c & 31, ob = rr * 64 + cc * 2; return st * 1024 + (ob ^ (((ob >> 9) & 1) << 5)); }
__host__ __device__ __forceinline__ void stage_rc(int b, int& R, int& C) { const int st = b / 1024, sb = b % 1024, swz = sb ^ (((sb >> 9) & 1) << 5); R = (st >> 1) * 16 + swz / 64; C = (st & 1) * 32 + (swz % 64) / 2; }
__host__ __device__ __forceinline__ int perm32(int rho) { const int n = rho >> 4, i = rho & 15; return 8 * (i >> 2) + 4 * n + (i & 3); }

struct Unit { int pm, pn, seg, ex; const char* A; const char* B; };

struct Rect {
    int nM, nN, nwg, G, c;
    __device__ __forceinline__ void init(int nM_, int nN_, int G_, int c_) { nM = nM_; nN = nN_; nwg = nM * nN; G = G_; c = c_; }
    __device__ __forceinline__ bool map(int L, int& pm, int& pn) const {
        if (L >= nwg) return false;
        int wgid = L; { const int q = nwg / NXCD, r = nwg % NXCD, xcd = wgid % NXCD, off = wgid / NXCD; wgid = (xcd < r ? xcd * (q + 1) : r * (q + 1) + (xcd - r) * q) + off; }
        const int nig = WGM * nN, gid = wgid / nig, fm = gid * WGM, gsz = (nM - fm) < WGM ? (nM - fm) : WGM;
        pm = fm + ((wgid % nig) % gsz); pn = (wgid % nig) / gsz; return true;
    }
};

__device__ __forceinline__ unsigned cvt_pk_bf16(float lo, float hi) { return pk2(lo, hi); }

typedef int v8i_t __attribute__((ext_vector_type(8)));
typedef int v4i_t __attribute__((ext_vector_type(4)));
__device__ __forceinline__ v8i_t cat8(const bf16x8 a, const bf16x8 b) { return __builtin_shufflevector(__builtin_bit_cast(v4i_t, a), __builtin_bit_cast(v4i_t, b), 0, 1, 2, 3, 4, 5, 6, 7); }
__device__ __forceinline__ bf16x8 lo8(const v8i_t v) { return __builtin_bit_cast(bf16x8, __builtin_shufflevector(v, v, 0, 1, 2, 3)); }
__device__ __forceinline__ bf16x8 hi8(const v8i_t v) { return __builtin_bit_cast(bf16x8, __builtin_shufflevector(v, v, 4, 5, 6, 7)); }
template <class E, class = void> struct epi_chain { static constexpr bool value = false; };
template <class E> struct epi_chain<E, decltype((void)E::CHAIN)> { static constexpr bool value = E::CHAIN; };
template <class Epi, class Sched, bool F8 = false, bool ALIGN_EPI = true, bool SP2 = true>
__device__ __forceinline__ void gemm_phase(PG8_LAS unsigned char* lds, const int tid, const int KB, const Sched& S, const Epi& E, unsigned long long* tm = nullptr) {
    const int wid = __builtin_amdgcn_readfirstlane(tid >> 6), lane = tid & 63, wr = wid >> 2, wc = wid & 3, fr = lane & 15, fq = lane >> 4;
    const int nt = KB / (BK * 2);
    unsigned voffA[2], voffB[2];
#pragma unroll
    for (int i = 0; i < 2; ++i) { int R, C; stage_rc(tid * 16 + i * 8192, R, C); const int Rb = Epi::PERM ? ((R & ~31) + perm32(R & 31)) : R;
        voffA[i] = (unsigned)(R * KB + C * 2); voffB[i] = (unsigned)(Rb * KB + C * 2); }
    const size_t kstep = (size_t)(BK * 2);
    const size_t hstep = (size_t)HALF * KB;
    const unsigned ldsw = (unsigned)wid * 1024u;
    const int aoff = lds_byte(wr * 64 + fr, fq * 8), boff = lds_byte(wc * 32 + fr, fq * 8);
    constexpr int KOFF = 1024;
#define PG8_SA(b, h) (((b) * 2 + (h)) * HTB)
#define PG8_SB(b, h) ((4 + (b) * 2 + (h)) * HTB)
#define PG8_STAGE(bufoff, gbase, voff) do { _Pragma("unroll") for (int _i = 0; _i < 2; ++_i) \
        __builtin_amdgcn_global_load_lds((const unsigned*)((const char*)(gbase) + (voff)[_i]), (PG8_LAS unsigned*)(lds + (bufoff) + ldsw + _i * 8192), 16, 0, 0); } while (0)
#define PG8_LDA(dst, b, h) do { _Pragma("unroll") for (int m = 0; m < 4; ++m) dst[m] = cat8(*(const PG8_LAS bf16x8*)(lds + PG8_SA(b, h) + aoff + m * 2048), *(const PG8_LAS bf16x8*)(lds + PG8_SA(b, h) + aoff + m * 2048 + KOFF)); } while (0)
#define PG8_LDB(dst, b, h) do { _Pragma("unroll") for (int n = 0; n < 2; ++n) dst[n] = cat8(*(const PG8_LAS bf16x8*)(lds + PG8_SB(b, h) + boff + n * 2048), *(const PG8_LAS bf16x8*)(lds + PG8_SB(b, h) + boff + n * 2048 + KOFF)); } while (0)
#define PG8_MMA(ai, bj, At, Bt) do { __builtin_amdgcn_s_setprio(1); _Pragma("unroll") for (int m = 0; m < 4; ++m) _Pragma("unroll") for (int n = 0; n < 2; ++n) { \
        if constexpr (F8) asm volatile("v_mfma_scale_f32_16x16x128_f8f6f4 %0, %1, %2, %0, %3, %3 op_sel_hi:[0,0,0]" : "+v"(acc[ai][bj][m][n]) : "v"(Bt[n]), "v"(At[m]), "v"(sc1)); \
        else { acc[ai][bj][m][n] = __builtin_amdgcn_mfma_f32_16x16x32_bf16(lo8(Bt[n]), lo8(At[m]), acc[ai][bj][m][n], 0, 0, 0); \
               acc[ai][bj][m][n] = __builtin_amdgcn_mfma_f32_16x16x32_bf16(hi8(Bt[n]), hi8(At[m]), acc[ai][bj][m][n], 0, 0, 0); } } \
        __builtin_amdgcn_s_setprio(0); } while (0)
#define PG8_WAIT_V(n) asm volatile("s_waitcnt vmcnt(" #n ")" ::: "memory")
#define PG8_WAIT_L(n) asm volatile("s_waitcnt lgkmcnt(" #n ")" ::: "memory")
#define PG8_BAR __builtin_amdgcn_s_barrier()
#define PG8_SCHED __builtin_amdgcn_sched_barrier(0)
    const int sc1 = 0x7f7f7f7f;
    Unit cur, nxt; int ui = 0;
    if (!S.next(0, cur)) return;
    f32x4 acc[2][2][4][2];
#pragma unroll
    for (int a = 0; a < 2; ++a)
#pragma unroll
        for (int b = 0; b < 2; ++b)
#pragma unroll
            for (int m = 0; m < 4; ++m)
#pragma unroll
                for (int n = 0; n < 2; ++n) acc[a][b][m][n] = (f32x4){0.f, 0.f, 0.f, 0.f};
    v8i_t At[4], B0[2], B1[2];
    const char* cA = cur.A; const char* cB = cur.B;
    if constexpr (SP2) {
        PG8_STAGE(PG8_SB(0, 0), cB, voffB); PG8_STAGE(PG8_SB(0, 1), cB + hstep, voffB); PG8_STAGE(PG8_SA(0, 0), cA, voffA); PG8_STAGE(PG8_SA(0, 1), cA + hstep, voffA);
        if (wr == 1) PG8_BAR;
        PG8_WAIT_V(2); PG8_BAR;
        PG8_STAGE(PG8_SB(1, 0), cB + kstep, voffB); PG8_STAGE(PG8_SA(1, 0), cA + kstep, voffA); PG8_STAGE(PG8_SB(1, 1), cB + hstep + kstep, voffB);
        PG8_WAIT_V(6); PG8_BAR;
    } else {
        PG8_STAGE(PG8_SB(0, 0), cB, voffB); PG8_STAGE(PG8_SA(0, 0), cA, voffA); PG8_STAGE(PG8_SB(0, 1), cB + hstep, voffB); PG8_STAGE(PG8_SA(0, 1), cA + hstep, voffA);
        if (wr == 1) PG8_BAR;
        PG8_WAIT_V(4); PG8_BAR;
        PG8_STAGE(PG8_SB(1, 0), cB + kstep, voffB); PG8_STAGE(PG8_SA(1, 0), cA + kstep, voffA); PG8_STAGE(PG8_SB(1, 1), cB + hstep + kstep, voffB);
        PG8_WAIT_V(6); PG8_BAR;
    }
    for (;;) {
        const bool has_next = S.next(ui + 1, nxt);
        const char* nA = has_next ? nxt.A : cA; const char* nB = has_next ? nxt.B : cB;
        unsigned long long tk0_ = 0; if ((DBG_TMASK & 0x800000u) && tm) tk0_ = wall_clock64();
#pragma unroll 1
        for (int t = 0; t < nt; t += 2) {
            const bool last = (t == nt - 2);
            const char* a1 = cA + (size_t)(t + 1) * kstep;
            const char* a2 = last ? nA : cA + (size_t)(t + 2) * kstep; const char* b2 = last ? nB : cB + (size_t)(t + 2) * kstep;
            const char* a3 = a2 + kstep; const char* b3 = b2 + kstep;
            if constexpr (SP2) {
            PG8_LDB(B0, 0, 0); PG8_LDB(B1, 0, 1); PG8_SCHED; PG8_LDA(At, 0, 0); PG8_STAGE(PG8_SA(1, 1), a1 + hstep, voffA);
            PG8_WAIT_V(8); PG8_WAIT_L(0); PG8_BAR; PG8_MMA(0, 0, At, B0); PG8_MMA(0, 1, At, B1); PG8_BAR; PG8_SCHED;
            PG8_LDA(At, 0, 1); PG8_STAGE(PG8_SB(0, 0), b2, voffB); PG8_STAGE(PG8_SB(0, 1), b2 + hstep, voffB); PG8_STAGE(PG8_SA(0, 0), a2, voffA);
            PG8_WAIT_V(8); PG8_WAIT_L(0); PG8_BAR; PG8_MMA(1, 0, At, B0); PG8_MMA(1, 1, At, B1); PG8_BAR; PG8_SCHED;
            PG8_LDB(B0, 1, 0); PG8_LDB(B1, 1, 1); PG8_SCHED; PG8_LDA(At, 1, 0); PG8_STAGE(PG8_SA(0, 1), a2 + hstep, voffA);
            PG8_WAIT_V(8); PG8_WAIT_L(0); PG8_BAR; PG8_MMA(0, 0, At, B0); PG8_MMA(0, 1, At, B1); PG8_BAR; PG8_SCHED;
            PG8_LDA(At, 1, 1); PG8_STAGE(PG8_SB(1, 0), b3, voffB); PG8_STAGE(PG8_SB(1, 1), b3 + hstep, voffB); PG8_STAGE(PG8_SA(1, 0), a3, voffA);
            PG8_WAIT_V(8); PG8_WAIT_L(0); PG8_BAR; PG8_MMA(1, 0, At, B0); PG8_MMA(1, 1, At, B1); PG8_BAR; PG8_SCHED;
            } else {
            PG8_LDB(B0, 0, 0); PG8_SCHED; PG8_LDA(At, 0, 0); PG8_STAGE(PG8_SA(1, 1), a1 + hstep, voffA);
            PG8_WAIT_L(8); PG8_BAR; PG8_WAIT_L(0); PG8_MMA(0, 0, At, B0); PG8_BAR; PG8_SCHED;
            PG8_LDB(B1, 0, 1); PG8_STAGE(PG8_SB(0, 0), b2, voffB);
            PG8_BAR; PG8_WAIT_L(0); PG8_MMA(0, 1, At, B1); PG8_BAR;
            PG8_LDA(At, 0, 1); PG8_STAGE(PG8_SA(0, 0), a2, voffA);
            PG8_BAR; PG8_WAIT_L(0); PG8_MMA(1, 0, At, B0); PG8_BAR; PG8_SCHED;
            PG8_STAGE(PG8_SB(0, 1), b2 + hstep, voffB);
            PG8_WAIT_V(6); PG8_BAR; PG8_MMA(1, 1, At, B1); PG8_BAR;
            PG8_LDB(B0, 1, 0); PG8_SCHED; PG8_LDA(At, 1, 0); PG8_STAGE(PG8_SA(0, 1), a2 + hstep, voffA);
            PG8_WAIT_L(8); PG8_BAR; PG8_WAIT_L(0); PG8_MMA(0, 0, At, B0); PG8_BAR; PG8_SCHED;
            PG8_LDB(B1, 1, 1); PG8_STAGE(PG8_SB(1, 0), b3, voffB);
            PG8_BAR; PG8_WAIT_L(0); PG8_MMA(0, 1, At, B1); PG8_BAR;
            PG8_LDA(At, 1, 1); PG8_STAGE(PG8_SA(1, 0), a3, voffA);
            PG8_BAR; PG8_WAIT_L(0); PG8_MMA(1, 0, At, B0); PG8_BAR; PG8_SCHED;
            PG8_STAGE(PG8_SB(1, 1), b3 + hstep, voffB);
            PG8_WAIT_V(6); PG8_BAR; PG8_MMA(1, 1, At, B1); PG8_BAR;
            }
        }
        if ((DBG_TMASK & 0x800000u) && tm) *tm += wall_clock64() - tk0_;
        if constexpr (F8) asm volatile("s_nop 15\n\ts_nop 15" ::: "memory");
        if constexpr (ALIGN_EPI) { if (wr == 0) PG8_BAR; }
        bool chained = false;
        if constexpr (epi_chain<Epi>::value) chained = cur.seg < 2;
        if constexpr (epi_chain<Epi>::value) { if (chained) E.mid(acc, cur, wr, wc, fr, fq); else E(acc, cur, wr, wc, fr, fq); }
        else {
        if ((DBG_TMASK & 0x400000u) && tm) { const unsigned long long t0_ = wall_clock64(); E(acc, cur, wr, wc, fr, fq); asm volatile("s_waitcnt vmcnt(0)" ::: "memory"); *tm += wall_clock64() - t0_; }
        else E(acc, cur, wr, wc, fr, fq);
        }
        if (!has_next) break;
#pragma unroll
        for (int a = 0; a < 2; ++a)
#pragma unroll
            for (int b = 0; b < 2; ++b)
#pragma unroll
                for (int m = 0; m < 4; ++m)
#pragma unroll
                    for (int n = 0; n < 2; ++n)
#pragma unroll
                        for (int j = 0; j < 4; ++j) acc[a][b][m][n][j] = chained ? acc[a][b][m][n][j] : 0.f;
        cur = nxt; cA = nA; cB = nB; ++ui;
        if constexpr (ALIGN_EPI) { if (wr == 1) PG8_BAR; }
    }
    PG8_WAIT_V(0);
    if constexpr (!ALIGN_EPI) { if (wr == 0) PG8_BAR; }
    PG8_BAR;
#undef PG8_SA
#undef PG8_SB
#undef PG8_STAGE
#undef PG8_LDA
#undef PG8_LDB
#undef PG8_MMA
#undef PG8_WAIT_V
#undef PG8_WAIT_L
#undef PG8_BAR
#undef PG8_SCHED
}
}
using pg8::Unit;

#define XB_TMO      128
#define XB_XCNT(j)  (256  + 64 * (j))
#define XB_XSUB(j)  (1280 + 64 * (j))
#define XB_XGEN(j)  (2304 + 64 * (j))
#define XB_TOP      3328
#define XB_TOPGEN   3392
#define XCD_BAR_WORDS 3456
#define XB_SPIN_CAP (1u << 18)
__device__ __forceinline__ unsigned xb_ld(unsigned* p)              { return __hip_atomic_load(p, __ATOMIC_RELAXED, __HIP_MEMORY_SCOPE_AGENT); }
__device__ __forceinline__ unsigned xb_add(unsigned* p, unsigned v) { return __hip_atomic_fetch_add(p, v, __ATOMIC_RELAXED, __HIP_MEMORY_SCOPE_AGENT); }
__device__ __forceinline__ unsigned xb_xcc_id() { return (unsigned)__builtin_amdgcn_s_getreg((3 << 11) | 20) & 0xFu; }
#define XB_SPIN(cond, bar) do { unsigned _sp = 0; while (cond) { __builtin_amdgcn_s_sleep(1); \
    if ((++_sp & 255u) == 0u) { if (xb_ld(&(bar)[XB_TMO])) break; if (_sp > XB_SPIN_CAP) { atomicAdd(&(bar)[XB_TMO], 1u); break; } } } } while (0)
struct XcdBarrier { unsigned* bar; unsigned x; volatile LAS unsigned* st; };
__device__ __forceinline__ XcdBarrier xcd_barrier_post(unsigned* bar, volatile LAS unsigned* st) {
    XcdBarrier b; b.bar = bar; b.x = xb_xcc_id(); b.st = st;
    if (threadIdx.x == 0) (void)xb_add(&bar[XB_XCNT(b.x)], 1u);
    return b;
}
__device__ __forceinline__ void xcd_barrier_complete(unsigned* bar, unsigned x, unsigned& nloc, unsigned& nx) {
    const unsigned G = gridDim.x * gridDim.y * gridDim.z;
    unsigned sum, cnt, mine, sp = 0u;
    for (;;) {
        sum = 0u; cnt = 0u; mine = 0u;
#pragma unroll
        for (unsigned j = 0; j < 16; ++j) { const unsigned c = xb_ld(&bar[XB_XCNT(j)]); sum += c; cnt += (c > 0u) ? 1u : 0u; mine = (j == x) ? c : mine; }
        if (sum == G) break;
        __builtin_amdgcn_s_sleep(1);
        if ((++sp & 255u) == 0u) { if (xb_ld(&bar[XB_TMO])) break; if (sp > XB_SPIN_CAP) { atomicAdd(&bar[XB_TMO], 1u); break; } }
    }
    nloc = mine > 0u ? mine : 1u; nx = cnt > 0u ? cnt : 1u;
}
__device__ __forceinline__ void xcd_barrier(const XcdBarrier& b, const int wave_s) {
    asm volatile("s_waitcnt vmcnt(0)" ::: "memory");
    __syncthreads();
    if (wave_s == 0 && __builtin_amdgcn_mbcnt_hi(~0u, __builtin_amdgcn_mbcnt_lo(~0u, 0u)) == 0u) {
        unsigned* bar = b.bar; asm volatile("" : "+v"(bar));
        __builtin_amdgcn_s_waitcnt(0);
        unsigned nloc = b.st[0], nx = b.st[1];
        if (nloc == 0u) { xcd_barrier_complete(bar, b.x, nloc, nx); b.st[0] = nloc; b.st[1] = nx; }
        const unsigned old = xb_add(&bar[XB_XSUB(b.x)], 1u);
        const unsigned gen = old / nloc;
        if (old + 1u == (gen + 1u) * nloc) {
            __builtin_amdgcn_fence(__ATOMIC_RELEASE, "agent");
            asm volatile("s_waitcnt vmcnt(0)" ::: "memory");
            const unsigned og = xb_add(&bar[XB_TOP], 1u);
            const unsigned tg = og / nx;
            if (og + 1u == (tg + 1u) * nx) xb_add(&bar[XB_TOPGEN], 1u);
            else XB_SPIN(xb_ld(&bar[XB_TOPGEN]) == tg, bar);
            __builtin_amdgcn_fence(__ATOMIC_ACQUIRE, "agent");
            xb_add(&bar[XB_XGEN(b.x)], 1u);
            asm volatile("s_waitcnt vmcnt(0)" ::: "memory");
        } else {
            XB_SPIN(xb_ld(&bar[XB_XGEN(b.x)]) == gen, bar);
            __builtin_amdgcn_fence(__ATOMIC_ACQUIRE, "agent");
            asm volatile("s_waitcnt vmcnt(0)" ::: "memory");
        }
    }
    __syncthreads();
}

struct Args { const float* in[N_IN]; float* out; unsigned char* ws; int ph_lo, ph_hi; };

struct Frame {
    LAS unsigned char* lds;
    int tid, lane, wave, vcu, G;
    const float* const* in; float* out; unsigned char* ws;
};

__device__ __forceinline__ const float* inp(const Frame& F, int k) { const GAS float* p = (const GAS float*)F.in[k]; asm volatile("" : "+s"(p)); return (const float*)p; }

struct SchedPlain {
    pg8::Rect R; const char* A; const char* B; size_t tsA, tsB; int xM, xN0, xNn;
    __device__ __forceinline__ bool next(int i, Unit& u) const {
        const int L = i * R.G + R.c;
        if (R.map(L, u.pm, u.pn)) {} else { const int e = L - R.nwg; if (e >= xM * xNn) return false; u.pm = R.nM + e / xNn; u.pn = xN0 + e % xNn; }
        u.seg = 0; u.ex = 0; u.A = A + (size_t)u.pm * tsA; u.B = B + (size_t)u.pn * tsB; return true;
    }
};
struct SchedMerge {
    pg8::Rect R; const char* A; const char* B; size_t tsA, tsB, sA, sB;
    __device__ __forceinline__ bool next(int i, Unit& u) const {
        const int ti = i / 3, sg = i - 3 * ti; const int L = ti * R.G + R.c;
        if (!R.map(L, u.pm, u.pn)) return false;
        u.seg = sg; u.ex = 0;
        u.A = A + (size_t)sg * sA + (size_t)u.pm * tsA; u.B = B + (size_t)sg * sB + (size_t)u.pn * tsB; return true;
    }
};
struct SchedMoe {
    pg8::Rect R; const char* A; const char* B; size_t tsA, tsB, esB; const int* tile_e; int tile0; bool a_global; unsigned epack;
    __device__ __forceinline__ bool next(int i, Unit& u) const {
        const int L = i * R.G + R.c;
        if (!R.map(L, u.pm, u.pn)) return false;
        const int gt = tile0 + u.pm; u.ex = gt; u.seg = 0; const int e = i < 10 ? (int)((epack >> (3 * i)) & 7u) : tile_e[gt];
        u.A = A + (size_t)(a_global ? gt : u.pm) * tsA; u.B = B + (size_t)e * esB + (size_t)u.pn * tsB; return true;
    }
    __device__ __forceinline__ void preload() {
        int ev[10];
#pragma unroll
        for (int i = 0; i < 10; ++i) { int pm, pn; const bool ok = R.map(i * R.G + R.c, pm, pn); ev[i] = tile_e[ok ? tile0 + pm : 0]; }
        unsigned w = 0u;
#pragma unroll
        for (int i = 0; i < 10; ++i) w |= ((unsigned)ev[i] & 7u) << (3 * i);
        epack = (unsigned)__builtin_amdgcn_readfirstlane((int)w);
    }
};

typedef const f32x4 (&AccRef)[2][2][4][2];
__device__ __forceinline__ v4u pack8(const f32x4 a, const f32x4 b) { v4u w; w.x = pg8::cvt_pk_bf16(a[0], a[1]); w.y = pg8::cvt_pk_bf16(a[2], a[3]); w.z = pg8::cvt_pk_bf16(b[0], b[1]); w.w = pg8::cvt_pk_bf16(b[2], b[3]); return w; }
__device__ __forceinline__ void unpack8(const v4u w, f32x4& a, f32x4& b) { a = (f32x4){bflo(w.x), bfhi(w.x), bflo(w.y), bfhi(w.y)}; b = (f32x4){bflo(w.z), bfhi(w.z), bflo(w.w), bfhi(w.w)}; }

struct EpiInproj {
    static constexpr bool PERM = true;
    bf16* phyT; bf16* ucf; bf16* ps5; int pn0;
    __device__ __forceinline__ void operator()(AccRef acc, const Unit& u0, int wr, int wc, int fr, int fq) const {
        Unit u = u0; u.pn += pn0;
        const int row0 = u.pm * 256 + wr * 64 + fr;
        if (u.pn < 6) {
#pragma unroll
            for (int ai = 0; ai < 2; ++ai)
#pragma unroll
                for (int m = 0; m < 4; ++m) { const int r = row0 + ai * 128 + m * 16;
#pragma unroll
                    for (int bj = 0; bj < 2; ++bj)
#pragma unroll
                        for (int n = 0; n < 2; ++n)
#pragma unroll
                            for (int j = 0; j < 4; ++j) { const int c = u.pn * 256 + bj * 128 + wc * 32 + 8 * fq + 4 * n + j; phyT[(size_t)c * RT + r] = (bf16)f2bf(acc[ai][bj][m][n][j]); } }
        } else if (u.pn < 10) {
            const int col0 = (u.pn - 6) * 128 + wc * 32 + 8 * fq;
#pragma unroll
            for (int ai = 0; ai < 2; ++ai)
#pragma unroll
                for (int m = 0; m < 4; ++m) { const int r = row0 + ai * 128 + m * 16; f32x4 o[2];
#pragma unroll
                    for (int n = 0; n < 2; ++n)
#pragma unroll
                        for (int j = 0; j < 4; ++j) o[n][j] = acc[ai][0][m][n][j] * sigmoidf_(acc[ai][1][m][n][j]);
                    *(v4u*)(ucf + (size_t)r * 512 + col0) = pack8(o[0], o[1]); }
        } else {
#pragma unroll
            for (int ai = 0; ai < 2; ++ai)
#pragma unroll
                for (int m = 0; m < 4; ++m) { const int r = row0 + ai * 128 + m * 16;
#pragma unroll
                    for (int bj = 0; bj < 2; ++bj) { const int col0 = (u.pn - 10) * 256 + bj * 128 + wc * 32 + 8 * fq; *(v4u*)(ps5 + (size_t)r * 512 + col0) = pack8(acc[ai][bj][m][0], acc[ai][bj][m][1]); } }
        }
    }
};
struct EpiHyT {
    static constexpr bool PERM = true;
    bf16* phyT;
    __device__ __forceinline__ void operator()(AccRef acc, const Unit& u, int wr, int wc, int fr, int fq) const {
        const int ch0 = u.pm * 256 + wr * 64 + fr, tok0 = u.pn * 256 + wc * 32 + 8 * fq;
#pragma unroll
        for (int ai = 0; ai < 2; ++ai)
#pragma unroll
            for (int m = 0; m < 4; ++m)
#pragma unroll
                for (int bj = 0; bj < 2; ++bj) *(v4u*)(phyT + (size_t)(ch0 + ai * 128 + m * 16) * RT + tok0 + bj * 128) = pack8(acc[ai][bj][m][0], acc[ai][bj][m][1]);
    }
};
struct EpiGates {
    static constexpr bool PERM = true;
    bf16* O; int tid;
    __device__ __forceinline__ void operator()(AccRef acc, const Unit& u, int wr, int wc, int fr, int fq) const {
        v4u* T = (v4u*)O + ((size_t)u.pm * 12 + u.pn) * 8192 + tid;
#pragma unroll
        for (int ai = 0; ai < 2; ++ai)
#pragma unroll
            for (int m = 0; m < 4; ++m)
#pragma unroll
                for (int bj = 0; bj < 2; ++bj) { f32x4 o[2];
#pragma unroll
                    for (int n = 0; n < 2; ++n)
#pragma unroll
                        for (int j = 0; j < 4; ++j) o[n][j] = sigmoidf_(acc[ai][bj][m][n][j]);
                    T[((ai * 4 + m) * 2 + bj) * 512] = pack8(o[0], o[1]); }
    }
};
struct EpiGlu {
    static constexpr bool PERM = true;
    const bf16* SG; bf16* O; const float* bglu;
    __device__ __forceinline__ void operator()(AccRef acc, const Unit& u, int wr, int wc, int fr, int fq) const {
        const int row0 = u.pm * 256 + wr * 64 + fr;
#pragma unroll
        for (int bj = 0; bj < 2; ++bj) { const int col0 = u.pn * 256 + bj * 128 + wc * 32 + 8 * fq;
            const f32x4 b0 = *(const f32x4*)(bglu + col0), b1 = *(const f32x4*)(bglu + col0 + 4);
            v4u gw[2][4];
#pragma unroll
            for (int ai = 0; ai < 2; ++ai)
#pragma unroll
                for (int m = 0; m < 4; ++m) gw[ai][m] = *(const v4u*)(SG + (size_t)(row0 + ai * 128 + m * 16) * 512 + col0);
#pragma unroll
            for (int ai = 0; ai < 2; ++ai)
#pragma unroll
                for (int m = 0; m < 4; ++m) { const int r = row0 + ai * 128 + m * 16;
                    f32x4 g0, g1; unpack8(gw[ai][m], g0, g1); f32x4 o0, o1;
#pragma unroll
                    for (int j = 0; j < 4; ++j) { o0[j] = g0[j] * sigmoidf_(acc[ai][bj][m][0][j] + b0[j]); o1[j] = g1[j] * sigmoidf_(acc[ai][bj][m][1][j] + b1[j]); }
                    *(v4u*)(O + (size_t)r * 512 + col0) = pack8(o0, o1); } }
    }
};
struct EpiMerge {
    static constexpr bool PERM = true, CHAIN = true;
    const bf16* GT; bf16* O; int tid;
    typedef f32x4 (&AccMut)[2][2][4][2];
    __device__ __forceinline__ void mid(AccMut acc, const Unit& u, int wr, int wc, int fr, int fq) const {
        const v4u* T0 = (const v4u*)GT + ((size_t)u.pm * 12 + u.seg * 4 + u.pn) * 8192 + tid; const v4u* T1 = T0 + 4 * 8192;
#pragma unroll
        for (int ai = 0; ai < 2; ++ai)
#pragma unroll
            for (int bj = 0; bj < 2; ++bj) { v4u ga[4], gb[4];
#pragma unroll
                for (int m = 0; m < 4; ++m) { ga[m] = T0[((ai * 4 + m) * 2 + bj) * 512]; gb[m] = T1[((ai * 4 + m) * 2 + bj) * 512]; }
#pragma unroll
                for (int m = 0; m < 4; ++m) { f32x4 a0, a1, b0, b1; unpack8(ga[m], a0, a1); unpack8(gb[m], b0, b1);
#pragma unroll
                    for (int j = 0; j < 4; ++j) { acc[ai][bj][m][0][j] *= fmaxf(a0[j], 1e-30f) * __builtin_amdgcn_rcpf(fmaxf(b0[j], 1e-30f)); acc[ai][bj][m][1][j] *= fmaxf(a1[j], 1e-30f) * __builtin_amdgcn_rcpf(fmaxf(b1[j], 1e-30f)); } }
                asm volatile("" ::: "memory"); }
    }
    __device__ __forceinline__ void operator()(AccRef acc, const Unit& u, int wr, int wc, int fr, int fq) const {
        const int row0 = u.pm * 256 + wr * 64 + fr, col0 = u.pn * 256 + wc * 32 + 8 * fq;
        const v4u* T = (const v4u*)GT + ((size_t)u.pm * 12 + u.seg * 4 + u.pn) * 8192 + tid;
#pragma unroll
        for (int ai = 0; ai < 2; ++ai) { v4u gw[4][2];
#pragma unroll
            for (int m = 0; m < 4; ++m)
#pragma unroll
                for (int bj = 0; bj < 2; ++bj) gw[m][bj] = T[((ai * 4 + m) * 2 + bj) * 512];
#pragma unroll
            for (int m = 0; m < 4; ++m)
#pragma unroll
                for (int bj = 0; bj < 2; ++bj) { f32x4 g0, g1; unpack8(gw[m][bj], g0, g1);
#pragma unroll
                    for (int j = 0; j < 4; ++j) { g0[j] = fmaxf(g0[j], 1e-30f); g1[j] = fmaxf(g1[j], 1e-30f); }
                    *(v4u*)(O + (size_t)(row0 + ai * 128 + m * 16) * 1024 + col0 + bj * 128) = pack8(g0 * acc[ai][bj][m][0], g1 * acc[ai][bj][m][1]); } }
    }
};
struct EpiRes {
    static constexpr bool PERM = true;
    const float* xl; const float* xc; bf16* R; const float* gbase; float sc;
    __device__ __forceinline__ void operator()(AccRef acc, const Unit& u, int wr, int wc, int fr, int fq) const {
        const bool isl = u.pm < (NX / 256);
        const int prow = isl ? u.pm * 256 : (u.pm - NX / 256) * 256; const int mi = isl ? (u.pm >> 3) : 16;
        const float* xs = isl ? xl : xc; const float* gv = gbase + (size_t)mi * INC;
        const int row0 = prow + wr * 64 + fr, grow0 = u.pm * 256 + wr * 64 + fr, col0 = u.pn * 256 + wc * 32 + 8 * fq;
#pragma unroll
        for (int bj = 0; bj < 2; ++bj) { const int c = col0 + bj * 128; const f32x4 g0 = *(const f32x4*)(gv + c) * sc, g1 = *(const f32x4*)(gv + c + 4) * sc;
#pragma unroll
            for (int ai = 0; ai < 2; ++ai) { f32x4 xr[4][2];
#pragma unroll
                for (int m = 0; m < 4; ++m) { const float* xp = xs + (size_t)(row0 + ai * 128 + m * 16) * 1024 + c; xr[m][0] = *(const f32x4*)xp; xr[m][1] = *(const f32x4*)(xp + 4); }
#pragma unroll
                for (int m = 0; m < 4; ++m) *(v4u*)(R + (size_t)(grow0 + ai * 128 + m * 16) * 1024 + c) = pack8(xr[m][0] * ALPHA_F + g0 * acc[ai][bj][m][0], xr[m][1] * ALPHA_F + g1 * acc[ai][bj][m][1]); } }
    }
};
struct EpiSwiglu {
    static constexpr bool PERM = true;
    bf16* O; int ldc;
    __device__ __forceinline__ void operator()(AccRef acc, const Unit& u, int wr, int wc, int fr, int fq) const {
        const int row0 = u.pm * 256 + wr * 64 + fr, col0 = u.pn * 128 + wc * 32 + 8 * fq;
#pragma unroll
        for (int ai = 0; ai < 2; ++ai)
#pragma unroll
            for (int m = 0; m < 4; ++m) { const int r = row0 + ai * 128 + m * 16; f32x4 o[2];
#pragma unroll
                for (int n = 0; n < 2; ++n)
#pragma unroll
                    for (int j = 0; j < 4; ++j) o[n][j] = siluf_(acc[ai][0][m][n][j]) * acc[ai][1][m][n][j];
                *(v4u*)(O + (size_t)r * ldc + col0) = pack8(o[0], o[1]); }
    }
};
struct EpiSwigluF8 {
    static constexpr bool PERM = true;
    unsigned char* O; int ldc; float sc;
    __device__ __forceinline__ void operator()(AccRef acc, const Unit& u, int wr, int wc, int fr, int fq) const {
        const int row0 = u.pm * 256 + wr * 64 + fr, col0 = u.pn * 128 + wc * 32 + 8 * fq;
#pragma unroll
        for (int ai = 0; ai < 2; ++ai)
#pragma unroll
            for (int m = 0; m < 4; ++m) { const int r = row0 + ai * 128 + m * 16; f32x4 o[2];
#pragma unroll
                for (int n = 0; n < 2; ++n) {
                    const f32x4 a = acc[ai][0][m][n], t = a * (-1.4426950408889634f * sc), p = (a * acc[ai][1][m][n]) * (sc * sc);
                    f32x4 e; e[0] = __builtin_amdgcn_exp2f(t[0]); e[1] = __builtin_amdgcn_exp2f(t[1]); e[2] = __builtin_amdgcn_exp2f(t[2]); e[3] = __builtin_amdgcn_exp2f(t[3]);
                    const f32x4 d = e + 1.0f;
                    f32x4 rc; rc[0] = __builtin_amdgcn_rcpf(d[0]); rc[1] = __builtin_amdgcn_rcpf(d[1]); rc[2] = __builtin_amdgcn_rcpf(d[2]); rc[3] = __builtin_amdgcn_rcpf(d[3]);
                    o[n] = p * rc; }
                v2u w; w.x = pk4_fp8(o[0][0], o[0][1], o[0][2], o[0][3]); w.y = pk4_fp8(o[1][0], o[1][1], o[1][2], o[1][3]);
                *(v2u*)(O + (size_t)r * ldc + col0) = w; }
    }
};
struct EpiMoeDown {
    static constexpr bool PERM = true;
    bf16* O; float sc;
    __device__ __forceinline__ void operator()(AccRef acc, const Unit& u, int wr, int wc, int fr, int fq) const {
        const int row0 = u.ex * 256 + wr * 64 + fr;
#pragma unroll
        for (int ai = 0; ai < 2; ++ai)
#pragma unroll
            for (int m = 0; m < 4; ++m) { const int r = row0 + ai * 128 + m * 16;
#pragma unroll
                for (int bj = 0; bj < 2; ++bj) { const int col0 = u.pn * 256 + bj * 128 + wc * 32 + 8 * fq; *(v4u*)(O + (size_t)r * 1024 + col0) = pack8(acc[ai][bj][m][0] * sc, acc[ai][bj][m][1] * sc); } }
    }
};

template <bool F8>
__device__ __forceinline__ void transpose_item64(const float* W, int K, int N, unsigned char* WT, int dst_row0, int k0, int n0, float scale, LAS float* scr, int lane) {
#pragma unroll 4
    for (int i = 0; i < 16; ++i) { const int row = 4 * i + (lane >> 4), nc = 4 * (lane & 15);
        const f32x4 v = __builtin_nontemporal_load((const f32x4*)(W + (size_t)(k0 + row) * N + n0 + nc));     *(LAS f32x4*)(scr + row * 68 + nc) = v * scale; }
    LDS_WAIT(); asm volatile("" ::: "memory");
    const LAS float* sp = scr + lane;
    if constexpr (F8) {
        unsigned char* dst = WT + (size_t)(dst_row0 + lane) * K + k0;
#pragma unroll
        for (int c4 = 0; c4 < 4; ++c4) { v4u o;
#pragma unroll
            for (int e = 0; e < 4; ++e) { const int kk = 16 * c4 + 4 * e; o[e] = pk4_fp8(sp[(kk + 0) * 68], sp[(kk + 1) * 68], sp[(kk + 2) * 68], sp[(kk + 3) * 68]); }
            *(v4u*)(dst + 16 * c4) = o; }
    } else {
        unsigned char* dst = WT + ((size_t)(dst_row0 + lane) * K + k0) * 2;
#pragma unroll
        for (int c8 = 0; c8 < 8; ++c8) { v4u o;
#pragma unroll
            for (int e = 0; e < 4; ++e) { const int kk = 8 * c8 + 2 * e; o[e] = pk2(sp[kk * 68], sp[(kk + 1) * 68]); }
            *(v4u*)(dst + 16 * c8) = o; }
    }
    LDS_WAIT(); asm volatile("" ::: "memory");
}
__device__ __forceinline__ int dst_row_map(int kind, int n0) {
    if (kind == 1) { if (n0 >= 1536 && n0 < 2560) { const int i = (n0 - 1536) & 511, hi = (n0 - 1536) >> 9; return 1536 + 256 * (i >> 7) + 128 * hi + (i & 127); } return n0; }
    if (kind == 2) return 256 * (n0 >> 7) + (n0 & 127);
    if (kind == 3) return 256 * (n0 >> 7) + 128 + (n0 & 127);
    return n0;
}
__device__ __forceinline__ void conv_matrix_item(const float* W, int K, int N, bf16* WT, int kind, int item, LAS float* scr, int lane) {
    const int nblk = N / 64, kb = item / nblk, nb = item - kb * nblk;
    transpose_item64<false>(W, K, N, (unsigned char*)WT, dst_row_map(kind, 64 * nb), 64 * kb, 64 * nb, 1.0f, scr, lane);
}
__device__ __forceinline__ void conv_matrix_item_f8(const float* W, int K, int N, unsigned char* WT, int kind, int item, float scale, LAS float* scr, int lane) {
    const int nblk = N / 64, kb = item / nblk, nb = item - kb * nblk;
    transpose_item64<true>(W, K, N, WT, dst_row_map(kind, 64 * nb), 64 * kb, 64 * nb, scale, scr, lane);
}
__device__ __forceinline__ void p0a_prologue(Frame& F) {
    LAS float* scr = (LAS float*)(F.lds + F.wave * 17408);
    const int gw = F.wave * F.G + F.vcu  , NGW = F.G * NWAVES;
    bf16* ws_win = (bf16*)(F.ws + WS_WIN); bf16* ws_outs = (bf16*)(F.ws + WS_WOUTS); bf16* ws_glu = (bf16*)(F.ws + WS_WGLU); bf16* ws_wo = (bf16*)(F.ws + WS_WO);
    bf16* ws_w13 = (bf16*)(F.ws + WS_W13); bf16* ws_w2 = (bf16*)(F.ws + WS_W2);
    constexpr int I_IN = (1024 / 64) * (6144 / 64), I_OUT = (512 / 64) * (1024 / 64), I_GLU = (512 / 64) * (512 / 64), I_WOI = (1024 / 64) * (1024 / 64), I_F1 = (1024 / 64) * (2816 / 64), I_F2 = (2816 / 64) * (1024 / 64);
    constexpr int NITEMS = 2 * I_IN + 6 * I_OUT + 2 * I_GLU + 2 * I_WOI + 2 * I_F1 + I_F2;
    for (int it = gw; it < NITEMS; it += NGW) {
        int r = it;
        if (r < 2 * I_IN) { const int l = r / I_IN; conv_matrix_item(inp(F, I_WIN) + (size_t)l * 1024 * 6144, 1024, 6144, ws_win + (size_t)l * 6144 * 1024, 1, r - l * I_IN, scr, F.lane); continue; } r -= 2 * I_IN;
        if (r < 6 * I_OUT) { const int q = r / I_OUT, l = q / 3, s = q - 3 * l; const float* src = inp(F, s == 0 ? I_WHY : (s == 1 ? I_WCF : I_WS5)) + (size_t)l * 512 * 1024;
            conv_matrix_item(src, 512, 1024, ws_outs + (size_t)(l * 3 + s) * 1024 * 512, 0, r - q * I_OUT, scr, F.lane); continue; } r -= 6 * I_OUT;
        if (r < 2 * I_GLU) { const int l = r / I_GLU; conv_matrix_item(inp(F, I_SWGLU) + (size_t)l * 512 * 512, 512, 512, ws_glu + (size_t)l * 512 * 512, 0, r - l * I_GLU, scr, F.lane); continue; } r -= 2 * I_GLU;
        if (r < 2 * I_WOI) { const int l = r / I_WOI; conv_matrix_item(inp(F, I_WO) + (size_t)l * 1024 * 1024, 1024, 1024, ws_wo + (size_t)l * 1024 * 1024, 0, r - l * I_WOI, scr, F.lane); continue; } r -= 2 * I_WOI;
        if (r < I_F1) { conv_matrix_item_f8(inp(F, I_FFW1), 1024, 2816, (unsigned char*)ws_w13, 2, r, 32.f, scr, F.lane); continue; } r -= I_F1;
        if (r < I_F1) { conv_matrix_item_f8(inp(F, I_FFW3), 1024, 2816, (unsigned char*)ws_w13, 3, r, 32.f, scr, F.lane); continue; } r -= I_F1;
        conv_matrix_item_f8(inp(F, I_FFW2), 2816, 1024, (unsigned char*)ws_w2, 0, r, 128.f, scr, F.lane);
    }
    __syncthreads();
    float* mods = (float*)(F.ws + WS_MODS);
    LAS float* sc = (LAS float*)F.lds;
    LAS float* red = sc + 1024 * 20;
    for (int e = F.tid; e < 17 * 1024; e += 512) { const int i = e >> 10, k = e & 1023; const float cv = i < 16 ? inp(F, I_C)[i * 1024 + k] : inp(F, I_CCTX)[k]; sc[k * 20 + i] = siluf_(cv); }
    __syncthreads();
    for (int it = F.vcu; it < 2 * 128; it += F.G) {
        const int l = it >> 7, nb = it & 127; const int kg = F.tid / 48, col = F.tid - kg * 48;
        if (kg < 10) { const float* w = inp(F, I_WMOD) + (size_t)l * 1024 * 6144 + nb * 48 + col;
            float acc[17];
#pragma unroll
            for (int i = 0; i < 17; ++i) acc[i] = 0.f;
#pragma unroll 4
            for (int k = kg; k < 1024; k += 10) { const float wv = __builtin_nontemporal_load(w + (size_t)k * 6144);
                const f32x4 s0 = *(const LAS f32x4*)(sc + k * 20), s1 = *(const LAS f32x4*)(sc + k * 20 + 4), s2 = *(const LAS f32x4*)(sc + k * 20 + 8), s3 = *(const LAS f32x4*)(sc + k * 20 + 12); const float s4 = sc[k * 20 + 16];
#pragma unroll
                for (int j = 0; j < 4; ++j) { acc[j] += s0[j] * wv; acc[4 + j] += s1[j] * wv; acc[8 + j] += s2[j] * wv; acc[12 + j] += s3[j] * wv; }
                acc[16] += s4 * wv; }
#pragma unroll
            for (int i = 0; i < 17; ++i) red[(kg * 17 + i) * 48 + col] = acc[i]; }
        __syncthreads();
        for (int e = F.tid; e < 17 * 48; e += 512) { const int i = e / 48, c = e - i * 48; float sum = inp(F, I_BMOD)[l * 6144 + nb * 48 + c];
#pragma unroll
            for (int g = 0; g < 10; ++g) sum += red[(g * 17 + i) * 48 + c];
            mods[(size_t)(l * 17 + i) * 6144 + nb * 48 + c] = sum; }
        __syncthreads();
    }
}

__device__ __forceinline__ void h2table_phase(Frame& F, int l) {
    const int gw = F.wave * F.G + F.vcu  , NGW = F.G * NWAVES, lane = F.lane;
    float* H2 = (float*)(F.ws + WS_FILT);
    const float* w1 = inp(F, I_FW1) + l * 33 * 64; const float* b1 = inp(F, I_FB1) + l * 64; const float* w2 = inp(F, I_FW2) + l * 64 * 64; const float* b2 = inp(F, I_FB2) + l * 64;
    const float* fq = inp(F, I_FREQ) + l * 128;
    for (int pos = gw; pos < LSEQ + LCTX; pos += NGW) {
        const bool isc = pos >= LSEQ; const int L = isc ? LCTX : LSEQ; const int t = isc ? pos - LSEQ : pos;
        const float tn = (float)t / (float)(L - 1);
        float z = 0.f;
        if (lane == 0) z = tn;
        else if (lane <= 32) { const int band = lane <= 16 ? lane : lane - 16; const int ph = (t * band) % L; const float ang = 6.283185307179586f * ((float)ph / (float)L); z = lane <= 16 ? cosf(ang) : sinf(ang); }
        float h = b1[lane];
        for (int k = 0; k < 33; ++k) h += lane_bcast(z, k) * w1[k * 64 + lane];
        h = sinf(fq[lane] * h);
        float h2 = b2[lane];
        for (int k = 0; k < 64; ++k) h2 += lane_bcast(h, k) * w2[k * 64 + lane];
        H2[(size_t)pos * 64 + lane] = sinf(fq[64 + lane] * h2);
    }
}
__device__ __forceinline__ void filter_expand_phase(Frame& F, int l) {
    const int gw = F.wave * F.G + F.vcu  , NGW = F.G * NWAVES, lane = F.lane;
    const float* H2 = (const float*)(F.ws + WS_FILT);
    const float* w3 = inp(F, I_FW3) + (size_t)l * 64 * 2048; const float* b3 = inp(F, I_FB3) + l * 2048; const float* dec = inp(F, I_DECAY) + l * 2048; const float* hb = inp(F, I_HBIAS) + l * 1024;
    LAS float* W = (LAS float*)(F.lds + F.wave * 17408);
#pragma unroll 1
    for (int it = gw; it < 1024 + 128; it += NGW) {
        const bool isc = it >= 1024; const int ii = isc ? it - 1024 : it; const int chunk = ii >> 5, grp = ii & 31;
        const int L = isc ? LCTX : LSEQ; const int t = chunk * 64 + lane; const int pos = isc ? LSEQ + t : t;
        bf16* KR = isc ? (bf16*)(F.ws + WS_KRC) : (bf16*)(F.ws + WS_KRL); const int KLEN = 2 * L;
        const float tn = (float)t / (float)(L - 1);
#pragma unroll 4
        for (int k = 0; k < 64; ++k) W[lane * 68 + k] = w3[(size_t)k * 2048 + grp * 64 + lane];
        f32x4 h2[16];
#pragma unroll
        for (int k = 0; k < 16; ++k) h2[k] = *(const f32x4*)(H2 + (size_t)pos * 64 + 4 * k);
        const int colL = grp * 64 + lane; const float b3L = b3[colL], decL = fabsf(dec[colL]); const float hbL = ((colL >> 9) & 1) == 0 ? hb[(colL >> 10) * 512 + (colL & 511)] : 0.f;
        LDS_WAIT();
#pragma unroll 1
        for (int cc = 0; cc < 64; ++cc) {
            const int col = grp * 64 + cc; float a = lane_bcast(b3L, cc);
#pragma unroll
            for (int k = 0; k < 16; ++k) { const f32x4 wv = *(const LAS f32x4*)(W + cc * 68 + 4 * k); a += (h2[k][0] * wv[0] + h2[k][1] * wv[1]) + (h2[k][2] * wv[2] + h2[k][3] * wv[3]); }
            const int o = col >> 10, dir = (col >> 9) & 1, c = col & 511;
            float v = a * __expf(-tn * lane_bcast(decL, cc));
            if (t == 0 && dir == 0) v += lane_bcast(hbL, cc);
            const bool valid = !(t == 0 && dir == 1);
            const int i = dir ? L + t : L - t;
            const unsigned short bv = (unsigned short)f2bf(v);
            bf16* base = (valid ? KR + (size_t)((o * 512 + c) * 8) * KLEN : (bf16*)(F.ws + WS_KDUMMY) + 16) + i;
#pragma unroll
            for (int m = 0; m < 8; ++m) base[(ptrdiff_t)m * (KLEN - 1)] = bv;
        }
        LDS_WAIT();
    }
    __syncthreads();
}
__device__ __forceinline__ void s5params_phase(Frame& F, int l) {
    float* P = (float*)(F.ws + WS_S5P);
    for (int e = F.vcu * 512 + F.tid; e < 2 * 32 * 64; e += F.G * 512) {
        const int base = l * 4096 + e;
        const int dg = e >> 6;
        const float lam_re = fminf(inp(F, I_SARE)[base], -1e-4f), lam_im = inp(F, I_SAIM)[base];
        const float dt = expf(inp(F, I_SLDT)[l * 64 + dg]);
        const float mag = expf(lam_re * dt), ang = lam_im * dt; const float abr = mag * cosf(ang), abi = mag * sinf(ang);
        const float den = lam_re * lam_re + lam_im * lam_im;
        const float qre = ((abr - 1.0f) * lam_re + abi * lam_im) / den, qim = (abi * lam_re - (abr - 1.0f) * lam_im) / den;
        float* o = P + (size_t)e * 36; o[0] = abr; o[1] = abi;
        const float* br = inp(F, I_SBRE) + (size_t)base * 16; const float* bi = inp(F, I_SBIM) + (size_t)base * 16;
        for (int c = 0; c < 16; ++c) { o[2 + c] = qre * br[c] - qim * bi[c]; o[18 + c] = qre * bi[c] + qim * br[c]; }
        o[34] = 0.f; o[35] = 0.f;
    }
}

struct Row { f32x4 v[4]; };
__device__ __forceinline__ void row_load(Row& r, const float* p, int lane) { const f32x4* x = (const f32x4*)p + lane;
#pragma unroll
    for (int j = 0; j < 4; ++j) r.v[j] = x[64 * j]; }
__device__ __forceinline__ void row_load_nt(Row& r, const float* p, int lane) { const f32x4* x = (const f32x4*)p + lane;
#pragma unroll
    for (int j = 0; j < 4; ++j) r.v[j] = __builtin_nontemporal_load(x + 64 * j); }
__device__ __forceinline__ void row_load_bf16(Row& r, const bf16* p, int lane) { const v2u* x = (const v2u*)p + lane;
#pragma unroll
    for (int j = 0; j < 4; ++j) { const v2u w = x[64 * j]; r.v[j] = (f32x4){bflo(w.x), bfhi(w.x), bflo(w.y), bfhi(w.y)}; } }
__device__ __forceinline__ void row_store(const Row& r, float* p, int lane) { f32x4* x = (f32x4*)p + lane;
#pragma unroll
    for (int j = 0; j < 4; ++j) x[64 * j] = r.v[j]; }
__device__ __forceinline__ void row_norm(Row& r) {
    float s = 0.f;
#pragma unroll
    for (int j = 0; j < 4; ++j) s += (r.v[j][0] + r.v[j][1]) + (r.v[j][2] + r.v[j][3]);
    const float mean = wave_sum(s) * (1.f / DM); float q = 0.f;
#pragma unroll
    for (int j = 0; j < 4; ++j) { r.v[j] = r.v[j] - mean; q += (r.v[j][0] * r.v[j][0] + r.v[j][1] * r.v[j][1]) + (r.v[j][2] * r.v[j][2] + r.v[j][3] * r.v[j][3]); }
    const float rstd = 1.f / sqrtf(wave_sum(q) * (1.f / DM) + LN_EPS);
#pragma unroll
    for (int j = 0; j < 4; ++j) r.v[j] = r.v[j] * rstd;
}
__device__ __forceinline__ void row_affine(Row& r, const float* g, const float* b, int lane, float gadd) {
    const f32x4* gp = (const f32x4*)g + lane; const f32x4* bp = (const f32x4*)b + lane;
#pragma unroll
    for (int j = 0; j < 4; ++j) r.v[j] = r.v[j] * (gp[64 * j] + gadd) + bp[64 * j];
}
struct Vec8 { f32x4 g[4], b[4]; };
__device__ __forceinline__ void vec8_load(Vec8& v, const float* g, const float* b, int lane) { const f32x4* gp = (const f32x4*)g + lane; const f32x4* bp = (const f32x4*)b + lane;
#pragma unroll
    for (int j = 0; j < 4; ++j) { v.g[j] = gp[64 * j]; v.b[j] = bp[64 * j]; } }
__device__ __forceinline__ void row_affine_reg(Row& r, const Vec8& v, float gadd) {
#pragma unroll
    for (int j = 0; j < 4; ++j) r.v[j] = r.v[j] * (v.g[j] + gadd) + v.b[j]; }
__device__ __forceinline__ int row_batch(int row) { return row < NX ? (row >> 11) : 16; }
__device__ __forceinline__ void row_store_bf16(const Row& r, bf16* p, int lane) { unsigned long long* o = (unsigned long long*)p + lane;
#pragma unroll
    for (int j = 0; j < 4; ++j) o[64 * j] = (unsigned long long)pk2(r.v[j][0], r.v[j][1]) | ((unsigned long long)pk2(r.v[j][2], r.v[j][3]) << 32); }

__device__ __forceinline__ const float* mod_vec(Frame& F, int l, int row, int which) { const int i = row < NX ? (row >> 11) : 16; return (const float*)(F.ws + WS_MODS) + ((size_t)l * 17 + i) * INC + which * 1024; }
__device__ __forceinline__ const float* xrow_ptr(Frame& F, int l, int row) {
    if (l == 0) return row < NX ? inp(F, I_X) + (size_t)row * DM : inp(F, I_CTX) + (size_t)(row - NX) * DM;
    return row < NX ? F.out + (size_t)row * DM : (const float*)(F.ws + WS_XC) + (size_t)(row - NX) * DM;
}
__device__ __forceinline__ float* xcur_ptr(Frame& F, int row) { return row < NX ? F.out + (size_t)row * DM : (float*)(F.ws + WS_XC) + (size_t)(row - NX) * DM; }

__device__ __forceinline__ void lnmod_phase(Frame& F, int l) {
    const int gw = F.vcu * NWAVES + F.wave, NGW = F.G * NWAVES; bf16* hx = (bf16*)(F.ws + WS_HX);
    const int m0 = (int)((long)RT * gw / NGW), m1 = (int)((long)RT * (gw + 1) / NGW); Vec8 md; int cb = -1;
    Row nx; if (m0 < m1) row_load_nt(nx, xrow_ptr(F, l, m0), F.lane);
    for (int m = m0; m < m1; ++m) { if (row_batch(m) != cb) { cb = row_batch(m); vec8_load(md, mod_vec(F, l, m, 1), mod_vec(F, l, m, 0), F.lane); }
        Row r = nx; if (m + 1 < m1) row_load_nt(nx, xrow_ptr(F, l, m + 1), F.lane);
        row_norm(r); row_affine_reg(r, md, 1.0f); row_store_bf16(r, hx + (size_t)m * DM, F.lane); }
}
template <bool MOE>
__device__ __forceinline__ void ln1_phase(Frame& F, int l) {
    const int gw = F.vcu * NWAVES + F.wave, NGW = F.G * NWAVES; bf16* hx = (bf16*)(F.ws + WS_HX); const int M = MOE ? NX : RT;
    const float* g = inp(F, I_LN1G) + l * DM; const float* b = inp(F, I_LN1B) + l * DM;
    int* toke = (int*)(F.ws + WS_META + META_TOKE); float* tokw = (float*)(F.ws + WS_META + META_TOKW);
    LAS unsigned* lcnt = (LAS unsigned*)(F.lds);
    unsigned c8[8];
#pragma unroll
    for (int e = 0; e < 8; ++e) c8[e] = 0u;
    if (MOE) { if (F.tid < 8) lcnt[F.tid] = 0u; __syncthreads(); }
    f32x4 rtr[4][4][2];
    if (MOE) { const float* rt = inp(F, I_ROUTER);
#pragma unroll
        for (int j = 0; j < 4; ++j)
#pragma unroll
            for (int q = 0; q < 4; ++q) { const int k = 256 * j + 4 * F.lane + q; rtr[j][q][0] = *(const f32x4*)(rt + k * 8); rtr[j][q][1] = *(const f32x4*)(rt + k * 8 + 4); } }
    Vec8 ln; if (!MOE) vec8_load(ln, g, b, F.lane); Vec8 md; int cb = -1;
    const int m0 = (int)((long)M * gw / NGW), m1 = (int)((long)M * (gw + 1) / NGW);
    for (int m = m0; m < m1; ++m) {
        if (row_batch(m) != cb) { cb = row_batch(m); vec8_load(md, mod_vec(F, l, m, 4), mod_vec(F, l, m, 3), F.lane); }
        float* xp = xcur_ptr(F, m); Row r; row_load_bf16(r, (const bf16*)(F.ws + WS_KRL) + (size_t)m * DM, F.lane); row_norm(r); if (MOE) row_affine(r, g, b, F.lane, 0.0f); else row_affine_reg(r, ln, 0.0f); row_store(r, xp, F.lane);
        row_norm(r); row_affine_reg(r, md, 1.0f);
        if (!MOE) { unsigned* d8 = (unsigned*)((unsigned char*)hx + (size_t)m * DM) + F.lane;
#pragma unroll
            for (int j = 0; j < 4; ++j) d8[64 * j] = pk4_fp8(r.v[j][0], r.v[j][1], r.v[j][2], r.v[j][3]); }
        else {
            float lg[8];
#pragma unroll
            for (int e = 0; e < 8; ++e) lg[e] = 0.f;
#pragma unroll
            for (int j = 0; j < 4; ++j)
#pragma unroll
                for (int q = 0; q < 4; ++q) { const f32x4 r0 = rtr[j][q][0], r1 = rtr[j][q][1]; const float hv = r.v[j][q];
                    lg[0] += hv * r0[0]; lg[1] += hv * r0[1]; lg[2] += hv * r0[2]; lg[3] += hv * r0[3]; lg[4] += hv * r1[0]; lg[5] += hv * r1[1]; lg[6] += hv * r1[2]; lg[7] += hv * r1[3]; }
#pragma unroll
            for (int e = 0; e < 8; ++e) lg[e] = wave_sum(lg[e]);
            int e0 = 0; float v0 = lg[0];
#pragma unroll
            for (int e = 1; e < 8; ++e) if (lg[e] > v0) { v0 = lg[e]; e0 = e; }
            int e1 = -1; float v1 = -3.0e38f;
#pragma unroll
            for (int e = 0; e < 8; ++e) if (e != e0 && lg[e] > v1) { v1 = lg[e]; e1 = e; }
            const float ex = __expf(v1 - v0); const float w0 = 1.0f / (1.0f + ex), w1 = ex / (1.0f + ex);
            if (F.lane == 0) { toke[2 * m] = e0; toke[2 * m + 1] = e1; tokw[2 * m] = w0; tokw[2 * m + 1] = w1; }
#pragma unroll
            for (int e = 0; e < 8; ++e) c8[e] += (e0 == e ? 1u : 0u) + (e1 == e ? 1u : 0u);
        }
    }
    if (MOE) {
        if (F.lane == 0) {
#pragma unroll
            for (int e = 0; e < 8; ++e) if (c8[e]) atomicAdd((unsigned*)&lcnt[e], c8[e]); }
        __syncthreads();
        if (F.tid < 8) ((unsigned*)(F.ws + WS_META + META_BCNT))[F.vcu * 8 + F.tid] = lcnt[F.tid];
        __syncthreads();
    }
}
__device__ __forceinline__ void ln2_phase(Frame& F, int l) {
    const int gw = F.vcu * NWAVES + F.wave, NGW = F.G * NWAVES;
    Vec8 ln; vec8_load(ln, inp(F, I_LN2G) + l * DM, inp(F, I_LN2B) + l * DM, F.lane);
    const int m0 = (int)((long)RT * gw / NGW), m1 = (int)((long)RT * (gw + 1) / NGW);
    const bf16* R16 = (const bf16*)(F.ws + WS_KRL);
    Row nx; if (m0 < m1) row_load_bf16(nx, R16 + (size_t)m0 * DM, F.lane);
    bf16* hx = (bf16*)(F.ws + WS_HX); Vec8 md; int cb = -1;
    for (int m = m0; m < m1; ++m) { float* xp = xcur_ptr(F, m); Row r = nx; if (m + 1 < m1) row_load_bf16(nx, R16 + (size_t)(m + 1) * DM, F.lane);
        if (row_batch(m) != cb) { cb = row_batch(m); vec8_load(md, mod_vec(F, l + 1, m, 1), mod_vec(F, l + 1, m, 0), F.lane); }
        row_norm(r); row_affine_reg(r, ln, 0.0f); row_store(r, xp, F.lane);
        row_norm(r); row_affine_reg(r, md, 1.0f); row_store_bf16(r, hx + (size_t)m * DM, F.lane); }
}

__device__ __forceinline__ void moe_convert_phase(Frame& F) {
    LAS float* scr = (LAS float*)(F.lds + 4096 + F.wave * 17408);
    const int gw = F.wave * F.G + F.vcu  , NGW = F.G * NWAVES;
    unsigned char* w13 = F.ws + WS_MW13; unsigned char* w2 = F.ws + WS_MW2;
    constexpr int I1 = (1024 / 64) * (3584 / 64), I2 = (3584 / 64) * (1024 / 64);
    for (int it = gw; it < 8 * (2 * I1 + I2); it += NGW) {
        const int e = it / (2 * I1 + I2); int r = it - e * (2 * I1 + I2);
        if (r < I1) { conv_matrix_item_f8(inp(F, I_MW1) + (size_t)e * 1024 * 3584, 1024, 3584, w13 + (size_t)e * 7168 * 1024, 2, r, 32.f, scr, F.lane); continue; } r -= I1;
        if (r < I1) { conv_matrix_item_f8(inp(F, I_MW3) + (size_t)e * 1024 * 3584, 1024, 3584, w13 + (size_t)e * 7168 * 1024, 3, r, 32.f, scr, F.lane); continue; } r -= I1;
        conv_matrix_item_f8(inp(F, I_MW2) + (size_t)e * 3584 * 1024, 3584, 1024, w2 + (size_t)e * 1024 * 3584, 0, r, 128.f, scr, F.lane);
    }
}
__device__ __forceinline__ void moe_setup_phase(Frame& F) {
    const int gw = F.vcu * NWAVES + F.wave, NGW = F.G * NWAVES, lane = F.lane;
    const int* toke = (const int*)(F.ws + WS_META + META_TOKE); int* tpos = (int*)(F.ws + WS_META + META_POS); int* tile_e = (int*)(F.ws + WS_META + META_TILE);
    const unsigned* bcnt = (const unsigned*)(F.ws + WS_META + META_BCNT); unsigned char* srt = F.ws + WS_SORT;
    LAS int* sh = (LAS int*)F.lds;
    const int mb = (int)((long)NX * gw / NGW), me = (int)((long)NX * (gw + 1) / NGW);
    __syncthreads();
    {
        const int e = F.wave; int tot = 0, pre = 0;
        for (int bk = lane; bk < F.G; bk += 64) { const int v = (int)bcnt[bk * 8 + e]; tot += v; pre += bk < F.vcu ? v : 0; }
#pragma unroll
        for (int o = 32; o >= 1; o >>= 1) { tot += __shfl_xor(tot, o); pre += __shfl_xor(pre, o); }
        if (lane == 0) { sh[e] = tot; sh[8 + e] = pre; }
        int c8[8];
#pragma unroll
        for (int q = 0; q < 8; ++q) c8[q] = 0;
        for (int base = mb; base < me; base += 64) { const int m = base + lane; const bool act = m < me;
            const int e0 = act ? toke[2 * m] : -1, e1 = act ? toke[2 * m + 1] : -1;
#pragma unroll
            for (int q = 0; q < 8; ++q) c8[q] += __popcll(__ballot(e0 == q)) + __popcll(__ballot(e1 == q)); }
        if (lane == 0) {
#pragma unroll
            for (int q = 0; q < 8; ++q) sh[16 + 8 * F.wave + q] = c8[q]; }
    }
    __syncthreads();
    int off[8], wbase[8], ntiles; { int o = 0;
#pragma unroll
        for (int e = 0; e < 8; ++e) { off[e] = o; o += (sh[e] + 255) & ~255; int wb = off[e] + sh[8 + e];
            for (int w2 = 0; w2 < F.wave; ++w2) wb += sh[16 + 8 * w2 + e];
            wbase[e] = wb; }
        ntiles = o >> 8; }
    if (F.vcu == 0 && F.tid < 8) { const int e = F.tid; const int t0 = off[e] >> 8; const int t1 = (e == 7 ? ntiles : (off[e + 1] >> 8)); for (int t = t0; t < t1; ++t) tile_e[t] = e; if (e == 0) tile_e[511] = ntiles; }
    for (int base = mb; base < me; base += 64) {
        const int m = base + lane; const bool act = m < me;
        const int e0 = act ? toke[2 * m] : -1, e1 = act ? toke[2 * m + 1] : -1;
        int p0 = 0, p1 = 0;
        const unsigned long long lt = (1ull << lane) - 1ull;
#pragma unroll
        for (int e = 0; e < 8; ++e) {
            const unsigned long long m0 = __ballot(e0 == e), m1 = __ballot(e1 == e);
            if (e0 == e) p0 = wbase[e] + __popcll(m0 & lt);
            if (e1 == e) p1 = wbase[e] + __popcll(m0) + __popcll(m1 & lt);
            wbase[e] += __popcll(m0) + __popcll(m1);
        }
        if (act) { tpos[2 * m] = p0; tpos[2 * m + 1] = p1; }
        const int nrows = me - base < 64 ? me - base : 64; Vec8 md; int cb = -1;
        for (int i = 0; i < nrows; ++i) {
            const int mi = base + i; const int q0 = __builtin_amdgcn_readlane(p0, i), q1 = __builtin_amdgcn_readlane(p1, i);
            if (row_batch(mi) != cb) { cb = row_batch(mi); vec8_load(md, mod_vec(F, 1, mi, 4), mod_vec(F, 1, mi, 3), lane); }
            Row r; row_load(r, F.out + (size_t)mi * DM, lane); row_norm(r); row_affine_reg(r, md, 1.0f);
            unsigned* d0 = (unsigned*)(srt + (size_t)q0 * DM) + lane; unsigned* d1 = (unsigned*)(srt + (size_t)q1 * DM) + lane;
#pragma unroll
            for (int j = 0; j < 4; ++j) { const unsigned w8 = pk4_fp8(r.v[j][0], r.v[j][1], r.v[j][2], r.v[j][3]); d0[64 * j] = w8; d1[64 * j] = w8; }
        }
    }
}
__device__ __forceinline__ void moe_combine_phase(Frame& F) {
    const int gw = F.vcu * NWAVES + F.wave, NGW = F.G * NWAVES, lane = F.lane;
    const float* tokw = (const float*)(F.ws + WS_META + META_TOKW); const int* tpos = (const int*)(F.ws + WS_META + META_POS); const bf16* Y = (const bf16*)(F.ws + WS_MOEY);
    Vec8 ln; vec8_load(ln, inp(F, I_LN2G) + DM, inp(F, I_LN2B) + DM, lane);
    const int mb = (int)((long)NX * gw / NGW), me = (int)((long)NX * (gw + 1) / NGW); f32x4 g2[4]; int cb = -1;
    for (int m = mb; m < me; ++m) {
        if (row_batch(m) != cb) { cb = row_batch(m); const f32x4* gp = (const f32x4*)mod_vec(F, 1, m, 5) + lane;
#pragma unroll
            for (int j = 0; j < 4; ++j) g2[j] = gp[64 * j]; }
        const float w0 = tokw[2 * m], w1 = tokw[2 * m + 1]; const int p0 = tpos[2 * m], p1 = tpos[2 * m + 1];
        Row r; row_load(r, F.out + (size_t)m * DM, lane);
        const unsigned long long* y0 = (const unsigned long long*)(Y + (size_t)p0 * DM) + lane; const unsigned long long* y1 = (const unsigned long long*)(Y + (size_t)p1 * DM) + lane;
#pragma unroll
        for (int j = 0; j < 4; ++j) { const unsigned long long a = y0[64 * j], c = y1[64 * j];
            const f32x4 ya = (f32x4){bflo((unsigned)a), bfhi((unsigned)a), bflo((unsigned)(a >> 32)), bfhi((unsigned)(a >> 32))};
            const f32x4 yc = (f32x4){bflo((unsigned)c), bfhi((unsigned)c), bflo((unsigned)(c >> 32)), bfhi((unsigned)(c >> 32))};
            r.v[j] = r.v[j] * ALPHA_F + g2[j] * (ya * w0 + yc * w1); }
        row_norm(r); row_affine_reg(r, ln, 0.0f); row_store(r, F.out + (size_t)m * DM, lane);
    }
}

constexpr int HY_U_OFF = 0, HY_U_STRIDE = 4128, HY_K_OFF = 16 * HY_U_STRIDE, HY_K_STRIDE = 8208;
constexpr int HYC_U_STRIDE = 544, HYC_K_STRIDE = 1040;
static_assert(HY_K_OFF + 8 * HY_K_STRIDE + 64 <= MISC_OFF, "hyena LDS map");
__device__ __forceinline__ float hy_short4(const bf16* p, int tb, int L, float w0, float w1, float w2, float bs, f32x4& x) {
    const v2u pw = *(const v2u*)(p + tb); const float c0 = bflo(pw.x), c1 = bfhi(pw.x), c2 = bflo(pw.y), c3 = bfhi(pw.y);
    const float pm = tb > 0 ? bf2f(p[tb - 1]) : 0.f, pp = tb + 4 < L ? bf2f(p[tb + 4]) : 0.f;
    x[0] = bs + w0 * pm + w1 * c0 + w2 * c1; x[1] = bs + w0 * c0 + w1 * c1 + w2 * c2; x[2] = bs + w0 * c1 + w1 * c2 + w2 * c3; x[3] = bs + w0 * c2 + w1 * c3 + w2 * pp; return 0.f;
}
__device__ __forceinline__ void hy_short4u(const bf16* pi, bool first, bool last, float w0, float w1, float w2, float bs, f32x4& x) {
    const v2u pw = *(const v2u*)pi; const float c0 = bflo(pw.x), c1 = bfhi(pw.x), c2 = bflo(pw.y), c3 = bfhi(pw.y);
    float pm = bf2f(pi[-1]), pp = bf2f(pi[4]); pm = first ? 0.f : pm; pp = last ? 0.f : pp;
    x[0] = bs + w0 * pm + w1 * c0 + w2 * c1; x[1] = bs + w0 * c0 + w1 * c1 + w2 * c2; x[2] = bs + w0 * c1 + w1 * c2 + w2 * c3; x[3] = bs + w0 * c2 + w1 * c3 + w2 * pp;
}
template <int L, int USTR>
__device__ __forceinline__ void hy_fill_u(Frame& F, const bf16* phyT, int col, int rowb0, float w0, float w1, float w2, float bs) {
    const bf16* pc = phyT + (size_t)col * RT + rowb0;
    constexpr int NIT = 16 * L / 8 / 512 > 0 ? 16 * L / 8 / 512 : 1;
#pragma unroll 4
    for (int it = 0; it < NIT; ++it) { const int ch = F.tid + 512 * it; const int b = ch / (L / 8), tb = (ch - b * (L / 8)) * 8; const bf16* p = pc + (size_t)b * L + tb;
        const v4u cw = *(const v4u*)p; float pm = bf2f(p[-1]), pp = bf2f(p[8]); pm = tb == 0 ? 0.f : pm; pp = tb + 8 >= L ? 0.f : pp;
        const float c0 = bflo(cw.x), c1 = bfhi(cw.x), c2 = bflo(cw.y), c3 = bfhi(cw.y), c4 = bflo(cw.z), c5 = bfhi(cw.z), c6 = bflo(cw.w), c7 = bfhi(cw.w);
        v4u o; o.x = pk2(bs + w0 * pm + w1 * c0 + w2 * c1, bs + w0 * c0 + w1 * c1 + w2 * c2); o.y = pk2(bs + w0 * c1 + w1 * c2 + w2 * c3, bs + w0 * c2 + w1 * c3 + w2 * c4);
        o.z = pk2(bs + w0 * c3 + w1 * c4 + w2 * c5, bs + w0 * c4 + w1 * c5 + w2 * c6); o.w = pk2(bs + w0 * c5 + w1 * c6 + w2 * c7, bs + w0 * c6 + w1 * c7 + w2 * pp);
        *(LAS v4u*)(F.lds + HY_U_OFF + b * USTR + tb * 2) = o; }
}
template <int KLEN, int KSTR>
__device__ __forceinline__ void hy_fill_k(Frame& F, const bf16* kr) {
    const bf16* src = kr + (size_t)F.wave * KLEN + F.lane * 8;
#pragma unroll
    for (int i = 0; i < KLEN * 2 / 1024; ++i)
        __builtin_amdgcn_global_load_lds((const unsigned*)(src + i * 512), (LAS unsigned*)(F.lds + HY_K_OFF + F.wave * KSTR + i * 1024), 16, 0, 0);
    VM_WAIT();
}
__device__ __forceinline__ void hyena_unit(Frame& F, int l, int c, bool with_ctx) {
    const bf16* phyT = (const bf16*)(F.ws + WS_PHYT);
    const bf16* KRL = (const bf16*)(F.ws + WS_KRL); const bf16* KRC = (const bf16*)(F.ws + WS_KRC);
    const float* sw = inp(F, I_HSW) + l * 3 * 1536; const float* sb = inp(F, I_HSB) + l * 1536;
    const int lane = F.lane, w = F.wave, r = lane & 15, q = lane >> 4, m = (-r) & 7;
    __syncthreads();
    { const int col = 1024 + c; hy_fill_u<LSEQ, HY_U_STRIDE>(F, phyT, col, 0, sw[col], sw[1536 + col], sw[3072 + col], sb[col]); }
    hy_fill_k<4096, HY_K_STRIDE>(F, KRL + (size_t)((0 * 512 + c) * 8) * 4096);
    __syncthreads();
#pragma unroll 1
    for (int o = 0; o < 2; ++o) {
        f32x4 acc[16];
#pragma unroll 1
        for (int rep_ = 0; rep_ < NREP(15); ++rep_) {
#pragma unroll
        for (int i = 0; i < 16; ++i) acc[i] = (f32x4){0.f, 0.f, 0.f, 0.f};
        const LAS unsigned char* pa = F.lds + HY_K_OFF + m * HY_K_STRIDE + 2 * (8 * q - r - m + 2048 - 256 * w);
        const LAS unsigned char* pb = F.lds + HY_U_OFF + r * HY_U_STRIDE + 16 * q;
        bf16x8 R[16];
#pragma unroll
        for (int i = 0; i < 16; ++i) R[i] = *(const LAS bf16x8*)(pa - 32 * i);
        bf16x8 bcur = *(const LAS bf16x8*)pb;
#pragma unroll 1
        for (int kg = 0; kg < 8; ++kg) {
#pragma unroll
            for (int kk = 0; kk < 8; ++kk) {
                const bf16x8 bnext = *(const LAS bf16x8*)(pb + 64 * (kk + 1));
                const bf16x8 n0 = *(const LAS bf16x8*)(pa + 64 * (kk + 1)), n1 = *(const LAS bf16x8*)(pa + 64 * (kk + 1) - 32);
#pragma unroll
                for (int i = 0; i < 16; ++i) acc[i] = __builtin_amdgcn_mfma_f32_16x16x32_bf16(R[(i - 2 * kk) & 15], bcur, acc[i], 0, 0, 0);
                R[(-2 * (kk + 1)) & 15] = n0; R[(1 - 2 * (kk + 1)) & 15] = n1; bcur = bnext;
                __builtin_amdgcn_sched_barrier(0);
            }
            pa += 512; pb += 512;
        }
        }
        const int col = o * 512 + c; const float w0 = sw[col], w1 = sw[1536 + col], w2 = sw[3072 + col], bs = sb[col];
        int tb0 = 256 * w + 4 * q; asm volatile("" : "+v"(tb0));
        const bf16* p = phyT + (size_t)col * RT + (size_t)r * LSEQ + tb0;
#pragma unroll
        for (int i = 0; i < 16; ++i) { f32x4 x; hy_short4u(p + 16 * i, tb0 + 16 * i == 0, tb0 + 16 * i + 4 >= LSEQ, w0, w1, w2, bs, x); acc[i] = acc[i] * x; }
        if (o == 0) {
            __syncthreads();
#pragma unroll
            for (int i = 0; i < 16; ++i) { v2u zw; zw.x = pk2(acc[i][0], acc[i][1]); zw.y = pk2(acc[i][2], acc[i][3]); *(LAS v2u*)(F.lds + HY_U_OFF + r * HY_U_STRIDE + (tb0 + 16 * i) * 2) = zw; }
            hy_fill_k<4096, HY_K_STRIDE>(F, KRL + (size_t)((1 * 512 + c) * 8) * 4096);
            __syncthreads();
        } else {
            GAS bf16* zt = (GAS bf16*)(F.ws + WS_PHYT) + (size_t)(1024 + c) * RT + (size_t)r * LSEQ + tb0; asm volatile("" : "+v"(zt));
#pragma unroll
            for (int i = 0; i < 16; ++i) { v2u zw; zw.x = pk2(acc[i][0], acc[i][1]); zw.y = pk2(acc[i][2], acc[i][3]); *(GAS v2u*)(zt + 16 * i) = zw; }
        }
    }
    if (!with_ctx) return;
    __syncthreads();
    { const int col = 1024 + c; hy_fill_u<LCTX, HYC_U_STRIDE>(F, phyT, col, NX, sw[col], sw[1536 + col], sw[3072 + col], sb[col]); }
    hy_fill_k<512, HYC_K_STRIDE>(F, KRC + (size_t)((0 * 512 + c) * 8) * 512);
    __syncthreads();
#pragma unroll 1
    for (int o = 0; o < 2; ++o) {
        f32x4 acc[2];
        acc[0] = (f32x4){0.f, 0.f, 0.f, 0.f}; acc[1] = acc[0];
        const LAS unsigned char* pa = F.lds + HY_K_OFF + m * HYC_K_STRIDE + 2 * (8 * q - r - m + 256 - 32 * w);
        const LAS unsigned char* pb = F.lds + HY_U_OFF + r * HYC_U_STRIDE + 16 * q;
#pragma unroll
        for (int k = 0; k < 8; ++k) { const bf16x8 bfr = *(const LAS bf16x8*)(pb + 64 * k);
#pragma unroll
            for (int i = 0; i < 2; ++i) acc[i] = __builtin_amdgcn_mfma_f32_16x16x32_bf16(*(const LAS bf16x8*)(pa + 64 * k - 32 * i), bfr, acc[i], 0, 0, 0); }
        const int col = o * 512 + c; const float w0 = sw[col], w1 = sw[1536 + col], w2 = sw[3072 + col], bs = sb[col];
        int tb0 = 32 * w + 4 * q; asm volatile("" : "+v"(tb0));
        const bf16* p = phyT + (size_t)col * RT + NX + (size_t)r * LCTX + tb0;
#pragma unroll
        for (int i = 0; i < 2; ++i) { f32x4 x; hy_short4u(p + 16 * i, tb0 + 16 * i == 0, tb0 + 16 * i + 4 >= LCTX, w0, w1, w2, bs, x); acc[i] = acc[i] * x; }
        if (o == 0) {
            __syncthreads();
#pragma unroll
            for (int i = 0; i < 2; ++i) { v2u zw; zw.x = pk2(acc[i][0], acc[i][1]); zw.y = pk2(acc[i][2], acc[i][3]); *(LAS v2u*)(F.lds + HY_U_OFF + r * HYC_U_STRIDE + (tb0 + 16 * i) * 2) = zw; }
            hy_fill_k<512, HYC_K_STRIDE>(F, KRC + (size_t)((1 * 512 + c) * 8) * 512);
            __syncthreads();
        } else {
            GAS bf16* zt = (GAS bf16*)(F.ws + WS_PHYT) + (size_t)(1024 + c) * RT + NX + (size_t)r * LCTX + tb0;
#pragma unroll
            for (int i = 0; i < 2; ++i) { v2u zw; zw.x = pk2(acc[i][0], acc[i][1]); zw.y = pk2(acc[i][2], acc[i][3]); *(GAS v2u*)(zt + 16 * i) = zw; }
        }
    }
}

__device__ __forceinline__ void zt_transpose_phase(Frame& F, int ntok) {
    const bf16* zT = (const bf16*)(F.ws + WS_PHYT) + (size_t)1024 * RT; bf16* z2 = (bf16*)(F.ws + WS_Z2);
    LAS unsigned char* scr = F.lds + F.wave * 8448;
    const int gw = F.wave * F.G + F.vcu  , NGW = F.G * NWAVES, lane = F.lane, nblk = ntok / 64;
    const int lr = lane >> 3, pc = lane & 7;
    __syncthreads();
    for (int it = gw; it < 8 * nblk; it += NGW) {
        const int cb = it / nblk, tbk = it - cb * nblk;
        v4u in[8];
#pragma unroll
        for (int j = 0; j < 8; ++j) in[j] = *(const v4u*)(zT + (size_t)(cb * 64 + 8 * j + lr) * RT + tbk * 64 + pc * 8);
#pragma unroll
        for (int j = 0; j < 8; ++j) { LAS unsigned* d = (LAS unsigned*)(scr + (8 * j + lr) * 132 + pc * 16); d[0] = in[j].x; d[1] = in[j].y; d[2] = in[j].z; d[3] = in[j].w; }
        LDS_WAIT();
#pragma unroll
        for (int j = 0; j < 8; ++j) {
            const LAS unsigned short* sp = (const LAS unsigned short*)(scr + (pc * 8) * 132 + (8 * j + lr) * 2);
            unsigned hv[8];
#pragma unroll
            for (int k = 0; k < 8; ++k) hv[k] = sp[k * 66];
            v4u o; o.x = hv[0] | (hv[1] << 16); o.y = hv[2] | (hv[3] << 16); o.z = hv[4] | (hv[5] << 16); o.w = hv[6] | (hv[7] << 16);
            *(v4u*)(z2 + (size_t)(tbk * 64 + 8 * j + lr) * 512 + cb * 64 + pc * 8) = o; }
        LDS_WAIT();
    }
    __syncthreads();
}

__device__ __forceinline__ void cf_unit(Frame& F, int l, int seqrow, int seqlen, int t0) {
    LAS bf16* U = (LAS bf16*)F.lds;
    LAS float* O = (LAS float*)(F.lds + 98304);
    const bf16* ucf = (const bf16*)(F.ws + WS_UCF); bf16* out = (bf16*)(F.ws + WS_UCF2);
    __syncthreads();
    { v4u wv[12];
#pragma unroll
        for (int j = 0; j < 12; ++j) { const int pc = F.tid + 512 * j; const int i = pc >> 6, ch = pc & 63; const int t = t0 - 15 + i;
            wv[j] = (v4u){0u, 0u, 0u, 0u}; if (pc < 94 * 64 && t >= 0 && t < seqlen) wv[j] = *(const v4u*)(ucf + (size_t)(seqrow + t) * 512 + ch * 8); }
#pragma unroll
        for (int j = 0; j < 12; ++j) { const int pc = F.tid + 512 * j; const int i = pc >> 6, ch = pc & 63; if (pc < 94 * 64) *(LAS v4u*)(U + i * 512 + ch * 8) = wv[j]; } }
    const int c = F.tid;
    float w[31];
#pragma unroll
    for (int k = 0; k < 31; ++k) w[k] = inp(F, I_CFW)[(size_t)l * 31 * 512 + k * 512 + c];
    const float bias = inp(F, I_CFB)[l * 512 + c];
    const f32x4 g0 = *((const f32x4*)(inp(F, I_CFG) + l * 512) + F.lane), g1 = *((const f32x4*)(inp(F, I_CFG) + l * 512) + 64 + F.lane);
    const f32x4 b0 = *((const f32x4*)(inp(F, I_CFLB) + l * 512) + F.lane), b1 = *((const f32x4*)(inp(F, I_CFLB) + l * 512) + 64 + F.lane);
    __syncthreads();
#pragma unroll 1
    for (int r = 0; r < 4; ++r) {
        float v[16];
#pragma unroll
        for (int t = 0; t < 16; ++t) v[t] = bias;
        const LAS bf16* Ur = U + (16 * r) * 512 + c;
#pragma unroll
        for (int ii = 0; ii < 46; ++ii) { const float x = bf2f(Ur[ii * 512]);
#pragma unroll
            for (int t = 0; t < 16; ++t) { if (ii - t >= 0 && ii - t <= 30) v[t] += w[ii - t] * x; } }
#pragma unroll
        for (int t = 0; t < 16; ++t) O[t * 512 + c] = v[t];
        __syncthreads();
#pragma unroll
        for (int q = 0; q < 2; ++q) {
            const int tt = 2 * F.wave + q;
            f32x4 x0 = *((const LAS f32x4*)(O + tt * 512) + F.lane), x1 = *((const LAS f32x4*)(O + tt * 512) + 64 + F.lane);
            const float mean = wave_sum((x0[0] + x0[1]) + (x0[2] + x0[3]) + (x1[0] + x1[1]) + (x1[2] + x1[3])) * (1.f / 512.f);
            x0 = x0 - mean; x1 = x1 - mean;
            const float var = wave_sum((x0[0] * x0[0] + x0[1] * x0[1]) + (x0[2] * x0[2] + x0[3] * x0[3]) + (x1[0] * x1[0] + x1[1] * x1[1]) + (x1[2] * x1[2] + x1[3] * x1[3])) * (1.f / 512.f);
            const float rstd = 1.f / sqrtf(var + LN_EPS);
            f32x4 y0 = x0 * rstd * g0 + b0, y1 = x1 * rstd * g1 + b1;
#pragma unroll
            for (int j = 0; j < 4; ++j) { y0[j] = siluf_(y0[j]); y1[j] = siluf_(y1[j]); }
            bf16* orow = out + (size_t)(seqrow + t0 + 16 * r + tt) * 512;
            v2u o0, o1; o0.x = pk2(y0[0], y0[1]); o0.y = pk2(y0[2], y0[3]); o1.x = pk2(y1[0], y1[1]); o1.y = pk2(y1[2], y1[3]);
            *((v2u*)orow + F.lane) = o0; *((v2u*)orow + 64 + F.lane) = o1;
        }
        __syncthreads();
    }
}

#define TSUB(slot) do { if (DBG_TMASK) { const unsigned long long now_ = wall_clock64(); if (((DBG_TMASK >> (slot)) & 1u) && ((DBG_TLAYER >> l) & 1u)) t_acc += now_ - t_prev; t_prev = now_; } } while (0)
__device__ __forceinline__ void s5_unit(Frame& F, int l, int b, int gp, unsigned long long& t_acc, unsigned long long& t_prev) {
    const int lane = F.lane, w = F.wave;
    bf16* ps5 = (bf16*)(F.ws + WS_PS5); bf16* ydir = (bf16*)(F.ws + WS_YDIR);
    __syncthreads();
#pragma unroll 1
    for (int rep_ = 0; rep_ < NREP(14); ++rep_)
    {
        const int gd = w & 3, role = w >> 2;
        const int g = 2 * gp + (gd >> 1), dir = gd & 1;
        const int r = lane & 15, q = lane >> 4;
        LAS unsigned char* wl = F.lds + gd * 33280;
        LAS unsigned char* uS0 = wl;
        LAS float* BuS0 = (LAS float*)(wl + 4096);
        LAS unsigned char* stS0 = wl + 4096 + 2 * 10240;
        constexpr int NCH = (LCTX + LSEQ) / 16;
        const float* P = (const float*)(F.ws + WS_S5P) + (size_t)((dir * 32 + g) * 64) * 36;
        float abr = 0.f, abi = 0.f; f32x2 s2 = (f32x2){0.f, 0.f}, Aa = s2, Bn = s2;
        bf16x8 Bf[8], Cf[4];
        const int ti = lane >> 2, cq = lane & 3;
        auto urow = [&](int k) -> size_t { const bool isc = k < LCTX / 16; const int kk = isc ? k : k - LCTX / 16; const int Ls = isc ? LCTX : LSEQ; const int rowb = isc ? NX + b * LCTX : b * LSEQ;
            const int st = kk * 16 + ti; const int t = dir ? (Ls - 1 - st) : st; return (size_t)(rowb + t) * 512 + g * 16 + 4 * cq; };
        v2u ublk[8];
#pragma unroll
        for (int j = 0; j < 8; ++j) ublk[j] = (v2u){0u, 0u};
        static_assert(((LCTX + LSEQ) / 16) % 8 == 0, "s5 input blocks");
        if (role == 0) { abr = P[lane * 36]; abi = P[lane * 36 + 1]; Aa = (f32x2){abr, abr}; Bn = (f32x2){-abi, abi}; }
        else {
#pragma unroll
            for (int blk = 0; blk < 8; ++blk) { const int pp = 16 * blk + r; const float* src = P + (size_t)(pp & 63) * 36 + (pp < 64 ? 2 : 18) + 8 * (q & 1);
                v4u t4; t4.x = pk2(src[0], src[1]); t4.y = pk2(src[2], src[3]); t4.z = pk2(src[4], src[5]); t4.w = pk2(src[6], src[7]);
                if (q >= 2) t4 = (v4u){0u, 0u, 0u, 0u};
                Bf[blk] = __builtin_bit_cast(bf16x8, t4); }
            const float* cre = inp(F, I_SCRE) + (size_t)(((l * 2 + dir) * 32 + g) * 16) * 64; const float* cim = inp(F, I_SCIM) + (size_t)(((l * 2 + dir) * 32 + g) * 16) * 64;
#pragma unroll
            for (int ks = 0; ks < 4; ++ks) { const int p0 = 16 * ks + 4 * q; const f32x4 a = *(const f32x4*)(cre + r * 64 + p0), c4 = *(const f32x4*)(cim + r * 64 + p0);
                v4u t4; t4.x = pk2(a[0], -c4[0]); t4.y = pk2(a[1], -c4[1]); t4.z = pk2(a[2], -c4[2]); t4.w = pk2(a[3], -c4[3]);
                Cf[ks] = __builtin_bit_cast(bf16x8, t4); }
#pragma unroll
            for (int j = 0; j < 8; ++j) ublk[j] = *(const v2u*)(ps5 + urow(j));
#pragma unroll
            for (int j = 0; j < 8; ++j) *(LAS v2u*)(uS0 + j * 512 + ti * 32 + 8 * cq) = ublk[j];
#pragma unroll
            for (int j = 0; j < 8; ++j) ublk[j] = *(const v2u*)(ps5 + urow(8 + j));
        }
        LDS_WAIT(); __builtin_amdgcn_s_barrier(); asm volatile("" ::: "memory");
#pragma unroll 1
        for (int k = 0; k < NCH + 2; ++k) {
            const int p0 = k & 1, p1 = p0 ^ 1;
            unsigned long long tb0_ = 0; if (DBG_TMASK & 0x300000u) tb0_ = wall_clock64();
            if (role == 1) {
                bf16x8 ua, sf[4];
                if (k < NCH) { const v4u t4 = *(const LAS v4u*)(uS0 + (k & 7) * 512 + r * 32 + 16 * (q & 1)); ua = __builtin_bit_cast(bf16x8, q < 2 ? t4 : (v4u){0u, 0u, 0u, 0u}); }
                if (k < NCH) {
#pragma unroll
                    for (int blk = 0; blk < 8; ++blk) { const f32x4 d = __builtin_amdgcn_mfma_f32_16x16x32_bf16(ua, Bf[blk], (f32x4){0.f, 0.f, 0.f, 0.f}, 0, 0, 0);
                        *(LAS f32x4*)(BuS0 + p0 * 2560 + (16 * blk + r) * 20 + 4 * q) = d; }
                }
                if (k >= 2) {
#pragma unroll
                    for (int ks = 0; ks < 4; ++ks) sf[ks] = *(const LAS bf16x8*)(stS0 + p0 * 4352 + r * 272 + 64 * ks + 16 * q); }
                if ((k & 7) == 7 && k + 1 < NCH) {
#pragma unroll
                    for (int j = 0; j < 8; ++j) *(LAS v2u*)(uS0 + j * 512 + ti * 32 + 8 * cq) = ublk[j];
                    if (k + 9 < NCH) {
#pragma unroll
                        for (int j = 0; j < 8; ++j) ublk[j] = *(const v2u*)(ps5 + urow(k + 9 + j)); } }
                if (k >= 2) {
                    f32x4 y0 = __builtin_amdgcn_mfma_f32_16x16x32_bf16(sf[0], Cf[0], (f32x4){0.f, 0.f, 0.f, 0.f}, 0, 0, 0), y1 = __builtin_amdgcn_mfma_f32_16x16x32_bf16(sf[1], Cf[1], (f32x4){0.f, 0.f, 0.f, 0.f}, 0, 0, 0);
                    y0 = __builtin_amdgcn_mfma_f32_16x16x32_bf16(sf[2], Cf[2], y0, 0, 0, 0); y1 = __builtin_amdgcn_mfma_f32_16x16x32_bf16(sf[3], Cf[3], y1, 0, 0, 0);
                    const f32x4 y = y0 + y1; const int kc = k - 2;
                    const bool isc = kc < LCTX / 16; const int kk = isc ? kc : kc - LCTX / 16; const int Ls = isc ? LCTX : LSEQ; const int rowb = isc ? NX + b * LCTX : b * LSEQ;
#pragma unroll
                    for (int i = 0; i < 4; ++i) { const int st = kk * 16 + 4 * q + i; const int t = dir ? (Ls - 1 - st) : st;
                        ydir[(size_t)dir * RT * 512 + (size_t)(rowb + t) * 512 + g * 16 + r] = (bf16)f2bf(y[i]); } }
            } else if (k >= 1 && k <= NCH) {
                __builtin_amdgcn_s_setprio(3);
                f32x4 bre[4], bim[4];
#pragma unroll
                for (int j = 0; j < 4; ++j) { bre[j] = *(const LAS f32x4*)(BuS0 + p1 * 2560 + lane * 20 + 4 * j); bim[j] = *(const LAS f32x4*)(BuS0 + p1 * 2560 + (64 + lane) * 20 + 4 * j); }
                float sr = s2[0], si = s2[1];
#pragma unroll
                for (int i = 0; i < 16; ++i) {
                    const float tr = __builtin_fmaf(-abi, si, bre[i >> 2][i & 3]), ti = __builtin_fmaf(abi, sr, bim[i >> 2][i & 3]);
                    sr = __builtin_fmaf(abr, sr, tr); si = __builtin_fmaf(abr, si, ti);
                    asm volatile("" : "+v"(sr), "+v"(si));
                    *(LAS unsigned*)(stS0 + p1 * 4352 + i * 272 + 4 * lane) = pk2(sr, si); }
                s2 = (f32x2){sr, si};
                __builtin_amdgcn_s_setprio(0);
            }
            if ((DBG_TMASK & 0x300000u) && ((DBG_TLAYER >> l) & 1u) && role == (int)((DBG_TMASK >> 21) & 1u)) { LDS_WAIT(); t_acc += wall_clock64() - tb0_; }
            LDS_WAIT(); __builtin_amdgcn_s_barrier(); asm volatile("" ::: "memory");
        }
    }
    VM_WAIT();
    __syncthreads();
    TSUB(19);
    const float* dsk = inp(F, I_SD) + l * 512 + gp * 32;
    static_assert((LCTX + LSEQ) * 4 % (512 * 3) == 0, "combine batches");
#pragma unroll 1
    for (int e0 = F.tid; e0 < (LCTX + LSEQ) * 4; e0 += 512 * 3) {
        const int pc = e0 & 3; size_t off[3]; v4u uw[3], fw[3], bw[3];
#pragma unroll
        for (int j = 0; j < 3; ++j) { const int rr = (e0 + 512 * j) >> 2; const int row = rr < LSEQ ? b * LSEQ + rr : NX + b * LCTX + (rr - LSEQ);
            off[j] = (size_t)row * 512 + gp * 32 + pc * 8;
            uw[j] = *(const v4u*)(ps5 + off[j]); fw[j] = *(const v4u*)(ydir + off[j]); bw[j] = *(const v4u*)(ydir + (size_t)RT * 512 + off[j]); }
        const f32x4 d0 = *(const f32x4*)(dsk + pc * 8), d1 = *(const f32x4*)(dsk + pc * 8 + 4);
#pragma unroll
        for (int j = 0; j < 3; ++j) {
            f32x4 u0, u1, f0, f1, b0, b1; unpack8(uw[j], u0, u1); unpack8(fw[j], f0, f1); unpack8(bw[j], b0, b1);
            f32x4 o0, o1;
#pragma unroll
            for (int i = 0; i < 4; ++i) { o0[i] = gelu_tanh(f0[i] + b0[i] + d0[i] * u0[i]); o1[i] = gelu_tanh(f1[i] + b1[i] + d1[i] * u1[i]); }
            *(v4u*)((bf16*)(F.ws + WS_SG) + off[j]) = pack8(o0, o1); }
    }
}

__device__ __forceinline__ Frame make_frame(const Args& args, LAS unsigned char* lds, int wave_s);
__device__ __forceinline__ void mixers_phase(const Args& args, LAS unsigned char* lds, int wave_s, int l, unsigned long long& t_acc, unsigned long long& t_prev) {
#ifndef MIXMASK
#define MIXMASK 7
#endif
    if (MIXMASK & 1) { Frame F = make_frame(args, lds, wave_s);
#pragma unroll 1
        for (int u = F.vcu; u < NB * 16; u += F.G) s5_unit(F, l, u >> 4, u & 15, t_acc, t_prev); }
    TSUB(16);
    if (MIXMASK & 2) { Frame F = make_frame(args, lds, wave_s);
#pragma unroll 1
        for (int u = F.vcu; u < 512; u += F.G) hyena_unit(F, l, u, l == 0);
        if (NREP(10) == 2) {
#pragma unroll 1
            for (int u = F.vcu; u < 512; u += F.G) hyena_unit(F, l, u, l == 0); } }
    TSUB(17);
    if (MIXMASK & 4) { Frame F = make_frame(args, lds, wave_s);
        const int ncf = l == 0 ? NB * 32 + NB * 4 : NB * 32;
#pragma unroll 1
        for (int u = F.vcu; u < ncf; u += F.G) { if (u < NB * 32) cf_unit(F, l, u * 64, 64, 0); else { const int q = u - NB * 32; cf_unit(F, l, NX + (q >> 2) * LCTX, LCTX, (q & 3) * 64); } } }
    TSUB(18);
    __syncthreads();
}

constexpr int PH_P0A = 0, PH_P0B = 1, PH_L0 = 2, PH_L1 = 12, N_PHASES = 27;
__device__ __forceinline__ Frame make_frame(const Args& args, LAS unsigned char* lds, int wave_s) {
    unsigned z0 = 0u; asm volatile("" : "+v"(z0));
    Frame F; int t = wave_s * 64 + (int)__builtin_amdgcn_mbcnt_hi(~0u, __builtin_amdgcn_mbcnt_lo(~0u, z0)); asm volatile("" : "+v"(t));
    unsigned char* ws = args.ws; float* out = args.out;
    F.lds = lds; F.tid = t; F.lane = t & 63; F.wave = wave_s;
    int G = gridDim.x, bx = blockIdx.x; asm volatile("" : "+s"(G), "+s"(bx));
    F.G = G; F.vcu = (G % 8 == 0) ? (bx % 8) * (G / 8) + bx / 8 : bx;
    const float* const* inp = args.in;
    F.in = inp; F.out = out; F.ws = ws; return F;
}
__global__ void __launch_bounds__(NWAVES * 64, 2) mega_fwd(Args args) {
    extern __shared__ __attribute__((aligned(16))) unsigned char lds_raw[];
    LAS unsigned char* const lds = (LAS unsigned char*)lds_raw;
    volatile LAS unsigned* MISC = (volatile LAS unsigned*)(lds + MISC_OFF);
    for (int u = threadIdx.x; u < (LDS_BYTES - MISC_OFF) / 4; u += NWAVES * 64) ((LAS unsigned*)(lds + MISC_OFF))[u] = 0u;
    int wave_s = __builtin_amdgcn_readfirstlane((int)threadIdx.x >> 6); asm volatile("" : "+s"(wave_s));
    __syncthreads();
    const int lo = MK_PER_PHASE_LAUNCH ? args.ph_lo : 0, hi = MK_PER_PHASE_LAUNCH ? args.ph_hi : N_PHASES;
    XcdBarrier bar; bar.bar = (unsigned*)(args.ws + WS_CTL) + CW_BAR; bar.x = 0; bar.st = nullptr;
    if (hi - lo > 1) bar = xcd_barrier_post((unsigned*)(args.ws + WS_CTL) + CW_BAR, MISC + 8);
#ifndef PHMASK
#define PHMASK 0xffffffffu
#endif
#define IN(k) (lo <= (k) && (k) < hi)
#define PM(b) ((PHMASK >> (b)) & 1u)
#define SEAM(k) do { if (IN(k) && IN((k) + 1)) xcd_barrier(bar, wave_s); } while (0)
    unsigned long long t_acc = 0, t_prev = DBG_TMASK ? wall_clock64() : 0ull;
#define TSLOT(slot, lyr) do { if (DBG_TMASK) { const unsigned long long now_ = wall_clock64(); if (((DBG_TMASK >> (slot)) & 1u) && ((DBG_TLAYER >> (lyr)) & 1u)) t_acc += now_ - t_prev; t_prev = now_; } } while (0)
#define FRAME() Frame F = make_frame(args, lds, wave_s); const char* ws = (const char*)F.ws; const int c = F.G == (int)gridDim.x ? (int)blockIdx.x : 0; (void)ws; (void)c

    if (PM(0) && IN(PH_P0A)) { FRAME(); REPEAT(NREP(12), p0a_prologue(F)); } SEAM(PH_P0A); TSLOT(0, 0);

#pragma unroll 1
    for (int l = 0; l < 2; ++l) {
        const int pb = l == 0 ? PH_L0 : PH_L1;
        const int nMl = l == 0 ? RT / 256 : NX / 256;
        if (l == 0) {
        if (PM(2) && IN(pb + 0)) { { FRAME(); REPEAT(NREP(8), lnmod_phase(F, l)); } { FRAME(); h2table_phase(F, l); } { FRAME(); s5params_phase(F, l); } } SEAM(pb + 0); TSLOT(2, l); }
        if (PM(3) && IN(pb + 1)) { { FRAME(); REPEAT(NREP(9), filter_expand_phase(F, l)); }
            { FRAME(); SchedPlain S; S.R.init(6, nMl, F.G, c); S.A = ws + WS_WIN + (size_t)l * 6144 * 1024 * 2; S.B = ws + WS_HX; S.tsA = 256 * 1024 * 2; S.tsB = 256 * 1024 * 2; S.xM = 0; S.xN0 = 0; S.xNn = 1;
              EpiHyT E{(bf16*)(F.ws + WS_PHYT)}; pg8::gemm_phase<EpiHyT, SchedPlain>(F.lds, F.tid, 2048, S, E); }
            { FRAME(); SchedPlain S; S.R.init(nMl, 6, F.G, (c + (F.G * 3) / 8) % F.G); S.A = ws + WS_HX; S.B = ws + WS_WIN + ((size_t)l * 6144 + 1536) * 1024 * 2; S.tsA = 256 * 1024 * 2; S.tsB = 256 * 1024 * 2;
              S.xM = l == 0 ? 0 : NCX / 256; S.xN0 = 4; S.xNn = 2;
              EpiInproj E{(bf16*)(F.ws + WS_PHYT), (bf16*)(F.ws + WS_UCF), (bf16*)(F.ws + WS_PS5), 6};
              pg8::gemm_phase<EpiInproj, SchedPlain>(F.lds, F.tid, 2048, S, E); }
        } SEAM(pb + 1); TSLOT(3, l);
        if (PM(4) && IN(pb + 2)) { mixers_phase(args, lds, wave_s, l, t_acc, t_prev); } SEAM(pb + 2); TSLOT(4, l);
        if (PM(5) && IN(pb + 3)) {
            { FRAME(); zt_transpose_phase(F, l == 0 ? RT : NX); }
            { FRAME(); SchedPlain S; S.R.init(nMl, 12, F.G, c); S.A = ws + WS_HX; S.B = ws + WS_WIN + ((size_t)l * 6144 + 3072) * 1024 * 2; S.tsA = 256 * 1024 * 2; S.tsB = 256 * 1024 * 2; S.xM = 0; S.xN0 = 0; S.xNn = 1;
              EpiGates E{(bf16*)(F.ws + WS_G), F.tid}; REPEAT(NREP(1), pg8::gemm_phase<EpiGates, SchedPlain>(F.lds, F.tid, 2048, S, E, (DBG_TMASK & 0x1000000u) && l == 0 ? &t_acc : nullptr)); }
#ifndef DBG_SKIP_GLU
            { FRAME(); SchedPlain S; S.R.init(nMl, 2, F.G, (c + F.G / 4) % F.G); S.A = ws + WS_SG; S.B = ws + WS_WGLU + (size_t)l * 512 * 512 * 2; S.tsA = 256 * 512 * 2; S.tsB = 256 * 512 * 2; S.xM = 0; S.xN0 = 0; S.xNn = 1;
              EpiGlu E{(const bf16*)(F.ws + WS_SG), (bf16*)(F.ws + WS_S5Y), inp(F, I_SBGLU) + l * 512}; REPEAT(NREP(2), pg8::gemm_phase<EpiGlu, SchedPlain>(F.lds, F.tid, 1024, S, E)); }
#endif
        } SEAM(pb + 3); TSLOT(5, l);
        if (PM(6) && IN(pb + 4)) { FRAME();
            SchedMerge S; S.R.init(nMl, 4, F.G, c); S.A = ws + WS_Z2; S.sA = WS_UCF2 - WS_Z2; S.B = ws + WS_WOUTS + (size_t)(l * 3) * 1024 * 512 * 2; S.sB = (size_t)1024 * 512 * 2;
            S.tsA = 256 * 512 * 2; S.tsB = 256 * 512 * 2;
            EpiMerge E{(const bf16*)(F.ws + WS_G), (bf16*)(F.ws + WS_HX), F.tid};
            REPEAT(NREP(3), pg8::gemm_phase<EpiMerge, SchedMerge>(F.lds, F.tid, 1024, S, E));
        } SEAM(pb + 4); TSLOT(6, l);
        if (PM(7) && IN(pb + 5)) { FRAME();
            SchedPlain S; S.R.init(nMl, 4, F.G, c); S.A = ws + WS_HX; S.B = ws + WS_WO + (size_t)l * 1024 * 1024 * 2; S.tsA = 256 * 1024 * 2; S.tsB = 256 * 1024 * 2; S.xM = 0; S.xN0 = 0; S.xNn = 1;
            EpiRes E{l == 0 ? inp(F, I_X) : F.out, l == 0 ? inp(F, I_CTX) : (const float*)(F.ws + WS_XC), (bf16*)(F.ws + WS_KRL), (const float*)(F.ws + WS_MODS) + (size_t)l * 17 * INC + 2 * 1024, 1.0f};
            REPEAT(((l == 0) ? NREP(4) : 1), pg8::gemm_phase<EpiRes, SchedPlain>(F.lds, F.tid, 2048, S, E));
        } SEAM(pb + 5); TSLOT(7, l);
        if (PM(8) && IN(pb + 6)) { { FRAME(); if (l == 0) ln1_phase<false>(F, l); else ln1_phase<true>(F, l); } if (l == 1) { FRAME(); REPEAT(NREP(13), moe_convert_phase(F)); } } SEAM(pb + 6); TSLOT(8, l);
        if (l == 0) {
            if (PM(9) && IN(pb + 7)) { FRAME();
                SchedPlain S; S.R.init(RT / 256, 22, F.G, c); S.A = ws + WS_HX; S.B = ws + WS_W13; S.tsA = 256 * 1024; S.tsB = 256 * 1024; S.xM = 0; S.xN0 = 0; S.xNn = 1;
                EpiSwigluF8 E{F.ws + WS_G, DFF, 0.03125f}; REPEAT(NREP(5), pg8::gemm_phase<EpiSwigluF8, SchedPlain, true>(F.lds, F.tid, 1024, S, E, (DBG_TMASK & 0x1000000u) ? nullptr : &t_acc));
            } SEAM(pb + 7); TSLOT(9, 0);
            if (PM(10) && IN(pb + 8)) { FRAME();
                SchedPlain S; S.R.init(RT / 256, 4, F.G, c); S.A = ws + WS_G; S.B = ws + WS_W2; S.tsA = (size_t)256 * DFF; S.tsB = (size_t)256 * DFF; S.xM = 0; S.xN0 = 0; S.xNn = 1;
                EpiRes E{F.out, (const float*)(F.ws + WS_XC), (bf16*)(F.ws + WS_KRL), (const float*)(F.ws + WS_MODS) + 5 * 1024, 0.0078125f};
                pg8::gemm_phase<EpiRes, SchedPlain, true>(F.lds, F.tid, DFF, S, E);
            } SEAM(pb + 8); TSLOT(10, 0);
            if (PM(11) && IN(pb + 9)) { { FRAME(); ln2_phase(F, l); } { FRAME(); h2table_phase(F, 1); } { FRAME(); s5params_phase(F, 1); } } SEAM(pb + 9); TSLOT(11, 0);
        } else {
            if (PM(15) && IN(pb + 7)) { FRAME(); moe_setup_phase(F); } SEAM(pb + 7); TSLOT(12, 1);
#pragma unroll 1
            for (int st = 0; st < 6; ++st) {
                if (PM(13) && IN(pb + 8 + st) && st >= 1) { FRAME(); const int* tile_e = (const int*)(F.ws + WS_META + META_TILE); const int ch = st - 1;
                    const int ntiles = tile_e[511]; int nmc = ntiles - 64 * ch; nmc = nmc < 0 ? 0 : (nmc > 64 ? 64 : nmc);
                    SchedMoe S; S.R.init(nmc, 4, F.G, c); S.A = ws + WS_HID + (size_t)(ch & 1) * HID_BUF; S.B = ws + WS_MW2; S.tsA = (size_t)256 * DEX; S.tsB = (size_t)256 * DEX; S.esB = (size_t)1024 * DEX; S.tile_e = tile_e; S.tile0 = 64 * ch; S.a_global = false; S.preload();
                    EpiMoeDown E{(bf16*)(F.ws + WS_MOEY), 0.0078125f}; REPEAT(NREP(7), pg8::gemm_phase<EpiMoeDown, SchedMoe, true>(F.lds, F.tid, DEX, S, E));
                }
                if (PM(12) && IN(pb + 8 + st) && st <= 4) { FRAME(); const int* tile_e = (const int*)(F.ws + WS_META + META_TILE); const int ch = st;
                    const int ntiles = tile_e[511]; int nmc = ntiles - 64 * ch; nmc = nmc < 0 ? 0 : (nmc > 64 ? 64 : nmc);
                    SchedMoe S; S.R.init(nmc, 28, F.G, c); S.A = ws + WS_SORT; S.B = ws + WS_MW13; S.tsA = 256 * 1024; S.tsB = 256 * 1024; S.esB = (size_t)7168 * 1024; S.tile_e = tile_e; S.tile0 = 64 * ch; S.a_global = true; S.preload();
                    EpiSwigluF8 E{F.ws + WS_HID + (size_t)(ch & 1) * HID_BUF, DEX, 0.03125f}; REPEAT(NREP(6), pg8::gemm_phase<EpiSwigluF8, SchedMoe, true>(F.lds, F.tid, 1024, S, E));
                }
                SEAM(pb + 8 + st); TSLOT(13, 1);
            }
            if (PM(14) && IN(pb + 14)) { FRAME(); moe_combine_phase(F); } TSLOT(14, 1);
        }
    }
    if (DBG_TMASK) { const unsigned long long t0_ = wall_clock64(); while (wall_clock64() - t0_ < t_acc) __builtin_amdgcn_s_sleep(16); }
#undef IN
#undef SEAM
#undef FRAME
}


#ifdef DBG_DUMP
__global__ void dbg_dump(const unsigned char* ws, float* out) {
    const size_t NE = (size_t)RT * 512; const bf16* a = (const bf16*)(ws + WS_PS5); const bf16* b = (const bf16*)(ws + WS_Z2); const bf16* c = (const bf16*)(ws + WS_UCF2);
    for (size_t i = (size_t)blockIdx.x * blockDim.x + threadIdx.x; i < (size_t)NX * DM; i += (size_t)gridDim.x * blockDim.x) {
        const size_t j = i % NE; const int k = (int)(i / NE);
        float v;
        if (DBG_DUMP == 8) v = i < (size_t)26 * 1024 * 1024 ? bf2f(((const bf16*)(ws + WS_WIN))[i]) : 0.f;
        else if (DBG_DUMP == 7) v = k == 0 ? bf2f(a[j]) : bf2f(((const bf16*)(ws + WS_UCF))[j]);
        else if (DBG_DUMP == 4) v = bf2f(((const bf16*)(ws + WS_HX))[i]);
        else if (DBG_DUMP == 5) v = bf2f(((const bf16*)(ws + WS_G))[i]);
        else if (DBG_DUMP == 6) v = bf2f(((const bf16*)(ws + WS_S5Y))[i % NE]);
        else if (DBG_DUMP == 1) v = k == 0 ? bf2f(a[j]) : bf2f(b[j]);
        else if (DBG_DUMP == 2) v = k == 0 ? bf2f(b[j]) : bf2f(c[j]);
        else v = k == 0 ? bf2f(c[j]) : bf2f(a[j]);
        out[i] = v;
    }
}
#endif
extern "C" void kernel_launch(void* const* d_in, const int* in_sizes, int n_in, void* d_out, int out_size, void* d_ws, size_t ws_size, hipStream_t stream) {
    static int grid = 0;
    if (grid == 0) {
        if (n_in != N_IN || out_size != NX * DM || ws_size < WS_END2) { fprintf(stderr, "kernel_launch: unexpected shapes (n_in %d, out %d, ws %zu)\n", n_in, out_size, ws_size); grid = -1; return; }
        int dev = 0, cus = 0, per_cu = 0;
        if (hipGetDevice(&dev) != hipSuccess || hipDeviceGetAttribute(&cus, hipDeviceAttributeMultiprocessorCount, dev) != hipSuccess) { grid = -1; return; }
        if (hipFuncSetAttribute((const void*)mega_fwd, hipFuncAttributeMaxDynamicSharedMemorySize, LDS_BYTES) != hipSuccess) { fprintf(stderr, "kernel_launch: hipFuncSetAttribute failed\n"); grid = -1; return; }
        if (hipOccupancyMaxActiveBlocksPerMultiprocessor(&per_cu, (const void*)mega_fwd, NWAVES * 64, LDS_BYTES) != hipSuccess || per_cu < 1) fprintf(stderr, "kernel_launch: occupancy query reports %d\n", per_cu);
        (void)hipGetLastError();
        grid = cus;
    }
    if (grid < 0) return;
    (void)hipMemsetAsync((char*)d_ws + WS_CTL, 0, CTL_ZERO_BYTES, stream);
    Args a{};
    for (int i = 0; i < N_IN; ++i) a.in[i] = (const float*)d_in[i];
    a.out = (float*)d_out; a.ws = (unsigned char*)d_ws;
#if MK_PER_PHASE_LAUNCH
    for (int p = 0; p < DBG_NPH; ++p) { a.ph_lo = p; a.ph_hi = p + 1; hipLaunchKernelGGL(mega_fwd, dim3(grid), dim3(NWAVES * 64), LDS_BYTES, stream, a); }
#ifdef DBG_DUMP
    hipLaunchKernelGGL(dbg_dump, dim3(2048), dim3(256), 0, stream, (const unsigned char*)d_ws, (float*)d_out);
#endif
#else
    a.ph_lo = 0; a.ph_hi = N_PHASES; hipLaunchKernelGGL(mega_fwd, dim3(grid), dim3(NWAVES * 64), LDS_BYTES, stream, a);
#endif
}
```

```cpp
#include <hip/hip_runtime.h>
#include <cstdio>
#include <cstdint>

#ifndef DBG_REP
#define DBG_REP 0
#endif
#define NREP(bit) (((DBG_REP >> (bit)) & 1) ? 2 : 1)
#define REPEAT(n, ...) do { __VA_ARGS__; if ((n) == 2) { __VA_ARGS__; } } while (0)
#ifndef DBG_NPH
#define DBG_NPH N_PHASES
#define DBG_TMASK 0u
#define DBG_TLAYER 3u
#endif
#ifndef MK_PER_PHASE_LAUNCH
#define MK_PER_PHASE_LAUNCH 0
#endif

#define GAS __attribute__((address_space(1)))
#define LAS __attribute__((address_space(3)))
typedef unsigned short bf16;
typedef unsigned v4u __attribute__((ext_vector_type(4)));
typedef unsigned v2u __attribute__((ext_vector_type(2)));
typedef float f32x4 __attribute__((ext_vector_type(4)));
typedef float f32x2 __attribute__((ext_vector_type(2)));
typedef short bf16x8 __attribute__((ext_vector_type(8)));

constexpr int NB = 16, LSEQ = 2048, LCTX = 256, DM = 1024;
constexpr int NX = NB * LSEQ;
constexpr int NCX = NB * LCTX;
constexpr int RT = NX + NCX;
constexpr int INC = 6144, DFF = 2816, DEX = 3584, NEXP = 8;
constexpr float ALPHA_F = 1.41421356237f;
constexpr float LN_EPS = 1e-5f;

enum { I_X = 0, I_C, I_CTX, I_CCTX, I_WMOD, I_BMOD, I_WIN, I_HSW, I_HSB, I_FW1, I_FB1, I_FW2, I_FB2, I_FW3, I_FB3, I_FREQ, I_DECAY, I_HBIAS, I_WHY,
       I_CFW, I_CFB, I_CFG, I_CFLB, I_WCF, I_SARE, I_SAIM, I_SLDT, I_SBRE, I_SBIM, I_SCRE, I_SCIM, I_SD, I_SWGLU, I_SBGLU, I_WS5, I_WO,
       I_LN1G, I_LN1B, I_LN2G, I_LN2B, I_FFW1, I_FFW3, I_FFW2, I_ROUTER, I_MW1, I_MW3, I_MW2, N_IN };

constexpr size_t MiB = 1u << 20;
constexpr size_t WS_CTL = 0, CTL_ZERO_BYTES = 1 * MiB;
constexpr size_t WS_MODS = 1 * MiB;
constexpr size_t WS_S5P = 2 * MiB;
constexpr size_t WS_META = 3 * MiB;
constexpr size_t WS_FILT = 4 * MiB;
constexpr size_t WS_XC = 22 * MiB;
constexpr size_t WS_WIN = 38 * MiB;
constexpr size_t WS_WOUTS = 62 * MiB;
constexpr size_t WS_WGLU = 68 * MiB;
constexpr size_t WS_WO = 69 * MiB;
constexpr size_t WS_W13 = 73 * MiB;
constexpr size_t WS_W2 = 84 * MiB;
constexpr size_t WS_HX = 90 * MiB;
constexpr size_t WS_G = 162 * MiB;
constexpr size_t WS_PHYT = WS_G, WS_YDIR = WS_G + 108 * MiB, WS_UCF = WS_G + 180 * MiB;
constexpr size_t WS_PS5 = 378 * MiB;
constexpr size_t WS_Z2 = 414 * MiB;
constexpr size_t WS_UCF2 = 450 * MiB;
constexpr size_t WS_S5Y = 486 * MiB;
constexpr size_t WS_KRL = 522 * MiB;
constexpr size_t WS_KRC = 586 * MiB;
constexpr size_t WS_SG = 596 * MiB;
constexpr size_t WS_KDUMMY = 594 * MiB;
constexpr size_t WS_END = 595 * MiB;
constexpr size_t WS_SORT = 90 * MiB;
constexpr size_t WS_MOEY = 156 * MiB;
constexpr size_t WS_MW13 = 288 * MiB;
constexpr size_t WS_MW2 = 344 * MiB;
constexpr size_t WS_HID = 372 * MiB;
constexpr int MOE_CH = 264, MOE_NST = (264 + MOE_CH - 1) / MOE_CH + 1;
constexpr size_t HID_BUF = (size_t)MOE_CH * 256 * 3584;
static_assert(372 * MiB + (MOE_NST > 2 ? 2 : 1) * HID_BUF <= 632 * MiB, "hidden buffers");
constexpr size_t WS_END2 = 632 * MiB;
static_assert(WS_HID + (size_t)67584 * 3584 <= WS_END2, "moe map");
constexpr size_t META_BCNT = 800 * 1024;
constexpr size_t META_TOKE = 0, META_TOKW = 256 * 1024, META_POS = 512 * 1024, META_TILE = 768 * 1024;
constexpr int CW_BAR = 4096;
constexpr int CW_CNT = 8192, CW_CUR = 8256;

constexpr int LDS_BYTES = 155648;
constexpr int MISC_OFF = 147456;
constexpr int NWAVES = 8;

typedef __bf16 bf2_t __attribute__((ext_vector_type(2)));
__device__ __forceinline__ unsigned pk2(float lo, float hi) { bf2_t v; v.x = (__bf16)lo; v.y = (__bf16)hi; return __builtin_bit_cast(unsigned, v); }
__device__ __forceinline__ unsigned f2bf(float f) { return (unsigned)__builtin_bit_cast(unsigned short, (__bf16)f); }
__device__ __forceinline__ unsigned pk4_fp8(float a, float b, float c, float d) { int w = 0; w = __builtin_amdgcn_cvt_pk_fp8_f32(a, b, w, false); w = __builtin_amdgcn_cvt_pk_fp8_f32(c, d, w, true); return (unsigned)w; }
__device__ __forceinline__ float bf2f(unsigned short b) { return __builtin_bit_cast(float, ((unsigned)b) << 16); }
__device__ __forceinline__ float bflo(unsigned w) { return __builtin_bit_cast(float, w << 16); }
__device__ __forceinline__ float bfhi(unsigned w) { return __builtin_bit_cast(float, w & 0xffff0000u); }
__device__ __forceinline__ float sigmoidf_(float x) { return __builtin_amdgcn_rcpf(1.0f + __expf(-x)); }
__device__ __forceinline__ float siluf_(float x) { return x * sigmoidf_(x); }
__device__ __forceinline__ float gelu_tanh(float x) { const float y = 0.7978845608028654f * (x + 0.044715f * x * x * x); const float e = __expf(2.0f * y); const float th = 1.0f - 2.0f * __builtin_amdgcn_rcpf(e + 1.0f); return 0.5f * x * (1.0f + th); }
__device__ __forceinline__ float wave_sum(float v) {
    v += __builtin_bit_cast(float, __builtin_amdgcn_mov_dpp(__builtin_bit_cast(int, v), 0xB1, 0xf, 0xf, true));
    v += __builtin_bit_cast(float, __builtin_amdgcn_mov_dpp(__builtin_bit_cast(int, v), 0x4E, 0xf, 0xf, true));
    v += __builtin_bit_cast(float, __builtin_amdgcn_mov_dpp(__builtin_bit_cast(int, v), 0x141, 0xf, 0xf, true));
    v += __builtin_bit_cast(float, __builtin_amdgcn_mov_dpp(__builtin_bit_cast(int, v), 0x140, 0xf, 0xf, true));
    v += __builtin_bit_cast(float, __builtin_amdgcn_ds_swizzle(__builtin_bit_cast(int, v), 0x401F));
    const unsigned u = __builtin_bit_cast(unsigned, v); const auto r = __builtin_amdgcn_permlane32_swap(u, u, false, false);
    return __builtin_bit_cast(float, (unsigned)r[0]) + __builtin_bit_cast(float, (unsigned)r[1]);
}
__device__ __forceinline__ float lane_bcast(float v, int k) { return __builtin_bit_cast(float, __builtin_amdgcn_readlane(__builtin_bit_cast(int, v), k)); }
#define LDS_WAIT() asm volatile("s_waitcnt lgkmcnt(0)" ::: "memory")
#define VM_WAIT() asm volatile("s_waitcnt vmcnt(0)" ::: "memory")

namespace pg8 {
#define PG8_LAS __attribute__((address_space(3)))
constexpr int BM = 256, BK = 64, HALF = 128, HTB = HALF * BK * 2, STAGE_BYTES = 8 * HTB, NXCD = 8, WGM = 8;
__host__ __device__ __forceinline__ int lds_byte(int r, int c) { const int st = (r >> 4) * 2 + (c >> 5), rr = r & 15, cc = c & 31, ob = rr * 64 + cc * 2; return st * 1024 + (ob ^ (((ob >> 9) & 1) << 5)); }
__host__ __device__ __forceinline__ void stage_rc(int b, int& R, int& C) { const int st = b / 1024, sb = b % 1024, swz = sb ^ (((sb >> 9) & 1) << 5); R = (st >> 1) * 16 + swz / 64; C = (st & 1) * 32 + (swz % 64) / 2; }
__host__ __device__ __forceinline__ int perm32(int rho) { const int n = rho >> 4, i = rho & 15; return 8 * (i >> 2) + 4 * n + (i & 3); }

struct Unit { int pm, pn, seg, ex; const char* A; const char* B; };

struct Rect {
    int nM, nN, nwg, G, c;
    __device__ __forceinline__ void init(int nM_, int nN_, int G_, int c_) { nM = nM_; nN = nN_; nwg = nM * nN; G = G_; c = c_; }
    __device__ __forceinline__ bool map(int L, int& pm, int& pn) const {
        if (L >= nwg) return false;
        int wgid = L; { const int q = nwg / NXCD, r = nwg % NXCD, xcd = wgid % NXCD, off = wgid / NXCD; wgid = (xcd < r ? xcd * (q + 1) : r * (q + 1) + (xcd - r) * q) + off; }
        const int nig = WGM * nN, gid = wgid / nig, fm = gid * WGM, gsz = (nM - fm) < WGM ? (nM - fm) : WGM;
        pm = fm + ((wgid % nig) % gsz); pn = (wgid % nig) / gsz; return true;
    }
};

__device__ __forceinline__ unsigned cvt_pk_bf16(float lo, float hi) { return pk2(lo, hi); }

typedef int v8i_t __attribute__((ext_vector_type(8)));
typedef int v4i_t __attribute__((ext_vector_type(4)));
__device__ __forceinline__ v8i_t cat8(const bf16x8 a, const bf16x8 b) { return __builtin_shufflevector(__builtin_bit_cast(v4i_t, a), __builtin_bit_cast(v4i_t, b), 0, 1, 2, 3, 4, 5, 6, 7); }
__device__ __forceinline__ bf16x8 lo8(const v8i_t v) { return __builtin_bit_cast(bf16x8, __builtin_shufflevector(v, v, 0, 1, 2, 3)); }
__device__ __forceinline__ bf16x8 hi8(const v8i_t v) { return __builtin_bit_cast(bf16x8, __builtin_shufflevector(v, v, 4, 5, 6, 7)); }
template <class E, class = void> struct epi_chain { static constexpr bool value = false; };
template <class E> struct epi_chain<E, decltype((void)E::CHAIN)> { static constexpr bool value = E::CHAIN; };
template <class Epi, class Sched, bool F8 = false, bool ALIGN_EPI = true, bool SP2 = true>
__device__ __forceinline__ void gemm_phase(PG8_LAS unsigned char* lds, const int tid, const int KB, const Sched& S, const Epi& E, unsigned long long* tm = nullptr) {
    const int wid = __builtin_amdgcn_readfirstlane(tid >> 6), lane = tid & 63, wr = wid >> 2, wc = wid & 3, fr = lane & 15, fq = lane >> 4;
    const int nt = KB / (BK * 2);
    unsigned voffA[2], voffB[2];
#pragma unroll
    for (int i = 0; i < 2; ++i) { int R, C; stage_rc(tid * 16 + i * 8192, R, C); const int Rb = Epi::PERM ? ((R & ~31) + perm32(R & 31)) : R;
        voffA[i] = (unsigned)(R * KB + C * 2); voffB[i] = (unsigned)(Rb * KB + C * 2); }
    const size_t kstep = (size_t)(BK * 2);
    const size_t hstep = (size_t)HALF * KB;
    const unsigned ldsw = (unsigned)wid * 1024u;
    const int aoff = lds_byte(wr * 64 + fr, fq * 8), boff = lds_byte(wc * 32 + fr, fq * 8);
    constexpr int KOFF = 1024;
#define PG8_SA(b, h) (((b) * 2 + (h)) * HTB)
#define PG8_SB(b, h) ((4 + (b) * 2 + (h)) * HTB)
#define PG8_STAGE(bufoff, gbase, voff) do { _Pragma("unroll") for (int _i = 0; _i < 2; ++_i) \
        __builtin_amdgcn_global_load_lds((const unsigned*)((const char*)(gbase) + (voff)[_i]), (PG8_LAS unsigned*)(lds + (bufoff) + ldsw + _i * 8192), 16, 0, 0); } while (0)
#define PG8_LDA(dst, b, h) do { _Pragma("unroll") for (int m = 0; m < 4; ++m) dst[m] = cat8(*(const PG8_LAS bf16x8*)(lds + PG8_SA(b, h) + aoff + m * 2048), *(const PG8_LAS bf16x8*)(lds + PG8_SA(b, h) + aoff + m * 2048 + KOFF)); } while (0)
#define PG8_LDB(dst, b, h) do { _Pragma("unroll") for (int n = 0; n < 2; ++n) dst[n] = cat8(*(const PG8_LAS bf16x8*)(lds + PG8_SB(b, h) + boff + n * 2048), *(const PG8_LAS bf16x8*)(lds + PG8_SB(b, h) + boff + n * 2048 + KOFF)); } while (0)
#define PG8_MMA(ai, bj, At, Bt) do { __builtin_amdgcn_s_setprio(1); _Pragma("unroll") for (int m = 0; m < 4; ++m) _Pragma("unroll") for (int n = 0; n < 2; ++n) { \
        if constexpr (F8) asm volatile("v_mfma_scale_f32_16x16x128_f8f6f4 %0, %1, %2, %0, %3, %3 op_sel_hi:[0,0,0]" : "+v"(acc[ai][bj][m][n]) : "v"(Bt[n]), "v"(At[m]), "v"(sc1)); \
        else { acc[ai][bj][m][n] = __builtin_amdgcn_mfma_f32_16x16x32_bf16(lo8(Bt[n]), lo8(At[m]), acc[ai][bj][m][n], 0, 0, 0); \
               acc[ai][bj][m][n] = __builtin_amdgcn_mfma_f32_16x16x32_bf16(hi8(Bt[n]), hi8(At[m]), acc[ai][bj][m][n], 0, 0, 0); } } \
        __builtin_amdgcn_s_setprio(0); } while (0)
#define PG8_WAIT_V(n) asm volatile("s_waitcnt vmcnt(" #n ")" ::: "memory")
#define PG8_WAIT_L(n) asm volatile("s_waitcnt lgkmcnt(" #n ")" ::: "memory")
#define PG8_BAR __builtin_amdgcn_s_barrier()
#define PG8_SCHED __builtin_amdgcn_sched_barrier(0)
    const int sc1 = 0x7f7f7f7f;
    Unit cur, nxt; int ui = 0;
    if (!S.next(0, cur)) return;
    f32x4 acc[2][2][4][2];
#pragma unroll
    for (int a = 0; a < 2; ++a)
#pragma unroll
        for (int b = 0; b < 2; ++b)
#pragma unroll
            for (int m = 0; m < 4; ++m)
#pragma unroll
                for (int n = 0; n < 2; ++n) acc[a][b][m][n] = (f32x4){0.f, 0.f, 0.f, 0.f};
    v8i_t At[4], B0[2], B1[2];
    const char* cA = cur.A; const char* cB = cur.B;
    if constexpr (SP2) {
        PG8_STAGE(PG8_SB(0, 0), cB, voffB); PG8_STAGE(PG8_SB(0, 1), cB + hstep, voffB); PG8_STAGE(PG8_SA(0, 0), cA, voffA); PG8_STAGE(PG8_SA(0, 1), cA + hstep, voffA);
        if (wr == 1) PG8_BAR;
        PG8_WAIT_V(2); PG8_BAR;
        PG8_STAGE(PG8_SB(1, 0), cB + kstep, voffB); PG8_STAGE(PG8_SA(1, 0), cA + kstep, voffA); PG8_STAGE(PG8_SB(1, 1), cB + hstep + kstep, voffB);
        PG8_WAIT_V(6); PG8_BAR;
    } else {
        PG8_STAGE(PG8_SB(0, 0), cB, voffB); PG8_STAGE(PG8_SA(0, 0), cA, voffA); PG8_STAGE(PG8_SB(0, 1), cB + hstep, voffB); PG8_STAGE(PG8_SA(0, 1), cA + hstep, voffA);
        if (wr == 1) PG8_BAR;
        PG8_WAIT_V(4); PG8_BAR;
        PG8_STAGE(PG8_SB(1, 0), cB + kstep, voffB); PG8_STAGE(PG8_SA(1, 0), cA + kstep, voffA); PG8_STAGE(PG8_SB(1, 1), cB + hstep + kstep, voffB);
        PG8_WAIT_V(6); PG8_BAR;
    }
    for (;;) {
        const bool has_next = S.next(ui + 1, nxt);
        const char* nA = has_next ? nxt.A : cA; const char* nB = has_next ? nxt.B : cB;
        unsigned long long tk0_ = 0; if ((DBG_TMASK & 0x800000u) && tm) tk0_ = wall_clock64();
#pragma unroll 1
        for (int t = 0; t < nt; t += 2) {
            const bool last = (t == nt - 2);
            const char* a1 = cA + (size_t)(t + 1) * kstep;
            const char* a2 = last ? nA : cA + (size_t)(t + 2) * kstep; const char* b2 = last ? nB : cB + (size_t)(t + 2) * kstep;
            const char* a3 = a2 + kstep; const char* b3 = b2 + kstep;
            if constexpr (SP2) {
            PG8_LDB(B0, 0, 0); PG8_LDB(B1, 0, 1); PG8_SCHED; PG8_LDA(At, 0, 0); PG8_STAGE(PG8_SA(1, 1), a1 + hstep, voffA);
            PG8_WAIT_V(8); PG8_WAIT_L(0); PG8_BAR; PG8_MMA(0, 0, At, B0); PG8_MMA(0, 1, At, B1); PG8_BAR; PG8_SCHED;
            PG8_LDA(At, 0, 1); PG8_STAGE(PG8_SB(0, 0), b2, voffB); PG8_STAGE(PG8_SB(0, 1), b2 + hstep, voffB); PG8_STAGE(PG8_SA(0, 0), a2, voffA);
            PG8_WAIT_V(8); PG8_WAIT_L(0); PG8_BAR; PG8_MMA(1, 0, At, B0); PG8_MMA(1, 1, At, B1); PG8_BAR; PG8_SCHED;
            PG8_LDB(B0, 1, 0); PG8_LDB(B1, 1, 1); PG8_SCHED; PG8_LDA(At, 1, 0); PG8_STAGE(PG8_SA(0, 1), a2 + hstep, voffA);
            PG8_WAIT_V(8); PG8_WAIT_L(0); PG8_BAR; PG8_MMA(0, 0, At, B0); PG8_MMA(0, 1, At, B1); PG8_BAR; PG8_SCHED;
            PG8_LDA(At, 1, 1); PG8_STAGE(PG8_SB(1, 0), b3, voffB); PG8_STAGE(PG8_SB(1, 1), b3 + hstep, voffB); PG8_STAGE(PG8_SA(1, 0), a3, voffA);
            PG8_WAIT_V(8); PG8_WAIT_L(0); PG8_BAR; PG8_MMA(1, 0, At, B0); PG8_MMA(1, 1, At, B1); PG8_BAR; PG8_SCHED;
            } else {
            PG8_LDB(B0, 0, 0); PG8_SCHED; PG8_LDA(At, 0, 0); PG8_STAGE(PG8_SA(1, 1), a1 + hstep, voffA);
            PG8_WAIT_L(8); PG8_BAR; PG8_WAIT_L(0); PG8_MMA(0, 0, At, B0); PG8_BAR; PG8_SCHED;
            PG8_LDB(B1, 0, 1); PG8_STAGE(PG8_SB(0, 0), b2, voffB);
            PG8_BAR; PG8_WAIT_L(0); PG8_MMA(0, 1, At, B1); PG8_BAR;
            PG8_LDA(At, 0, 1); PG8_STAGE(PG8_SA(0, 0), a2, voffA);
            PG8_BAR; PG8_WAIT_L(0); PG8_MMA(1, 0, At, B0); PG8_BAR; PG8_SCHED;
            PG8_STAGE(PG8_SB(0, 1), b2 + hstep, voffB);
            PG8_WAIT_V(6); PG8_BAR; PG8_MMA(1, 1, At, B1); PG8_BAR;
            PG8_LDB(B0, 1, 0); PG8_SCHED; PG8_LDA(At, 1, 0); PG8_STAGE(PG8_SA(0, 1), a2 + hstep, voffA);
            PG8_WAIT_L(8); PG8_BAR; PG8_WAIT_L(0); PG8_MMA(0, 0, At, B0); PG8_BAR; PG8_SCHED;
            PG8_LDB(B1, 1, 1); PG8_STAGE(PG8_SB(1, 0), b3, voffB);
            PG8_BAR; PG8_WAIT_L(0); PG8_MMA(0, 1, At, B1); PG8_BAR;
            PG8_LDA(At, 1, 1); PG8_STAGE(PG8_SA(1, 0), a3, voffA);
            PG8_BAR; PG8_WAIT_L(0); PG8_MMA(1, 0, At, B0); PG8_BAR; PG8_SCHED;
            PG8_STAGE(PG8_SB(1, 1), b3 + hstep, voffB);
            PG8_WAIT_V(6); PG8_BAR; PG8_MMA(1, 1, At, B1); PG8_BAR;
            }
        }
        if ((DBG_TMASK & 0x800000u) && tm) *tm += wall_clock64() - tk0_;
        if constexpr (F8) asm volatile("s_nop 15\n\ts_nop 15" ::: "memory");
        if constexpr (ALIGN_EPI) { if (wr == 0) PG8_BAR; }
        bool chained = false;
        if constexpr (epi_chain<Epi>::value) chained = cur.seg < 2;
        if constexpr (epi_chain<Epi>::value) { if (chained) E.mid(acc, cur, wr, wc, fr, fq); else E(acc, cur, wr, wc, fr, fq); }
        else {
        if ((DBG_TMASK & 0x400000u) && tm) { const unsigned long long t0_ = wall_clock64(); E(acc, cur, wr, wc, fr, fq); asm volatile("s_waitcnt vmcnt(0)" ::: "memory"); *tm += wall_clock64() - t0_; }
        else E(acc, cur, wr, wc, fr, fq);
        }
        if (!has_next) break;
#pragma unroll
        for (int a = 0; a < 2; ++a)
#pragma unroll
            for (int b = 0; b < 2; ++b)
#pragma unroll
                for (int m = 0; m < 4; ++m)
#pragma unroll
                    for (int n = 0; n < 2; ++n)
#pragma unroll
                        for (int j = 0; j < 4; ++j) acc[a][b][m][n][j] = chained ? acc[a][b][m][n][j] : 0.f;
        cur = nxt; cA = nA; cB = nB; ++ui;
        if constexpr (ALIGN_EPI) { if (wr == 1) PG8_BAR; }
    }
    PG8_WAIT_V(0);
    if constexpr (!ALIGN_EPI) { if (wr == 0) PG8_BAR; }
    PG8_BAR;
#undef PG8_SA
#undef PG8_SB
#undef PG8_STAGE
#undef PG8_LDA
#undef PG8_LDB
#undef PG8_MMA
#undef PG8_WAIT_V
#undef PG8_WAIT_L
#undef PG8_BAR
#undef PG8_SCHED
}
}
using pg8::Unit;

#define XB_TMO      128
#define XB_XCNT(j)  (256  + 64 * (j))
#define XB_XSUB(j)  (1280 + 64 * (j))
#define XB_XGEN(j)  (2304 + 64 * (j))
#define XB_TOP      3328
#define XB_TOPGEN   3392
#define XCD_BAR_WORDS 3456
#define XB_SPIN_CAP (1u << 18)
__device__ __forceinline__ unsigned xb_ld(unsigned* p)              { return __hip_atomic_load(p, __ATOMIC_RELAXED, __HIP_MEMORY_SCOPE_AGENT); }
__device__ __forceinline__ unsigned xb_add(unsigned* p, unsigned v) { return __hip_atomic_fetch_add(p, v, __ATOMIC_RELAXED, __HIP_MEMORY_SCOPE_AGENT); }
__device__ __forceinline__ unsigned xb_xcc_id() { return (unsigned)__builtin_amdgcn_s_getreg((3 << 11) | 20) & 0xFu; }
#define XB_SPIN(cond, bar) do { unsigned _sp = 0; while (cond) { __builtin_amdgcn_s_sleep(1); \
    if ((++_sp & 255u) == 0u) { if (xb_ld(&(bar)[XB_TMO])) break; if (_sp > XB_SPIN_CAP) { atomicAdd(&(bar)[XB_TMO], 1u); break; } } } } while (0)
struct XcdBarrier { unsigned* bar; unsigned x; volatile LAS unsigned* st; };
__device__ __forceinline__ XcdBarrier xcd_barrier_post(unsigned* bar, volatile LAS unsigned* st) {
    XcdBarrier b; b.bar = bar; b.x = xb_xcc_id(); b.st = st;
    if (threadIdx.x == 0) (void)xb_add(&bar[XB_XCNT(b.x)], 1u);
    return b;
}
__device__ __forceinline__ void xcd_barrier_complete(unsigned* bar, unsigned x, unsigned& nloc, unsigned& nx) {
    const unsigned G = gridDim.x * gridDim.y * gridDim.z;
    unsigned sum, cnt, mine, sp = 0u;
    for (;;) {
        sum = 0u; cnt = 0u; mine = 0u;
#pragma unroll
        for (unsigned j = 0; j < 16; ++j) { const unsigned c = xb_ld(&bar[XB_XCNT(j)]); sum += c; cnt += (c > 0u) ? 1u : 0u; mine = (j == x) ? c : mine; }
        if (sum == G) break;
        __builtin_amdgcn_s_sleep(1);
        if ((++sp & 255u) == 0u) { if (xb_ld(&bar[XB_TMO])) break; if (sp > XB_SPIN_CAP) { atomicAdd(&bar[XB_TMO], 1u); break; } }
    }
    nloc = mine > 0u ? mine : 1u; nx = cnt > 0u ? cnt : 1u;
}
__device__ __forceinline__ void xcd_barrier(const XcdBarrier& b, const int wave_s) {
    asm volatile("s_waitcnt vmcnt(0)" ::: "memory");
    __syncthreads();
    if (wave_s == 0 && __builtin_amdgcn_mbcnt_hi(~0u, __builtin_amdgcn_mbcnt_lo(~0u, 0u)) == 0u) {
        unsigned* bar = b.bar; asm volatile("" : "+v"(bar));
        __builtin_amdgcn_s_waitcnt(0);
        unsigned nloc = b.st[0], nx = b.st[1];
        if (nloc == 0u) { xcd_barrier_complete(bar, b.x, nloc, nx); b.st[0] = nloc; b.st[1] = nx; }
        const unsigned old = xb_add(&bar[XB_XSUB(b.x)], 1u);
        const unsigned gen = old / nloc;
        if (old + 1u == (gen + 1u) * nloc) {
            __builtin_amdgcn_fence(__ATOMIC_RELEASE, "agent");
            asm volatile("s_waitcnt vmcnt(0)" ::: "memory");
            const unsigned og = xb_add(&bar[XB_TOP], 1u);
            const unsigned tg = og / nx;
            if (og + 1u == (tg + 1u) * nx) xb_add(&bar[XB_TOPGEN], 1u);
            else XB_SPIN(xb_ld(&bar[XB_TOPGEN]) == tg, bar);
            __builtin_amdgcn_fence(__ATOMIC_ACQUIRE, "agent");
            xb_add(&bar[XB_XGEN(b.x)], 1u);
            asm volatile("s_waitcnt vmcnt(0)" ::: "memory");
        } else {
            XB_SPIN(xb_ld(&bar[XB_XGEN(b.x)]) == gen, bar);
            __builtin_amdgcn_fence(__ATOMIC_ACQUIRE, "agent");
            asm volatile("s_waitcnt vmcnt(0)" ::: "memory");
        }
    }
    __syncthreads();
}

struct Args { const float* in[N_IN]; float* out; unsigned char* ws; int ph_lo, ph_hi; };

struct Frame {
    LAS unsigned char* lds;
    int tid, lane, wave, vcu, G;
    const float* const* in; float* out; unsigned char* ws;
};

__device__ __forceinline__ const float* inp(const Frame& F, int k) { const GAS float* p = (const GAS float*)F.in[k]; asm volatile("" : "+s"(p)); return (const float*)p; }

struct SchedPlain {
    pg8::Rect R; const char* A; const char* B; size_t tsA, tsB; int xM, xN0, xNn;
    __device__ __forceinline__ bool next(int i, Unit& u) const {
        const int L = i * R.G + R.c;
        if (R.map(L, u.pm, u.pn)) {} else { const int e = L - R.nwg; if (e >= xM * xNn) return false; u.pm = R.nM + e / xNn; u.pn = xN0 + e % xNn; }
        u.seg = 0; u.ex = 0; u.A = A + (size_t)u.pm * tsA; u.B = B + (size_t)u.pn * tsB; return true;
    }
};
struct SchedInproj {
    pg8::Rect R1, R2; const char* W; const char* H; size_t ts; int xM, xN0, xNn;
    __device__ __forceinline__ bool next(int i, Unit& u) const {
        const int L = i * R1.G + R1.c; u.ex = 0;
        if (R1.map(L, u.pm, u.pn)) { u.seg = 1; u.A = W + (size_t)u.pm * ts; u.B = H + (size_t)u.pn * ts; return true; }
        const int L2 = L - R1.nwg; u.seg = 0;
        if (R2.map(L2, u.pm, u.pn)) {} else { const int e = L2 - R2.nwg; if (e >= xM * xNn) return false; u.pm = R2.nM + e / xNn; u.pn = xN0 + e % xNn; }
        u.A = H + (size_t)u.pm * ts; u.B = W + (size_t)(6 + u.pn) * ts; return true;
    }
};
struct SchedMerge {
    pg8::Rect R; const char* A; const char* B; size_t tsA, tsB, sA, sB;
    __device__ __forceinline__ bool next(int i, Unit& u) const {
        const int ti = i / 3, sg = i - 3 * ti; const int L = ti * R.G + R.c;
        if (!R.map(L, u.pm, u.pn)) return false;
        u.seg = sg; u.ex = 0;
        u.A = A + (size_t)sg * sA + (size_t)u.pm * tsA; u.B = B + (size_t)sg * sB + (size_t)u.pn * tsB; return true;
    }
};
struct SchedMoe {
    pg8::Rect R; const char* A; const char* B; size_t tsA, tsB, esB; const int* tile_e; int tile0; bool a_global;
    __device__ __forceinline__ bool next(int i, Unit& u) const {
        const int L = i * R.G + R.c;
        if (!R.map(L, u.pm, u.pn)) return false;
        const int gt = tile0 + u.pm; u.ex = gt; u.seg = 0; const int e = tile_e[gt];
        u.A = A + (size_t)(a_global ? gt : u.pm) * tsA; u.B = B + (size_t)e * esB + (size_t)u.pn * tsB; return true;
    }
};

typedef const f32x4 (&AccRef)[2][2][4][2];
__device__ __forceinline__ v4u pack8(const f32x4 a, const f32x4 b) { v4u w; w.x = pg8::cvt_pk_bf16(a[0], a[1]); w.y = pg8::cvt_pk_bf16(a[2], a[3]); w.z = pg8::cvt_pk_bf16(b[0], b[1]); w.w = pg8::cvt_pk_bf16(b[2], b[3]); return w; }
__device__ __forceinline__ void unpack8(const v4u w, f32x4& a, f32x4& b) { a = (f32x4){bflo(w.x), bfhi(w.x), bflo(w.y), bfhi(w.y)}; b = (f32x4){bflo(w.z), bfhi(w.z), bflo(w.w), bfhi(w.w)}; }

struct EpiInproj {
    static constexpr bool PERM = true;
    bf16* phyT; bf16* ucf; bf16* ps5; int pn0;
    __device__ __forceinline__ void operator()(AccRef acc, const Unit& u0, int wr, int wc, int fr, int fq) const {
        Unit u = u0; u.pn += pn0;
        const int row0 = u.pm * 256 + wr * 64 + fr;
        if (u.pn < 6) {
#pragma unroll
            for (int ai = 0; ai < 2; ++ai)
#pragma unroll
                for (int m = 0; m < 4; ++m) { const int r = row0 + ai * 128 + m * 16;
#pragma unroll
                    for (int bj = 0; bj < 2; ++bj)
#pragma unroll
                        for (int n = 0; n < 2; ++n)
#pragma unroll
                            for (int j = 0; j < 4; ++j) { const int c = u.pn * 256 + bj * 128 + wc * 32 + 8 * fq + 4 * n + j; phyT[(size_t)c * RT + r] = (bf16)f2bf(acc[ai][bj][m][n][j]); } }
        } else if (u.pn < 10) {
            const int col0 = (u.pn - 6) * 128 + wc * 32 + 8 * fq;
#pragma unroll
            for (int ai = 0; ai < 2; ++ai)
#pragma unroll
                for (int m = 0; m < 4; ++m) { const int r = row0 + ai * 128 + m * 16; f32x4 o[2];
#pragma unroll
                    for (int n = 0; n < 2; ++n)
#pragma unroll
                        for (int j = 0; j < 4; ++j) o[n][j] = acc[ai][0][m][n][j] * sigmoidf_(acc[ai][1][m][n][j]);
                    *(v4u*)(ucf + (size_t)r * 512 + col0) = pack8(o[0], o[1]); }
        } else {
#pragma unroll
            for (int ai = 0; ai < 2; ++ai)
#pragma unroll
                for (int m = 0; m < 4; ++m) { const int r = row0 + ai * 128 + m * 16;
#pragma unroll
                    for (int bj = 0; bj < 2; ++bj) { const int col0 = (u.pn - 10) * 256 + bj * 128 + wc * 32 + 8 * fq; *(v4u*)(ps5 + (size_t)r * 512 + col0) = pack8(acc[ai][bj][m][0], acc[ai][bj][m][1]); } }
        }
    }
};
struct EpiHyT {
    static constexpr bool PERM = true;
    bf16* phyT;
    __device__ __forceinline__ void operator()(AccRef acc, const Unit& u, int wr, int wc, int fr, int fq) const {
        const int ch0 = u.pm * 256 + wr * 64 + fr, tok0 = u.pn * 256 + wc * 32 + 8 * fq;
#pragma unroll
        for (int ai = 0; ai < 2; ++ai)
#pragma unroll
            for (int m = 0; m < 4; ++m)
#pragma unroll
                for (int bj = 0; bj < 2; ++bj) *(v4u*)(phyT + (size_t)(ch0 + ai * 128 + m * 16) * RT + tok0 + bj * 128) = pack8(acc[ai][bj][m][0], acc[ai][bj][m][1]);
    }
};
struct EpiInprojAll {
    static constexpr bool PERM = true;
    EpiHyT hy; EpiInproj rest;
    __device__ __forceinline__ void operator()(AccRef acc, const Unit& u, int wr, int wc, int fr, int fq) const { if (u.seg == 1) hy(acc, u, wr, wc, fr, fq); else rest(acc, u, wr, wc, fr, fq); }
};
struct EpiGates {
    static constexpr bool PERM = true;
    bf16* O; int tid;
    __device__ __forceinline__ void operator()(AccRef acc, const Unit& u, int wr, int wc, int fr, int fq) const {
        v4u* T = (v4u*)O + ((size_t)u.pm * 12 + u.pn) * 8192 + tid;
#pragma unroll
        for (int ai = 0; ai < 2; ++ai)
#pragma unroll
            for (int m = 0; m < 4; ++m)
#pragma unroll
                for (int bj = 0; bj < 2; ++bj) { f32x4 o[2];
#pragma unroll
                    for (int n = 0; n < 2; ++n)
#pragma unroll
                        for (int j = 0; j < 4; ++j) o[n][j] = sigmoidf_(acc[ai][bj][m][n][j]);
                    T[((ai * 4 + m) * 2 + bj) * 512] = pack8(o[0], o[1]); }
    }
};
struct EpiGlu {
    static constexpr bool PERM = true;
    const bf16* SG; bf16* O; const float* bglu;
    __device__ __forceinline__ void operator()(AccRef acc, const Unit& u, int wr, int wc, int fr, int fq) const {
        const int row0 = u.pm * 256 + wr * 64 + fr;
#pragma unroll
        for (int bj = 0; bj < 2; ++bj) { const int col0 = u.pn * 256 + bj * 128 + wc * 32 + 8 * fq;
            const f32x4 b0 = *(const f32x4*)(bglu + col0), b1 = *(const f32x4*)(bglu + col0 + 4);
            v4u gw[2][4];
#pragma unroll
            for (int ai = 0; ai < 2; ++ai)
#pragma unroll
                for (int m = 0; m < 4; ++m) gw[ai][m] = *(const v4u*)(SG + (size_t)(row0 + ai * 128 + m * 16) * 512 + col0);
#pragma unroll
            for (int ai = 0; ai < 2; ++ai)
#pragma unroll
                for (int m = 0; m < 4; ++m) { const int r = row0 + ai * 128 + m * 16;
                    f32x4 g0, g1; unpack8(gw[ai][m], g0, g1); f32x4 o0, o1;
#pragma unroll
                    for (int j = 0; j < 4; ++j) { o0[j] = g0[j] * sigmoidf_(acc[ai][bj][m][0][j] + b0[j]); o1[j] = g1[j] * sigmoidf_(acc[ai][bj][m][1][j] + b1[j]); }
                    *(v4u*)(O + (size_t)r * 512 + col0) = pack8(o0, o1); } }
    }
};
struct EpiMerge {
    static constexpr bool PERM = true, CHAIN = true;
    const bf16* GT; bf16* O; int tid;
    typedef f32x4 (&AccMut)[2][2][4][2];
    __device__ __forceinline__ void mid(AccMut acc, const Unit& u, int wr, int wc, int fr, int fq) const {
        const v4u* T0 = (const v4u*)GT + ((size_t)u.pm * 12 + u.seg * 4 + u.pn) * 8192 + tid; const v4u* T1 = T0 + 4 * 8192;
#pragma unroll
        for (int ai = 0; ai < 2; ++ai)
#pragma unroll
            for (int bj = 0; bj < 2; ++bj) { v4u ga[4], gb[4];
#pragma unroll
                for (int m = 0; m < 4; ++m) { ga[m] = T0[((ai * 4 + m) * 2 + bj) * 512]; gb[m] = T1[((ai * 4 + m) * 2 + bj) * 512]; }
#pragma unroll
                for (int m = 0; m < 4; ++m) { f32x4 a0, a1, b0, b1; unpack8(ga[m], a0, a1); unpack8(gb[m], b0, b1);
#pragma unroll
                    for (int j = 0; j < 4; ++j) { acc[ai][bj][m][0][j] *= fmaxf(a0[j], 1e-30f) * __builtin_amdgcn_rcpf(fmaxf(b0[j], 1e-30f)); acc[ai][bj][m][1][j] *= fmaxf(a1[j], 1e-30f) * __builtin_amdgcn_rcpf(fmaxf(b1[j], 1e-30f)); } }
                asm volatile("" ::: "memory"); }
    }
    __device__ __forceinline__ void operator()(AccRef acc, const Unit& u, int wr, int wc, int fr, int fq) const {
        const int row0 = u.pm * 256 + wr * 64 + fr, col0 = u.pn * 256 + wc * 32 + 8 * fq;
        const v4u* T = (const v4u*)GT + ((size_t)u.pm * 12 + u.seg * 4 + u.pn) * 8192 + tid;
#pragma unroll
        for (int ai = 0; ai < 2; ++ai) { v4u gw[4][2];
#pragma unroll
            for (int m = 0; m < 4; ++m)
#pragma unroll
                for (int bj = 0; bj < 2; ++bj) gw[m][bj] = T[((ai * 4 + m) * 2 + bj) * 512];
#pragma unroll
            for (int m = 0; m < 4; ++m)
#pragma unroll
                for (int bj = 0; bj < 2; ++bj) { f32x4 g0, g1; unpack8(gw[m][bj], g0, g1);
#pragma unroll
                    for (int j = 0; j < 4; ++j) { g0[j] = fmaxf(g0[j], 1e-30f); g1[j] = fmaxf(g1[j], 1e-30f); }
                    *(v4u*)(O + (size_t)(row0 + ai * 128 + m * 16) * 1024 + col0 + bj * 128) = pack8(g0 * acc[ai][bj][m][0], g1 * acc[ai][bj][m][1]); } }
    }
};
struct EpiRes {
    static constexpr bool PERM = true;
    const float* xl; const float* xc; bf16* R; const float* gbase; float sc;
    __device__ __forceinline__ void operator()(AccRef acc, const Unit& u, int wr, int wc, int fr, int fq) const {
        const bool isl = u.pm < (NX / 256);
        const int prow = isl ? u.pm * 256 : (u.pm - NX / 256) * 256; const int mi = isl ? (u.pm >> 3) : 16;
        const float* xs = isl ? xl : xc; const float* gv = gbase + (size_t)mi * INC;
        const int row0 = prow + wr * 64 + fr, grow0 = u.pm * 256 + wr * 64 + fr, col0 = u.pn * 256 + wc * 32 + 8 * fq;
#pragma unroll
        for (int bj = 0; bj < 2; ++bj) { const int c = col0 + bj * 128; const f32x4 g0 = *(const f32x4*)(gv + c) * sc, g1 = *(const f32x4*)(gv + c + 4) * sc;
#pragma unroll
            for (int ai = 0; ai < 2; ++ai) { f32x4 xr[4][2];
#pragma unroll
                for (int m = 0; m < 4; ++m) { const float* xp = xs + (size_t)(row0 + ai * 128 + m * 16) * 1024 + c; xr[m][0] = *(const f32x4*)xp; xr[m][1] = *(const f32x4*)(xp + 4); }
#pragma unroll
                for (int m = 0; m < 4; ++m) *(v4u*)(R + (size_t)(grow0 + ai * 128 + m * 16) * 1024 + c) = pack8(xr[m][0] * ALPHA_F + g0 * acc[ai][bj][m][0], xr[m][1] * ALPHA_F + g1 * acc[ai][bj][m][1]); } }
    }
};
struct EpiSwiglu {
    static constexpr bool PERM = true;
    bf16* O; int ldc;
    __device__ __forceinline__ void operator()(AccRef acc, const Unit& u, int wr, int wc, int fr, int fq) const {
        const int row0 = u.pm * 256 + wr * 64 + fr, col0 = u.pn * 128 + wc * 32 + 8 * fq;
#pragma unroll
        for (int ai = 0; ai < 2; ++ai)
#pragma unroll
            for (int m = 0; m < 4; ++m) { const int r = row0 + ai * 128 + m * 16; f32x4 o[2];
#pragma unroll
                for (int n = 0; n < 2; ++n)
#pragma unroll
                    for (int j = 0; j < 4; ++j) o[n][j] = siluf_(acc[ai][0][m][n][j]) * acc[ai][1][m][n][j];
                *(v4u*)(O + (size_t)r * ldc + col0) = pack8(o[0], o[1]); }
    }
};
struct EpiSwigluF8 {
    static constexpr bool PERM = true;
    unsigned char* O; int ldc; float sc;
    __device__ __forceinline__ void operator()(AccRef acc, const Unit& u, int wr, int wc, int fr, int fq) const {
        const int row0 = u.pm * 256 + wr * 64 + fr, col0 = u.pn * 128 + wc * 32 + 8 * fq;
#pragma unroll
        for (int ai = 0; ai < 2; ++ai)
#pragma unroll
            for (int m = 0; m < 4; ++m) { const int r = row0 + ai * 128 + m * 16; f32x4 o[2];
#pragma unroll
                for (int n = 0; n < 2; ++n) {
                    const f32x4 a = acc[ai][0][m][n], t = a * (-1.4426950408889634f * sc), p = (a * acc[ai][1][m][n]) * (sc * sc);
                    f32x4 e; e[0] = __builtin_amdgcn_exp2f(t[0]); e[1] = __builtin_amdgcn_exp2f(t[1]); e[2] = __builtin_amdgcn_exp2f(t[2]); e[3] = __builtin_amdgcn_exp2f(t[3]);
                    const f32x4 d = e + 1.0f;
                    f32x4 rc; rc[0] = __builtin_amdgcn_rcpf(d[0]); rc[1] = __builtin_amdgcn_rcpf(d[1]); rc[2] = __builtin_amdgcn_rcpf(d[2]); rc[3] = __builtin_amdgcn_rcpf(d[3]);
                    o[n] = p * rc; }
                v2u w; w.x = pk4_fp8(o[0][0], o[0][1], o[0][2], o[0][3]); w.y = pk4_fp8(o[1][0], o[1][1], o[1][2], o[1][3]);
                *(v2u*)(O + (size_t)r * ldc + col0) = w; }
    }
};
struct EpiMoeDown {
    static constexpr bool PERM = true;
    bf16* O; float sc;
    __device__ __forceinline__ void operator()(AccRef acc, const Unit& u, int wr, int wc, int fr, int fq) const {
        const int row0 = u.ex * 256 + wr * 64 + fr;
#pragma unroll
        for (int ai = 0; ai < 2; ++ai)
#pragma unroll
            for (int m = 0; m < 4; ++m) { const int r = row0 + ai * 128 + m * 16;
#pragma unroll
                for (int bj = 0; bj < 2; ++bj) { const int col0 = u.pn * 256 + bj * 128 + wc * 32 + 8 * fq; *(v4u*)(O + (size_t)r * 1024 + col0) = pack8(acc[ai][bj][m][0] * sc, acc[ai][bj][m][1] * sc); } }
    }
};

template <bool F8>
__device__ __forceinline__ void transpose_item64(const float* W, int K, int N, unsigned char* WT, int dst_row0, int k0, int n0, float scale, LAS float* scr, int lane) {
#pragma unroll 4
    for (int i = 0; i < 16; ++i) { const int row = 4 * i + (lane >> 4), nc = 4 * (lane & 15);
        const f32x4 v = __builtin_nontemporal_load((const f32x4*)(W + (size_t)(k0 + row) * N + n0 + nc));     *(LAS f32x4*)(scr + row * 68 + nc) = v * scale; }
    LDS_WAIT(); asm volatile("" ::: "memory");
    const LAS float* sp = scr + lane;
    if constexpr (F8) {
        unsigned char* dst = WT + (size_t)(dst_row0 + lane) * K + k0;
#pragma unroll
        for (int c4 = 0; c4 < 4; ++c4) { v4u o;
#pragma unroll
            for (int e = 0; e < 4; ++e) { const int kk = 16 * c4 + 4 * e; o[e] = pk4_fp8(sp[(kk + 0) * 68], sp[(kk + 1) * 68], sp[(kk + 2) * 68], sp[(kk + 3) * 68]); }
            *(v4u*)(dst + 16 * c4) = o; }
    } else {
        unsigned char* dst = WT + ((size_t)(dst_row0 + lane) * K + k0) * 2;
#pragma unroll
        for (int c8 = 0; c8 < 8; ++c8) { v4u o;
#pragma unroll
            for (int e = 0; e < 4; ++e) { const int kk = 8 * c8 + 2 * e; o[e] = pk2(sp[kk * 68], sp[(kk + 1) * 68]); }
            *(v4u*)(dst + 16 * c8) = o; }
    }
    LDS_WAIT(); asm volatile("" ::: "memory");
}
__device__ __forceinline__ int dst_row_map(int kind, int n0) {
    if (kind == 1) { if (n0 >= 1536 && n0 < 2560) { const int i = (n0 - 1536) & 511, hi = (n0 - 1536) >> 9; return 1536 + 256 * (i >> 7) + 128 * hi + (i & 127); } return n0; }
    if (kind == 2) return 256 * (n0 >> 7) + (n0 & 127);
    if (kind == 3) return 256 * (n0 >> 7) + 128 + (n0 & 127);
    return n0;
}
__device__ __forceinline__ void conv_matrix_item(const float* W, int K, int N, bf16* WT, int kind, int item, LAS float* scr, int lane) {
    const int nblk = N / 64, kb = item / nblk, nb = item - kb * nblk;
    transpose_item64<false>(W, K, N, (unsigned char*)WT, dst_row_map(kind, 64 * nb), 64 * kb, 64 * nb, 1.0f, scr, lane);
}
__device__ __forceinline__ void conv_matrix_item_f8(const float* W, int K, int N, unsigned char* WT, int kind, int item, float scale, LAS float* scr, int lane) {
    const int nblk = N / 64, kb = item / nblk, nb = item - kb * nblk;
    transpose_item64<true>(W, K, N, WT, dst_row_map(kind, 64 * nb), 64 * kb, 64 * nb, scale, scr, lane);
}
__device__ __forceinline__ void p0a_prologue(Frame& F) {
    LAS float* scr = (LAS float*)(F.lds + F.wave * 17408);
    const int gw = F.wave * F.G + F.vcu  , NGW = F.G * NWAVES;
    bf16* ws_win = (bf16*)(F.ws + WS_WIN); bf16* ws_outs = (bf16*)(F.ws + WS_WOUTS); bf16* ws_glu = (bf16*)(F.ws + WS_WGLU); bf16* ws_wo = (bf16*)(F.ws + WS_WO);
    bf16* ws_w13 = (bf16*)(F.ws + WS_W13); bf16* ws_w2 = (bf16*)(F.ws + WS_W2);
    constexpr int I_IN = (1024 / 64) * (6144 / 64), I_OUT = (512 / 64) * (1024 / 64), I_GLU = (512 / 64) * (512 / 64), I_WOI = (1024 / 64) * (1024 / 64), I_F1 = (1024 / 64) * (2816 / 64), I_F2 = (2816 / 64) * (1024 / 64);
    constexpr int NITEMS = 2 * I_IN + 6 * I_OUT + 2 * I_GLU + 2 * I_WOI + 2 * I_F1 + I_F2;
    for (int it = gw; it < NITEMS; it += NGW) {
        int r = it;
        if (r < 2 * I_IN) { const int l = r / I_IN; conv_matrix_item(inp(F, I_WIN) + (size_t)l * 1024 * 6144, 1024, 6144, ws_win + (size_t)l * 6144 * 1024, 1, r - l * I_IN, scr, F.lane); continue; } r -= 2 * I_IN;
        if (r < 6 * I_OUT) { const int q = r / I_OUT, l = q / 3, s = q - 3 * l; const float* src = inp(F, s == 0 ? I_WHY : (s == 1 ? I_WCF : I_WS5)) + (size_t)l * 512 * 1024;
            conv_matrix_item(src, 512, 1024, ws_outs + (size_t)(l * 3 + s) * 1024 * 512, 0, r - q * I_OUT, scr, F.lane); continue; } r -= 6 * I_OUT;
        if (r < 2 * I_GLU) { const int l = r / I_GLU; conv_matrix_item(inp(F, I_SWGLU) + (size_t)l * 512 * 512, 512, 512, ws_glu + (size_t)l * 512 * 512, 0, r - l * I_GLU, scr, F.lane); continue; } r -= 2 * I_GLU;
        if (r < 2 * I_WOI) { const int l = r / I_WOI; conv_matrix_item(inp(F, I_WO) + (size_t)l * 1024 * 1024, 1024, 1024, ws_wo + (size_t)l * 1024 * 1024, 0, r - l * I_WOI, scr, F.lane); continue; } r -= 2 * I_WOI;
        if (r < I_F1) { conv_matrix_item_f8(inp(F, I_FFW1), 1024, 2816, (unsigned char*)ws_w13, 2, r, 32.f, scr, F.lane); continue; } r -= I_F1;
        if (r < I_F1) { conv_matrix_item_f8(inp(F, I_FFW3), 1024, 2816, (unsigned char*)ws_w13, 3, r, 32.f, scr, F.lane); continue; } r -= I_F1;
        conv_matrix_item_f8(inp(F, I_FFW2), 2816, 1024, (unsigned char*)ws_w2, 0, r, 128.f, scr, F.lane);
    }
    __syncthreads();
    float* mods = (float*)(F.ws + WS_MODS);
    LAS float* sc = (LAS float*)F.lds;
    LAS float* red = sc + 1024 * 20;
    for (int e = F.tid; e < 17 * 1024; e += 512) { const int i = e >> 10, k = e & 1023; const float cv = i < 16 ? inp(F, I_C)[i * 1024 + k] : inp(F, I_CCTX)[k]; sc[k * 20 + i] = siluf_(cv); }
    __syncthreads();
    for (int it = F.vcu; it < 2 * 128; it += F.G) {
        const int l = it >> 7, nb = it & 127; const int kg = F.tid / 48, col = F.tid - kg * 48;
        if (kg < 10) { const float* w = inp(F, I_WMOD) + (size_t)l * 1024 * 6144 + nb * 48 + col;
            float acc[17];
#pragma unroll
            for (int i = 0; i < 17; ++i) acc[i] = 0.f;
#pragma unroll 4
            for (int k = kg; k < 1024; k += 10) { const float wv = __builtin_nontemporal_load(w + (size_t)k * 6144);
                const f32x4 s0 = *(const LAS f32x4*)(sc + k * 20), s1 = *(const LAS f32x4*)(sc + k * 20 + 4), s2 = *(const LAS f32x4*)(sc + k * 20 + 8), s3 = *(const LAS f32x4*)(sc + k * 20 + 12); const float s4 = sc[k * 20 + 16];
#pragma unroll
                for (int j = 0; j < 4; ++j) { acc[j] += s0[j] * wv; acc[4 + j] += s1[j] * wv; acc[8 + j] += s2[j] * wv; acc[12 + j] += s3[j] * wv; }
                acc[16] += s4 * wv; }
#pragma unroll
            for (int i = 0; i < 17; ++i) red[(kg * 17 + i) * 48 + col] = acc[i]; }
        __syncthreads();
        for (int e = F.tid; e < 17 * 48; e += 512) { const int i = e / 48, c = e - i * 48; float sum = inp(F, I_BMOD)[l * 6144 + nb * 48 + c];
#pragma unroll
            for (int g = 0; g < 10; ++g) sum += red[(g * 17 + i) * 48 + c];
            mods[(size_t)(l * 17 + i) * 6144 + nb * 48 + c] = sum; }
        __syncthreads();
    }
}

__device__ __forceinline__ void h2table_phase(Frame& F, int l) {
    const int gw = F.wave * F.G + F.vcu  , NGW = F.G * NWAVES, lane = F.lane;
    float* H2 = (float*)(F.ws + WS_FILT);
    const float* w1 = inp(F, I_FW1) + l * 33 * 64; const float* b1 = inp(F, I_FB1) + l * 64; const float* w2 = inp(F, I_FW2) + l * 64 * 64; const float* b2 = inp(F, I_FB2) + l * 64;
    const float* fq = inp(F, I_FREQ) + l * 128;
    for (int pos = gw; pos < LSEQ + LCTX; pos += NGW) {
        const bool isc = pos >= LSEQ; const int L = isc ? LCTX : LSEQ; const int t = isc ? pos - LSEQ : pos;
        const float tn = (float)t / (float)(L - 1);
        float z = 0.f;
        if (lane == 0) z = tn;
        else if (lane <= 32) { const int band = lane <= 16 ? lane : lane - 16; const int ph = (t * band) % L; const float ang = 6.283185307179586f * ((float)ph / (float)L); z = lane <= 16 ? cosf(ang) : sinf(ang); }
        float h = b1[lane];
        for (int k = 0; k < 33; ++k) h += lane_bcast(z, k) * w1[k * 64 + lane];
        h = sinf(fq[lane] * h);
        float h2 = b2[lane];
        for (int k = 0; k < 64; ++k) h2 += lane_bcast(h, k) * w2[k * 64 + lane];
        H2[(size_t)pos * 64 + lane] = sinf(fq[64 + lane] * h2);
    }
}
__device__ __forceinline__ void filter_expand_phase(Frame& F, int l) {
    const int gw = F.wave * F.G + F.vcu  , NGW = F.G * NWAVES, lane = F.lane;
    const float* H2 = (const float*)(F.ws + WS_FILT);
    const float* w3 = inp(F, I_FW3) + (size_t)l * 64 * 2048; const float* b3 = inp(F, I_FB3) + l * 2048; const float* dec = inp(F, I_DECAY) + l * 2048; const float* hb = inp(F, I_HBIAS) + l * 1024;
    LAS float* W = (LAS float*)(F.lds + F.wave * 17408);
#pragma unroll 1
    for (int it = gw; it < 1024 + 128; it += NGW) {
        const bool isc = it >= 1024; const int ii = isc ? it - 1024 : it; const int chunk = ii >> 5, grp = ii & 31;
        const int L = isc ? LCTX : LSEQ; const int t = chunk * 64 + lane; const int pos = isc ? LSEQ + t : t;
        bf16* KR = isc ? (bf16*)(F.ws + WS_KRC) : (bf16*)(F.ws + WS_KRL); const int KLEN = 2 * L;
        const float tn = (float)t / (float)(L - 1);
#pragma unroll 4
        for (int k = 0; k < 64; ++k) W[lane * 68 + k] = w3[(size_t)k * 2048 + grp * 64 + lane];
        f32x4 h2[16];
#pragma unroll
        for (int k = 0; k < 16; ++k) h2[k] = *(const f32x4*)(H2 + (size_t)pos * 64 + 4 * k);
        const int colL = grp * 64 + lane; const float b3L = b3[colL], decL = fabsf(dec[colL]); const float hbL = ((colL >> 9) & 1) == 0 ? hb[(colL >> 10) * 512 + (colL & 511)] : 0.f;
        LDS_WAIT();
#pragma unroll 1
        for (int cc = 0; cc < 64; ++cc) {
            const int col = grp * 64 + cc; float a = lane_bcast(b3L, cc);
#pragma unroll
            for (int k = 0; k < 16; ++k) { const f32x4 wv = *(const LAS f32x4*)(W + cc * 68 + 4 * k); a += (h2[k][0] * wv[0] + h2[k][1] * wv[1]) + (h2[k][2] * wv[2] + h2[k][3] * wv[3]); }
            const int o = col >> 10, dir = (col >> 9) & 1, c = col & 511;
            float v = a * __expf(-tn * lane_bcast(decL, cc));
            if (t == 0 && dir == 0) v += lane_bcast(hbL, cc);
            const bool valid = !(t == 0 && dir == 1);
            const int i = dir ? L + t : L - t;
            const unsigned short bv = (unsigned short)f2bf(v);
            bf16* base = (valid ? KR + (size_t)((o * 512 + c) * 8) * KLEN : (bf16*)(F.ws + WS_KDUMMY) + 16) + i;
#pragma unroll
            for (int m = 0; m < 8; ++m) base[(ptrdiff_t)m * (KLEN - 1)] = bv;
        }
        LDS_WAIT();
    }
    __syncthreads();
}
__device__ __forceinline__ void s5params_phase(Frame& F, int l) {
    float* P = (float*)(F.ws + WS_S5P);
    for (int e = F.vcu * 512 + F.tid; e < 2 * 32 * 64; e += F.G * 512) {
        const int base = l * 4096 + e;
        const int dg = e >> 6;
        const float lam_re = fminf(inp(F, I_SARE)[base], -1e-4f), lam_im = inp(F, I_SAIM)[base];
        const float dt = expf(inp(F, I_SLDT)[l * 64 + dg]);
        const float mag = expf(lam_re * dt), ang = lam_im * dt; const float abr = mag * cosf(ang), abi = mag * sinf(ang);
        const float den = lam_re * lam_re + lam_im * lam_im;
        const float qre = ((abr - 1.0f) * lam_re + abi * lam_im) / den, qim = (abi * lam_re - (abr - 1.0f) * lam_im) / den;
        float* o = P + (size_t)e * 36; o[0] = abr; o[1] = abi;
        const float* br = inp(F, I_SBRE) + (size_t)base * 16; const float* bi = inp(F, I_SBIM) + (size_t)base * 16;
        for (int c = 0; c < 16; ++c) { o[2 + c] = qre * br[c] - qim * bi[c]; o[18 + c] = qre * bi[c] + qim * br[c]; }
        o[34] = 0.f; o[35] = 0.f;
    }
}

struct Row { f32x4 v[4]; };
__device__ __forceinline__ void row_load(Row& r, const float* p, int lane) { const f32x4* x = (const f32x4*)p + lane;
#pragma unroll
    for (int j = 0; j < 4; ++j) r.v[j] = x[64 * j]; }
__device__ __forceinline__ void row_load_nt(Row& r, const float* p, int lane) { const f32x4* x = (const f32x4*)p + lane;
#pragma unroll
    for (int j = 0; j < 4; ++j) r.v[j] = __builtin_nontemporal_load(x + 64 * j); }
__device__ __forceinline__ void row_load_bf16(Row& r, const bf16* p, int lane) { const v2u* x = (const v2u*)p + lane;
#pragma unroll
    for (int j = 0; j < 4; ++j) { const v2u w = x[64 * j]; r.v[j] = (f32x4){bflo(w.x), bfhi(w.x), bflo(w.y), bfhi(w.y)}; } }
__device__ __forceinline__ void row_store(const Row& r, float* p, int lane) { f32x4* x = (f32x4*)p + lane;
#pragma unroll
    for (int j = 0; j < 4; ++j) x[64 * j] = r.v[j]; }
__device__ __forceinline__ void row_norm(Row& r) {
    float s = 0.f;
#pragma unroll
    for (int j = 0; j < 4; ++j) s += (r.v[j][0] + r.v[j][1]) + (r.v[j][2] + r.v[j][3]);
    const float mean = wave_sum(s) * (1.f / DM); float q = 0.f;
#pragma unroll
    for (int j = 0; j < 4; ++j) { r.v[j] = r.v[j] - mean; q += (r.v[j][0] * r.v[j][0] + r.v[j][1] * r.v[j][1]) + (r.v[j][2] * r.v[j][2] + r.v[j][3] * r.v[j][3]); }
    const float rstd = 1.f / sqrtf(wave_sum(q) * (1.f / DM) + LN_EPS);
#pragma unroll
    for (int j = 0; j < 4; ++j) r.v[j] = r.v[j] * rstd;
}
__device__ __forceinline__ void row_affine(Row& r, const float* g, const float* b, int lane, float gadd) {
    const f32x4* gp = (const f32x4*)g + lane; const f32x4* bp = (const f32x4*)b + lane;
#pragma unroll
    for (int j = 0; j < 4; ++j) r.v[j] = r.v[j] * (gp[64 * j] + gadd) + bp[64 * j];
}
struct Vec8 { f32x4 g[4], b[4]; };
__device__ __forceinline__ void vec8_load(Vec8& v, const float* g, const float* b, int lane) { const f32x4* gp = (const f32x4*)g + lane; const f32x4* bp = (const f32x4*)b + lane;
#pragma unroll
    for (int j = 0; j < 4; ++j) { v.g[j] = gp[64 * j]; v.b[j] = bp[64 * j]; } }
__device__ __forceinline__ void row_affine_reg(Row& r, const Vec8& v, float gadd) {
#pragma unroll
    for (int j = 0; j < 4; ++j) r.v[j] = r.v[j] * (v.g[j] + gadd) + v.b[j]; }
__device__ __forceinline__ int row_batch(int row) { return row < NX ? (row >> 11) : 16; }
__device__ __forceinline__ void row_store_bf16(const Row& r, bf16* p, int lane) { unsigned long long* o = (unsigned long long*)p + lane;
#pragma unroll
    for (int j = 0; j < 4; ++j) o[64 * j] = (unsigned long long)pk2(r.v[j][0], r.v[j][1]) | ((unsigned long long)pk2(r.v[j][2], r.v[j][3]) << 32); }

__device__ __forceinline__ const float* mod_vec(Frame& F, int l, int row, int which) { const int i = row < NX ? (row >> 11) : 16; return (const float*)(F.ws + WS_MODS) + ((size_t)l * 17 + i) * INC + which * 1024; }
__device__ __forceinline__ const float* xrow_ptr(Frame& F, int l, int row) {
    if (l == 0) return row < NX ? inp(F, I_X) + (size_t)row * DM : inp(F, I_CTX) + (size_t)(row - NX) * DM;
    return row < NX ? F.out + (size_t)row * DM : (const float*)(F.ws + WS_XC) + (size_t)(row - NX) * DM;
}
__device__ __forceinline__ float* xcur_ptr(Frame& F, int row) { return row < NX ? F.out + (size_t)row * DM : (float*)(F.ws + WS_XC) + (size_t)(row - NX) * DM; }

__device__ __forceinline__ void lnmod_phase(Frame& F, int l) {
    const int gw = F.vcu * NWAVES + F.wave, NGW = F.G * NWAVES; bf16* hx = (bf16*)(F.ws + WS_HX);
    const int m0 = (int)((long)RT * gw / NGW), m1 = (int)((long)RT * (gw + 1) / NGW); Vec8 md; int cb = -1;
    Row nx; if (m0 < m1) row_load_nt(nx, xrow_ptr(F, l, m0), F.lane);
    for (int m = m0; m < m1; ++m) { if (row_batch(m) != cb) { cb = row_batch(m); vec8_load(md, mod_vec(F, l, m, 1), mod_vec(F, l, m, 0), F.lane); }
        Row r = nx; if (m + 1 < m1) row_load_nt(nx, xrow_ptr(F, l, m + 1), F.lane);
        row_norm(r); row_affine_reg(r, md, 1.0f); row_store_bf16(r, hx + (size_t)m * DM, F.lane); }
}
template <bool MOE>
__device__ __forceinline__ void ln1_phase(Frame& F, int l) {
    const int gw = F.vcu * NWAVES + F.wave, NGW = F.G * NWAVES; bf16* hx = (bf16*)(F.ws + WS_HX); const int M = MOE ? NX : RT;
    const float* g = inp(F, I_LN1G) + l * DM; const float* b = inp(F, I_LN1B) + l * DM;
    int* toke = (int*)(F.ws + WS_META + META_TOKE); float* tokw = (float*)(F.ws + WS_META + META_TOKW);
    LAS unsigned* lcnt = (LAS unsigned*)(F.lds);
    unsigned c8[8];
#pragma unroll
    for (int e = 0; e < 8; ++e) c8[e] = 0u;
    if (MOE) { if (F.tid < 8) lcnt[F.tid] = 0u; __syncthreads(); }
    f32x4 rtr[4][4][2];
    if (MOE) { const float* rt = inp(F, I_ROUTER);
#pragma unroll
        for (int j = 0; j < 4; ++j)
#pragma unroll
            for (int q = 0; q < 4; ++q) { const int k = 256 * j + 4 * F.lane + q; rtr[j][q][0] = *(const f32x4*)(rt + k * 8); rtr[j][q][1] = *(const f32x4*)(rt + k * 8 + 4); } }
    Vec8 ln; if (!MOE) vec8_load(ln, g, b, F.lane); Vec8 md; int cb = -1;
    const int m0 = (int)((long)M * gw / NGW), m1 = (int)((long)M * (gw + 1) / NGW);
    for (int m = m0; m < m1; ++m) {
        if (row_batch(m) != cb) { cb = row_batch(m); vec8_load(md, mod_vec(F, l, m, 4), mod_vec(F, l, m, 3), F.lane); }
        float* xp = xcur_ptr(F, m); Row r; row_load_bf16(r, (const bf16*)(F.ws + WS_KRL) + (size_t)m * DM, F.lane); row_norm(r); if (MOE) row_affine(r, g, b, F.lane, 0.0f); else row_affine_reg(r, ln, 0.0f); row_store(r, xp, F.lane);
        row_norm(r); row_affine_reg(r, md, 1.0f);
        if (!MOE) { unsigned* d8 = (unsigned*)((unsigned char*)hx + (size_t)m * DM) + F.lane;
#pragma unroll
            for (int j = 0; j < 4; ++j) d8[64 * j] = pk4_fp8(r.v[j][0], r.v[j][1], r.v[j][2], r.v[j][3]); }
        else {
            float lg[8];
#pragma unroll
            for (int e = 0; e < 8; ++e) lg[e] = 0.f;
#pragma unroll
            for (int j = 0; j < 4; ++j)
#pragma unroll
                for (int q = 0; q < 4; ++q) { const f32x4 r0 = rtr[j][q][0], r1 = rtr[j][q][1]; const float hv = r.v[j][q];
                    lg[0] += hv * r0[0]; lg[1] += hv * r0[1]; lg[2] += hv * r0[2]; lg[3] += hv * r0[3]; lg[4] += hv * r1[0]; lg[5] += hv * r1[1]; lg[6] += hv * r1[2]; lg[7] += hv * r1[3]; }
#pragma unroll
            for (int e = 0; e < 8; ++e) lg[e] = wave_sum(lg[e]);
            int e0 = 0; float v0 = lg[0];
#pragma unroll
            for (int e = 1; e < 8; ++e) if (lg[e] > v0) { v0 = lg[e]; e0 = e; }
            int e1 = -1; float v1 = -3.0e38f;
#pragma unroll
            for (int e = 0; e < 8; ++e) if (e != e0 && lg[e] > v1) { v1 = lg[e]; e1 = e; }
            const float ex = __expf(v1 - v0); const float w0 = 1.0f / (1.0f + ex), w1 = ex / (1.0f + ex);
            if (F.lane == 0) { toke[2 * m] = e0; toke[2 * m + 1] = e1; tokw[2 * m] = w0; tokw[2 * m + 1] = w1; }
#pragma unroll
            for (int e = 0; e < 8; ++e) c8[e] += (e0 == e ? 1u : 0u) + (e1 == e ? 1u : 0u);
        }
    }
    if (MOE) {
        if (F.lane == 0) {
#pragma unroll
            for (int e = 0; e < 8; ++e) if (c8[e]) atomicAdd((unsigned*)&lcnt[e], c8[e]); }
        __syncthreads();
        if (F.tid < 8) ((unsigned*)(F.ws + WS_META + META_BCNT))[F.vcu * 8 + F.tid] = lcnt[F.tid];
        __syncthreads();
    }
}
__device__ __forceinline__ void ln2_phase(Frame& F, int l) {
    const int gw = F.vcu * NWAVES + F.wave, NGW = F.G * NWAVES;
    Vec8 ln; vec8_load(ln, inp(F, I_LN2G) + l * DM, inp(F, I_LN2B) + l * DM, F.lane);
    const int m0 = (int)((long)RT * gw / NGW), m1 = (int)((long)RT * (gw + 1) / NGW);
    const bf16* R16 = (const bf16*)(F.ws + WS_KRL);
    Row nx; if (m0 < m1) row_load_bf16(nx, R16 + (size_t)m0 * DM, F.lane);
    bf16* hx = (bf16*)(F.ws + WS_HX); Vec8 md; int cb = -1;
    for (int m = m0; m < m1; ++m) { float* xp = xcur_ptr(F, m); Row r = nx; if (m + 1 < m1) row_load_bf16(nx, R16 + (size_t)(m + 1) * DM, F.lane);
        if (row_batch(m) != cb) { cb = row_batch(m); vec8_load(md, mod_vec(F, l + 1, m, 1), mod_vec(F, l + 1, m, 0), F.lane); }
        row_norm(r); row_affine_reg(r, ln, 0.0f); row_store(r, xp, F.lane);
        row_norm(r); row_affine_reg(r, md, 1.0f); row_store_bf16(r, hx + (size_t)m * DM, F.lane); }
}

__device__ __forceinline__ void moe_convert_phase(Frame& F) {
    LAS float* scr = (LAS float*)(F.lds + 4096 + F.wave * 17408);
    const int gw = F.wave * F.G + F.vcu  , NGW = F.G * NWAVES;
    unsigned char* w13 = F.ws + WS_MW13; unsigned char* w2 = F.ws + WS_MW2;
    constexpr int I1 = (1024 / 64) * (3584 / 64), I2 = (3584 / 64) * (1024 / 64);
    for (int it = gw; it < 8 * (2 * I1 + I2); it += NGW) {
        const int e = it / (2 * I1 + I2); int r = it - e * (2 * I1 + I2);
        if (r < I1) { conv_matrix_item_f8(inp(F, I_MW1) + (size_t)e * 1024 * 3584, 1024, 3584, w13 + (size_t)e * 7168 * 1024, 2, r, 32.f, scr, F.lane); continue; } r -= I1;
        if (r < I1) { conv_matrix_item_f8(inp(F, I_MW3) + (size_t)e * 1024 * 3584, 1024, 3584, w13 + (size_t)e * 7168 * 1024, 3, r, 32.f, scr, F.lane); continue; } r -= I1;
        conv_matrix_item_f8(inp(F, I_MW2) + (size_t)e * 3584 * 1024, 3584, 1024, w2 + (size_t)e * 1024 * 3584, 0, r, 128.f, scr, F.lane);
    }
}
__device__ __forceinline__ void moe_setup_phase(Frame& F) {
    const int gw = F.vcu * NWAVES + F.wave, NGW = F.G * NWAVES, lane = F.lane;
    const int* toke = (const int*)(F.ws + WS_META + META_TOKE); int* tpos = (int*)(F.ws + WS_META + META_POS); int* tile_e = (int*)(F.ws + WS_META + META_TILE);
    const unsigned* bcnt = (const unsigned*)(F.ws + WS_META + META_BCNT); unsigned char* srt = F.ws + WS_SORT;
    LAS int* sh = (LAS int*)F.lds;
    const int mb = (int)((long)NX * gw / NGW), me = (int)((long)NX * (gw + 1) / NGW);
    __syncthreads();
    {
        const int e = F.wave; int tot = 0, pre = 0;
        for (int bk = lane; bk < F.G; bk += 64) { const int v = (int)bcnt[bk * 8 + e]; tot += v; pre += bk < F.vcu ? v : 0; }
#pragma unroll
        for (int o = 32; o >= 1; o >>= 1) { tot += __shfl_xor(tot, o); pre += __shfl_xor(pre, o); }
        if (lane == 0) { sh[e] = tot; sh[8 + e] = pre; }
        int c8[8];
#pragma unroll
        for (int q = 0; q < 8; ++q) c8[q] = 0;
        for (int base = mb; base < me; base += 64) { const int m = base + lane; const bool act = m < me;
            const int e0 = act ? toke[2 * m] : -1, e1 = act ? toke[2 * m + 1] : -1;
#pragma unroll
            for (int q = 0; q < 8; ++q) c8[q] += __popcll(__ballot(e0 == q)) + __popcll(__ballot(e1 == q)); }
        if (lane == 0) {
#pragma unroll
            for (int q = 0; q < 8; ++q) sh[16 + 8 * F.wave + q] = c8[q]; }
    }
    __syncthreads();
    int off[8], wbase[8], ntiles; { int o = 0;
#pragma unroll
        for (int e = 0; e < 8; ++e) { off[e] = o; o += (sh[e] + 255) & ~255; int wb = off[e] + sh[8 + e];
            for (int w2 = 0; w2 < F.wave; ++w2) wb += sh[16 + 8 * w2 + e];
            wbase[e] = wb; }
        ntiles = o >> 8; }
    if (F.vcu == 0 && F.tid < 8) { const int e = F.tid; const int t0 = off[e] >> 8; const int t1 = (e == 7 ? ntiles : (off[e + 1] >> 8)); for (int t = t0; t < t1; ++t) tile_e[t] = e; if (e == 0) tile_e[511] = ntiles; }
    for (int base = mb; base < me; base += 64) {
        const int m = base + lane; const bool act = m < me;
        const int e0 = act ? toke[2 * m] : -1, e1 = act ? toke[2 * m + 1] : -1;
        int p0 = 0, p1 = 0;
        const unsigned long long lt = (1ull << lane) - 1ull;
#pragma unroll
        for (int e = 0; e < 8; ++e) {
            const unsigned long long m0 = __ballot(e0 == e), m1 = __ballot(e1 == e);
            if (e0 == e) p0 = wbase[e] + __popcll(m0 & lt);
            if (e1 == e) p1 = wbase[e] + __popcll(m0) + __popcll(m1 & lt);
            wbase[e] += __popcll(m0) + __popcll(m1);
        }
        if (act) { tpos[2 * m] = p0; tpos[2 * m + 1] = p1; }
        const int nrows = me - base < 64 ? me - base : 64; Vec8 md; int cb = -1;
        for (int i = 0; i < nrows; ++i) {
            const int mi = base + i; const int q0 = __builtin_amdgcn_readlane(p0, i), q1 = __builtin_amdgcn_readlane(p1, i);
            if (row_batch(mi) != cb) { cb = row_batch(mi); vec8_load(md, mod_vec(F, 1, mi, 4), mod_vec(F, 1, mi, 3), lane); }
            Row r; row_load(r, F.out + (size_t)mi * DM, lane); row_norm(r); row_affine_reg(r, md, 1.0f);
            unsigned* d0 = (unsigned*)(srt + (size_t)q0 * DM) + lane; unsigned* d1 = (unsigned*)(srt + (size_t)q1 * DM) + lane;
#pragma unroll
            for (int j = 0; j < 4; ++j) { const unsigned w8 = pk4_fp8(r.v[j][0], r.v[j][1], r.v[j][2], r.v[j][3]); d0[64 * j] = w8; d1[64 * j] = w8; }
        }
    }
}
__device__ __forceinline__ void moe_combine_phase(Frame& F) {
    const int gw = F.vcu * NWAVES + F.wave, NGW = F.G * NWAVES, lane = F.lane;
    const float* tokw = (const float*)(F.ws + WS_META + META_TOKW); const int* tpos = (const int*)(F.ws + WS_META + META_POS); const bf16* Y = (const bf16*)(F.ws + WS_MOEY);
    Vec8 ln; vec8_load(ln, inp(F, I_LN2G) + DM, inp(F, I_LN2B) + DM, lane);
    const int mb = (int)((long)NX * gw / NGW), me = (int)((long)NX * (gw + 1) / NGW); f32x4 g2[4]; int cb = -1;
    for (int m = mb; m < me; ++m) {
        if (row_batch(m) != cb) { cb = row_batch(m); const f32x4* gp = (const f32x4*)mod_vec(F, 1, m, 5) + lane;
#pragma unroll
            for (int j = 0; j < 4; ++j) g2[j] = gp[64 * j]; }
        const float w0 = tokw[2 * m], w1 = tokw[2 * m + 1]; const int p0 = tpos[2 * m], p1 = tpos[2 * m + 1];
        Row r; row_load(r, F.out + (size_t)m * DM, lane);
        const unsigned long long* y0 = (const unsigned long long*)(Y + (size_t)p0 * DM) + lane; const unsigned long long* y1 = (const unsigned long long*)(Y + (size_t)p1 * DM) + lane;
#pragma unroll
        for (int j = 0; j < 4; ++j) { const unsigned long long a = y0[64 * j], c = y1[64 * j];
            const f32x4 ya = (f32x4){bflo((unsigned)a), bfhi((unsigned)a), bflo((unsigned)(a >> 32)), bfhi((unsigned)(a >> 32))};
            const f32x4 yc = (f32x4){bflo((unsigned)c), bfhi((unsigned)c), bflo((unsigned)(c >> 32)), bfhi((unsigned)(c >> 32))};
            r.v[j] = r.v[j] * ALPHA_F + g2[j] * (ya * w0 + yc * w1); }
        row_norm(r); row_affine_reg(r, ln, 0.0f); row_store(r, F.out + (size_t)m * DM, lane);
    }
}

constexpr int HY_U_OFF = 0, HY_U_STRIDE = 4128, HY_K_OFF = 16 * HY_U_STRIDE, HY_K_STRIDE = 8208;
constexpr int HYC_U_STRIDE = 544, HYC_K_STRIDE = 1040;
static_assert(HY_K_OFF + 8 * HY_K_STRIDE + 64 <= MISC_OFF, "hyena LDS map");
__device__ __forceinline__ float hy_short4(const bf16* p, int tb, int L, float w0, float w1, float w2, float bs, f32x4& x) {
    const v2u pw = *(const v2u*)(p + tb); const float c0 = bflo(pw.x), c1 = bfhi(pw.x), c2 = bflo(pw.y), c3 = bfhi(pw.y);
    const float pm = tb > 0 ? bf2f(p[tb - 1]) : 0.f, pp = tb + 4 < L ? bf2f(p[tb + 4]) : 0.f;
    x[0] = bs + w0 * pm + w1 * c0 + w2 * c1; x[1] = bs + w0 * c0 + w1 * c1 + w2 * c2; x[2] = bs + w0 * c1 + w1 * c2 + w2 * c3; x[3] = bs + w0 * c2 + w1 * c3 + w2 * pp; return 0.f;
}
__device__ __forceinline__ void hy_short4u(const bf16* pi, bool first, bool last, float w0, float w1, float w2, float bs, f32x4& x) {
    const v2u pw = *(const v2u*)pi; const float c0 = bflo(pw.x), c1 = bfhi(pw.x), c2 = bflo(pw.y), c3 = bfhi(pw.y);
    float pm = bf2f(pi[-1]), pp = bf2f(pi[4]); pm = first ? 0.f : pm; pp = last ? 0.f : pp;
    x[0] = bs + w0 * pm + w1 * c0 + w2 * c1; x[1] = bs + w0 * c0 + w1 * c1 + w2 * c2; x[2] = bs + w0 * c1 + w1 * c2 + w2 * c3; x[3] = bs + w0 * c2 + w1 * c3 + w2 * pp;
}
template <int L, int USTR>
__device__ __forceinline__ void hy_fill_u(Frame& F, const bf16* phyT, int col, int rowb0, float w0, float w1, float w2, float bs) {
    const bf16* pc = phyT + (size_t)col * RT + rowb0;
    constexpr int NIT = 16 * L / 8 / 512 > 0 ? 16 * L / 8 / 512 : 1;
#pragma unroll 4
    for (int it = 0; it < NIT; ++it) { const int ch = F.tid + 512 * it; const int b = ch / (L / 8), tb = (ch - b * (L / 8)) * 8; const bf16* p = pc + (size_t)b * L + tb;
        const v4u cw = *(const v4u*)p; float pm = bf2f(p[-1]), pp = bf2f(p[8]); pm = tb == 0 ? 0.f : pm; pp = tb + 8 >= L ? 0.f : pp;
        const float c0 = bflo(cw.x), c1 = bfhi(cw.x), c2 = bflo(cw.y), c3 = bfhi(cw.y), c4 = bflo(cw.z), c5 = bfhi(cw.z), c6 = bflo(cw.w), c7 = bfhi(cw.w);
        v4u o; o.x = pk2(bs + w0 * pm + w1 * c0 + w2 * c1, bs + w0 * c0 + w1 * c1 + w2 * c2); o.y = pk2(bs + w0 * c1 + w1 * c2 + w2 * c3, bs + w0 * c2 + w1 * c3 + w2 * c4);
        o.z = pk2(bs + w0 * c3 + w1 * c4 + w2 * c5, bs + w0 * c4 + w1 * c5 + w2 * c6); o.w = pk2(bs + w0 * c5 + w1 * c6 + w2 * c7, bs + w0 * c6 + w1 * c7 + w2 * pp);
        *(LAS v4u*)(F.lds + HY_U_OFF + b * USTR + tb * 2) = o; }
}
template <int KLEN, int KSTR>
__device__ __forceinline__ void hy_fill_k(Frame& F, const bf16* kr) {
    const bf16* src = kr + (size_t)F.wave * KLEN + F.lane * 8;
#pragma unroll
    for (int i = 0; i < KLEN * 2 / 1024; ++i)
        __builtin_amdgcn_global_load_lds((const unsigned*)(src + i * 512), (LAS unsigned*)(F.lds + HY_K_OFF + F.wave * KSTR + i * 1024), 16, 0, 0);
    VM_WAIT();
}
__device__ __forceinline__ void hyena_unit(Frame& F, int l, int c, bool with_ctx) {
    const bf16* phyT = (const bf16*)(F.ws + WS_PHYT);
    const bf16* KRL = (const bf16*)(F.ws + WS_KRL); const bf16* KRC = (const bf16*)(F.ws + WS_KRC);
    const float* sw = inp(F, I_HSW) + l * 3 * 1536; const float* sb = inp(F, I_HSB) + l * 1536;
    const int lane = F.lane, w = F.wave, r = lane & 15, q = lane >> 4, m = (-r) & 7;
    __syncthreads();
    { const int col = 1024 + c; hy_fill_u<LSEQ, HY_U_STRIDE>(F, phyT, col, 0, sw[col], sw[1536 + col], sw[3072 + col], sb[col]); }
    hy_fill_k<4096, HY_K_STRIDE>(F, KRL + (size_t)((0 * 512 + c) * 8) * 4096);
    __syncthreads();
#pragma unroll 1
    for (int o = 0; o < 2; ++o) {
        f32x4 acc[16];
#pragma unroll 1
        for (int rep_ = 0; rep_ < NREP(15); ++rep_) {
#pragma unroll
        for (int i = 0; i < 16; ++i) acc[i] = (f32x4){0.f, 0.f, 0.f, 0.f};
        const LAS unsigned char* pa = F.lds + HY_K_OFF + m * HY_K_STRIDE + 2 * (8 * q - r - m + 2048 - 256 * w);
        const LAS unsigned char* pb = F.lds + HY_U_OFF + r * HY_U_STRIDE + 16 * q;
        bf16x8 R[16];
#pragma unroll
        for (int i = 0; i < 16; ++i) R[i] = *(const LAS bf16x8*)(pa - 32 * i);
        bf16x8 bcur = *(const LAS bf16x8*)pb;
#pragma unroll 1
        for (int kg = 0; kg < 8; ++kg) {
#pragma unroll
            for (int kk = 0; kk < 8; ++kk) {
                const bf16x8 bnext = *(const LAS bf16x8*)(pb + 64 * (kk + 1));
                const bf16x8 n0 = *(const LAS bf16x8*)(pa + 64 * (kk + 1)), n1 = *(const LAS bf16x8*)(pa + 64 * (kk + 1) - 32);
#pragma unroll
                for (int i = 0; i < 16; ++i) acc[i] = __builtin_amdgcn_mfma_f32_16x16x32_bf16(R[(i - 2 * kk) & 15], bcur, acc[i], 0, 0, 0);
                R[(-2 * (kk + 1)) & 15] = n0; R[(1 - 2 * (kk + 1)) & 15] = n1; bcur = bnext;
                __builtin_amdgcn_sched_barrier(0);
            }
            pa += 512; pb += 512;
        }
        }
        const int col = o * 512 + c; const float w0 = sw[col], w1 = sw[1536 + col], w2 = sw[3072 + col], bs = sb[col];
        int tb0 = 256 * w + 4 * q; asm volatile("" : "+v"(tb0));
        const bf16* p = phyT + (size_t)col * RT + (size_t)r * LSEQ + tb0;
#pragma unroll
        for (int i = 0; i < 16; ++i) { f32x4 x; hy_short4u(p + 16 * i, tb0 + 16 * i == 0, tb0 + 16 * i + 4 >= LSEQ, w0, w1, w2, bs, x); acc[i] = acc[i] * x; }
        if (o == 0) {
            __syncthreads();
#pragma unroll
            for (int i = 0; i < 16; ++i) { v2u zw; zw.x = pk2(acc[i][0], acc[i][1]); zw.y = pk2(acc[i][2], acc[i][3]); *(LAS v2u*)(F.lds + HY_U_OFF + r * HY_U_STRIDE + (tb0 + 16 * i) * 2) = zw; }
            hy_fill_k<4096, HY_K_STRIDE>(F, KRL + (size_t)((1 * 512 + c) * 8) * 4096);
            __syncthreads();
        } else {
            GAS bf16* zt = (GAS bf16*)(F.ws + WS_PHYT) + (size_t)(1024 + c) * RT + (size_t)r * LSEQ + tb0; asm volatile("" : "+v"(zt));
#pragma unroll
            for (int i = 0; i < 16; ++i) { v2u zw; zw.x = pk2(acc[i][0], acc[i][1]); zw.y = pk2(acc[i][2], acc[i][3]); *(GAS v2u*)(zt + 16 * i) = zw; }
        }
    }
    if (!with_ctx) return;
    __syncthreads();
    { const int col = 1024 + c; hy_fill_u<LCTX, HYC_U_STRIDE>(F, phyT, col, NX, sw[col], sw[1536 + col], sw[3072 + col], sb[col]); }
    hy_fill_k<512, HYC_K_STRIDE>(F, KRC + (size_t)((0 * 512 + c) * 8) * 512);
    __syncthreads();
#pragma unroll 1
    for (int o = 0; o < 2; ++o) {
        f32x4 acc[2];
        acc[0] = (f32x4){0.f, 0.f, 0.f, 0.f}; acc[1] = acc[0];
        const LAS unsigned char* pa = F.lds + HY_K_OFF + m * HYC_K_STRIDE + 2 * (8 * q - r - m + 256 - 32 * w);
        const LAS unsigned char* pb = F.lds + HY_U_OFF + r * HYC_U_STRIDE + 16 * q;
#pragma unroll
        for (int k = 0; k < 8; ++k) { const bf16x8 bfr = *(const LAS bf16x8*)(pb + 64 * k);
#pragma unroll
            for (int i = 0; i < 2; ++i) acc[i] = __builtin_amdgcn_mfma_f32_16x16x32_bf16(*(const LAS bf16x8*)(pa + 64 * k - 32 * i), bfr, acc[i], 0, 0, 0); }
        const int col = o * 512 + c; const float w0 = sw[col], w1 = sw[1536 + col], w2 = sw[3072 + col], bs = sb[col];
        int tb0 = 32 * w + 4 * q; asm volatile("" : "+v"(tb0));
        const bf16* p = phyT + (size_t)col * RT + NX + (size_t)r * LCTX + tb0;
#pragma unroll
        for (int i = 0; i < 2; ++i) { f32x4 x; hy_short4u(p + 16 * i, tb0 + 16 * i == 0, tb0 + 16 * i + 4 >= LCTX, w0, w1, w2, bs, x); acc[i] = acc[i] * x; }
        if (o == 0) {
            __syncthreads();
#pragma unroll
            for (int i = 0; i < 2; ++i) { v2u zw; zw.x = pk2(acc[i][0], acc[i][1]); zw.y = pk2(acc[i][2], acc[i][3]); *(LAS v2u*)(F.lds + HY_U_OFF + r * HYC_U_STRIDE + (tb0 + 16 * i) * 2) = zw; }
            hy_fill_k<512, HYC_K_STRIDE>(F, KRC + (size_t)((1 * 512 + c) * 8) * 512);
            __syncthreads();
        } else {
            GAS bf16* zt = (GAS bf16*)(F.ws + WS_PHYT) + (size_t)(1024 + c) * RT + NX + (size_t)r * LCTX + tb0;
#pragma unroll
            for (int i = 0; i < 2; ++i) { v2u zw; zw.x = pk2(acc[i][0], acc[i][1]); zw.y = pk2(acc[i][2], acc[i][3]); *(GAS v2u*)(zt + 16 * i) = zw; }
        }
    }
}

__device__ __forceinline__ void zt_transpose_phase(Frame& F, int ntok) {
    const bf16* zT = (const bf16*)(F.ws + WS_PHYT) + (size_t)1024 * RT; bf16* z2 = (bf16*)(F.ws + WS_Z2);
    LAS unsigned char* scr = F.lds + F.wave * 8448;
    const int gw = F.wave * F.G + F.vcu  , NGW = F.G * NWAVES, lane = F.lane, nblk = ntok / 64;
    const int lr = lane >> 3, pc = lane & 7;
    __syncthreads();
    for (int it = gw; it < 8 * nblk; it += NGW) {
        const int cb = it / nblk, tbk = it - cb * nblk;
        v4u in[8];
#pragma unroll
        for (int j = 0; j < 8; ++j) in[j] = *(const v4u*)(zT + (size_t)(cb * 64 + 8 * j + lr) * RT + tbk * 64 + pc * 8);
#pragma unroll
        for (int j = 0; j < 8; ++j) { LAS unsigned* d = (LAS unsigned*)(scr + (8 * j + lr) * 132 + pc * 16); d[0] = in[j].x; d[1] = in[j].y; d[2] = in[j].z; d[3] = in[j].w; }
        LDS_WAIT();
#pragma unroll
        for (int j = 0; j < 8; ++j) {
            const LAS unsigned short* sp = (const LAS unsigned short*)(scr + (pc * 8) * 132 + (8 * j + lr) * 2);
            unsigned hv[8];
#pragma unroll
            for (int k = 0; k < 8; ++k) hv[k] = sp[k * 66];
            v4u o; o.x = hv[0] | (hv[1] << 16); o.y = hv[2] | (hv[3] << 16); o.z = hv[4] | (hv[5] << 16); o.w = hv[6] | (hv[7] << 16);
            *(v4u*)(z2 + (size_t)(tbk * 64 + 8 * j + lr) * 512 + cb * 64 + pc * 8) = o; }
        LDS_WAIT();
    }
    __syncthreads();
}

__device__ __forceinline__ void cf_unit(Frame& F, int l, int seqrow, int seqlen, int t0) {
    LAS bf16* U = (LAS bf16*)F.lds;
    LAS float* O = (LAS float*)(F.lds + 98304);
    const bf16* ucf = (const bf16*)(F.ws + WS_UCF); bf16* out = (bf16*)(F.ws + WS_UCF2);
    __syncthreads();
    { v4u wv[12];
#pragma unroll
        for (int j = 0; j < 12; ++j) { const int pc = F.tid + 512 * j; const int i = pc >> 6, ch = pc & 63; const int t = t0 - 15 + i;
            wv[j] = (v4u){0u, 0u, 0u, 0u}; if (pc < 94 * 64 && t >= 0 && t < seqlen) wv[j] = *(const v4u*)(ucf + (size_t)(seqrow + t) * 512 + ch * 8); }
#pragma unroll
        for (int j = 0; j < 12; ++j) { const int pc = F.tid + 512 * j; const int i = pc >> 6, ch = pc & 63; if (pc < 94 * 64) *(LAS v4u*)(U + i * 512 + ch * 8) = wv[j]; } }
    const int c = F.tid;
    float w[31];
#pragma unroll
    for (int k = 0; k < 31; ++k) w[k] = inp(F, I_CFW)[(size_t)l * 31 * 512 + k * 512 + c];
    const float bias = inp(F, I_CFB)[l * 512 + c];
    const f32x4 g0 = *((const f32x4*)(inp(F, I_CFG) + l * 512) + F.lane), g1 = *((const f32x4*)(inp(F, I_CFG) + l * 512) + 64 + F.lane);
    const f32x4 b0 = *((const f32x4*)(inp(F, I_CFLB) + l * 512) + F.lane), b1 = *((const f32x4*)(inp(F, I_CFLB) + l * 512) + 64 + F.lane);
    __syncthreads();
#pragma unroll 1
    for (int r = 0; r < 4; ++r) {
        float v[16];
#pragma unroll
        for (int t = 0; t < 16; ++t) v[t] = bias;
        const LAS bf16* Ur = U + (16 * r) * 512 + c;
#pragma unroll
        for (int ii = 0; ii < 46; ++ii) { const float x = bf2f(Ur[ii * 512]);
#pragma unroll
            for (int t = 0; t < 16; ++t) { if (ii - t >= 0 && ii - t <= 30) v[t] += w[ii - t] * x; } }
#pragma unroll
        for (int t = 0; t < 16; ++t) O[t * 512 + c] = v[t];
        __syncthreads();
#pragma unroll
        for (int q = 0; q < 2; ++q) {
            const int tt = 2 * F.wave + q;
            f32x4 x0 = *((const LAS f32x4*)(O + tt * 512) + F.lane), x1 = *((const LAS f32x4*)(O + tt * 512) + 64 + F.lane);
            const float mean = wave_sum((x0[0] + x0[1]) + (x0[2] + x0[3]) + (x1[0] + x1[1]) + (x1[2] + x1[3])) * (1.f / 512.f);
            x0 = x0 - mean; x1 = x1 - mean;
            const float var = wave_sum((x0[0] * x0[0] + x0[1] * x0[1]) + (x0[2] * x0[2] + x0[3] * x0[3]) + (x1[0] * x1[0] + x1[1] * x1[1]) + (x1[2] * x1[2] + x1[3] * x1[3])) * (1.f / 512.f);
            const float rstd = 1.f / sqrtf(var + LN_EPS);
            f32x4 y0 = x0 * rstd * g0 + b0, y1 = x1 * rstd * g1 + b1;
#pragma unroll
            for (int j = 0; j < 4; ++j) { y0[j] = siluf_(y0[j]); y1[j] = siluf_(y1[j]); }
            bf16* orow = out + (size_t)(seqrow + t0 + 16 * r + tt) * 512;
            v2u o0, o1; o0.x = pk2(y0[0], y0[1]); o0.y = pk2(y0[2], y0[3]); o1.x = pk2(y1[0], y1[1]); o1.y = pk2(y1[2], y1[3]);
            *((v2u*)orow + F.lane) = o0; *((v2u*)orow + 64 + F.lane) = o1;
        }
        __syncthreads();
    }
}

#define TSUB(slot) do { if (DBG_TMASK) { const unsigned long long now_ = wall_clock64(); if (((DBG_TMASK >> (slot)) & 1u) && ((DBG_TLAYER >> l) & 1u)) t_acc += now_ - t_prev; t_prev = now_; } } while (0)
__device__ __forceinline__ void s5_unit(Frame& F, int l, int b, int gp, unsigned long long& t_acc, unsigned long long& t_prev) {
    const int lane = F.lane, w = F.wave;
    bf16* ps5 = (bf16*)(F.ws + WS_PS5); bf16* ydir = (bf16*)(F.ws + WS_YDIR);
    __syncthreads();
#pragma unroll 1
    for (int rep_ = 0; rep_ < NREP(14); ++rep_)
    {
        const int gd = w & 3, role = w >> 2;
        const int g = 2 * gp + (gd >> 1), dir = gd & 1;
        const int r = lane & 15, q = lane >> 4;
        LAS unsigned char* wl = F.lds + gd * 33280;
        LAS unsigned char* uS0 = wl;
        LAS float* BuS0 = (LAS float*)(wl + 4096);
        LAS unsigned char* stS0 = wl + 4096 + 2 * 10240;
        constexpr int NCH = (LCTX + LSEQ) / 16;
        const float* P = (const float*)(F.ws + WS_S5P) + (size_t)((dir * 32 + g) * 64) * 36;
        float abr = 0.f, abi = 0.f; f32x2 s2 = (f32x2){0.f, 0.f}, Aa = s2, Bn = s2;
        bf16x8 Bf[8], Cf[4];
        const int ti = lane >> 2, cq = lane & 3;
        auto urow = [&](int k) -> size_t { const bool isc = k < LCTX / 16; const int kk = isc ? k : k - LCTX / 16; const int Ls = isc ? LCTX : LSEQ; const int rowb = isc ? NX + b * LCTX : b * LSEQ;
            const int st = kk * 16 + ti; const int t = dir ? (Ls - 1 - st) : st; return (size_t)(rowb + t) * 512 + g * 16 + 4 * cq; };
        v2u ublk[8];
#pragma unroll
        for (int j = 0; j < 8; ++j) ublk[j] = (v2u){0u, 0u};
        static_assert(((LCTX + LSEQ) / 16) % 8 == 0, "s5 input blocks");
        if (role == 0) { abr = P[lane * 36]; abi = P[lane * 36 + 1]; Aa = (f32x2){abr, abr}; Bn = (f32x2){-abi, abi}; }
        else {
#pragma unroll
            for (int blk = 0; blk < 8; ++blk) { const int pp = 16 * blk + r; const float* src = P + (size_t)(pp & 63) * 36 + (pp < 64 ? 2 : 18) + 8 * (q & 1);
                v4u t4; t4.x = pk2(src[0], src[1]); t4.y = pk2(src[2], src[3]); t4.z = pk2(src[4], src[5]); t4.w = pk2(src[6], src[7]);
                if (q >= 2) t4 = (v4u){0u, 0u, 0u, 0u};
                Bf[blk] = __builtin_bit_cast(bf16x8, t4); }
            const float* cre = inp(F, I_SCRE) + (size_t)(((l * 2 + dir) * 32 + g) * 16) * 64; const float* cim = inp(F, I_SCIM) + (size_t)(((l * 2 + dir) * 32 + g) * 16) * 64;
#pragma unroll
            for (int ks = 0; ks < 4; ++ks) { const int p0 = 16 * ks + 4 * q; const f32x4 a = *(const f32x4*)(cre + r * 64 + p0), c4 = *(const f32x4*)(cim + r * 64 + p0);
                v4u t4; t4.x = pk2(a[0], -c4[0]); t4.y = pk2(a[1], -c4[1]); t4.z = pk2(a[2], -c4[2]); t4.w = pk2(a[3], -c4[3]);
                Cf[ks] = __builtin_bit_cast(bf16x8, t4); }
#pragma unroll
            for (int j = 0; j < 8; ++j) ublk[j] = *(const v2u*)(ps5 + urow(j));
#pragma unroll
            for (int j = 0; j < 8; ++j) *(LAS v2u*)(uS0 + j * 512 + ti * 32 + 8 * cq) = ublk[j];
#pragma unroll
            for (int j = 0; j < 8; ++j) ublk[j] = *(const v2u*)(ps5 + urow(8 + j));
        }
        LDS_WAIT(); __builtin_amdgcn_s_barrier(); asm volatile("" ::: "memory");
#pragma unroll 1
        for (int k = 0; k < NCH + 2; ++k) {
            const int p0 = k & 1, p1 = p0 ^ 1;
            unsigned long long tb0_ = 0; if (DBG_TMASK & 0x300000u) tb0_ = wall_clock64();
            if (role == 1) {
                bf16x8 ua, sf[4];
                if (k < NCH) { const v4u t4 = *(const LAS v4u*)(uS0 + (k & 7) * 512 + r * 32 + 16 * (q & 1)); ua = __builtin_bit_cast(bf16x8, q < 2 ? t4 : (v4u){0u, 0u, 0u, 0u}); }
                if (k < NCH) {
#pragma unroll
                    for (int blk = 0; blk < 8; ++blk) { const f32x4 d = __builtin_amdgcn_mfma_f32_16x16x32_bf16(ua, Bf[blk], (f32x4){0.f, 0.f, 0.f, 0.f}, 0, 0, 0);
                        *(LAS f32x4*)(BuS0 + p0 * 2560 + (16 * blk + r) * 20 + 4 * q) = d; }
                }
                if (k >= 2) {
#pragma unroll
                    for (int ks = 0; ks < 4; ++ks) sf[ks] = *(const LAS bf16x8*)(stS0 + p0 * 4352 + r * 272 + 64 * ks + 16 * q); }
                if ((k & 7) == 7 && k + 1 < NCH) {
#pragma unroll
                    for (int j = 0; j < 8; ++j) *(LAS v2u*)(uS0 + j * 512 + ti * 32 + 8 * cq) = ublk[j];
                    if (k + 9 < NCH) {
#pragma unroll
                        for (int j = 0; j < 8; ++j) ublk[j] = *(const v2u*)(ps5 + urow(k + 9 + j)); } }
                if (k >= 2) {
                    f32x4 y0 = __builtin_amdgcn_mfma_f32_16x16x32_bf16(sf[0], Cf[0], (f32x4){0.f, 0.f, 0.f, 0.f}, 0, 0, 0), y1 = __builtin_amdgcn_mfma_f32_16x16x32_bf16(sf[1], Cf[1], (f32x4){0.f, 0.f, 0.f, 0.f}, 0, 0, 0);
                    y0 = __builtin_amdgcn_mfma_f32_16x16x32_bf16(sf[2], Cf[2], y0, 0, 0, 0); y1 = __builtin_amdgcn_mfma_f32_16x16x32_bf16(sf[3], Cf[3], y1, 0, 0, 0);
                    const f32x4 y = y0 + y1; const int kc = k - 2;
                    const bool isc = kc < LCTX / 16; const int kk = isc ? kc : kc - LCTX / 16; const int Ls = isc ? LCTX : LSEQ; const int rowb = isc ? NX + b * LCTX : b * LSEQ;
#pragma unroll
                    for (int i = 0; i < 4; ++i) { const int st = kk * 16 + 4 * q + i; const int t = dir ? (Ls - 1 - st) : st;
                        ydir[(size_t)dir * RT * 512 + (size_t)(rowb + t) * 512 + g * 16 + r] = (bf16)f2bf(y[i]); } }
            } else if (k >= 1 && k <= NCH) {
                __builtin_amdgcn_s_setprio(3);
                f32x4 bre[4], bim[4];
#pragma unroll
                for (int j = 0; j < 4; ++j) { bre[j] = *(const LAS f32x4*)(BuS0 + p1 * 2560 + lane * 20 + 4 * j); bim[j] = *(const LAS f32x4*)(BuS0 + p1 * 2560 + (64 + lane) * 20 + 4 * j); }
                float sr = s2[0], si = s2[1];
#pragma unroll
                for (int i = 0; i < 16; ++i) {
                    const float tr = __builtin_fmaf(-abi, si, bre[i >> 2][i & 3]), ti = __builtin_fmaf(abi, sr, bim[i >> 2][i & 3]);
                    sr = __builtin_fmaf(abr, sr, tr); si = __builtin_fmaf(abr, si, ti);
                    asm volatile("" : "+v"(sr), "+v"(si));
                    *(LAS unsigned*)(stS0 + p1 * 4352 + i * 272 + 4 * lane) = pk2(sr, si); }
                s2 = (f32x2){sr, si};
                __builtin_amdgcn_s_setprio(0);
            }
            if ((DBG_TMASK & 0x300000u) && ((DBG_TLAYER >> l) & 1u) && role == (int)((DBG_TMASK >> 21) & 1u)) { LDS_WAIT(); t_acc += wall_clock64() - tb0_; }
            LDS_WAIT(); __builtin_amdgcn_s_barrier(); asm volatile("" ::: "memory");
        }
    }
    VM_WAIT();
    __syncthreads();
    TSUB(19);
    const float* dsk = inp(F, I_SD) + l * 512 + gp * 32;
    static_assert((LCTX + LSEQ) * 4 % (512 * 3) == 0, "combine batches");
#pragma unroll 1
    for (int e0 = F.tid; e0 < (LCTX + LSEQ) * 4; e0 += 512 * 3) {
        const int pc = e0 & 3; size_t off[3]; v4u uw[3], fw[3], bw[3];
#pragma unroll
        for (int j = 0; j < 3; ++j) { const int rr = (e0 + 512 * j) >> 2; const int row = rr < LSEQ ? b * LSEQ + rr : NX + b * LCTX + (rr - LSEQ);
            off[j] = (size_t)row * 512 + gp * 32 + pc * 8;
            uw[j] = *(const v4u*)(ps5 + off[j]); fw[j] = *(const v4u*)(ydir + off[j]); bw[j] = *(const v4u*)(ydir + (size_t)RT * 512 + off[j]); }
        const f32x4 d0 = *(const f32x4*)(dsk + pc * 8), d1 = *(const f32x4*)(dsk + pc * 8 + 4);
#pragma unroll
        for (int j = 0; j < 3; ++j) {
            f32x4 u0, u1, f0, f1, b0, b1; unpack8(uw[j], u0, u1); unpack8(fw[j], f0, f1); unpack8(bw[j], b0, b1);
            f32x4 o0, o1;
#pragma unroll
            for (int i = 0; i < 4; ++i) { o0[i] = gelu_tanh(f0[i] + b0[i] + d0[i] * u0[i]); o1[i] = gelu_tanh(f1[i] + b1[i] + d1[i] * u1[i]); }
            *(v4u*)((bf16*)(F.ws + WS_SG) + off[j]) = pack8(o0, o1); }
    }
}

__device__ __forceinline__ Frame make_frame(const Args& args, LAS unsigned char* lds, int wave_s);
__device__ __forceinline__ void mixers_phase(const Args& args, LAS unsigned char* lds, int wave_s, int l, unsigned long long& t_acc, unsigned long long& t_prev) {
#ifndef MIXMASK
#define MIXMASK 7
#endif
    if (MIXMASK & 1) { Frame F = make_frame(args, lds, wave_s);
#pragma unroll 1
        for (int u = F.vcu; u < NB * 16; u += F.G) s5_unit(F, l, u >> 4, u & 15, t_acc, t_prev); }
    TSUB(16);
    if (MIXMASK & 2) { Frame F = make_frame(args, lds, wave_s);
#pragma unroll 1
        for (int u = F.vcu; u < 512; u += F.G) hyena_unit(F, l, u, l == 0);
        if (NREP(10) == 2) {
#pragma unroll 1
            for (int u = F.vcu; u < 512; u += F.G) hyena_unit(F, l, u, l == 0); } }
    TSUB(17);
    if (MIXMASK & 4) { Frame F = make_frame(args, lds, wave_s);
        const int ncf = l == 0 ? NB * 32 + NB * 4 : NB * 32;
#pragma unroll 1
        for (int u = F.vcu; u < ncf; u += F.G) { if (u < NB * 32) cf_unit(F, l, u * 64, 64, 0); else { const int q = u - NB * 32; cf_unit(F, l, NX + (q >> 2) * LCTX, LCTX, (q & 3) * 64); } } }
    TSUB(18);
    __syncthreads();
}

constexpr int PH_P0A = 0, PH_P0B = 1, PH_L0 = 2, PH_L1 = 12, N_PHASES = 27;
__device__ __forceinline__ Frame make_frame(const Args& args, LAS unsigned char* lds, int wave_s) {
    unsigned z0 = 0u; asm volatile("" : "+v"(z0));
    Frame F; int t = wave_s * 64 + (int)__builtin_amdgcn_mbcnt_hi(~0u, __builtin_amdgcn_mbcnt_lo(~0u, z0)); asm volatile("" : "+v"(t));
    unsigned char* ws = args.ws; float* out = args.out;
    F.lds = lds; F.tid = t; F.lane = t & 63; F.wave = wave_s;
    int G = gridDim.x, bx = blockIdx.x; asm volatile("" : "+s"(G), "+s"(bx));
    F.G = G; F.vcu = (G % 8 == 0) ? (bx % 8) * (G / 8) + bx / 8 : bx;
    const float* const* inp = args.in;
    F.in = inp; F.out = out; F.ws = ws; return F;
}
__global__ void __launch_bounds__(NWAVES * 64, 2) mega_fwd(Args args) {
    extern __shared__ __attribute__((aligned(16))) unsigned char lds_raw[];
    LAS unsigned char* const lds = (LAS unsigned char*)lds_raw;
    volatile LAS unsigned* MISC = (volatile LAS unsigned*)(lds + MISC_OFF);
    for (int u = threadIdx.x; u < (LDS_BYTES - MISC_OFF) / 4; u += NWAVES * 64) ((LAS unsigned*)(lds + MISC_OFF))[u] = 0u;
    int wave_s = __builtin_amdgcn_readfirstlane((int)threadIdx.x >> 6); asm volatile("" : "+s"(wave_s));
    __syncthreads();
    const int lo = MK_PER_PHASE_LAUNCH ? args.ph_lo : 0, hi = MK_PER_PHASE_LAUNCH ? args.ph_hi : N_PHASES;
    XcdBarrier bar; bar.bar = (unsigned*)(args.ws + WS_CTL) + CW_BAR; bar.x = 0; bar.st = nullptr;
    if (hi - lo > 1) bar = xcd_barrier_post((unsigned*)(args.ws + WS_CTL) + CW_BAR, MISC + 8);
#ifndef PHMASK
#define PHMASK 0xffffffffu
#endif
#define IN(k) (lo <= (k) && (k) < hi)
#define PM(b) ((PHMASK >> (b)) & 1u)
#define SEAM(k) do { if (IN(k) && IN((k) + 1)) xcd_barrier(bar, wave_s); } while (0)
    unsigned long long t_acc = 0, t_prev = DBG_TMASK ? wall_clock64() : 0ull;
#define TSLOT(slot, lyr) do { if (DBG_TMASK) { const unsigned long long now_ = wall_clock64(); if (((DBG_TMASK >> (slot)) & 1u) && ((DBG_TLAYER >> (lyr)) & 1u)) t_acc += now_ - t_prev; t_prev = now_; } } while (0)
#define FRAME() Frame F = make_frame(args, lds, wave_s); const char* ws = (const char*)F.ws; const int c = F.G == (int)gridDim.x ? (int)blockIdx.x : 0; (void)ws; (void)c

    if (PM(0) && IN(PH_P0A)) { FRAME(); REPEAT(NREP(12), p0a_prologue(F)); } SEAM(PH_P0A); TSLOT(0, 0);

#pragma unroll 1
    for (int l = 0; l < 2; ++l) {
        const int pb = l == 0 ? PH_L0 : PH_L1;
        const int nMl = l == 0 ? RT / 256 : NX / 256;
        if (l == 0) {
        if (PM(2) && IN(pb + 0)) { { FRAME(); REPEAT(NREP(8), lnmod_phase(F, l)); } { FRAME(); h2table_phase(F, l); } { FRAME(); s5params_phase(F, l); } } SEAM(pb + 0); TSLOT(2, l); }
        if (PM(3) && IN(pb + 1)) { { FRAME(); REPEAT(NREP(9), filter_expand_phase(F, l)); }
            { FRAME(); SchedInproj S; S.R1.init(6, nMl, F.G, c); S.R2.init(nMl, 6, F.G, c); S.W = ws + WS_WIN + (size_t)l * 6144 * 1024 * 2; S.H = ws + WS_HX; S.ts = 256 * 1024 * 2;
              S.xM = l == 0 ? 0 : NCX / 256; S.xN0 = 4; S.xNn = 2;
              EpiInprojAll E{EpiHyT{(bf16*)(F.ws + WS_PHYT)}, EpiInproj{(bf16*)(F.ws + WS_PHYT), (bf16*)(F.ws + WS_UCF), (bf16*)(F.ws + WS_PS5), 6}};
              pg8::gemm_phase<EpiInprojAll, SchedInproj>(F.lds, F.tid, 2048, S, E); }
        } SEAM(pb + 1); TSLOT(3, l);
        if (PM(4) && IN(pb + 2)) { mixers_phase(args, lds, wave_s, l, t_acc, t_prev); } SEAM(pb + 2); TSLOT(4, l);
        if (PM(5) && IN(pb + 3)) {
            { FRAME(); zt_transpose_phase(F, l == 0 ? RT : NX); }
            { FRAME(); SchedPlain S; S.R.init(nMl, 12, F.G, c); S.A = ws + WS_HX; S.B = ws + WS_WIN + ((size_t)l * 6144 + 3072) * 1024 * 2; S.tsA = 256 * 1024 * 2; S.tsB = 256 * 1024 * 2; S.xM = 0; S.xN0 = 0; S.xNn = 1;
              EpiGates E{(bf16*)(F.ws + WS_G), F.tid}; REPEAT(NREP(1), pg8::gemm_phase<EpiGates, SchedPlain>(F.lds, F.tid, 2048, S, E, (DBG_TMASK & 0x1000000u) && l == 0 ? &t_acc : nullptr)); }
#ifndef DBG_SKIP_GLU
            { FRAME(); SchedPlain S; S.R.init(nMl, 2, F.G, (c + F.G / 4) % F.G); S.A = ws + WS_SG; S.B = ws + WS_WGLU + (size_t)l * 512 * 512 * 2; S.tsA = 256 * 512 * 2; S.tsB = 256 * 512 * 2; S.xM = 0; S.xN0 = 0; S.xNn = 1;
              EpiGlu E{(const bf16*)(F.ws + WS_SG), (bf16*)(F.ws + WS_S5Y), inp(F, I_SBGLU) + l * 512}; REPEAT(NREP(2), pg8::gemm_phase<EpiGlu, SchedPlain>(F.lds, F.tid, 1024, S, E)); }
#endif
        } SEAM(pb + 3); TSLOT(5, l);
        if (PM(6) && IN(pb + 4)) { FRAME();
            SchedMerge S; S.R.init(nMl, 4, F.G, c); S.A = ws + WS_Z2; S.sA = WS_UCF2 - WS_Z2; S.B = ws + WS_WOUTS + (size_t)(l * 3) * 1024 * 512 * 2; S.sB = (size_t)1024 * 512 * 2;
            S.tsA = 256 * 512 * 2; S.tsB = 256 * 512 * 2;
            EpiMerge E{(const bf16*)(F.ws + WS_G), (bf16*)(F.ws + WS_HX), F.tid};
            REPEAT(NREP(3), pg8::gemm_phase<EpiMerge, SchedMerge>(F.lds, F.tid, 1024, S, E));
        } SEAM(pb + 4); TSLOT(6, l);
        if (PM(7) && IN(pb + 5)) { FRAME();
            SchedPlain S; S.R.init(nMl, 4, F.G, c); S.A = ws + WS_HX; S.B = ws + WS_WO + (size_t)l * 1024 * 1024 * 2; S.tsA = 256 * 1024 * 2; S.tsB = 256 * 1024 * 2; S.xM = 0; S.xN0 = 0; S.xNn = 1;
            EpiRes E{l == 0 ? inp(F, I_X) : F.out, l == 0 ? inp(F, I_CTX) : (const float*)(F.ws + WS_XC), (bf16*)(F.ws + WS_KRL), (const float*)(F.ws + WS_MODS) + (size_t)l * 17 * INC + 2 * 1024, 1.0f};
            REPEAT(((l == 0) ? NREP(4) : 1), pg8::gemm_phase<EpiRes, SchedPlain>(F.lds, F.tid, 2048, S, E));
        } SEAM(pb + 5); TSLOT(7, l);
        if (PM(8) && IN(pb + 6)) { { FRAME(); if (l == 0) ln1_phase<false>(F, l); else ln1_phase<true>(F, l); } if (l == 1) { FRAME(); REPEAT(NREP(13), moe_convert_phase(F)); } } SEAM(pb + 6); TSLOT(8, l);
        if (l == 0) {
            if (PM(9) && IN(pb + 7)) { FRAME();
                SchedPlain S; S.R.init(RT / 256, 22, F.G, c); S.A = ws + WS_HX; S.B = ws + WS_W13; S.tsA = 256 * 1024; S.tsB = 256 * 1024; S.xM = 0; S.xN0 = 0; S.xNn = 1;
                EpiSwigluF8 E{F.ws + WS_G, DFF, 0.03125f}; REPEAT(NREP(5), pg8::gemm_phase<EpiSwigluF8, SchedPlain, true>(F.lds, F.tid, 1024, S, E, (DBG_TMASK & 0x1000000u) ? nullptr : &t_acc));
            } SEAM(pb + 7); TSLOT(9, 0);
            if (PM(10) && IN(pb + 8)) { FRAME();
                SchedPlain S; S.R.init(RT / 256, 4, F.G, c); S.A = ws + WS_G; S.B = ws + WS_W2; S.tsA = (size_t)256 * DFF; S.tsB = (size_t)256 * DFF; S.xM = 0; S.xN0 = 0; S.xNn = 1;
                EpiRes E{F.out, (const float*)(F.ws + WS_XC), (bf16*)(F.ws + WS_KRL), (const float*)(F.ws + WS_MODS) + 5 * 1024, 0.0078125f};
                pg8::gemm_phase<EpiRes, SchedPlain, true>(F.lds, F.tid, DFF, S, E);
            } SEAM(pb + 8); TSLOT(10, 0);
            if (PM(11) && IN(pb + 9)) { { FRAME(); ln2_phase(F, l); } { FRAME(); h2table_phase(F, 1); } { FRAME(); s5params_phase(F, 1); } } SEAM(pb + 9); TSLOT(11, 0);
        } else {
            if (PM(15) && IN(pb + 7)) { FRAME(); moe_setup_phase(F); } SEAM(pb + 7); TSLOT(12, 1);
#pragma unroll 1
            for (int st = 0; st < MOE_NST; ++st) {
                if (PM(13) && IN(pb + 8 + st) && st >= 1) { FRAME(); const int* tile_e = (const int*)(F.ws + WS_META + META_TILE); const int ch = st - 1;
                    const int ntiles = tile_e[511]; int nmc = ntiles - MOE_CH * ch; nmc = nmc < 0 ? 0 : (nmc > MOE_CH ? MOE_CH : nmc);
                    SchedMoe S; S.R.init(nmc, 4, F.G, c); S.A = ws + WS_HID + (size_t)(ch & 1) * HID_BUF; S.B = ws + WS_MW2; S.tsA = (size_t)256 * DEX; S.tsB = (size_t)256 * DEX; S.esB = (size_t)1024 * DEX; S.tile_e = tile_e; S.tile0 = MOE_CH * ch; S.a_global = false;
                    EpiMoeDown E{(bf16*)(F.ws + WS_MOEY), 0.0078125f}; REPEAT(NREP(7), pg8::gemm_phase<EpiMoeDown, SchedMoe, true>(F.lds, F.tid, DEX, S, E));
                }
                if (PM(12) && IN(pb + 8 + st) && st <= MOE_NST - 2) { FRAME(); const int* tile_e = (const int*)(F.ws + WS_META + META_TILE); const int ch = st;
                    const int ntiles = tile_e[511]; int nmc = ntiles - MOE_CH * ch; nmc = nmc < 0 ? 0 : (nmc > MOE_CH ? MOE_CH : nmc);
                    SchedMoe S; S.R.init(nmc, 28, F.G, c); S.A = ws + WS_SORT; S.B = ws + WS_MW13; S.tsA = 256 * 1024; S.tsB = 256 * 1024; S.esB = (size_t)7168 * 1024; S.tile_e = tile_e; S.tile0 = MOE_CH * ch; S.a_global = true;
                    EpiSwigluF8 E{F.ws + WS_HID + (size_t)(ch & 1) * HID_BUF, DEX, 0.03125f}; REPEAT(NREP(6), pg8::gemm_phase<EpiSwigluF8, SchedMoe, true>(F.lds, F.tid, 1024, S, E));
                }
                SEAM(pb + 8 + st); TSLOT(13, 1);
            }
            if (PM(14) && IN(pb + 14)) { FRAME(); moe_combine_phase(F); } TSLOT(14, 1);
        }
    }
    if (DBG_TMASK) { const unsigned long long t0_ = wall_clock64(); while (wall_clock64() - t0_ < t_acc) __builtin_amdgcn_s_sleep(16); }
#undef IN
#undef SEAM
#undef FRAME
}


#ifdef DBG_DUMP
__global__ void dbg_dump(const unsigned char* ws, float* out) {
    const size_t NE = (size_t)RT * 512; const bf16* a = (const bf16*)(ws + WS_PS5); const bf16* b = (const bf16*)(ws + WS_Z2); const bf16* c = (const bf16*)(ws + WS_UCF2);
    for (size_t i = (size_t)blockIdx.x * blockDim.x + threadIdx.x; i < (size_t)NX * DM; i += (size_t)gridDim.x * blockDim.x) {
        const size_t j = i % NE; const int k = (int)(i / NE);
        float v;
        if (DBG_DUMP == 8) v = i < (size_t)26 * 1024 * 1024 ? bf2f(((const bf16*)(ws + WS_WIN))[i]) : 0.f;
        else if (DBG_DUMP == 7) v = k == 0 ? bf2f(a[j]) : bf2f(((const bf16*)(ws + WS_UCF))[j]);
        else if (DBG_DUMP == 4) v = bf2f(((const bf16*)(ws + WS_HX))[i]);
        else if (DBG_DUMP == 5) v = bf2f(((const bf16*)(ws + WS_G))[i]);
        else if (DBG_DUMP == 6) v = bf2f(((const bf16*)(ws + WS_S5Y))[i % NE]);
        else if (DBG_DUMP == 1) v = k == 0 ? bf2f(a[j]) : bf2f(b[j]);
        else if (DBG_DUMP == 2) v = k == 0 ? bf2f(b[j]) : bf2f(c[j]);
        else v = k == 0 ? bf2f(c[j]) : bf2f(a[j]);
        out[i] = v;
    }
}
#endif
extern "C" void kernel_launch(void* const* d_in, const int* in_sizes, int n_in, void* d_out, int out_size, void* d_ws, size_t ws_size, hipStream_t stream) {
    static int grid = 0;
    if (grid == 0) {
        if (n_in != N_IN || out_size != NX * DM || ws_size < WS_END2) { fprintf(stderr, "kernel_launch: unexpected shapes (n_in %d, out %d, ws %zu)\n", n_in, out_size, ws_size); grid = -1; return; }
        int dev = 0, cus = 0, per_cu = 0;
        if (hipGetDevice(&dev) != hipSuccess || hipDeviceGetAttribute(&cus, hipDeviceAttributeMultiprocessorCount, dev) != hipSuccess) { grid = -1; return; }
        if (hipFuncSetAttribute((const void*)mega_fwd, hipFuncAttributeMaxDynamicSharedMemorySize, LDS_BYTES) != hipSuccess) { fprintf(stderr, "kernel_launch: hipFuncSetAttribute failed\n"); grid = -1; return; }
        if (hipOccupancyMaxActiveBlocksPerMultiprocessor(&per_cu, (const void*)mega_fwd, NWAVES * 64, LDS_BYTES) != hipSuccess || per_cu < 1) fprintf(stderr, "kernel_launch: occupancy query reports %d\n", per_cu);
        (void)hipGetLastError();
        grid = cus;
    }
    if (grid < 0) return;
    (void)hipMemsetAsync((char*)d_ws + WS_CTL, 0, CTL_ZERO_BYTES, stream);
    Args a{};
    for (int i = 0; i < N_IN; ++i) a.in[i] = (const float*)d_in[i];
    a.out = (float*)d_out; a.ws = (unsigned char*)d_ws;
#if MK_PER_PHASE_LAUNCH
    for (int p = 0; p < DBG_NPH; ++p) { a.ph_lo = p; a.ph_hi = p + 1; hipLaunchKernelGGL(mega_fwd, dim3(grid), dim3(NWAVES * 64), LDS_BYTES, stream, a); }
#ifdef DBG_DUMP
    hipLaunchKernelGGL(dbg_dump, dim3(2048), dim3(256), 0, stream, (const unsigned char*)d_ws, (float*)d_out);
#endif
#else
    a.ph_lo = 0; a.ph_hi = N_PHASES; hipLaunchKernelGGL(mega_fwd, dim3(grid), dim3(NWAVES * 64), LDS_BYTES, stream, a);
#endif
}
```
